# Optimizing an MI355X kernel written in HIP

```python
import math
import jax, jax.numpy as jnp
from jax import lax
import numpy as np

D_MODEL = 1024
BATCH = 16
SEQ = 2048
DEPTH = 1

HEAD_DIM = 64
MOBA_HEADS = 8
MOBA_WIDTH = MOBA_HEADS * HEAD_DIM
MOBA_BLOCK = 256
MOBA_TOPK = 3
MOBA_QCHUNK = 32
MLA_HEADS = 8
MLA_Q_RANK = 256
MLA_KV_RANK = 128
MLA_NOPE_DIM = 64
MLA_ROPE_DIM = 32
MLA_V_DIM = 64
MLA_QK_DIM = MLA_NOPE_DIM + MLA_ROPE_DIM
MLA_WIDTH = MLA_HEADS * MLA_V_DIM
MIX_WIDTH = MOBA_WIDTH + MLA_WIDTH
IN_WIDTH = 3 * MOBA_WIDTH + MLA_Q_RANK + MLA_KV_RANK + MLA_ROPE_DIM
ATTN_QBLOCK = 128
D_FF = -(-8 * D_MODEL // (3 * 256)) * 256
ROPE_THETA = 10000.0
EPS = 1e-6

kernel_name = "hybrid_moba_mla_parallel_heads"


def rms_norm(x, g):
    xf = x.astype(jnp.float32)
    y = xf * lax.rsqrt(jnp.mean(xf * xf, axis=-1, keepdims=True) + EPS)
    return (y * g.astype(jnp.float32)).astype(x.dtype)


def rope_tables(seq, dim):
    inv = ROPE_THETA ** (-jnp.arange(0, dim, 2, dtype=jnp.float32) / dim)
    ang = jnp.arange(seq, dtype=jnp.float32)[:, None] * inv[None, :]
    return jnp.cos(ang), jnp.sin(ang)


def apply_rope(x, cos, sin):
    half = x.shape[-1] // 2
    xf = x.astype(jnp.float32)
    x1, x2 = xf[..., :half], xf[..., half:]
    c, s = cos[:, None, :], sin[:, None, :]
    return jnp.concatenate([x1 * c - x2 * s, x2 * c + x1 * s], axis=-1).astype(x.dtype)


def moba_attention(q, k, v):
    B, S, H, D = q.shape
    f32 = jnp.float32
    nb = -(-S // MOBA_BLOCK)
    sp = nb * MOBA_BLOCK
    pad = sp - S
    q, k, v = [jnp.pad(t, ((0, 0), (0, pad), (0, 0), (0, 0))).transpose(0, 2, 1, 3)
               for t in (q, k, v)]
    scale = D ** -0.5
    blk = jnp.arange(sp) // MOBA_BLOCK
    qb = q.reshape(B, H, nb, MOBA_BLOCK, D)
    kb = k.reshape(B, H, nb, MOBA_BLOCK, D)
    vb = v.reshape(B, H, nb, MOBA_BLOCK, D)

    s_self = jnp.einsum('bhnqd,bhnkd->bhnqk', qb, kb, preferred_element_type=f32) * scale
    tri = jnp.tril(jnp.ones((MOBA_BLOCK, MOBA_BLOCK), dtype=bool))
    s_self = jnp.where(tri, s_self, -jnp.inf)
    m_self = jnp.max(s_self, axis=-1, keepdims=True)
    p_self = jnp.exp(s_self - m_self)
    l_self = jnp.sum(p_self, axis=-1, keepdims=True)
    o_self = jnp.einsum('bhnqk,bhnkd->bhnqd', p_self, vb.astype(f32)) / l_self
    lse_self = (m_self + jnp.log(l_self))[..., 0].reshape(B, H, sp)
    o_self = o_self.reshape(B, H, sp, D)

    n_sel = min(MOBA_TOPK, nb - 1)
    if n_sel == 0:
        o = o_self
    else:
        k_mean = jnp.mean(kb.astype(f32), axis=3)
        gate = jnp.einsum('bhsd,bhnd->bhsn', q.astype(f32), k_mean)
        past = jnp.arange(nb)[None, :] < blk[:, None]
        gate = jnp.where(past, gate, -jnp.inf)
        _, idx = lax.top_k(gate, n_sel)
        valid = jnp.arange(n_sel)[None, :] < blk[:, None]

        nc = sp // MOBA_QCHUNK

        def to_chunks(t):
            t = t.reshape(B, H, nc, MOBA_QCHUNK, *t.shape[3:])
            return jnp.moveaxis(t, 2, 0)

        bi = jnp.arange(B)[:, None, None, None]
        hi = jnp.arange(H)[None, :, None, None]

        def past_chunk(args):
            qc, ic, vc = args
            kg = kb[bi, hi, ic]
            vg = vb[bi, hi, ic]
            s = jnp.einsum('bhqd,bhqnjd->bhqnj', qc, kg, preferred_element_type=f32) * scale
            s = jnp.where(vc[None, None, :, :, None], s, -jnp.inf)
            m = jnp.max(s, axis=(-2, -1), keepdims=True)
            m = jnp.where(jnp.isfinite(m), m, 0.0)
            p = jnp.exp(s - m)
            l = jnp.sum(p, axis=(-2, -1))
            o = jnp.einsum('bhqnj,bhqnjd->bhqd', p, vg.astype(f32))
            o = o / jnp.where(l > 0, l, 1.0)[..., None]
            lse = m[..., 0, 0] + jnp.log(l)
            return o, lse

        o_past, lse_past = lax.map(
            past_chunk,
            (to_chunks(q), to_chunks(idx), valid.reshape(nc, MOBA_QCHUNK, n_sel)))
        o_past = jnp.moveaxis(o_past, 0, 2).reshape(B, H, sp, D)
        lse_past = jnp.moveaxis(lse_past, 0, 2).reshape(B, H, sp)
        m = jnp.maximum(lse_self, lse_past)
        w_s = jnp.exp(lse_self - m)
        w_p = jnp.exp(lse_past - m)
        o = (w_s[..., None] * o_self + w_p[..., None] * o_past) / (w_s + w_p)[..., None]
    return o[:, :, :S].transpose(0, 2, 1, 3).astype(v.dtype)


def causal_attention(q, k, v):
    B, S, H, Dk = q.shape
    Dv = v.shape[-1]
    scale = Dk ** -0.5
    nqb = S // ATTN_QBLOCK
    qb = q.reshape(B, nqb, ATTN_QBLOCK, H, Dk).transpose(1, 0, 3, 2, 4)
    kt = k.transpose(0, 2, 1, 3)
    vt = v.transpose(0, 2, 1, 3)
    kpos = jnp.arange(S)

    def block(args):
        qblk, start = args
        s = jnp.einsum('bhqd,bhkd->bhqk', qblk, kt, preferred_element_type=jnp.float32) * scale
        qpos = start + jnp.arange(ATTN_QBLOCK)
        s = jnp.where(kpos[None, :] <= qpos[:, None], s, -jnp.inf)
        p = jax.nn.softmax(s, axis=-1)
        return jnp.einsum('bhqk,bhkd->bhqd', p, vt.astype(jnp.float32))

    o = lax.map(block, (qb, jnp.arange(nqb) * ATTN_QBLOCK))
    return o.transpose(1, 0, 3, 2, 4).reshape(B, S, H, Dv).astype(v.dtype)


def mla_attention(c_q, c_kv, k_pe, q_a_g, w_q_up, kv_a_g, w_kv_up, q_norm_g, k_norm_g, cos, sin):
    B, S, _ = c_q.shape
    q = (rms_norm(c_q, q_a_g) @ w_q_up).reshape(B, S, MLA_HEADS, MLA_QK_DIM)
    kv = (rms_norm(c_kv, kv_a_g) @ w_kv_up).reshape(B, S, MLA_HEADS, MLA_NOPE_DIM + MLA_V_DIM)
    k_nope, v = kv[..., :MLA_NOPE_DIM], kv[..., MLA_NOPE_DIM:]
    k_rope = jnp.broadcast_to(k_pe[:, :, None, :], (B, S, MLA_HEADS, MLA_ROPE_DIM))
    k = jnp.concatenate([k_nope, k_rope], axis=-1)
    q = rms_norm(q, q_norm_g)
    k = rms_norm(k, k_norm_g)
    q = jnp.concatenate([q[..., :MLA_NOPE_DIM], apply_rope(q[..., MLA_NOPE_DIM:], cos, sin)], axis=-1)
    k = jnp.concatenate([k[..., :MLA_NOPE_DIM], apply_rope(k[..., MLA_NOPE_DIM:], cos, sin)], axis=-1)
    return causal_attention(q, k, v)


def setup_inputs(seed: int = 0) -> dict:
    key = jax.random.key(seed)
    ks = jax.random.split(key, 16)
    f32 = jnp.float32

    def w(k, shape, fan_in):
        return jax.random.normal(k, (DEPTH,) + shape, f32) * (fan_in ** -0.5)

    def g(k, n):
        return 1.0 + 0.02 * jax.random.normal(k, (DEPTH, n), f32)

    return {
        "x": jax.random.normal(ks[0], (BATCH, SEQ, D_MODEL), f32),
        "attn_norm_g": g(ks[1], D_MODEL),
        "w_in": w(ks[2], (D_MODEL, IN_WIDTH), D_MODEL),
        "moba_q_norm_g": g(ks[3], HEAD_DIM),
        "moba_k_norm_g": g(ks[4], HEAD_DIM),
        "mla_q_a_norm_g": g(ks[5], MLA_Q_RANK),
        "w_q_up": w(ks[6], (MLA_Q_RANK, MLA_HEADS * MLA_QK_DIM), MLA_Q_RANK),
        "mla_kv_a_norm_g": g(ks[7], MLA_KV_RANK),
        "w_kv_up": w(ks[8], (MLA_KV_RANK, MLA_HEADS * (MLA_NOPE_DIM + MLA_V_DIM)), MLA_KV_RANK),
        "mla_q_norm_g": g(ks[9], MLA_QK_DIM),
        "mla_k_norm_g": g(ks[10], MLA_QK_DIM),
        "w_o": w(ks[11], (MIX_WIDTH, D_MODEL), MIX_WIDTH),
        "ffn_norm_g": g(ks[12], D_MODEL),
        "w_gate": w(ks[13], (D_MODEL, D_FF), D_MODEL),
        "w_up": w(ks[14], (D_MODEL, D_FF), D_MODEL),
        "w_down": w(ks[15], (D_FF, D_MODEL), D_FF),
    }


def reference(x, attn_norm_g, w_in, moba_q_norm_g, moba_k_norm_g, mla_q_a_norm_g, w_q_up,
              mla_kv_a_norm_g, w_kv_up, mla_q_norm_g, mla_k_norm_g, w_o, ffn_norm_g,
              w_gate, w_up, w_down):
    B, S, _ = x.shape
    cos_a, sin_a = rope_tables(S, HEAD_DIM)
    cos_b, sin_b = rope_tables(S, MLA_ROPE_DIM)
    split_pts = [MOBA_WIDTH, 2 * MOBA_WIDTH, 3 * MOBA_WIDTH,
                 3 * MOBA_WIDTH + MLA_Q_RANK,
                 3 * MOBA_WIDTH + MLA_Q_RANK + MLA_KV_RANK]
    h = x
    for l in range(DEPTH):
        hn = rms_norm(h, attn_norm_g[l])
        proj = hn @ w_in[l]
        q_a, k_a, v_a, c_q, c_kv, k_pe = jnp.split(proj, split_pts, axis=-1)

        q_a = rms_norm(q_a.reshape(B, S, MOBA_HEADS, HEAD_DIM), moba_q_norm_g[l])
        k_a = rms_norm(k_a.reshape(B, S, MOBA_HEADS, HEAD_DIM), moba_k_norm_g[l])
        q_a = apply_rope(q_a, cos_a, sin_a)
        k_a = apply_rope(k_a, cos_a, sin_a)
        v_a = v_a.reshape(B, S, MOBA_HEADS, HEAD_DIM)
        o_a = moba_attention(q_a, k_a, v_a).reshape(B, S, MOBA_WIDTH)

        o_b = mla_attention(c_q, c_kv, k_pe, mla_q_a_norm_g[l], w_q_up[l], mla_kv_a_norm_g[l],
                            w_kv_up[l], mla_q_norm_g[l], mla_k_norm_g[l], cos_b, sin_b)
        o_b = o_b.reshape(B, S, MLA_WIDTH)

        h = h + jnp.concatenate([o_a, o_b], axis=-1) @ w_o[l]

        gn = rms_norm(h, ffn_norm_g[l])
        h = h + (jax.nn.silu(gn @ w_gate[l]) * (gn @ w_up[l])) @ w_down[l]
    return h.astype(x.dtype)
```

```cpp
#include <hip/hip_runtime.h>
#include <cstdio>
#include <cstdint>

typedef unsigned short bf16_t;
constexpr int BATCH = 16, SEQ = 2048, DM = 1024, M = BATCH * SEQ;
constexpr int NH = 8, HD = 64, MW = 512;
constexpr int QR = 256, KVR = 128, ROPE = 32, NOPE = 64, QKD = 96;
constexpr int INW = 1952, DFF = 2816;
constexpr float EPS = 1e-6f, LOG2E = 1.4426950408889634f;
constexpr float C2A = 0.125f * LOG2E;
constexpr float C2B = 0.10206207261596577f * LOG2E;

constexpr size_t MiB = 1u << 20;
constexpr size_t WS_CTL = 0, CTL_ZERO_BYTES = 1 * MiB;
constexpr size_t WS_TAB = 1 * MiB;
constexpr size_t WS_WIN = 2 * MiB;
constexpr size_t WS_WQUP = 6 * MiB;
constexpr size_t WS_WKVUP = 6 * MiB + 512 * 1024;
constexpr size_t WS_WO = 7 * MiB;
constexpr size_t WS_WGU = 9 * MiB;
constexpr size_t WS_WD = 20 * MiB;
constexpr size_t WS_RX = 26 * MiB;
constexpr size_t WS_KPESS = WS_RX + 128 * 1024;
constexpr size_t WS_CKVSS = WS_KPESS + 128 * 1024;
constexpr size_t WS_CQSS = WS_CKVSS + 256 * 1024;
constexpr size_t WS_KMEANP = WS_CQSS + 512 * 1024;
constexpr size_t WS_H1SS = WS_CTL + 512 * 1024;
constexpr size_t WS_KR = WS_KMEANP + 1024 * 1024;
constexpr size_t WS_XB = 34 * MiB;
constexpr size_t WS_H1B = WS_XB;
constexpr size_t WS_QA = 98 * MiB, WS_KA = 130 * MiB, WS_VA = 162 * MiB;
constexpr size_t WS_CQKV = 194 * MiB;
constexpr size_t WS_QM = 218 * MiB, WS_KM = 266 * MiB;
constexpr size_t WS_VM = 314 * MiB;
constexpr size_t WS_AO = 346 * MiB;
constexpr size_t WS_ACT = 98 * MiB;
constexpr size_t WS_END = 410 * MiB;
static_assert(WS_KR + (size_t)M * 32 * 4 <= WS_XB && WS_ACT + (size_t)M * DFF * 2 <= WS_AO && WS_WD + (size_t)DM * DFF * 2 <= WS_RX, "d_ws map");

__device__ __forceinline__ void sincos_d(double a, double& s, double& c) {
    const double kd = __builtin_rint(a * 0.63661977236758134308);
    double r = __builtin_fma(-kd, 1.57079632679489655800e+00, a); r = __builtin_fma(-kd, 6.12323399573676603587e-17, r);
    const int k = (int)kd & 3; const double r2 = r * r;
    const double sp = r * (1.0 + r2 * (-1.0 / 6 + r2 * (1.0 / 120 + r2 * (-1.0 / 5040 + r2 * (1.0 / 362880 + r2 * (-1.0 / 39916800 + r2 * (1.0 / 6227020800.0 + r2 * (-1.0 / 1307674368000.0))))))));
    const double cp = 1.0 + r2 * (-0.5 + r2 * (1.0 / 24 + r2 * (-1.0 / 720 + r2 * (1.0 / 40320 + r2 * (-1.0 / 3628800 + r2 * (1.0 / 479001600 + r2 * (-1.0 / 87178291200.0 + r2 * (1.0 / 20922789888000.0))))))));
    s = (k == 0) ? sp : (k == 1) ? cp : (k == 2) ? -sp : -cp;
    c = (k == 0) ? cp : (k == 1) ? -sp : (k == 2) ? -cp : sp;
}
__device__ __forceinline__ void rope_table_entry(int i, float* tab) {
    const int pos = i / 48, f = i % 48, steps = f < 32 ? f : 2 * (f - 32);
    double inv = 1.0; for (int j = 0; j < steps; ++j) inv *= 0.7498942093324558;
    const float ang = (float)pos * (float)inv;
    double s, c; sincos_d((double)ang, s, c);
    if (f < 32) { tab[pos * 32 + f] = (float)c; tab[2048 * 32 + pos * 32 + f] = (float)s; }
    else { tab[2 * 2048 * 32 + pos * 16 + (f - 32)] = (float)c; tab[2 * 2048 * 32 + 2048 * 16 + pos * 16 + (f - 32)] = (float)s; }
}
__global__ __launch_bounds__(256) void n_tables(float* tab) { const int i = blockIdx.x * 256 + threadIdx.x; if (i < 2048 * 48) rope_table_entry(i, tab); }
#define OPT_MASK 0x7e
#define ACT_STORE_MODE 2
#define OUT_STORE_NT 1
namespace nv {
__device__ __forceinline__ float bf2f(bf16_t v) { return __uint_as_float((unsigned)v << 16); }
__device__ __forceinline__ bf16_t f2bf(float f) { unsigned u = __float_as_uint(f); return (bf16_t)((u + 0x7fffu + ((u >> 16) & 1u)) >> 16); }

__global__ __launch_bounds__(256) void n_rowstat(const float* __restrict__ x, float* __restrict__ RX) {
    const int row = blockIdx.x * 4 + (threadIdx.x >> 6), lane = threadIdx.x & 63;
    const float* xr = x + (size_t)row * DM; float s = 0.f;
    for (int i = lane; i < DM; i += 64) { const float v = xr[i]; s += v * v; }
    for (int o = 1; o < 64; o <<= 1) s += __shfl_xor(s, o);
    if (lane == 0) RX[row] = 1.0f / sqrtf(s * (1.0f / DM) + EPS);
}

template <class OP> __global__ __launch_bounds__(256) void ngemm(OP op) {
    __shared__ float As[16][64], Bs[16][64], B2s[OP::DUAL ? 16 : 1][64], T[64][65], T2[OP::DUAL ? 64 : 1][65];
    const int tid = threadIdx.x, ty = tid >> 4, tx = tid & 15, row0 = blockIdx.y * 64, col0 = blockIdx.x * 64;
    float acc[4][4] = {}, acc2[4][4] = {};
    for (int k0 = 0; k0 < OP::K; k0 += 16) {
#pragma unroll
        for (int l = 0; l < 4; ++l) { const int idx = tid + 256 * l;
            { const int m = idx >> 4, k = idx & 15; As[k][m] = op.a(row0 + m, k0 + k); }
            { const int k = idx >> 6, n = idx & 63; const bool in = (col0 + n) < OP::N; Bs[k][n] = in ? op.b(k0 + k, col0 + n) : 0.f; if (OP::DUAL) B2s[k][n] = in ? op.b2(k0 + k, col0 + n) : 0.f; } }
        __syncthreads();
#pragma unroll
        for (int k = 0; k < 16; ++k) { float a[4], b[4], c[4];
#pragma unroll
            for (int i = 0; i < 4; ++i) { a[i] = As[k][ty * 4 + i]; b[i] = Bs[k][tx * 4 + i]; c[i] = OP::DUAL ? B2s[k][tx * 4 + i] : 0.f; }
#pragma unroll
            for (int i = 0; i < 4; ++i)
#pragma unroll
                for (int j = 0; j < 4; ++j) { acc[i][j] = fmaf(a[i], b[j], acc[i][j]); if (OP::DUAL) acc2[i][j] = fmaf(a[i], c[j], acc2[i][j]); } }
        __syncthreads();
    }
#pragma unroll
    for (int i = 0; i < 4; ++i)
#pragma unroll
        for (int j = 0; j < 4; ++j) { T[ty * 4 + i][tx * 4 + j] = acc[i][j]; if (OP::DUAL) T2[ty * 4 + i][tx * 4 + j] = acc2[i][j]; }
    __syncthreads();
    op.epi(T, T2, row0, col0, tid);
}

struct Bufs {
    const float* x; const float* in[16]; float* out;
    float *RX, *CQSS, *CKVSS, *KPESS, *KR, *KMEANP, *H1SS, *COSA, *SINA, *COSB, *SINB;
    bf16_t *QA, *KA, *VA, *CQKV, *QM, *KM, *VM, *AO, *H1B, *ACT;
};
enum { I_X = 0, I_GATT = 1, I_WIN = 2, I_GMQ = 3, I_GMK = 4, I_GQA = 5, I_WQUP = 6, I_GKVA = 7, I_WKVUP = 8, I_GLQ = 9, I_GLK = 10, I_WO = 11, I_GFFN = 12, I_WG = 13, I_WU = 14, I_WD = 15 };

struct OpInProj { static constexpr int K = DM, N = INW; static constexpr bool DUAL = false; Bufs B;
    __device__ float a(int m, int k) const { return B.x[(size_t)m * DM + k] * B.RX[m] * B.in[I_GATT][k]; }
    __device__ float b(int k, int n) const { return B.in[I_WIN][(size_t)k * INW + n]; }
    __device__ float b2(int, int) const { return 0.f; }
    __device__ void epi(float (*T)[65], float (*)[65], int row0, int col0, int tid) const {
        const int r = tid & 63, row = row0 + r, pos = row & (SEQ - 1);
        if (col0 < 1024) {
            const bool isq = col0 < 512; const float* g = B.in[isq ? I_GMQ : I_GMK];
            if (tid < 64) { float ss = 0.f; for (int d = 0; d < 64; ++d) ss += T[r][d] * T[r][d];
                const float rn = 1.0f / sqrtf(ss * (1.0f / 64) + EPS); float o[64];
#pragma unroll
                for (int d = 0; d < 32; ++d) { const float x1 = T[r][d] * rn * g[d], x2 = T[r][d + 32] * rn * g[d + 32], c = B.COSA[pos * 32 + d], s = B.SINA[pos * 32 + d]; o[d] = x1 * c - x2 * s; o[d + 32] = x2 * c + x1 * s; }
#pragma unroll
                for (int d = 0; d < 64; ++d) { T[r][d] = o[d]; if (isq) B.QA[(size_t)row * MW + col0 + d] = f2bf(o[d] * C2A); else B.KA[(size_t)row * MW + (col0 - 512) + d] = f2bf(o[d]); } }
            __syncthreads();
            if (!isq && tid < 64) { float cs = 0.f; for (int rr = 0; rr < 64; ++rr) cs += T[rr][tid];
                B.KMEANP[((size_t)(row0 >> 8) * 4 + ((row0 & 255) >> 6)) * MW + (col0 - 512) + tid] = cs; }
        } else if (col0 < 1536) { if (tid < 64) for (int d = 0; d < 64; ++d) B.VA[(size_t)row * MW + (col0 - 1024) + d] = f2bf(T[r][d]);
        } else if (col0 < 1792) { if (tid < 64) { float ss = 0.f; for (int d = 0; d < 64; ++d) { ss += T[r][d] * T[r][d]; B.CQKV[(size_t)row * 384 + (col0 - 1536) + d] = f2bf(T[r][d]); } B.CQSS[(size_t)row * 4 + ((col0 - 1536) >> 6)] = ss; }
        } else if (col0 < 1920) { if (tid < 64) { float ss = 0.f; for (int d = 0; d < 64; ++d) { ss += T[r][d] * T[r][d]; B.CQKV[(size_t)row * 384 + 256 + (col0 - 1792) + d] = f2bf(T[r][d]); } B.CKVSS[(size_t)row * 2 + ((col0 - 1792) >> 6)] = ss; }
        } else { if (tid < 64) { float ss = 0.f; for (int d = 0; d < 32; ++d) ss += T[r][d] * T[r][d]; B.KPESS[row] = ss; const float* g = B.in[I_GLK] + 64;
                for (int i = 0; i < 16; ++i) { const float x1 = T[r][i] * g[i], x2 = T[r][i + 16] * g[i + 16], c = B.COSB[pos * 16 + i], s = B.SINB[pos * 16 + i];
                    B.KR[(size_t)row * 32 + i] = x1 * c - x2 * s; B.KR[(size_t)row * 32 + i + 16] = x2 * c + x1 * s; } } }
    }
};
struct OpQUp { static constexpr int K = QR, N = 768; static constexpr bool DUAL = false; Bufs B;
    __device__ float a(int m, int k) const { return bf2f(B.CQKV[(size_t)m * 384 + k]) * B.in[I_GQA][k]; }
    __device__ float b(int k, int n) const { return B.in[I_WQUP][(size_t)k * 768 + n]; }
    __device__ float b2(int, int) const { return 0.f; }
    __device__ void epi(float (*T)[65], float (*)[65], int row0, int col0, int tid) const {
        if (tid < 64) { const int r = tid, row = row0 + r; const float* s4 = B.CQSS + (size_t)row * 4; const float rc = 1.0f / sqrtf((s4[0] + s4[1] + s4[2] + s4[3]) * (1.0f / QR) + EPS);
            for (int d = 0; d < 64; ++d) B.QM[(size_t)row * 768 + col0 + d] = f2bf(T[r][d] * rc); }
    }
};
struct OpKvUp { static constexpr int K = KVR, N = 1024; static constexpr bool DUAL = false; Bufs B;
    __device__ float a(int m, int k) const { return bf2f(B.CQKV[(size_t)m * 384 + 256 + k]) * B.in[I_GKVA][k]; }
    __device__ float b(int k, int n) const { return B.in[I_WKVUP][(size_t)k * 1024 + n]; }
    __device__ float b2(int, int) const { return 0.f; }
    __device__ void epi(float (*T)[65], float (*)[65], int row0, int col0, int tid) const {
        if (tid < 64) { const int r = tid, row = row0 + r, head = col0 >> 7; const float* s2 = B.CKVSS + (size_t)row * 2; const float rc = 1.0f / sqrtf((s2[0] + s2[1]) * (1.0f / KVR) + EPS);
            if ((col0 >> 6) & 1) { for (int d = 0; d < 64; ++d) B.VM[(size_t)row * MW + head * 64 + d] = f2bf(T[r][d] * rc); }
            else { float ss = B.KPESS[row]; for (int d = 0; d < 64; ++d) { const float v = T[r][d] * rc; ss += v * v; }
                const float rk = 1.0f / sqrtf(ss * (1.0f / QKD) + EPS); const float* g = B.in[I_GLK];
                for (int d = 0; d < 64; ++d) B.KM[(size_t)row * 768 + head * 96 + d] = f2bf(T[r][d] * rc * rk * g[d]);
                for (int d = 0; d < 32; ++d) B.KM[(size_t)row * 768 + head * 96 + 64 + d] = f2bf(B.KR[(size_t)row * 32 + d] * rk); } }
    }
};
struct OpOProj { static constexpr int K = DM, N = DM; static constexpr bool DUAL = false; Bufs B;
    __device__ float a(int m, int k) const { return bf2f(B.AO[(size_t)m * DM + k]); }
    __device__ float b(int k, int n) const { return B.in[I_WO][(size_t)k * DM + n]; }
    __device__ float b2(int, int) const { return 0.f; }
    __device__ void epi(float (*T)[65], float (*)[65], int row0, int col0, int tid) const {
        if (tid < 64) { const int r = tid, row = row0 + r; float ss = 0.f;
            for (int d = 0; d < 64; ++d) { const float h = B.x[(size_t)row * DM + col0 + d] + T[r][d]; ss += h * h; B.H1B[(size_t)row * DM + col0 + d] = f2bf(h); }
            atomicAdd(B.H1SS + row, ss); }
    }
};
struct OpFfn1 { static constexpr int K = DM, N = DFF; static constexpr bool DUAL = true; Bufs B;
    __device__ float a(int m, int k) const { return bf2f(B.H1B[(size_t)m * DM + k]) * B.in[I_GFFN][k]; }
    __device__ float b(int k, int n) const { return B.in[I_WG][(size_t)k * DFF + n]; }
    __device__ float b2(int k, int n) const { return B.in[I_WU][(size_t)k * DFF + n]; }
    __device__ void epi(float (*T)[65], float (*T2)[65], int row0, int col0, int tid) const {
        if (tid < 64) { const int r = tid, row = row0 + r; const float t = B.H1SS[row];
            const float rh = 1.0f / sqrtf(t * (1.0f / DM) + EPS);
            for (int d = 0; d < 64; ++d) { const float g = T[r][d] * rh, u = T2[r][d] * rh; B.ACT[(size_t)row * DFF + col0 + d] = f2bf(g / (1.0f + __expf(-g)) * u); } }
    }
};
struct OpFfn2 { static constexpr int K = DFF, N = DM; static constexpr bool DUAL = false; Bufs B;
    __device__ float a(int m, int k) const { return bf2f(B.ACT[(size_t)m * DFF + k]); }
    __device__ float b(int k, int n) const { return B.in[I_WD][(size_t)k * DM + n]; }
    __device__ float b2(int, int) const { return 0.f; }
    __device__ void epi(float (*T)[65], float (*)[65], int row0, int col0, int tid) const {
        if (tid < 64) { const int r = tid, row = row0 + r; for (int d = 0; d < 64; ++d) B.out[(size_t)row * DM + col0 + d] = bf2f(B.H1B[(size_t)row * DM + col0 + d]) + T[r][d]; }
    }
};

__global__ __launch_bounds__(256) void n_attn_moba(Bufs B) {
    const int gid = blockIdx.x * 256 + threadIdx.x, q = gid & (SEQ - 1), h = (gid >> 11) & 7, b = gid >> 14, row = b * SEQ + q, n = q >> 8;
    float qv[64];
#pragma unroll
    for (int d = 0; d < 64; ++d) qv[d] = bf2f(B.QA[(size_t)row * MW + h * 64 + d]);
    unsigned sel = (1u << n) - 1u;
    if (n > 3) { float gate[8];
#pragma unroll
        for (int j = 0; j < 8; ++j) { gate[j] = -INFINITY; if (j < n) { float g = 0.f; const float* kp = B.KMEANP + (size_t)(b * 8 + j) * 4 * MW + h * 64;
#pragma unroll
                for (int d = 0; d < 64; ++d) g += qv[d] * ((kp[d] + kp[MW + d]) + (kp[2 * MW + d] + kp[3 * MW + d])); gate[j] = g; } }
        sel = 0u;
#pragma unroll
        for (int j = 0; j < 8; ++j) { int rank = 0;
#pragma unroll
            for (int i = 0; i < 8; ++i) rank += (gate[i] > gate[j] || (gate[i] == gate[j] && i < j)) ? 1 : 0;
            if (j < n && rank < 3) sel |= 1u << j; } }
    float m = -INFINITY, l = 0.f, o[64];
#pragma unroll
    for (int d = 0; d < 64; ++d) o[d] = 0.f;
    for (int j = 0; j <= n; ++j) {
        const bool mine = (j == n) || ((sel >> j) & 1u);
        for (int kk = 0; kk < 256; ++kk) { const int key = j * 256 + kk; if (!mine || key > q) continue;
            const bf16_t* kr = B.KA + (size_t)(b * SEQ + key) * MW + h * 64; float s = 0.f;
#pragma unroll
            for (int d = 0; d < 64; ++d) s += qv[d] * bf2f(kr[d]);
            const float mn = fmaxf(m, s), al = exp2f(m - mn), p = exp2f(s - mn); m = mn; l = l * al + p;
            const bf16_t* vr = B.VA + (size_t)(b * SEQ + key) * MW + h * 64;
#pragma unroll
            for (int d = 0; d < 64; ++d) o[d] = o[d] * al + p * bf2f(vr[d]); } }
    const float il = 1.0f / l;
#pragma unroll
    for (int d = 0; d < 64; ++d) B.AO[(size_t)row * DM + h * 64 + d] = f2bf(o[d] * il);
}
__global__ __launch_bounds__(256) void n_attn_mla(Bufs B) {
    const int gid = blockIdx.x * 256 + threadIdx.x, q = gid & (SEQ - 1), h = (gid >> 11) & 7, b = gid >> 14, row = b * SEQ + q;
    float qv[96]; float ss = 0.f;
#pragma unroll
    for (int d = 0; d < 96; ++d) { qv[d] = bf2f(B.QM[(size_t)row * 768 + h * 96 + d]); ss += qv[d] * qv[d]; }
    const float rq = 1.0f / sqrtf(ss * (1.0f / QKD) + EPS); const float* g = B.in[I_GLQ];
#pragma unroll
    for (int d = 0; d < 96; ++d) qv[d] = qv[d] * rq * g[d];
#pragma unroll
    for (int i = 0; i < 16; ++i) { const float x1 = qv[64 + i], x2 = qv[80 + i], c = B.COSB[q * 16 + i], s = B.SINB[q * 16 + i]; qv[64 + i] = x1 * c - x2 * s; qv[80 + i] = x2 * c + x1 * s; }
#pragma unroll
    for (int d = 0; d < 96; ++d) qv[d] *= C2B;
    float m = -INFINITY, l = 0.f, o[64];
#pragma unroll
    for (int d = 0; d < 64; ++d) o[d] = 0.f;
    const int qmax = q | 63;
    for (int key = 0; key <= qmax; ++key) { if (key > q) continue;
        const bf16_t* kr = B.KM + (size_t)(b * SEQ + key) * 768 + h * 96; float s = 0.f;
#pragma unroll
        for (int d = 0; d < 96; ++d) s += qv[d] * bf2f(kr[d]);
        const float mn = fmaxf(m, s), al = exp2f(m - mn), p = exp2f(s - mn); m = mn; l = l * al + p;
        const bf16_t* vr = B.VM + (size_t)(b * SEQ + key) * MW + h * 64;
#pragma unroll
        for (int d = 0; d < 64; ++d) o[d] = o[d] * al + p * bf2f(vr[d]); }
    const float il = 1.0f / l;
#pragma unroll
    for (int d = 0; d < 64; ++d) B.AO[(size_t)row * DM + 512 + h * 64 + d] = f2bf(o[d] * il);
}
}
constexpr size_t WS_GAIN = WS_TAB + 768 * 1024;
struct Ctx { const float* x; float* out; unsigned char* ws;
#define CTX_F(NAME, OFF) __device__ __forceinline__ float* NAME() const { return (float*)(ws + (OFF)); }
#define CTX_H(NAME, OFF) __device__ __forceinline__ bf16_t* NAME() const { return (bf16_t*)(ws + (OFF)); }
    CTX_F(RX, WS_RX) CTX_F(CQSS, WS_CQSS) CTX_F(CKVSS, WS_CKVSS) CTX_F(KPESS, WS_KPESS) CTX_F(KR, WS_KR) CTX_F(KMEANP, WS_KMEANP) CTX_F(H1SS, WS_H1SS)
    CTX_F(COSA, WS_TAB) CTX_F(SINA, WS_TAB + 2048 * 32 * 4) CTX_F(COSB, WS_TAB + 2 * 2048 * 32 * 4) CTX_F(SINB, WS_TAB + 2 * 2048 * 32 * 4 + 2048 * 16 * 4)
    CTX_F(gmq, WS_GAIN) CTX_F(gmk, WS_GAIN + 256) CTX_F(glq, WS_GAIN + 512) CTX_F(glk, WS_GAIN + 896)
    CTX_H(QA, WS_QA) CTX_H(KA, WS_KA) CTX_H(VA, WS_VA) CTX_H(CQKV, WS_CQKV) CTX_H(QM, WS_QM) CTX_H(KM, WS_KM) CTX_H(VM, WS_VM) CTX_H(AO, WS_AO) CTX_H(H1B, WS_H1B) CTX_H(ACT, WS_ACT)
    CTX_H(XB, WS_XB) CTX_H(WIN, WS_WIN) CTX_H(WQUP, WS_WQUP) CTX_H(WKVUP, WS_WKVUP) CTX_H(WO, WS_WO) CTX_H(WGU, WS_WGU) CTX_H(WD, WS_WD)
#undef CTX_F
#undef CTX_H
};
#ifndef WGM_SET
#define WGM_SET 8
#endif
namespace pg8 {
#define PG8_LAS __attribute__((address_space(3)))
typedef short bf16x8 __attribute__((ext_vector_type(8)));
typedef float f32x4 __attribute__((ext_vector_type(4)));
typedef float f32x2 __attribute__((ext_vector_type(2)));
typedef unsigned u32x4 __attribute__((ext_vector_type(4)));
constexpr int BM = 256, BK = 64, HALF = 128, HTB = HALF * BK * 2  , STAGE_BYTES = 8 * HTB, NXCD = 8, WGM = WGM_SET;

__host__ __device__ __forceinline__ int lds_byte(int r, int c) { const int st = (r >> 4) * 2 + (c >> 5), rr = r & 15, cc = c & 31, ob = rr * 64 + cc * 2; return st * 1024 + (ob ^ (((ob >> 9) & 1) << 5)); }
__host__ __device__ __forceinline__ void stage_rc(int b, int& R, int& C) { const int st = b / 1024, sb = b % 1024, swz = sb ^ (((sb >> 9) & 1) << 5); R = (st >> 1) * 16 + swz / 64; C = (st & 1) * 32 + (swz % 64) / 2; }
__host__ __device__ __forceinline__ int perm32(int rho) { const int n = rho >> 4, i = rho & 15; return 8 * (i >> 2) + 4 * n + (i & 3); }

struct Unit { int pm, pn; };
struct Gemm { const bf16_t* A; const bf16_t* Bt; int M, N, K, lda; };

struct StaticOrder {
    int nM, nN, nwg, G, c, wgm;
    __host__ __device__ void init(int M_, int N_, int G_, int c_, int wgm_ = WGM) { nM = M_ / BM; nN = N_ / BM; nwg = nM * nN; G = G_; c = c_; wgm = wgm_; }
    __host__ __device__ bool next(int i, Unit& u) const {
        const long L = (long)i * G + c; if (L >= nwg) return false;
        int wgid = (int)L; { const int q = nwg / NXCD, r = nwg % NXCD, xcd = wgid % NXCD, off = wgid / NXCD; wgid = (xcd < r ? xcd * (q + 1) : r * (q + 1) + (xcd - r) * q) + off; }
        const int nig = wgm * nN, gid = wgid / nig, fm = gid * wgm, gsz = (nM - fm) < wgm ? (nM - fm) : wgm;
        u.pm = fm + ((wgid % nig) % gsz); u.pn = (wgid % nig) / gsz; return true;
    }
    __device__ __forceinline__ void a_ready(const Unit&) const {}
    __device__ __forceinline__ void done(const Unit&) const {}
};

typedef float f32x2_c __attribute__((ext_vector_type(2))); typedef __bf16 bf16x2_c __attribute__((ext_vector_type(2)));
__device__ __forceinline__ unsigned cvt_pk_bf16(float lo, float hi) { f32x2_c v = {lo, hi}; bf16x2_c b = __builtin_convertvector(v, bf16x2_c); return __builtin_bit_cast(unsigned, b); }
__device__ __forceinline__ u32x4 pack8(const f32x4 a, const f32x4 b) { u32x4 w; w.x = cvt_pk_bf16(a[0], a[1]); w.y = cvt_pk_bf16(a[2], a[3]); w.z = cvt_pk_bf16(b[0], b[1]); w.w = cvt_pk_bf16(b[2], b[3]); return w; }
__device__ __forceinline__ float hsum4(const f32x4 a) { return (a[0] + a[1]) + (a[2] + a[3]); }
__device__ __forceinline__ float dot4(const f32x4 a) { return (a[0] * a[0] + a[1] * a[1]) + (a[2] * a[2] + a[3] * a[3]); }
__device__ __forceinline__ float fq_sum(float s) { s += __shfl_xor(s, 16); s += __shfl_xor(s, 32); return s; }
__device__ __forceinline__ float rsq(float v) { return __builtin_amdgcn_rsqf(v); }
#define EPI_FENCE() asm volatile("" ::: "memory")
template <int MODE> __device__ __forceinline__ void st16(void* p, const u32x4 v) {
    if constexpr (MODE == 1) asm volatile("global_store_dwordx4 %0, %1, off sc1\n\ts_nop 1" :: "v"(p), "v"(v) : "memory");
    else if constexpr (MODE == 2) __builtin_nontemporal_store(v, (u32x4*)p);
    else *(u32x4*)p = v; }
#define OPAQUE(x) asm volatile("" : "+v"(x))


#ifndef P1_STORE_MODE
#define P1_STORE_MODE 0
#endif
struct EpiInProj { static constexpr bool PERM = true, AFTER_DRAIN = false; Ctx B;
    __device__ __forceinline__ void qk(const f32x4 (&acc)[2][2][4][2], const Unit& u, int wc, int fq, int rbase, bool isq) const {
        const int head = (u.pn & 1) * 4 + wc; const float* g = isq ? B.gmq() : B.gmk();
        f32x4 g0[2], g1[2], cd[2], sd[2];
#pragma unroll
        for (int n = 0; n < 2; ++n) { g0[n] = *(const f32x4*)(g + fq * 8 + n * 4); g1[n] = *(const f32x4*)(g + 32 + fq * 8 + n * 4);
            cd[n] = *(const f32x4*)(B.COSA() + 16 * 32 + fq * 8 + n * 4); sd[n] = *(const f32x4*)(B.SINA() + 16 * 32 + fq * 8 + n * 4); }
        bf16_t* dst = (isq ? B.QA() : B.KA()) + head * 64 + fq * 8; const float osc = isq ? C2A : 1.0f;
#pragma unroll
        for (int ai = 0; ai < 2; ++ai) { f32x4 c[2], sn[2]; float rx[4]; int rb = rbase + ai * HALF; OPAQUE(rb); const int pos0 = rb & (SEQ - 1);
#pragma unroll
            for (int m = 0; m < 4; ++m) rx[m] = B.RX()[rb + m * 16];
#pragma unroll
            for (int n = 0; n < 2; ++n) { c[n] = *(const f32x4*)(B.COSA() + pos0 * 32 + fq * 8 + n * 4); sn[n] = *(const f32x4*)(B.SINA() + pos0 * 32 + fq * 8 + n * 4); }
#pragma unroll
            for (int m = 0; m < 4; ++m) { const int row = rb + m * 16; float ss = 0.f;
#pragma unroll
                for (int bj = 0; bj < 2; ++bj)
#pragma unroll
                    for (int n = 0; n < 2; ++n) ss += dot4(acc[ai][bj][m][n]);
                const float rxv = rx[m]; ss = fq_sum(ss) * rxv * rxv; const float rn = rsq(ss * (1.0f / 64) + EPS) * rxv * osc; f32x4 o1[2], o2[2];
#pragma unroll
                for (int n = 0; n < 2; ++n) { const f32x4 x1 = acc[ai][0][m][n] * rn * g0[n], x2 = acc[ai][1][m][n] * rn * g1[n]; o1[n] = x1 * c[n] - x2 * sn[n]; o2[n] = x2 * c[n] + x1 * sn[n];
                    const f32x4 cn = c[n] * cd[n] - sn[n] * sd[n]; sn[n] = sn[n] * cd[n] + c[n] * sd[n]; c[n] = cn; }
                st16<P1_STORE_MODE>(dst + (size_t)row * MW, pack8(o1[0], o1[1])); st16<P1_STORE_MODE>(dst + (size_t)row * MW + 32, pack8(o2[0], o2[1])); } }
    }
    __device__ __forceinline__ void operator()(const f32x4 (&acc)[2][2][4][2], const Unit& u, int wr, int wc, int fr, int fq) const {
        const int pn = u.pn; int rbase = u.pm * BM + wr * 64 + fr; OPAQUE(rbase);
        if (pn < 4) { qk(acc, u, wc, fq, rbase, pn < 2); return; }
        float rx[2][4];
#pragma unroll
        for (int ai = 0; ai < 2; ++ai)
#pragma unroll
            for (int m = 0; m < 4; ++m) rx[ai][m] = B.RX()[rbase + ai * HALF + m * 16];
        if (pn < 6) {
            bf16_t* dst = B.VA() + ((pn - 4) * 4 + wc) * 64 + fq * 8;
#pragma unroll
            for (int ai = 0; ai < 2; ++ai)
#pragma unroll
                for (int m = 0; m < 4; ++m) { const int row = rbase + ai * HALF + m * 16; const float rxv = rx[ai][m];
#pragma unroll
                    for (int bj = 0; bj < 2; ++bj) st16<P1_STORE_MODE>(dst + (size_t)row * MW + bj * 32, pack8(acc[ai][bj][m][0] * rxv, acc[ai][bj][m][1] * rxv)); }
        } else if (pn == 6 || wc < 2) {
            const int cb = (pn == 6 ? 0 : 256) + wc * 64 + fq * 8; float* ssp = pn == 6 ? B.CQSS() + wc : B.CKVSS() + wc; const int sstr = pn == 6 ? 4 : 2;
#pragma unroll
            for (int ai = 0; ai < 2; ++ai)
#pragma unroll
                for (int m = 0; m < 4; ++m) { const int row = rbase + ai * HALF + m * 16; const float rxv = rx[ai][m]; float ss = 0.f;
#pragma unroll
                    for (int bj = 0; bj < 2; ++bj) { const f32x4 a = acc[ai][bj][m][0] * rxv, b = acc[ai][bj][m][1] * rxv; ss += dot4(a) + dot4(b); st16<P1_STORE_MODE>(B.CQKV() + (size_t)row * 384 + cb + bj * 32, pack8(a, b)); }
                    ss = fq_sum(ss); if (fq == 0) ssp[(size_t)row * sstr] = ss; }
        } else if (wc == 2) {
            const float* g = B.glk() + 64 + fq * 8; const f32x4 ga = *(const f32x4*)g, gb = *(const f32x4*)(g + 4); const float sg = fq < 2 ? -1.f : 1.f;
#pragma unroll
            for (int ai = 0; ai < 2; ++ai)
#pragma unroll
                for (int m = 0; m < 4; ++m) { int row = rbase + ai * HALF + m * 16; OPAQUE(row); const int pos = row & (SEQ - 1); const float rxv = rx[ai][m];
                    const f32x4 a = acc[ai][0][m][0] * rxv, b = acc[ai][0][m][1] * rxv; float ss = fq_sum(dot4(a) + dot4(b)); if (fq == 0) B.KPESS()[row] = ss;
                    const f32x4 xa = a * ga, xb = b * gb; f32x4 pa, pb;
#pragma unroll
                    for (int j = 0; j < 4; ++j) { pa[j] = __shfl_xor(xa[j], 32); pb[j] = __shfl_xor(xb[j], 32); }
                    const int ci = pos * 16 + (fq & 1) * 8; const f32x4 ca = *(const f32x4*)(B.COSB() + ci), cb = *(const f32x4*)(B.COSB() + ci + 4), sa = *(const f32x4*)(B.SINB() + ci), sb = *(const f32x4*)(B.SINB() + ci + 4);
                    *(f32x4*)(B.KR() + (size_t)row * 32 + fq * 8) = xa * ca + pa * sa * sg; *(f32x4*)(B.KR() + (size_t)row * 32 + fq * 8 + 4) = xb * cb + pb * sb * sg; }
        }
    }
};
struct EpiQUp { static constexpr bool PERM = true, AFTER_DRAIN = false; Ctx B;
    __device__ __forceinline__ void operator()(const f32x4 (&acc)[2][2][4][2], const Unit& u, int wr, int wc, int fr, int fq) const {
        int rbase = u.pm * BM + wr * 64 + fr; OPAQUE(rbase); const int head = 2 * u.pn + (wc >> 1), dbase = (wc & 1) ? 64 : 0; bf16_t* dst = B.QM() + head * 96 + dbase + fq * 8;
#pragma unroll
        for (int ai = 0; ai < 2; ++ai) { int rb = rbase + ai * HALF; OPAQUE(rb); f32x4 s4[4];
#pragma unroll
            for (int m = 0; m < 4; ++m) s4[m] = *(const f32x4*)(B.CQSS() + (size_t)(rb + m * 16) * 4);
#pragma unroll
            for (int m = 0; m < 4; ++m) { const int row = rb + m * 16; const float rc = rsq(hsum4(s4[m]) * (1.0f / QR) + EPS);
                *(u32x4*)(dst + (size_t)row * 768) = pack8(acc[ai][0][m][0] * rc, acc[ai][0][m][1] * rc);
                if (!(wc & 1)) *(u32x4*)(dst + (size_t)row * 768 + 32) = pack8(acc[ai][1][m][0] * rc, acc[ai][1][m][1] * rc); } }
    }
};
struct EpiKvUp { static constexpr bool PERM = true, AFTER_DRAIN = false; Ctx B;
    __device__ __forceinline__ void operator()(const f32x4 (&acc)[2][2][4][2], const Unit& u, int wr, int wc, int fr, int fq) const {
        int rbase = u.pm * BM + wr * 64 + fr; OPAQUE(rbase); const int head = 2 * u.pn + (wc >> 1);
        if (wc & 1) { bf16_t* dst = B.VM() + head * 64 + fq * 8; f32x2 s2[2][4];
#pragma unroll
            for (int ai = 0; ai < 2; ++ai)
#pragma unroll
                for (int m = 0; m < 4; ++m) s2[ai][m] = *(const f32x2*)(B.CKVSS() + (size_t)(rbase + ai * HALF + m * 16) * 2);
#pragma unroll
            for (int ai = 0; ai < 2; ++ai)
#pragma unroll
                for (int m = 0; m < 4; ++m) { const int row = rbase + ai * HALF + m * 16; const float rc = rsq((s2[ai][m][0] + s2[ai][m][1]) * (1.0f / KVR) + EPS);
#pragma unroll
                    for (int bj = 0; bj < 2; ++bj) *(u32x4*)(dst + (size_t)row * MW + bj * 32) = pack8(acc[ai][bj][m][0] * rc, acc[ai][bj][m][1] * rc); }
        } else { int fqo = fq; OPAQUE(fqo); const float* g = B.glk() + fqo * 8; f32x4 gg[2][2];
#pragma unroll
            for (int bj = 0; bj < 2; ++bj)
#pragma unroll
                for (int n = 0; n < 2; ++n) gg[bj][n] = *(const f32x4*)(g + bj * 32 + n * 4);
            bf16_t* dst = B.KM() + head * 96 + fq * 8;
#pragma unroll
            for (int ai = 0; ai < 2; ++ai) { int rb = rbase + ai * HALF; OPAQUE(rb); float kp[4]; f32x4 ka[4], kb[4]; f32x2 s2v[4];
#pragma unroll
                for (int m = 0; m < 4; ++m) { const int row = rb + m * 16; kp[m] = B.KPESS()[row]; s2v[m] = *(const f32x2*)(B.CKVSS() + (size_t)row * 2); ka[m] = *(const f32x4*)(B.KR() + (size_t)row * 32 + fq * 8); kb[m] = *(const f32x4*)(B.KR() + (size_t)row * 32 + fq * 8 + 4); }
#pragma unroll
                for (int m = 0; m < 4; ++m) { const int row = rb + m * 16; const float rc = rsq((s2v[m][0] + s2v[m][1]) * (1.0f / KVR) + EPS);
                    f32x4 v[2][2]; float ss = 0.f;
#pragma unroll
                    for (int bj = 0; bj < 2; ++bj)
#pragma unroll
                        for (int n = 0; n < 2; ++n) { v[bj][n] = acc[ai][bj][m][n] * rc; ss += dot4(v[bj][n]); }
                    ss = fq_sum(ss) + kp[m]; const float rk = rsq(ss * (1.0f / QKD) + EPS);
#pragma unroll
                    for (int bj = 0; bj < 2; ++bj) *(u32x4*)(dst + (size_t)row * 768 + bj * 32) = pack8(v[bj][0] * rk * gg[bj][0], v[bj][1] * rk * gg[bj][1]);
                    *(u32x4*)(dst + (size_t)row * 768 + 64) = pack8(ka[m] * rk, kb[m] * rk); } }
        }
    }
};
template <int WT = 0> struct EpiOProjT { static constexpr bool PERM = true, AFTER_DRAIN = false; Ctx B;
    __device__ __forceinline__ void operator()(const f32x4 (&acc)[2][2][4][2], const Unit& u, int wr, int wc, int fr, int fq) const {
        const int rbase = u.pm * BM + wr * 64 + fr, col = u.pn * BM + wc * 64 + fq * 8;
#pragma unroll
        for (int ai = 0; ai < 2; ++ai) { int rb = rbase + ai * HALF; OPAQUE(rb); u32x4 xw[4][2];
#pragma unroll
            for (int m = 0; m < 4; ++m)
#pragma unroll
                for (int bj = 0; bj < 2; ++bj) xw[m][bj] = *(const u32x4*)(B.H1B() + (size_t)(rb + m * 16) * DM + col + bj * 32);
#pragma unroll
            for (int m = 0; m < 4; ++m) { const int row = rb + m * 16; const size_t off = (size_t)row * DM + col; float ss = 0.f;
#pragma unroll
                for (int bj = 0; bj < 2; ++bj) { const u32x4 w = xw[m][bj];
                    const f32x4 x0 = {__uint_as_float(w.x << 16), __uint_as_float(w.x & 0xffff0000u), __uint_as_float(w.y << 16), __uint_as_float(w.y & 0xffff0000u)};
                    const f32x4 x1 = {__uint_as_float(w.z << 16), __uint_as_float(w.z & 0xffff0000u), __uint_as_float(w.w << 16), __uint_as_float(w.w & 0xffff0000u)};
                    const f32x4 a = x0 + acc[ai][bj][m][0], b = x1 + acc[ai][bj][m][1];
                    ss += dot4(a) + dot4(b); st16<WT>(B.H1B() + off + bj * 32, pack8(a, b)); }
                ss = fq_sum(ss); if (fq == 0) atomicAdd(B.H1SS() + row, ss); } }
    }
};
typedef EpiOProjT<0> EpiOProj;
template <int WT = 0> struct EpiFfn1T { static constexpr bool PERM = true, AFTER_DRAIN = false; Ctx B;
    __device__ __forceinline__ void operator()(const f32x4 (&acc)[2][2][4][2], const Unit& u, int wr, int wc, int fr, int fq) const {
        const int rbase = u.pm * BM + wr * 64 + fr, col = u.pn * HALF + wc * 32 + fq * 8; float ssv[2][4];
#pragma unroll
        for (int ai = 0; ai < 2; ++ai)
#pragma unroll
            for (int m = 0; m < 4; ++m) ssv[ai][m] = B.H1SS()[rbase + ai * HALF + m * 16];
#pragma unroll
        for (int ai = 0; ai < 2; ++ai)
#pragma unroll
            for (int m = 0; m < 4; ++m) { int row = rbase + ai * HALF + m * 16; OPAQUE(row);
                const float rh = rsq(ssv[ai][m] * (1.0f / DM) + EPS), nrl = -LOG2E * rh, rh2 = rh * rh; f32x4 o[2];
#pragma unroll
                for (int n = 0; n < 2; ++n) { const f32x4 ga = acc[ai][0][m][n], gu = ga * acc[ai][1][m][n];
#pragma unroll
                    for (int j = 0; j < 4; ++j) o[n][j] = gu[j] * (rh2 * __builtin_amdgcn_rcpf(1.0f + __builtin_amdgcn_exp2f(ga[j] * nrl))); }
                st16<WT>(B.ACT() + (size_t)row * DFF + col, pack8(o[0], o[1])); }
    }
};
#ifndef ACT_STORE_MODE
#define ACT_STORE_MODE 0
#endif
typedef EpiFfn1T<ACT_STORE_MODE> EpiFfn1;
#ifndef OUT_STORE_NT
#define OUT_STORE_NT 0
#endif
struct EpiFfn2 { static constexpr bool PERM = true, AFTER_DRAIN = false; Ctx B;
    __device__ __forceinline__ void operator()(const f32x4 (&acc)[2][2][4][2], const Unit& u, int wr, int wc, int fr, int fq) const {
        const int rbase = u.pm * BM + wr * 64 + fr, col = u.pn * BM + wc * 64 + fq * 8;
#pragma unroll
        for (int ai = 0; ai < 2; ++ai) { int rb = rbase + ai * HALF; OPAQUE(rb); u32x4 hw[4][2];
#pragma unroll
            for (int m = 0; m < 4; ++m)
#pragma unroll
                for (int bj = 0; bj < 2; ++bj) hw[m][bj] = __builtin_nontemporal_load((const u32x4*)(B.H1B() + (size_t)(rb + m * 16) * DM + col + bj * 32));
#pragma unroll
            for (int m = 0; m < 4; ++m) { const size_t off = (size_t)(rb + m * 16) * DM + col;
#pragma unroll
                for (int bj = 0; bj < 2; ++bj) { const u32x4 w = hw[m][bj];
                    const f32x4 h0 = {__uint_as_float(w.x << 16), __uint_as_float(w.x & 0xffff0000u), __uint_as_float(w.y << 16), __uint_as_float(w.y & 0xffff0000u)};
                    const f32x4 h1 = {__uint_as_float(w.z << 16), __uint_as_float(w.z & 0xffff0000u), __uint_as_float(w.w << 16), __uint_as_float(w.w & 0xffff0000u)};
                    const f32x4 o0 = h0 + acc[ai][bj][m][0], o1 = h1 + acc[ai][bj][m][1];
#if OUT_STORE_NT
                    __builtin_nontemporal_store(o0, (f32x4*)(B.out + off + bj * 32)); __builtin_nontemporal_store(o1, (f32x4*)(B.out + off + bj * 32 + 4)); } } }
#else
                    *(f32x4*)(B.out + off + bj * 32) = o0; *(f32x4*)(B.out + off + bj * 32 + 4) = o1; } } }
#endif
    }
};

template <class Epi, class Sched, bool ALIGN_EPI>
__device__ __forceinline__ void gemm_phase(PG8_LAS unsigned char* lds, const Gemm g, const Sched& S, const Epi& E) {
    const int tid = threadIdx.x, wid = __builtin_amdgcn_readfirstlane(tid >> 6), lane = tid & 63, wr = wid >> 2, wc = wid & 3, fr = lane & 15, fq = lane >> 4;
    const int K = g.K, nt = K / BK, lda = g.lda;
    unsigned voffA[2], voffB[2];
#pragma unroll
    for (int i = 0; i < 2; ++i) { int R, C; stage_rc(tid * 16 + i * 8192, R, C); const int Rb = Epi::PERM ? ((R & ~31) + perm32(R & 31)) : R;
        voffA[i] = (unsigned)(R * lda + C) * 2u; voffB[i] = (unsigned)(Rb * K + C) * 2u; }
    const size_t kstep = (size_t)(BK * 2);
    const size_t hstepA = (size_t)HALF * lda * 2, hstepB = (size_t)HALF * K * 2;
    const size_t tstepA = 2 * hstepA, tstepB = 2 * hstepB;
    const unsigned ldsw = (unsigned)wid * 1024u;
    const int aoff = lds_byte(wr * 64 + fr, fq * 8), boff = lds_byte(wc * 32 + fr, fq * 8);
#define PG8_SA(b, h) (((b) * 2 + (h)) * HTB)
#define PG8_SB(b, h) ((4 + (b) * 2 + (h)) * HTB)
#define PG8_STAGE(bufoff, gbase, voff) do { _Pragma("unroll") for (int _i = 0; _i < 2; ++_i) \
        __builtin_amdgcn_global_load_lds((const unsigned*)((const char*)(gbase) + (voff)[_i]), (PG8_LAS unsigned*)(lds + (bufoff) + ldsw + _i * 8192), 16, 0, 0); } while (0)
#define PG8_LDA(dst, b, h) do { _Pragma("unroll") for (int m = 0; m < 4; ++m) _Pragma("unroll") for (int k = 0; k < 2; ++k) dst[m][k] = *(const PG8_LAS bf16x8*)(lds + PG8_SA(b, h) + aoff + m * 2048 + k * 1024); } while (0)
#define PG8_LDB(dst, b, h) do { _Pragma("unroll") for (int n = 0; n < 2; ++n) _Pragma("unroll") for (int k = 0; k < 2; ++k) dst[n][k] = *(const PG8_LAS bf16x8*)(lds + PG8_SB(b, h) + boff + n * 2048 + k * 1024); } while (0)
#define PG8_MMA(ai, bj, At, Bt) do { __builtin_amdgcn_s_setprio(1); _Pragma("unroll") for (int m = 0; m < 4; ++m) _Pragma("unroll") for (int n = 0; n < 2; ++n) _Pragma("unroll") for (int k = 0; k < 2; ++k) \
        acc[ai][bj][m][n] = __builtin_amdgcn_mfma_f32_16x16x32_bf16(Bt[n][k], At[m][k], acc[ai][bj][m][n], 0, 0, 0); __builtin_amdgcn_s_setprio(0); } while (0)
#define PG8_WAIT_V(n) asm volatile("s_waitcnt vmcnt(" #n ")" ::: "memory")
#define PG8_WAIT_L(n) asm volatile("s_waitcnt lgkmcnt(" #n ")" ::: "memory")
#define PG8_BAR __builtin_amdgcn_s_barrier()
#define PG8_SCHED __builtin_amdgcn_sched_barrier(0)
    Unit cur, nxt; int ui = 0;
    if (!S.next(0, cur)) return;
    f32x4 acc[2][2][4][2];
#pragma unroll
    for (int a = 0; a < 2; ++a)
#pragma unroll
        for (int b = 0; b < 2; ++b)
#pragma unroll
            for (int m = 0; m < 4; ++m)
#pragma unroll
                for (int n = 0; n < 2; ++n) acc[a][b][m][n] = (f32x4){0.f, 0.f, 0.f, 0.f};
    bf16x8 At[4][2], B0[2][2], B1[2][2];
    const char* cA = (const char*)g.A + (size_t)cur.pm * tstepA; const char* cB = (const char*)g.Bt + (size_t)cur.pn * tstepB;
    S.a_ready(cur);
    PG8_STAGE(PG8_SB(0, 0), cB, voffB); PG8_STAGE(PG8_SB(0, 1), cB + hstepB, voffB); PG8_STAGE(PG8_SA(0, 0), cA, voffA); PG8_STAGE(PG8_SA(0, 1), cA + hstepA, voffA);
    if (wr == 1) PG8_BAR;
    PG8_WAIT_V(2); PG8_BAR;
    PG8_STAGE(PG8_SB(1, 0), cB + kstep, voffB); PG8_STAGE(PG8_SA(1, 0), cA + kstep, voffA); PG8_STAGE(PG8_SB(1, 1), cB + hstepB + kstep, voffB);
    PG8_WAIT_V(6); PG8_BAR;
    for (;;) {
        const bool has_next = S.next(ui + 1, nxt);
        const char* nA = has_next ? (const char*)g.A + (size_t)nxt.pm * tstepA : cA; const char* nB = has_next ? (const char*)g.Bt + (size_t)nxt.pn * tstepB : cB;
#pragma unroll 1
        for (int t = 0; t < nt; t += 2) {
            const bool last = (t == nt - 2);
            const char* a1 = cA + (size_t)(t + 1) * kstep;
            const char* a2 = last ? nA : cA + (size_t)(t + 2) * kstep; const char* b2 = last ? nB : cB + (size_t)(t + 2) * kstep;
            const char* a3 = a2 + kstep; const char* b3 = b2 + kstep;
            if (last && has_next) S.a_ready(nxt);
            PG8_LDB(B0, 0, 0); PG8_LDB(B1, 0, 1); PG8_SCHED; PG8_LDA(At, 0, 0); PG8_STAGE(PG8_SA(1, 1), a1 + hstepA, voffA);
            PG8_WAIT_V(8); PG8_WAIT_L(0); PG8_BAR; PG8_MMA(0, 0, At, B0); PG8_MMA(0, 1, At, B1); PG8_BAR; PG8_SCHED;
            PG8_LDA(At, 0, 1); PG8_STAGE(PG8_SB(0, 0), b2, voffB); PG8_STAGE(PG8_SB(0, 1), b2 + hstepB, voffB); PG8_STAGE(PG8_SA(0, 0), a2, voffA);
            PG8_WAIT_V(8); PG8_WAIT_L(0); PG8_BAR; PG8_MMA(1, 0, At, B0); PG8_MMA(1, 1, At, B1); PG8_BAR; PG8_SCHED;
            PG8_LDB(B0, 1, 0); PG8_LDB(B1, 1, 1); PG8_SCHED; PG8_LDA(At, 1, 0); PG8_STAGE(PG8_SA(0, 1), a2 + hstepA, voffA);
            PG8_WAIT_V(8); PG8_WAIT_L(0); PG8_BAR; PG8_MMA(0, 0, At, B0); PG8_MMA(0, 1, At, B1); PG8_BAR; PG8_SCHED;
            PG8_LDA(At, 1, 1); PG8_STAGE(PG8_SB(1, 0), b3, voffB); PG8_STAGE(PG8_SB(1, 1), b3 + hstepB, voffB); PG8_STAGE(PG8_SA(1, 0), a3, voffA);
            PG8_WAIT_V(8); PG8_WAIT_L(0); PG8_BAR; PG8_MMA(1, 0, At, B0); PG8_MMA(1, 1, At, B1); PG8_BAR; PG8_SCHED;
        }
        if constexpr (ALIGN_EPI) { if (wr == 0) PG8_BAR; }
        { int fr_ = fr, fq_ = fq; OPAQUE(fr_); OPAQUE(fq_); E(acc, cur, wr, wc, fr_, fq_); } S.done(cur);
        if (!has_next) break;
#pragma unroll
        for (int a = 0; a < 2; ++a)
#pragma unroll
            for (int b = 0; b < 2; ++b)
#pragma unroll
                for (int m = 0; m < 4; ++m)
#pragma unroll
                    for (int n = 0; n < 2; ++n) acc[a][b][m][n] = (f32x4){0.f, 0.f, 0.f, 0.f};
        cur = nxt; cA = nA; cB = nB; ++ui;
        if constexpr (ALIGN_EPI) { if (wr == 1) PG8_BAR; }
    }
    PG8_WAIT_V(0);
    if constexpr (!ALIGN_EPI) { if (wr == 0) PG8_BAR; }
    PG8_BAR;
#undef PG8_SA
#undef PG8_SB
#undef PG8_STAGE
#undef PG8_LDA
#undef PG8_LDB
#undef PG8_MMA
#undef PG8_WAIT_V
#undef PG8_WAIT_L
#undef PG8_BAR
#undef PG8_SCHED
}

#ifndef STREAM_ALIGN_EPI
#define STREAM_ALIGN_EPI 1
#endif
struct GDesc { const bf16_t* A; const bf16_t* Bt; int K, lda; };
struct UnitX { int pm, pn, kind; };
template <class Prog, int A_AUX = 0>
__device__ __forceinline__ void gemm_stream(PG8_LAS unsigned char* lds, Prog& P) {
    const int tid = threadIdx.x, wid = __builtin_amdgcn_readfirstlane(tid >> 6), lane = tid & 63, wr = wid >> 2, wc = wid & 3, fr = lane & 15, fq = lane >> 4;
    int R_[2], C_[2], Rb_[2];
#pragma unroll
    for (int i = 0; i < 2; ++i) { stage_rc(tid * 16 + i * 8192, R_[i], C_[i]); Rb_[i] = (R_[i] & ~31) + perm32(R_[i] & 31); }
    const size_t kstep = (size_t)(BK * 2);
    const unsigned ldsw = (unsigned)wid * 1024u;
    const int aoff = lds_byte(wr * 64 + fr, fq * 8), boff = lds_byte(wc * 32 + fr, fq * 8);
#define PG8_SA(b, h) (((b) * 2 + (h)) * HTB)
#define PG8_SB(b, h) ((4 + (b) * 2 + (h)) * HTB)
#define PG8_STAGE2(bufoff, gbase, v0, v1) do { \
        __builtin_amdgcn_global_load_lds((const unsigned*)((const char*)(gbase) + (v0)), (PG8_LAS unsigned*)(lds + (bufoff) + ldsw), 16, 0, 0); \
        __builtin_amdgcn_global_load_lds((const unsigned*)((const char*)(gbase) + (v1)), (PG8_LAS unsigned*)(lds + (bufoff) + ldsw + 8192), 16, 0, 0); } while (0)
#define PG8_STAGE2A(bufoff, gbase, v0, v1) do { \
        __builtin_amdgcn_global_load_lds((const unsigned*)((const char*)(gbase) + (v0)), (PG8_LAS unsigned*)(lds + (bufoff) + ldsw), 16, 0, A_AUX); \
        __builtin_amdgcn_global_load_lds((const unsigned*)((const char*)(gbase) + (v1)), (PG8_LAS unsigned*)(lds + (bufoff) + ldsw + 8192), 16, 0, A_AUX); } while (0)
#define PG8_LDA(dst, b, h) do { _Pragma("unroll") for (int m = 0; m < 4; ++m) _Pragma("unroll") for (int k = 0; k < 2; ++k) dst[m][k] = *(const PG8_LAS bf16x8*)(lds + PG8_SA(b, h) + aoff + m * 2048 + k * 1024); } while (0)
#define PG8_LDB(dst, b, h) do { _Pragma("unroll") for (int n = 0; n < 2; ++n) _Pragma("unroll") for (int k = 0; k < 2; ++k) dst[n][k] = *(const PG8_LAS bf16x8*)(lds + PG8_SB(b, h) + boff + n * 2048 + k * 1024); } while (0)
#define PG8_MMA(ai, bj, At, Bt) do { __builtin_amdgcn_s_setprio(1); _Pragma("unroll") for (int m = 0; m < 4; ++m) _Pragma("unroll") for (int n = 0; n < 2; ++n) _Pragma("unroll") for (int k = 0; k < 2; ++k) \
        acc[ai][bj][m][n] = __builtin_amdgcn_mfma_f32_16x16x32_bf16(Bt[n][k], At[m][k], acc[ai][bj][m][n], 0, 0, 0); __builtin_amdgcn_s_setprio(0); } while (0)
#define PG8_WAIT_V(n) asm volatile("s_waitcnt vmcnt(" #n ")" ::: "memory")
#define PG8_WAIT_L(n) asm volatile("s_waitcnt lgkmcnt(" #n ")" ::: "memory")
#define PG8_BAR __builtin_amdgcn_s_barrier()
#define PG8_SCHED __builtin_amdgcn_sched_barrier(0)
#define PG8_SETUP(u, pA, pB, vA0, vA1, vB0, vB1, hA, hB, ntv) do { const GDesc d_ = P.desc((u).kind); (ntv) = d_.K / BK; (hA) = (size_t)HALF * d_.lda * 2; (hB) = (size_t)HALF * d_.K * 2; \
        (pA) = (const char*)d_.A + (size_t)(u).pm * 2 * (hA); (pB) = (const char*)d_.Bt + (size_t)(u).pn * 2 * (hB); \
        (vA0) = (unsigned)(R_[0] * d_.lda + C_[0]) * 2u; (vA1) = (unsigned)(R_[1] * d_.lda + C_[1]) * 2u; (vB0) = (unsigned)(Rb_[0] * d_.K + C_[0]) * 2u; (vB1) = (unsigned)(Rb_[1] * d_.K + C_[1]) * 2u; } while (0)
    UnitX cur, nxt; int ui = 0;
    if (!P.next(0, cur)) return;
    const char *cA, *cB, *nA, *nB; unsigned cvA0, cvA1, cvB0, cvB1, nvA0, nvA1, nvB0, nvB1; size_t chA, chB, nhA, nhB; int cnt, nnt;
    PG8_SETUP(cur, cA, cB, cvA0, cvA1, cvB0, cvB1, chA, chB, cnt);
    f32x4 acc[2][2][4][2];
#pragma unroll
    for (int a = 0; a < 2; ++a)
#pragma unroll
        for (int b = 0; b < 2; ++b)
#pragma unroll
            for (int m = 0; m < 4; ++m)
#pragma unroll
                for (int n = 0; n < 2; ++n) acc[a][b][m][n] = (f32x4){0.f, 0.f, 0.f, 0.f};
    bf16x8 At[4][2], B0[2][2], B1[2][2];
    P.a_ready(cur);
    PG8_STAGE2(PG8_SB(0, 0), cB, cvB0, cvB1); PG8_STAGE2(PG8_SB(0, 1), cB + chB, cvB0, cvB1); PG8_STAGE2A(PG8_SA(0, 0), cA, cvA0, cvA1); PG8_STAGE2A(PG8_SA(0, 1), cA + chA, cvA0, cvA1);
    if (wr == 1) PG8_BAR;
    PG8_WAIT_V(2); PG8_BAR;
    PG8_STAGE2(PG8_SB(1, 0), cB + kstep, cvB0, cvB1); PG8_STAGE2A(PG8_SA(1, 0), cA + kstep, cvA0, cvA1); PG8_STAGE2(PG8_SB(1, 1), cB + chB + kstep, cvB0, cvB1);
    PG8_WAIT_V(6); PG8_BAR;
    for (;;) {
        const bool has_next = P.next(ui + 1, nxt);
        if (has_next) { PG8_SETUP(nxt, nA, nB, nvA0, nvA1, nvB0, nvB1, nhA, nhB, nnt); }
        else { nA = cA; nB = cB; nvA0 = cvA0; nvA1 = cvA1; nvB0 = cvB0; nvB1 = cvB1; nhA = chA; nhB = chB; nnt = cnt; }
#pragma unroll 1
        for (int t = 0; t < cnt; t += 2) {
            const bool last = (t == cnt - 2);
            const char* a1 = cA + (size_t)(t + 1) * kstep;
            const char* a2 = last ? nA : cA + (size_t)(t + 2) * kstep; const char* b2 = last ? nB : cB + (size_t)(t + 2) * kstep;
            const char* a3 = a2 + kstep; const char* b3 = b2 + kstep;
            const unsigned xA0 = last ? nvA0 : cvA0, xA1 = last ? nvA1 : cvA1, xB0 = last ? nvB0 : cvB0, xB1 = last ? nvB1 : cvB1; const size_t xhA = last ? nhA : chA, xhB = last ? nhB : chB;
            if (last && has_next) P.a_ready(nxt);
            PG8_LDB(B0, 0, 0); PG8_LDB(B1, 0, 1); PG8_SCHED; PG8_LDA(At, 0, 0); PG8_STAGE2A(PG8_SA(1, 1), a1 + chA, cvA0, cvA1);
            PG8_WAIT_V(8); PG8_WAIT_L(0); PG8_BAR; PG8_MMA(0, 0, At, B0); PG8_MMA(0, 1, At, B1); PG8_BAR; PG8_SCHED;
            PG8_LDA(At, 0, 1); PG8_STAGE2(PG8_SB(0, 0), b2, xB0, xB1); PG8_STAGE2(PG8_SB(0, 1), b2 + xhB, xB0, xB1); PG8_STAGE2A(PG8_SA(0, 0), a2, xA0, xA1);
            PG8_WAIT_V(8); PG8_WAIT_L(0); PG8_BAR; PG8_MMA(1, 0, At, B0); PG8_MMA(1, 1, At, B1); PG8_BAR; PG8_SCHED;
            PG8_LDB(B0, 1, 0); PG8_LDB(B1, 1, 1); PG8_SCHED; PG8_LDA(At, 1, 0); PG8_STAGE2A(PG8_SA(0, 1), a2 + xhA, xA0, xA1);
            PG8_WAIT_V(8); if (t == 0) P.publish();
            PG8_WAIT_L(0); PG8_BAR; PG8_MMA(0, 0, At, B0); PG8_MMA(0, 1, At, B1); PG8_BAR; PG8_SCHED;
            PG8_LDA(At, 1, 1); PG8_STAGE2(PG8_SB(1, 0), b3, xB0, xB1); PG8_STAGE2(PG8_SB(1, 1), b3 + xhB, xB0, xB1); PG8_STAGE2A(PG8_SA(1, 0), a3, xA0, xA1);
            PG8_WAIT_V(8); PG8_WAIT_L(0); PG8_BAR; PG8_MMA(1, 0, At, B0); PG8_MMA(1, 1, At, B1); PG8_BAR; PG8_SCHED;
        }
#if STREAM_ALIGN_EPI
        if (wr == 0) PG8_BAR;
#endif
        { int fr_ = fr, fq_ = fq; OPAQUE(fr_); OPAQUE(fq_); P.epi(acc, cur, wr, wc, fr_, fq_); } P.done(cur);
        if (!has_next) break;
#pragma unroll
        for (int a = 0; a < 2; ++a)
#pragma unroll
            for (int b = 0; b < 2; ++b)
#pragma unroll
                for (int m = 0; m < 4; ++m)
#pragma unroll
                    for (int n = 0; n < 2; ++n) acc[a][b][m][n] = (f32x4){0.f, 0.f, 0.f, 0.f};
        cur = nxt; cA = nA; cB = nB; cvA0 = nvA0; cvA1 = nvA1; cvB0 = nvB0; cvB1 = nvB1; chA = nhA; chB = nhB; cnt = nnt; ++ui;
#if STREAM_ALIGN_EPI
        if (wr == 1) PG8_BAR;
#endif
    }
    PG8_WAIT_V(0); P.publish();
#if !STREAM_ALIGN_EPI
    if (wr == 0) PG8_BAR;
#endif
    PG8_BAR;
#undef PG8_SA
#undef PG8_SB
#undef PG8_STAGE2
#undef PG8_STAGE2A
#undef PG8_LDA
#undef PG8_LDB
#undef PG8_MMA
#undef PG8_WAIT_V
#undef PG8_WAIT_L
#undef PG8_BAR
#undef PG8_SCHED
#undef PG8_SETUP
}
struct ProgP2 { Ctx B; StaticOrder S;
    __device__ __forceinline__ void init(const Ctx& b, int G, int c) { B = b; S.init(M, 1024, G, c); }
    __device__ __forceinline__ bool next(int i, UnitX& u) const { Unit t; const int per = (S.nwg - S.c + S.G - 1) / S.G; const bool q = i < per; if (!S.next(q ? i : i - per, t)) return false; u.pm = t.pm; u.pn = t.pn; u.kind = q ? 0 : 1; return true; }
    __device__ __forceinline__ GDesc desc(int kind) const { return kind == 0 ? GDesc{B.CQKV(), B.WQUP(), 256, 384} : GDesc{B.CQKV() + 256, B.WKVUP(), 128, 384}; }
    __device__ __forceinline__ void epi(const f32x4 (&acc)[2][2][4][2], const UnitX& u, int wr, int wc, int fr, int fq) const { const Unit t{u.pm, u.pn};
        if (u.kind == 0) EpiQUp{B}(acc, t, wr, wc, fr, fq); else EpiKvUp{B}(acc, t, wr, wc, fr, fq); }
    __device__ __forceinline__ void a_ready(const UnitX&) const {}
    __device__ __forceinline__ void done(const UnitX&) const {}
    __device__ __forceinline__ void publish() const {}
};

template <class Epi, int DUPMODE = 0> struct ProgOne { Ctx B; StaticOrder S; GDesc d;
    __device__ __forceinline__ void init(const Ctx& b, const GDesc& g, int N, int G, int c, int wgm = WGM) { B = b; d = g; S.init(M, N, G, c, wgm); }
    __device__ __forceinline__ bool next(int i, UnitX& u) const { Unit t; if (!S.next(DUPMODE ? (i >> 1) : i, t)) return false; u.pm = t.pm; u.pn = t.pn; u.kind = (DUPMODE == 2 && !(i & 1)) ? 1 : 0; return true; }
    __device__ __forceinline__ GDesc desc(int) const { return d; }
    __device__ __forceinline__ void epi(const f32x4 (&acc)[2][2][4][2], const UnitX& u, int wr, int wc, int fr, int fq) const { if (DUPMODE == 2 && u.kind == 1) return; const Unit t{u.pm, u.pn}; Epi{B}(acc, t, wr, wc, fr, fq); }
    __device__ __forceinline__ void a_ready(const UnitX&) const {}
    __device__ __forceinline__ void done(const UnitX&) const {}
    __device__ __forceinline__ void publish() const {}
};

struct ProgFFN { Ctx B; StaticOrder S4, S5; unsigned* cnt4; unsigned* cnt5; unsigned* tmo; int seg, p6, acq4; unsigned* pend;
    enum { K_P4 = 0, K_P5 = 1, K_P6 = 2 };
    __device__ __forceinline__ void init(const Ctx& b, int G, int c, unsigned* c4, unsigned* c5, unsigned* t) { B = b; S4.init(M, DM, G, c); S5.init(M, 2 * DFF, G, c); cnt4 = c4; cnt5 = c5; tmo = t; seg = 0; p6 = 1 + (c >> 3) % 5; acq4 = -1; pend = nullptr; }
    __device__ __forceinline__ bool next(int i, UnitX& u) const { Unit t; int kind, r;
        if (seg == 0) { if (i > 1) return false; kind = K_P4; r = i; }
        else if (seg == 1) { if (i < 6) { kind = K_P5; r = i; } else if (i < 12) { const int k = i - 6; if (k == p6) { kind = K_P6; r = 0; } else { kind = K_P5; r = 6 + (k < p6 ? k : k - 1); } } else return false; }
        else { if (i > 0) return false; kind = K_P6; r = 1; }
        if (!(kind == K_P5 ? S5.next(r, t) : S4.next(r, t))) return false;
        u.pm = t.pm; u.pn = t.pn; u.kind = kind; return true; }
    __device__ __forceinline__ GDesc desc(int kind) const { return kind == K_P4 ? GDesc{B.AO(), B.WO(), DM, DM} : kind == K_P5 ? GDesc{B.H1B(), B.WGU(), DM, DM} : GDesc{B.ACT(), B.WD(), DFF, DFF}; }
    __device__ __forceinline__ void epi(const f32x4 (&acc)[2][2][4][2], const UnitX& u, int wr, int wc, int fr, int fq) const { const Unit t{u.pm, u.pn};
        if (u.kind == K_P4) EpiOProjT<1>{B}(acc, t, wr, wc, fr, fq); else if (u.kind == K_P5) EpiFfn1T<1>{B}(acc, t, wr, wc, fr, fq); else EpiFfn2{B}(acc, t, wr, wc, fr, fq); }
    __device__ __forceinline__ void a_ready(const UnitX& u) {
        if (u.kind == K_P4 || (u.kind == K_P5 && u.pm == acq4)) return;
        if (threadIdx.x < 64) {
            unsigned* c = u.kind == K_P5 ? cnt4 + 64 * u.pm : cnt5 + 64 * u.pm; const unsigned need = u.kind == K_P5 ? 4u * 8u : 22u * 8u; unsigned sp = 0u;
            while ((unsigned)__builtin_amdgcn_readfirstlane(__hip_atomic_load(c, __ATOMIC_RELAXED, __HIP_MEMORY_SCOPE_AGENT)) < need) { __builtin_amdgcn_s_sleep(2);
                if ((++sp & 255u) == 0u) { if (__builtin_amdgcn_readfirstlane(__hip_atomic_load(tmo, __ATOMIC_RELAXED, __HIP_MEMORY_SCOPE_AGENT)) != 0u) break; if (sp > (1u << 18)) { if (threadIdx.x == 0) atomicAdd(tmo, 1u); break; } } }
            __builtin_amdgcn_fence(__ATOMIC_ACQUIRE, "agent");
            asm volatile("s_waitcnt vmcnt(0)" ::: "memory");
        }
        asm volatile("" ::: "memory"); __builtin_amdgcn_s_barrier(); asm volatile("" ::: "memory");
        if (u.kind == K_P5) acq4 = u.pm;
    }
    __device__ __forceinline__ void done(const UnitX& u) { pend = u.kind == K_P4 ? cnt4 + 64 * u.pm : u.kind == K_P5 ? cnt5 + 64 * u.pm : nullptr; }
    __device__ __forceinline__ void publish() { if (pend) { if ((threadIdx.x & 63) == 0) (void)__hip_atomic_fetch_add(pend, 1u, __ATOMIC_RELAXED, __HIP_MEMORY_SCOPE_AGENT); pend = nullptr; } }
};
}
namespace attm {
using bf16=bf16_t;
using bf16x8=__attribute__((ext_vector_type(8)))short;
using s16x4=__attribute__((ext_vector_type(4)))short;
using f32x16=__attribute__((ext_vector_type(16)))float;
using u32x4=__attribute__((ext_vector_type(4)))unsigned;
using f32x4=__attribute__((ext_vector_type(4)))float;
constexpr int D=64,DM=512,DMO=1024;
constexpr int NW=8,QBLK=32,QB=QBLK*NW,KVBLK=64;
__device__ __forceinline__ int crow(int r,int hi){return (r&3)+8*(r>>2)+4*hi;}
#define SBAR() __builtin_amdgcn_sched_barrier(0)
__device__ __forceinline__ void cmask(f32x16&p0,f32x16&p1,int jb,int qrel,int hi){
  const float NEG=-INFINITY; int kb=64*jb+4*hi;
  #pragma unroll
  for(int r=0;r<16;++r){int kv=kb+(r&3)+8*(r>>2); if(kv>qrel)p0[r]=NEG; if(kv+32>qrel)p1[r]=NEG;}
}

constexpr int NSLOT=3, SLOTB=8192;
constexpr int LDS_K=0, LDS_V=NSLOT*SLOTB, LDS_WS=2*NSLOT*SLOTB, LDS_OST=LDS_WS+NW*64*4, LDS_BYTES=LDS_OST+NW*4096;
constexpr float C2=0.125f*1.4426950408889634f;
__device__ __forceinline__ void glds16(const void*gsrc,unsigned lds_dst){unsigned keep;
  asm volatile("s_mov_b32 %0, m0\n\ts_mov_b32 m0, %2\n\ts_nop 0\n\tglobal_load_lds_dwordx4 %1, off\n\ts_mov_b32 m0, %0":"=&s"(keep):"v"(gsrc),"s"(lds_dst):"memory");}
__device__ __forceinline__ float max3f(float a,float b,float c){float r;asm("v_max3_f32 %0, %1, %2, %3":"=v"(r):"v"(a),"v"(b),"v"(c));return r;}
__device__ __forceinline__ float max2f(float a,float b){float r;asm("v_max_f32_e32 %0, %1, %2":"=v"(r):"v"(a),"v"(b));return r;}
__device__ __forceinline__ float fadd_s(float a,float b){float r;asm("v_add_f32_e32 %0, %1, %2":"=v"(r):"v"(a),"v"(b));return r;}
__device__ __forceinline__ float fsub_s(float a,float b){float r;asm("v_sub_f32_e32 %0, %1, %2":"=v"(r):"v"(a),"v"(b));return r;}
typedef float f32x2_t __attribute__((ext_vector_type(2))); typedef __bf16 bf16x2_t __attribute__((ext_vector_type(2)));
__device__ __forceinline__ unsigned cvtpk_s(float lo,float hi){f32x2_t v={lo,hi};bf16x2_t b=__builtin_convertvector(v,bf16x2_t);return __builtin_bit_cast(unsigned,b);}
__device__ __forceinline__ void glds16s(const void*sbase,unsigned voff,unsigned lds_dst){unsigned keep;
  asm volatile("s_mov_b32 %0, m0\n\ts_mov_b32 m0, %3\n\ts_nop 0\n\tglobal_load_lds_dwordx4 %1, %2\n\ts_mov_b32 m0, %0":"=&s"(keep):"v"(voff),"s"(sbase),"s"(lds_dst):"memory");}
__device__ __forceinline__ const bf16_t* uptr(const bf16_t*p){ const unsigned long long v=(unsigned long long)p; const unsigned lo=__builtin_amdgcn_readfirstlane((unsigned)v),hi=__builtin_amdgcn_readfirstlane((unsigned)(v>>32)); return (const bf16_t*)(((unsigned long long)hi<<32)|lo); }
#define WAIT_BAR(N) asm volatile("s_waitcnt vmcnt(" #N ") lgkmcnt(0)\n\ts_barrier":::"memory")

__device__ __forceinline__ void qkt(f32x16&p0,f32x16&p1,const char*Kslot,const bf16x8*qr,const f32x16&negm,int r32,int hi){
  const char*kb=Kslot+hi*1024+r32*16;
  #pragma unroll
  for(int d0=0;d0<4;++d0){
    const bf16x8 b0=*reinterpret_cast<const bf16x8*>(kb+d0*2048);
    const bf16x8 b1=*reinterpret_cast<const bf16x8*>(kb+d0*2048+512);
    if(d0==0){p0=__builtin_amdgcn_mfma_f32_32x32x16_bf16(b0,qr[0],negm,0,0,0);p1=__builtin_amdgcn_mfma_f32_32x32x16_bf16(b1,qr[0],negm,0,0,0);}
    else{p0=__builtin_amdgcn_mfma_f32_32x32x16_bf16(b0,qr[d0],p0,0,0,0);p1=__builtin_amdgcn_mfma_f32_32x32x16_bf16(b1,qr[d0],p1,0,0,0);}}
}
typedef __attribute__((address_space(3))) const char* lds_cptr;
typedef short v4i16_t __attribute__((ext_vector_type(4)));
__device__ __forceinline__ void kload8(bf16x8*kf,lds_cptr kp){
  kf[0]=*(const __attribute__((address_space(3))) bf16x8*)(kp);      kf[1]=*(const __attribute__((address_space(3))) bf16x8*)(kp+512);
  kf[2]=*(const __attribute__((address_space(3))) bf16x8*)(kp+2048); kf[3]=*(const __attribute__((address_space(3))) bf16x8*)(kp+2560);
  kf[4]=*(const __attribute__((address_space(3))) bf16x8*)(kp+4096); kf[5]=*(const __attribute__((address_space(3))) bf16x8*)(kp+4608);
  kf[6]=*(const __attribute__((address_space(3))) bf16x8*)(kp+6144); kf[7]=*(const __attribute__((address_space(3))) bf16x8*)(kp+6656);
}
__device__ __forceinline__ void kload2(bf16x8*kf,lds_cptr kp,int j){ kf[2*j]=*(const __attribute__((address_space(3))) bf16x8*)(kp+j*2048); kf[2*j+1]=*(const __attribute__((address_space(3))) bf16x8*)(kp+j*2048+512); }
__device__ __forceinline__ s16x4 vtr(lds_cptr p){ return __builtin_bit_cast(s16x4,__builtin_amdgcn_ds_read_tr16_b64_v4i16((__attribute__((address_space(3))) v4i16_t*)p)); }
__device__ __forceinline__ float rowmax(const f32x16&p0,const f32x16&p1){
  float a=max3f(p0[0],p0[1],p1[0]),b=max3f(p0[2],p0[3],p1[1]);a=max3f(a,p1[2],p1[3]);
  #pragma unroll
  for(int r=4;r<16;r+=4){a=max3f(a,p0[r],p0[r+1]);b=max3f(b,p0[r+2],p0[r+3]);a=max3f(a,p1[r],p1[r+1]);b=max3f(b,p1[r+2],p1[r+3]);}
  const float m=max2f(a,b);
  auto rr=__builtin_amdgcn_permlane32_swap(__float_as_uint(m),__float_as_uint(m),false,false);
  return max2f(__uint_as_float(rr[0]),__uint_as_float(rr[1]));
}
__device__ __forceinline__ void pv(f32x16*o,int vb,bf16x8 pa0,bf16x8 pa1,bf16x8 pa2,bf16x8 pa3){
  #pragma unroll
  for(int d0=0;d0<2;++d0){s16x4 lo[4],hi[4];
    #pragma unroll
    for(int ks=0;ks<4;++ks){
      asm volatile("ds_read_b64_tr_b16 %0,%1 offset:%c2":"=&v"(lo[ks]):"v"(vb),"i"(d0*4096+ks*1024):"memory");
      asm volatile("ds_read_b64_tr_b16 %0,%1 offset:%c2":"=&v"(hi[ks]):"v"(vb),"i"(d0*4096+ks*1024+512):"memory");}
    asm volatile("s_waitcnt lgkmcnt(0)":::"memory");SBAR();
    #define PK(k) (bf16x8){lo[k][0],lo[k][1],lo[k][2],lo[k][3],hi[k][0],hi[k][1],hi[k][2],hi[k][3]}
    o[d0]=__builtin_amdgcn_mfma_f32_32x32x16_bf16(pa0,PK(0),o[d0],0,0,0);
    o[d0]=__builtin_amdgcn_mfma_f32_32x32x16_bf16(pa1,PK(1),o[d0],0,0,0);
    o[d0]=__builtin_amdgcn_mfma_f32_32x32x16_bf16(pa2,PK(2),o[d0],0,0,0);
    o[d0]=__builtin_amdgcn_mfma_f32_32x32x16_bf16(pa3,PK(3),o[d0],0,0,0);
    #undef PK
  }
}

#ifndef ATTN_STORE16
#define ATTN_STORE16(p,v) (*(u32x4*)(p)=(v))
#endif
template<int THRL> __device__ __forceinline__ void attn_unit(int qb,int b8,int h,const bf16*Q,const bf16*__restrict__ K,const bf16*__restrict__ V,bf16*O,const Ctx&B,char*shm){
  const int tid=threadIdx.x; int lane=tid&63; asm volatile("":"+v"(lane));
  const int r32=lane&31,hi=lane>>5; const int wid=__builtin_amdgcn_readfirstlane(tid>>6);
  const int q0=qb*QB;
  const bf16*Qw=Q+(long)(q0+wid*QBLK)*DM;
  const bf16*Kh=K,*Vh=V;
  const unsigned lds0=(unsigned)(uintptr_t)shm;
  float*wsf=(float*)(shm+LDS_WS)+wid*64;
  const unsigned koff=(unsigned)(lane*DM+wid*8)*2u;
  const unsigned voffv=(unsigned)((16*(wid&3)+(lane>>2))*DM+(wid>>2)*32+(lane&3)*8)*2u;
  const unsigned kdst=lds0+LDS_K+wid*1024, vdst=lds0+LDS_V+wid*1024;
  #define DMA_K(t,slot) glds16s(uptr(Kh+(long)(t)*KVBLK*DM),koff,(unsigned)__builtin_amdgcn_readfirstlane(kdst+(slot)))
  #define DMA_V(t,slot) glds16s(uptr(Vh+(long)(t)*KVBLK*DM),voffv,(unsigned)__builtin_amdgcn_readfirstlane(vdst+(slot)))
  const int vb0=(int)(lds0+LDS_V)+((lane>>4)&1)*32+(lane&3)*8+(4*hi+((lane&15)>>2))*64;
  const char*Kbase=shm+LDS_K; bf16x8 kf[8];
  const lds_cptr shm3=(lds_cptr)shm; const lds_cptr kp0=shm3+LDS_K+hi*1024+r32*16; const lds_cptr vp0=shm3+LDS_V+((lane>>4)&1)*32+(lane&3)*8+(4*hi+((lane&15)>>2))*64;
  const int NT=(q0+QB)/KVBLK;
  DMA_K(0,0);DMA_V(0,0);DMA_K(1,SLOTB);
  bf16x8 qr[4];
  #pragma unroll
  for(int d0=0;d0<4;++d0)qr[d0]=__builtin_nontemporal_load(reinterpret_cast<const bf16x8*>(&Qw[(long)r32*DM+d0*16+hi*8]));
  unsigned sel=0xffu;
  if(qb>3){
    int r32o=r32; asm volatile("":"+v"(r32o));
    f32x16 G=f32x16{};
    #pragma unroll
    for(int d0=0;d0<4;++d0){ float km[8];
      #pragma unroll
      for(int j=0;j<8;++j)km[j]=0.f;
      if(r32o<qb){ const float*kpp=B.KMEANP()+(size_t)(b8+r32o)*4*512+h*64+d0*16+hi*8;
        #pragma unroll
        for(int qq=0;qq<4;++qq){ const f32x4 a=*(const f32x4*)(kpp+qq*512),bb=*(const f32x4*)(kpp+qq*512+4);
          #pragma unroll
          for(int j=0;j<4;++j){km[j]+=a[j];km[4+j]+=bb[j];} } }
      unsigned whi[4],wlo[4];
      #pragma unroll
      for(int w=0;w<4;++w){ whi[w]=cvtpk_s(km[2*w],km[2*w+1]); wlo[w]=cvtpk_s(km[2*w]-__uint_as_float(whi[w]<<16),km[2*w+1]-__uint_as_float(whi[w]&0xffff0000u)); }
      const u32x4 vh={whi[0],whi[1],whi[2],whi[3]},vl={wlo[0],wlo[1],wlo[2],wlo[3]};
      G=__builtin_amdgcn_mfma_f32_32x32x16_bf16(__builtin_bit_cast(bf16x8,vh),qr[d0],G,0,0,0);
      G=__builtin_amdgcn_mfma_f32_32x32x16_bf16(__builtin_bit_cast(bf16x8,vl),qr[d0],G,0,0,0); }
    float gate[8];
    #pragma unroll
    for(int r=0;r<4;++r){ auto rr=__builtin_amdgcn_permlane32_swap(__float_as_uint(G[r]),__float_as_uint(G[r]),false,false); gate[r]=__uint_as_float(rr[0]); gate[4+r]=__uint_as_float(rr[1]); }
    #pragma unroll
    for(int j=0;j<8;++j)if(j>=qb)gate[j]=-INFINITY;
    sel=0u;
    #pragma unroll
    for(int j=0;j<8;++j){ int rank=0;
      #pragma unroll
      for(int i=0;i<8;++i)rank+=(gate[i]>gate[j]||(gate[i]==gate[j]&&i<j))?1:0;
      if(j<qb&&rank<3)sel|=1u<<j; }
  }
  float mhat=0.f,l_reg=0.f;f32x16 o[2];o[0]=f32x16{};o[1]=f32x16{};f32x16 negm;
  #define SETNEGM(tt) do{ const float nm_=((tt)>=NT-4||((sel>>((tt)>>2))&1u))?-mhat:-INFINITY; _Pragma("unroll") for(int r=0;r<16;++r)negm[r]=nm_; asm volatile("":"+v"(negm)); }while(0)
  const int qrel=wid*QBLK+r32;
  #define CMASK(P0,P1,t) do{int jb_=(t)-(NT-4); if(jb_>=0)cmask(P0,P1,jb_,qrel,hi);}while(0)
  bool resc=false;
  #define START(P0,P1) do{ const float rm=rowmax(P0,P1); resc=false; \
    { const float dl=(rm==-INFINITY)?0.f:rm; mhat=fadd_s(mhat,dl); \
      _Pragma("unroll") for(int r=0;r<16;++r){P0[r]=fsub_s(P0[r],dl);P1[r]=fsub_s(P1[r],dl);} \
      SETNEGM(1); } \
    _Pragma("unroll") for(int r=0;r<16;++r)P0[r]=__builtin_amdgcn_exp2f(P0[r]); }while(0)
  #define RESC() do{ if(resc){ asm volatile("s_waitcnt lgkmcnt(0)":::"memory"); \
      _Pragma("unroll") for(int d_=0;d_<2;++d_) _Pragma("unroll") for(int r=0;r<16;++r)o[d_][r]*=wsf[crow(r,hi)]; } }while(0)
  f32x16 pA0,pA1,pB0,pB1;
  int sl_prev=0,sl_cur=0,sl_next=SLOTB;
  #define ROT() do{sl_prev=sl_cur;sl_cur=sl_next;sl_next=(sl_next==(NSLOT-1)*SLOTB)?0:sl_next+SLOTB;}while(0)
  DMA_K(2,2*SLOTB);
  WAIT_BAR(3);
  SETNEGM(0);
  qkt(pA0,pA1,Kbase,qr,negm,r32,hi);asm volatile("s_nop 15\n\ts_nop 7":"+v"(pA0),"+v"(pA1));CMASK(pA0,pA1,0);
  START(pA0,pA1);
  _Pragma("unroll") for(int r=0;r<16;++r)pA1[r]=__builtin_amdgcn_exp2f(pA1[r]);
  WAIT_BAR(0);
  DMA_K(3,0);DMA_V(1,SLOTB);
  ROT();
  kload8(kf,kp0+sl_cur);
  WAIT_BAR(2);
  s16x4 vlo[8],vhi[8]; u32x4 pw0,pw1,pw2,pw3;
  #define PKW(P,B) cvtpk_s(P[B],P[B+1])
  #define PAF(k) __builtin_bit_cast(bf16x8,pw##k)
  #define VFR(i) (bf16x8){vlo[i][0],vlo[i][1],vlo[i][2],vlo[i][3],vhi[i][0],vhi[i][1],vhi[i][2],vhi[i][3]}
  #define PIN(x) asm volatile("":"+v"(x))
  #define MX3(a,b,c) __builtin_fmaxf(__builtin_fmaxf((a),(b)),(c))
  #define GAPA(MF,A0,A1,A2,A3,W0,W1,PW) do{ MF; sacc+=A0; sacc+=A1; sacc+=A2; sacc+=A3; PIN(sacc); W0; W1; PIN(PW); SBAR(); }while(0)
  #define EX(v) __builtin_amdgcn_exp2f(v)
  #define GAPB(MF,X,B) do{ MF; X[B]=EX(X[B]); X[B+1]=EX(X[B+1]); X[B+2]=EX(X[B+2]); X[B+3]=EX(X[B+3]); PIN(X); SBAR(); }while(0)
  #define VRD(i) do{ vlo[i]=vtr(vp_+(((i)>>2)*4096+((i)&3)*1024)); vhi[i]=vtr(vp_+(((i)>>2)*4096+((i)&3)*1024+512)); }while(0)
  #define KRD(G,j) do{ if(G){ kload2(kf,kp0+sl_next,j); SBAR(); } }while(0)
  #define STEP(C0,C1,P0,P1,t,GK,GV,GL) do{ SBAR(); \
    const lds_cptr vp_=vp0+sl_prev; \
    VRD(0); SBAR(); float sacc=(P0[0]+P0[1]); \
    GAPA(C0=__builtin_amdgcn_mfma_f32_32x32x16_bf16(kf[0],qr[0],negm,0,0,0), P0[2],P0[3],P0[4],P0[5],     pw0[0]=PKW(P0,0), pw0[1]=PKW(P0,2), pw0); \
    VRD(4); SBAR(); GAPA(C1=__builtin_amdgcn_mfma_f32_32x32x16_bf16(kf[1],qr[0],negm,0,0,0), P0[6],P0[7],P0[8],P0[9],     pw0[2]=PKW(P0,4), pw0[3]=PKW(P0,6), pw0); \
    VRD(1); SBAR(); GAPA(C0=__builtin_amdgcn_mfma_f32_32x32x16_bf16(kf[2],qr[1],C0,0,0,0),   P0[10],P0[11],P0[12],P0[13], pw1[0]=PKW(P0,8), pw1[1]=PKW(P0,10), pw1); \
    VRD(5); SBAR(); GAPA(C1=__builtin_amdgcn_mfma_f32_32x32x16_bf16(kf[3],qr[1],C1,0,0,0),   P0[14],P0[15],P1[0],P1[1],   pw1[2]=PKW(P0,12),pw1[3]=PKW(P0,14), pw1); \
    VRD(2); SBAR(); GAPA(C0=__builtin_amdgcn_mfma_f32_32x32x16_bf16(kf[4],qr[2],C0,0,0,0),   P1[2],P1[3],P1[4],P1[5],     pw2[0]=PKW(P1,0), pw2[1]=PKW(P1,2), pw2); \
    VRD(6); SBAR(); GAPA(C1=__builtin_amdgcn_mfma_f32_32x32x16_bf16(kf[5],qr[2],C1,0,0,0),   P1[6],P1[7],P1[8],P1[9],     pw2[2]=PKW(P1,4), pw2[3]=PKW(P1,6), pw2); \
    VRD(3); SBAR(); GAPA(C0=__builtin_amdgcn_mfma_f32_32x32x16_bf16(kf[6],qr[3],C0,0,0,0),   P1[10],P1[11],P1[12],P1[13], pw3[0]=PKW(P1,8), pw3[1]=PKW(P1,10), pw3); \
    VRD(7); SBAR(); GAPA(C1=__builtin_amdgcn_mfma_f32_32x32x16_bf16(kf[7],qr[3],C1,0,0,0),   P1[14],P1[15],0.f,0.f,       pw3[2]=PKW(P1,12),pw3[3]=PKW(P1,14), pw3); \
    l_reg+=sacc; \
    if(GK){DMA_K((t)+3,sl_cur);} if(GV){DMA_V((t)+1,sl_next);} \
    CMASK(C0,C1,t); \
    { float a=MX3(C0[0],C0[1],C1[0]),b=MX3(C0[2],C0[3],C1[1]); a=MX3(a,C1[2],C1[3]); \
      _Pragma("unroll") for(int r=4;r<16;r+=4){a=MX3(a,C0[r],C0[r+1]);b=MX3(b,C0[r+2],C0[r+3]);a=MX3(a,C1[r],C1[r+1]);b=MX3(b,C1[r+2],C1[r+3]);} \
      float rm=__builtin_fmaxf(a,b); { auto rr=__builtin_amdgcn_permlane32_swap(__float_as_uint(rm),__float_as_uint(rm),false,false); rm=__builtin_fmaxf(__uint_as_float(rr[0]),__uint_as_float(rr[1])); } \
      resc=false; \
      if(__builtin_expect(__any(rm>(float)THRL),0)){ const float dl=__builtin_fmaxf(rm,0.f); mhat+=dl; \
        _Pragma("unroll") for(int r=0;r<16;++r){C0[r]-=dl;C1[r]-=dl;} \
        const float f=__builtin_amdgcn_exp2f(-dl); l_reg*=f; if(hi==0)wsf[r32]=f; resc=true; } \
      SETNEGM((t)+1); } \
    SBAR(); \
    GAPB(o[0]=__builtin_amdgcn_mfma_f32_32x32x16_bf16(PAF(0),VFR(0),o[0],0,0,0), C0,0); \
    GAPB(o[1]=__builtin_amdgcn_mfma_f32_32x32x16_bf16(PAF(0),VFR(4),o[1],0,0,0), C0,4); \
    KRD(GL,0); GAPB(o[0]=__builtin_amdgcn_mfma_f32_32x32x16_bf16(PAF(1),VFR(1),o[0],0,0,0), C0,8); \
    KRD(GL,1); GAPB(o[1]=__builtin_amdgcn_mfma_f32_32x32x16_bf16(PAF(1),VFR(5),o[1],0,0,0), C0,12); \
    KRD(GL,2); GAPB(o[0]=__builtin_amdgcn_mfma_f32_32x32x16_bf16(PAF(2),VFR(2),o[0],0,0,0), C1,0); \
    KRD(GL,3); GAPB(o[1]=__builtin_amdgcn_mfma_f32_32x32x16_bf16(PAF(2),VFR(6),o[1],0,0,0), C1,4); \
    GAPB(o[0]=__builtin_amdgcn_mfma_f32_32x32x16_bf16(PAF(3),VFR(3),o[0],0,0,0), C1,8); \
    GAPB(o[1]=__builtin_amdgcn_mfma_f32_32x32x16_bf16(PAF(3),VFR(7),o[1],0,0,0), C1,12); \
    }while(0)
  int t=1;
  #undef CMASK
  #define CMASK(P0,P1,t) do{}while(0)
  for(;t+5<NT;t+=2){
    STEP(pB0,pB1,pA0,pA1,t,true,true,true);     WAIT_BAR(2); RESC(); ROT();
    STEP(pA0,pA1,pB0,pB1,t+1,true,true,true);   WAIT_BAR(2); RESC(); ROT();
  }
  #undef CMASK
  #define CMASK(P0,P1,t) do{int jb_=(t)-(NT-4); if(jb_>=0)cmask(P0,P1,jb_,qrel,hi);}while(0)
  #define ENDW(tt) do{ if((tt)+3<NT){WAIT_BAR(2);} else if((tt)+2<NT){WAIT_BAR(1);} else {WAIT_BAR(0);} }while(0)
  for(;t+1<NT;t+=2){
    STEP(pB0,pB1,pA0,pA1,t,(t+3<NT),(t+1<NT),(t+1<NT));       ENDW(t);   RESC(); ROT();
    STEP(pA0,pA1,pB0,pB1,t+1,(t+4<NT),(t+2<NT),(t+2<NT));     ENDW(t+1); RESC(); ROT();
  }
  STEP(pB0,pB1,pA0,pA1,NT-1,false,false,false); RESC();
  { float sacc=pB0[0]+pB0[1]; _Pragma("unroll") for(int r=2;r<16;++r)sacc+=pB0[r]; _Pragma("unroll") for(int r=0;r<16;++r)sacc+=pB1[r]; l_reg+=sacc;
    pw0=(u32x4){PKW(pB0,0),PKW(pB0,2),PKW(pB0,4),PKW(pB0,6)};pw1=(u32x4){PKW(pB0,8),PKW(pB0,10),PKW(pB0,12),PKW(pB0,14)};pw2=(u32x4){PKW(pB1,0),PKW(pB1,2),PKW(pB1,4),PKW(pB1,6)};pw3=(u32x4){PKW(pB1,8),PKW(pB1,10),PKW(pB1,12),PKW(pB1,14)};
    SBAR(); pv(o,vb0+sl_cur,PAF(0),PAF(1),PAF(2),PAF(3)); }
  #undef PKW
  #undef PAF
  #undef VFR
  #undef PIN
  #undef MX3
  #undef GAPA
  #undef GAPB
  #undef EX
  #undef VRD
  #undef KRD
  #undef STEP
  #undef ENDW
  {auto rr=__builtin_amdgcn_permlane32_swap(__float_as_uint(l_reg),__float_as_uint(l_reg),false,false);l_reg=__uint_as_float(rr[0])+__uint_as_float(rr[1]);}
  if(hi==0)wsf[32+r32]=l_reg;asm volatile("s_waitcnt lgkmcnt(0)":::"memory");
  float rli[16];
  #pragma unroll
  for(int r=0;r<16;++r)rli[r]=__builtin_amdgcn_rcpf(wsf[32+crow(r,hi)]);
  int lno=lane; asm volatile("":"+v"(lno));
  bf16*Ow=O+(long)(q0+wid*QBLK)*DMO;
  { bf16*stg=(bf16*)(shm+LDS_OST)+wid*2048;
    #pragma unroll
    for(int r=0;r<16;++r){const int orow=crow(r,hi);
      #pragma unroll
      for(int d0=0;d0<2;++d0)stg[orow*64+d0*32+r32]=(bf16)(cvtpk_s(o[d0][r]*rli[r],0.f)&0xffffu);}
    asm volatile("s_waitcnt lgkmcnt(0)":::"memory");
    #pragma unroll
    for(int i=0;i<4;++i){const int row=i*8+(lno>>3),ch=lno&7; const u32x4 v=*(const u32x4*)(stg+row*64+ch*8); ATTN_STORE16(Ow+(long)row*DMO+ch*8,v);} }
  asm volatile("s_waitcnt lgkmcnt(0)\n\ts_barrier":::"memory");
  #undef DMA_K
  #undef DMA_V
  #undef CMASK
  #undef START
  #undef RESC
  #undef ROT
}
constexpr int ATTN_LDS_BYTES=LDS_BYTES;
#undef SBAR
#undef WAIT_BAR
#undef SETNEGM
}
namespace attl {
using bf16=bf16_t;
using bf16x8=__attribute__((ext_vector_type(8)))short;
using s16x4=__attribute__((ext_vector_type(4)))short;
using f32x16=__attribute__((ext_vector_type(16)))float;
using u32x4=__attribute__((ext_vector_type(4)))unsigned;
using f32x4=__attribute__((ext_vector_type(4)))float;
constexpr int DMK=768,DMV=512,DMO=1024;
constexpr int NW=8,QBLK=32,QB=QBLK*NW,KVBLK=64;
__device__ __forceinline__ int crow(int r,int hi){return (r&3)+8*(r>>2)+4*hi;}
#define SBAR() __builtin_amdgcn_sched_barrier(0)
__device__ __forceinline__ void cmask(f32x16&p0,f32x16&p1,int jb,int qrel,int hi){
  const float NEG=-INFINITY; int kb=64*jb+4*hi;
  #pragma unroll
  for(int r=0;r<16;++r){int kv=kb+(r&3)+8*(r>>2); if(kv>qrel)p0[r]=NEG; if(kv+32>qrel)p1[r]=NEG;}
}

constexpr int NSLOT=3, SLOTK=12288, SLOTV=8192;
constexpr int LDS_K=0, LDS_V=NSLOT*SLOTK, LDS_WS=LDS_V+NSLOT*SLOTV, LDS_OST=LDS_WS+NW*64*4, LDS_BYTES=LDS_OST+NW*4096;
constexpr float C2=0.125f*1.4426950408889634f;
__device__ __forceinline__ void glds16(const void*gsrc,unsigned lds_dst){unsigned keep;
  asm volatile("s_mov_b32 %0, m0\n\ts_mov_b32 m0, %2\n\ts_nop 0\n\tglobal_load_lds_dwordx4 %1, off\n\ts_mov_b32 m0, %0":"=&s"(keep):"v"(gsrc),"s"(lds_dst):"memory");}
__device__ __forceinline__ float max3f(float a,float b,float c){float r;asm("v_max3_f32 %0, %1, %2, %3":"=v"(r):"v"(a),"v"(b),"v"(c));return r;}
__device__ __forceinline__ float max2f(float a,float b){float r;asm("v_max_f32_e32 %0, %1, %2":"=v"(r):"v"(a),"v"(b));return r;}
__device__ __forceinline__ float fadd_s(float a,float b){float r;asm("v_add_f32_e32 %0, %1, %2":"=v"(r):"v"(a),"v"(b));return r;}
__device__ __forceinline__ float fsub_s(float a,float b){float r;asm("v_sub_f32_e32 %0, %1, %2":"=v"(r):"v"(a),"v"(b));return r;}
typedef float f32x2_t __attribute__((ext_vector_type(2))); typedef __bf16 bf16x2_t __attribute__((ext_vector_type(2)));
__device__ __forceinline__ unsigned cvtpk_s(float lo,float hi){f32x2_t v={lo,hi};bf16x2_t b=__builtin_convertvector(v,bf16x2_t);return __builtin_bit_cast(unsigned,b);}
__device__ __forceinline__ void glds16s(const void*sbase,unsigned voff,unsigned lds_dst){unsigned keep;
  asm volatile("s_mov_b32 %0, m0\n\ts_mov_b32 m0, %3\n\ts_nop 0\n\tglobal_load_lds_dwordx4 %1, %2\n\ts_mov_b32 m0, %0":"=&s"(keep):"v"(voff),"s"(sbase),"s"(lds_dst):"memory");}
__device__ __forceinline__ const bf16_t* uptr(const bf16_t*p){ const unsigned long long v=(unsigned long long)p; const unsigned lo=__builtin_amdgcn_readfirstlane((unsigned)v),hi=__builtin_amdgcn_readfirstlane((unsigned)(v>>32)); return (const bf16_t*)(((unsigned long long)hi<<32)|lo); }
#define WAIT_BAR(N) asm volatile("s_waitcnt vmcnt(" #N ") lgkmcnt(0)\n\ts_barrier":::"memory")

__device__ __forceinline__ void qkt(f32x16&p0,f32x16&p1,const char*Kslot,const bf16x8*qr,const f32x16&negm,int r32,int hi){
  const char*kb=Kslot+hi*1024+r32*16;
  #pragma unroll
  for(int d0=0;d0<6;++d0){
    const bf16x8 b0=*reinterpret_cast<const bf16x8*>(kb+d0*2048);
    const bf16x8 b1=*reinterpret_cast<const bf16x8*>(kb+d0*2048+512);
    if(d0==0){p0=__builtin_amdgcn_mfma_f32_32x32x16_bf16(b0,qr[0],negm,0,0,0);p1=__builtin_amdgcn_mfma_f32_32x32x16_bf16(b1,qr[0],negm,0,0,0);}
    else{p0=__builtin_amdgcn_mfma_f32_32x32x16_bf16(b0,qr[d0],p0,0,0,0);p1=__builtin_amdgcn_mfma_f32_32x32x16_bf16(b1,qr[d0],p1,0,0,0);}}
}
typedef __attribute__((address_space(3))) const char* lds_cptr;
typedef short v4i16_t __attribute__((ext_vector_type(4)));
__device__ __forceinline__ void kload8(bf16x8*kf,lds_cptr kp){
  kf[0]=*(const __attribute__((address_space(3))) bf16x8*)(kp);      kf[1]=*(const __attribute__((address_space(3))) bf16x8*)(kp+512);
  kf[2]=*(const __attribute__((address_space(3))) bf16x8*)(kp+2048); kf[3]=*(const __attribute__((address_space(3))) bf16x8*)(kp+2560);
  kf[4]=*(const __attribute__((address_space(3))) bf16x8*)(kp+4096); kf[5]=*(const __attribute__((address_space(3))) bf16x8*)(kp+4608);
  kf[6]=*(const __attribute__((address_space(3))) bf16x8*)(kp+6144); kf[7]=*(const __attribute__((address_space(3))) bf16x8*)(kp+6656);
  kf[8]=*(const __attribute__((address_space(3))) bf16x8*)(kp+8192); kf[9]=*(const __attribute__((address_space(3))) bf16x8*)(kp+8704);
  kf[10]=*(const __attribute__((address_space(3))) bf16x8*)(kp+10240); kf[11]=*(const __attribute__((address_space(3))) bf16x8*)(kp+10752);
}
__device__ __forceinline__ void kload2(bf16x8*kf,lds_cptr kp,int j){ kf[2*j]=*(const __attribute__((address_space(3))) bf16x8*)(kp+j*2048); kf[2*j+1]=*(const __attribute__((address_space(3))) bf16x8*)(kp+j*2048+512); }
__device__ __forceinline__ s16x4 vtr(lds_cptr p){ return __builtin_bit_cast(s16x4,__builtin_amdgcn_ds_read_tr16_b64_v4i16((__attribute__((address_space(3))) v4i16_t*)p)); }
__device__ __forceinline__ float rowmax(const f32x16&p0,const f32x16&p1){
  float a=max3f(p0[0],p0[1],p1[0]),b=max3f(p0[2],p0[3],p1[1]);a=max3f(a,p1[2],p1[3]);
  #pragma unroll
  for(int r=4;r<16;r+=4){a=max3f(a,p0[r],p0[r+1]);b=max3f(b,p0[r+2],p0[r+3]);a=max3f(a,p1[r],p1[r+1]);b=max3f(b,p1[r+2],p1[r+3]);}
  const float m=max2f(a,b);
  auto rr=__builtin_amdgcn_permlane32_swap(__float_as_uint(m),__float_as_uint(m),false,false);
  return max2f(__uint_as_float(rr[0]),__uint_as_float(rr[1]));
}
__device__ __forceinline__ void pv(f32x16*o,int vb,bf16x8 pa0,bf16x8 pa1,bf16x8 pa2,bf16x8 pa3){
  #pragma unroll
  for(int d0=0;d0<2;++d0){s16x4 lo[4],hi[4];
    #pragma unroll
    for(int ks=0;ks<4;++ks){
      asm volatile("ds_read_b64_tr_b16 %0,%1 offset:%c2":"=&v"(lo[ks]):"v"(vb),"i"(d0*4096+ks*1024):"memory");
      asm volatile("ds_read_b64_tr_b16 %0,%1 offset:%c2":"=&v"(hi[ks]):"v"(vb),"i"(d0*4096+ks*1024+512):"memory");}
    asm volatile("s_waitcnt lgkmcnt(0)":::"memory");SBAR();
    #define PK(k) (bf16x8){lo[k][0],lo[k][1],lo[k][2],lo[k][3],hi[k][0],hi[k][1],hi[k][2],hi[k][3]}
    o[d0]=__builtin_amdgcn_mfma_f32_32x32x16_bf16(pa0,PK(0),o[d0],0,0,0);
    o[d0]=__builtin_amdgcn_mfma_f32_32x32x16_bf16(pa1,PK(1),o[d0],0,0,0);
    o[d0]=__builtin_amdgcn_mfma_f32_32x32x16_bf16(pa2,PK(2),o[d0],0,0,0);
    o[d0]=__builtin_amdgcn_mfma_f32_32x32x16_bf16(pa3,PK(3),o[d0],0,0,0);
    #undef PK
  }
}

#ifndef ATTN_STORE16
#define ATTN_STORE16(p,v) (*(u32x4*)(p)=(v))
#endif
template<int THRL> __device__ __forceinline__ void attn_unit(int qb,const bf16*Q,const bf16*__restrict__ K,const bf16*__restrict__ V,bf16*O,const Ctx&B,char*shm){
  const int tid=threadIdx.x; int lane=tid&63; asm volatile("":"+v"(lane));
  const int r32=lane&31,hi=lane>>5; const int wid=__builtin_amdgcn_readfirstlane(tid>>6);
  const int q0=qb*QB;
  const bf16*Qw=Q+(long)(q0+wid*QBLK)*DMK;
  const bf16*Kh=K,*Vh=V;
  const unsigned lds0=(unsigned)(uintptr_t)shm;
  float*wsf=(float*)(shm+LDS_WS)+wid*64;
  const unsigned koff=(unsigned)(lane*DMK+wid*8)*2u, koff2=(unsigned)(lane*DMK+(8+(wid&3))*8)*2u;
  const unsigned voffv=(unsigned)((16*(wid&3)+(lane>>2))*DMV+(wid>>2)*32+(lane&3)*8)*2u;
  const unsigned kdst=lds0+LDS_K+wid*1024, kdst2=lds0+LDS_K+(8+(wid&3))*1024, vdst=lds0+LDS_V+wid*1024;
  #define DMA_K(t,slot) do{ const bf16*kb_=uptr(Kh+(long)(t)*KVBLK*DMK); glds16s(kb_,koff,(unsigned)__builtin_amdgcn_readfirstlane(kdst+(slot)*SLOTK)); glds16s(kb_,koff2,(unsigned)__builtin_amdgcn_readfirstlane(kdst2+(slot)*SLOTK)); }while(0)
  #define DMA_V(t,slot) glds16s(uptr(Vh+(long)(t)*KVBLK*DMV),voffv,(unsigned)__builtin_amdgcn_readfirstlane(vdst+(slot)*SLOTV))
  const int vb0=(int)(lds0+LDS_V)+((lane>>4)&1)*32+(lane&3)*8+(4*hi+((lane&15)>>2))*64;
  const char*Kbase=shm+LDS_K; bf16x8 kf[12];
  const lds_cptr shm3=(lds_cptr)shm; const lds_cptr kp0=shm3+LDS_K+hi*1024+r32*16; const lds_cptr vp0=shm3+LDS_V+((lane>>4)&1)*32+(lane&3)*8+(4*hi+((lane&15)>>2))*64;
  const int NT=(q0+QB)/KVBLK;
  DMA_K(0,0);DMA_V(0,0);DMA_K(1,1);
  bf16x8 qr[6];
  { u32x4 raw[6]; float ss=0.f; const bf16*Ql=Qw+(long)r32*DMK+hi*8;
    #pragma unroll
    for(int d0=0;d0<6;++d0){ raw[d0]=__builtin_nontemporal_load(reinterpret_cast<const u32x4*>(Ql+d0*16));
      #pragma unroll
      for(int w=0;w<4;++w){ const float a=__uint_as_float(raw[d0][w]<<16),bb=__uint_as_float(raw[d0][w]&0xffff0000u); ss+=a*a+bb*bb; } }
    { auto rr=__builtin_amdgcn_permlane32_swap(__float_as_uint(ss),__float_as_uint(ss),false,false); ss=__uint_as_float(rr[0])+__uint_as_float(rr[1]); }
    const float rq=(1.0f/sqrtf(ss*(1.0f/96)+EPS))*C2B; const float*g=B.glq()+hi*8;
    float qf[6][8];
    #pragma unroll
    for(int d0=0;d0<6;++d0){ const f32x4 ga=*(const f32x4*)(g+d0*16),gb=*(const f32x4*)(g+d0*16+4);
      #pragma unroll
      for(int w=0;w<4;++w){ qf[d0][2*w]=__uint_as_float(raw[d0][w]<<16)*rq*(w<2?ga[2*w]:gb[2*w-4]); qf[d0][2*w+1]=__uint_as_float(raw[d0][w]&0xffff0000u)*rq*(w<2?ga[2*w+1]:gb[2*w-3]); } }
    { const int pos=q0+wid*QBLK+r32; const f32x4 ca=*(const f32x4*)(B.COSB()+pos*16+hi*8),cb=*(const f32x4*)(B.COSB()+pos*16+hi*8+4),sa=*(const f32x4*)(B.SINB()+pos*16+hi*8),sb=*(const f32x4*)(B.SINB()+pos*16+hi*8+4);
      #pragma unroll
      for(int j=0;j<8;++j){ const float c=j<4?ca[j]:cb[j-4],sn=j<4?sa[j]:sb[j-4],x1=qf[4][j],x2=qf[5][j]; qf[4][j]=x1*c-x2*sn; qf[5][j]=x2*c+x1*sn; } }
    #pragma unroll
    for(int d0=0;d0<6;++d0){ const u32x4 w={cvtpk_s(qf[d0][0],qf[d0][1]),cvtpk_s(qf[d0][2],qf[d0][3]),cvtpk_s(qf[d0][4],qf[d0][5]),cvtpk_s(qf[d0][6],qf[d0][7])}; qr[d0]=__builtin_bit_cast(bf16x8,w); } }
  float mhat=0.f,l_reg=0.f;f32x16 o[2];o[0]=f32x16{};o[1]=f32x16{};
  #define MSUB(tt) (mhat)
  const int qrel=wid*QBLK+r32;
  #define CMASK(P0,P1,t) do{int jb_=(t)-(NT-4); if(jb_>=0)cmask(P0,P1,jb_,qrel,hi);}while(0)
  bool resc=false;
  #define START(P0,P1) do{ const float rm=fsub_s(rowmax(P0,P1),MSUB(0)); resc=false; \
    { const float dl=(rm==-INFINITY)?0.f:rm; mhat=fadd_s(mhat,dl); } \
    msub0=MSUB(0); \
    _Pragma("unroll") for(int r=0;r<16;++r)P0[r]=__builtin_amdgcn_exp2f(fsub_s(P0[r],msub0)); }while(0)
  #define RESC() do{ if(resc){ asm volatile("s_waitcnt lgkmcnt(0)":::"memory"); \
      _Pragma("unroll") for(int d_=0;d_<2;++d_) _Pragma("unroll") for(int r=0;r<16;++r)o[d_][r]*=wsf[crow(r,hi)]; } }while(0)
  f32x16 pA0,pA1,pB0,pB1;
  int sl_prev=0,sl_cur=0,sl_next=1;
  #define ROT() do{sl_prev=sl_cur;sl_cur=sl_next;sl_next=(sl_next==NSLOT-1)?0:sl_next+1;}while(0)
  DMA_K(2,2);
  WAIT_BAR(5);
  const f32x16 zc=f32x16{}; float msub0;
  qkt(pA0,pA1,Kbase,qr,zc,r32,hi);asm volatile("s_nop 15\n\ts_nop 7":"+v"(pA0),"+v"(pA1));CMASK(pA0,pA1,0);
  START(pA0,pA1);
  _Pragma("unroll") for(int r=0;r<16;++r)pA1[r]=__builtin_amdgcn_exp2f(fsub_s(pA1[r],msub0));
  WAIT_BAR(0);
  DMA_K(3,0);DMA_V(1,1);
  ROT();
  kload8(kf,kp0+sl_cur*SLOTK);
  WAIT_BAR(3);
  s16x4 vlo[8],vhi[8]; u32x4 pw0,pw1,pw2,pw3;
  #define PKW(P,B) cvtpk_s(P[B],P[B+1])
  #define PAF(k) __builtin_bit_cast(bf16x8,pw##k)
  #define VFR(i) (bf16x8){vlo[i][0],vlo[i][1],vlo[i][2],vlo[i][3],vhi[i][0],vhi[i][1],vhi[i][2],vhi[i][3]}
  #define PIN(x) asm volatile("":"+v"(x))
  #define MX3(a,b,c) __builtin_fmaxf(__builtin_fmaxf((a),(b)),(c))
  #define GAPA(MF,A0,A1,A2,A3,W0,W1,PW) do{ MF; sacc+=A0; sacc+=A1; sacc+=A2; sacc+=A3; PIN(sacc); W0; W1; PIN(PW); SBAR(); }while(0)
  #define EX(v) __builtin_amdgcn_exp2f((v)-msub)
  #define GAPB(MF,X,B) do{ MF; X[B]=EX(X[B]); X[B+1]=EX(X[B+1]); X[B+2]=EX(X[B+2]); X[B+3]=EX(X[B+3]); PIN(X); SBAR(); }while(0)
  #define VRD(i) do{ vlo[i]=vtr(vp_+(((i)>>2)*4096+((i)&3)*1024)); vhi[i]=vtr(vp_+(((i)>>2)*4096+((i)&3)*1024+512)); }while(0)
  #define KRD(G,j) do{ if(G){ kload2(kf,kp0+sl_next*SLOTK,j); SBAR(); } }while(0)
  #define STEP(C0,C1,P0,P1,t,GK,GV,GL) do{ SBAR(); float msub; \
    const lds_cptr vp_=vp0+sl_prev*SLOTV; \
    C0=__builtin_amdgcn_mfma_f32_32x32x16_bf16(kf[8],qr[4],zc,0,0,0); C1=__builtin_amdgcn_mfma_f32_32x32x16_bf16(kf[9],qr[4],zc,0,0,0); SBAR(); \
    C0=__builtin_amdgcn_mfma_f32_32x32x16_bf16(kf[10],qr[5],C0,0,0,0); C1=__builtin_amdgcn_mfma_f32_32x32x16_bf16(kf[11],qr[5],C1,0,0,0); SBAR(); \
    VRD(0); SBAR(); float sacc=(P0[0]+P0[1]); \
    GAPA(C0=__builtin_amdgcn_mfma_f32_32x32x16_bf16(kf[0],qr[0],C0,0,0,0), P0[2],P0[3],P0[4],P0[5],     pw0[0]=PKW(P0,0), pw0[1]=PKW(P0,2), pw0); \
    VRD(4); SBAR(); GAPA(C1=__builtin_amdgcn_mfma_f32_32x32x16_bf16(kf[1],qr[0],C1,0,0,0), P0[6],P0[7],P0[8],P0[9],     pw0[2]=PKW(P0,4), pw0[3]=PKW(P0,6), pw0); \
    VRD(1); SBAR(); GAPA(C0=__builtin_amdgcn_mfma_f32_32x32x16_bf16(kf[2],qr[1],C0,0,0,0),   P0[10],P0[11],P0[12],P0[13], pw1[0]=PKW(P0,8), pw1[1]=PKW(P0,10), pw1); \
    VRD(5); SBAR(); GAPA(C1=__builtin_amdgcn_mfma_f32_32x32x16_bf16(kf[3],qr[1],C1,0,0,0),   P0[14],P0[15],P1[0],P1[1],   pw1[2]=PKW(P0,12),pw1[3]=PKW(P0,14), pw1); \
    VRD(2); SBAR(); GAPA(C0=__builtin_amdgcn_mfma_f32_32x32x16_bf16(kf[4],qr[2],C0,0,0,0),   P1[2],P1[3],P1[4],P1[5],     pw2[0]=PKW(P1,0), pw2[1]=PKW(P1,2), pw2); \
    VRD(6); SBAR(); GAPA(C1=__builtin_amdgcn_mfma_f32_32x32x16_bf16(kf[5],qr[2],C1,0,0,0),   P1[6],P1[7],P1[8],P1[9],     pw2[2]=PKW(P1,4), pw2[3]=PKW(P1,6), pw2); \
    VRD(3); SBAR(); GAPA(C0=__builtin_amdgcn_mfma_f32_32x32x16_bf16(kf[6],qr[3],C0,0,0,0),   P1[10],P1[11],P1[12],P1[13], pw3[0]=PKW(P1,8), pw3[1]=PKW(P1,10), pw3); \
    VRD(7); SBAR(); GAPA(C1=__builtin_amdgcn_mfma_f32_32x32x16_bf16(kf[7],qr[3],C1,0,0,0),   P1[14],P1[15],0.f,0.f,       pw3[2]=PKW(P1,12),pw3[3]=PKW(P1,14), pw3); \
    l_reg+=sacc; \
    if(GK){DMA_K((t)+3,sl_cur);} if(GV){DMA_V((t)+1,sl_next);} \
    CMASK(C0,C1,t); \
    { float a=MX3(C0[0],C0[1],C1[0]),b=MX3(C0[2],C0[3],C1[1]); a=MX3(a,C1[2],C1[3]); \
      _Pragma("unroll") for(int r=4;r<16;r+=4){a=MX3(a,C0[r],C0[r+1]);b=MX3(b,C0[r+2],C0[r+3]);a=MX3(a,C1[r],C1[r+1]);b=MX3(b,C1[r+2],C1[r+3]);} \
      float rm=__builtin_fmaxf(a,b); { auto rr=__builtin_amdgcn_permlane32_swap(__float_as_uint(rm),__float_as_uint(rm),false,false); rm=__builtin_fmaxf(__uint_as_float(rr[0]),__uint_as_float(rr[1])); } \
      msub=MSUB(t); rm-=msub; \
      resc=false; \
      if(__builtin_expect(__any(rm>(float)THRL),0)){ const float dl=__builtin_fmaxf(rm,0.f); mhat+=dl; msub+=dl; \
        const float f=__builtin_amdgcn_exp2f(-dl); l_reg*=f; if(hi==0)wsf[r32]=f; resc=true; } } \
    SBAR(); \
    GAPB(o[0]=__builtin_amdgcn_mfma_f32_32x32x16_bf16(PAF(0),VFR(0),o[0],0,0,0), C0,0); \
    KRD(GL,0); GAPB(o[1]=__builtin_amdgcn_mfma_f32_32x32x16_bf16(PAF(0),VFR(4),o[1],0,0,0), C0,4); \
    KRD(GL,1); GAPB(o[0]=__builtin_amdgcn_mfma_f32_32x32x16_bf16(PAF(1),VFR(1),o[0],0,0,0), C0,8); \
    KRD(GL,2); GAPB(o[1]=__builtin_amdgcn_mfma_f32_32x32x16_bf16(PAF(1),VFR(5),o[1],0,0,0), C0,12); \
    KRD(GL,3); GAPB(o[0]=__builtin_amdgcn_mfma_f32_32x32x16_bf16(PAF(2),VFR(2),o[0],0,0,0), C1,0); \
    KRD(GL,4); GAPB(o[1]=__builtin_amdgcn_mfma_f32_32x32x16_bf16(PAF(2),VFR(6),o[1],0,0,0), C1,4); \
    KRD(GL,5); GAPB(o[0]=__builtin_amdgcn_mfma_f32_32x32x16_bf16(PAF(3),VFR(3),o[0],0,0,0), C1,8); \
    GAPB(o[1]=__builtin_amdgcn_mfma_f32_32x32x16_bf16(PAF(3),VFR(7),o[1],0,0,0), C1,12); \
    }while(0)
  int t=1;
  #undef CMASK
  #define CMASK(P0,P1,t) do{}while(0)
  for(;t+5<NT;t+=2){
    STEP(pB0,pB1,pA0,pA1,t,true,true,true);     WAIT_BAR(3); RESC(); ROT();
    STEP(pA0,pA1,pB0,pB1,t+1,true,true,true);   WAIT_BAR(3); RESC(); ROT();
  }
  #undef CMASK
  #define CMASK(P0,P1,t) do{int jb_=(t)-(NT-4); if(jb_>=0)cmask(P0,P1,jb_,qrel,hi);}while(0)
  #define ENDW(tt) do{ if((tt)+3<NT){WAIT_BAR(3);} else if((tt)+2<NT){WAIT_BAR(1);} else {WAIT_BAR(0);} }while(0)
  for(;t+1<NT;t+=2){
    STEP(pB0,pB1,pA0,pA1,t,(t+3<NT),(t+1<NT),(t+1<NT));       ENDW(t);   RESC(); ROT();
    STEP(pA0,pA1,pB0,pB1,t+1,(t+4<NT),(t+2<NT),(t+2<NT));     ENDW(t+1); RESC(); ROT();
  }
  STEP(pB0,pB1,pA0,pA1,NT-1,false,false,false); RESC();
  { float sacc=pB0[0]+pB0[1]; _Pragma("unroll") for(int r=2;r<16;++r)sacc+=pB0[r]; _Pragma("unroll") for(int r=0;r<16;++r)sacc+=pB1[r]; l_reg+=sacc;
    pw0=(u32x4){PKW(pB0,0),PKW(pB0,2),PKW(pB0,4),PKW(pB0,6)};pw1=(u32x4){PKW(pB0,8),PKW(pB0,10),PKW(pB0,12),PKW(pB0,14)};pw2=(u32x4){PKW(pB1,0),PKW(pB1,2),PKW(pB1,4),PKW(pB1,6)};pw3=(u32x4){PKW(pB1,8),PKW(pB1,10),PKW(pB1,12),PKW(pB1,14)};
    SBAR(); pv(o,vb0+sl_cur*SLOTV,PAF(0),PAF(1),PAF(2),PAF(3)); }
  #undef PKW
  #undef PAF
  #undef VFR
  #undef PIN
  #undef MX3
  #undef GAPA
  #undef GAPB
  #undef EX
  #undef VRD
  #undef KRD
  #undef STEP
  #undef ENDW
  {auto rr=__builtin_amdgcn_permlane32_swap(__float_as_uint(l_reg),__float_as_uint(l_reg),false,false);l_reg=__uint_as_float(rr[0])+__uint_as_float(rr[1]);}
  if(hi==0)wsf[32+r32]=l_reg;asm volatile("s_waitcnt lgkmcnt(0)":::"memory");
  float rli[16];
  #pragma unroll
  for(int r=0;r<16;++r)rli[r]=__builtin_amdgcn_rcpf(wsf[32+crow(r,hi)]);
  int lno=lane; asm volatile("":"+v"(lno));
  bf16*Ow=O+(long)(q0+wid*QBLK)*DMO;
  { bf16*stg=(bf16*)(shm+LDS_OST)+wid*2048;
    #pragma unroll
    for(int r=0;r<16;++r){const int orow=crow(r,hi);
      #pragma unroll
      for(int d0=0;d0<2;++d0)stg[orow*64+d0*32+r32]=(bf16)(cvtpk_s(o[d0][r]*rli[r],0.f)&0xffffu);}
    asm volatile("s_waitcnt lgkmcnt(0)":::"memory");
    #pragma unroll
    for(int i=0;i<4;++i){const int row=i*8+(lno>>3),ch=lno&7; const u32x4 v=*(const u32x4*)(stg+row*64+ch*8); ATTN_STORE16(Ow+(long)row*DMO+ch*8,v);} }
  asm volatile("s_waitcnt lgkmcnt(0)\n\ts_barrier":::"memory");
  #undef DMA_K
  #undef DMA_V
  #undef CMASK
  #undef START
  #undef RESC
  #undef ROT
}
constexpr int ATTN_LDS_BYTES=LDS_BYTES;
#undef SBAR
#undef WAIT_BAR
#undef MSUB
}
#ifndef P1_WGM
#define P1_WGM 8
#endif
constexpr int NWAVES = 8;
constexpr int N_PHASES = 7;
constexpr int CW_TMO = 0, CW_CODE = 1;
constexpr int CW_BAR = 4096;
constexpr int CW_DEP4 = 65536, CW_DEP5 = CW_DEP4 + 128 * 64;
constexpr int CW_GRP = 32768;
constexpr int RING_OFF = 0, RING_BYTES = 131072;
constexpr int LDSCTL_OFF = RING_BYTES, MISC_OFF = LDSCTL_OFF + 320;
constexpr int LDS_BYTES = 147456;
static_assert(attm::ATTN_LDS_BYTES <= RING_BYTES && attl::ATTN_LDS_BYTES <= RING_BYTES && pg8::STAGE_BYTES <= RING_BYTES, "LDS map");

#define GAS __attribute__((address_space(1)))
#define LAS __attribute__((address_space(3)))
typedef unsigned v4u __attribute__((ext_vector_type(4)));
typedef float f32x4 __attribute__((ext_vector_type(4)));
typedef GAS unsigned gu32;
#define RLX_AGENT __ATOMIC_RELAXED, __HIP_MEMORY_SCOPE_AGENT
#define LDS_WAIT() asm volatile("s_waitcnt lgkmcnt(0)" ::: "memory")
#define VM_WAIT() asm volatile("s_waitcnt vmcnt(0)" ::: "memory")
__device__ __forceinline__ unsigned f2bf(float f) { unsigned u = __builtin_bit_cast(unsigned, f); return (u + 0x7fffu + ((u >> 16) & 1u)) >> 16; }
__device__ __forceinline__ unsigned pk2(float lo, float hi) { return f2bf(lo) | (f2bf(hi) << 16); }

#define XB_TMO      128
#define XB_XCNT(j)  (256  + 64 * (j))
#define XB_XSUB(j)  (1280 + 64 * (j))
#define XB_XGEN(j)  (2304 + 64 * (j))
#define XB_TOP      3328
#define XB_TOPGEN   3392
#define XCD_BAR_WORDS 3456
#define XB_SPIN_CAP (1u << 18)
__device__ __forceinline__ unsigned xb_ld(unsigned* p)              { return __hip_atomic_load(p, __ATOMIC_RELAXED, __HIP_MEMORY_SCOPE_AGENT); }
__device__ __forceinline__ unsigned xb_add(unsigned* p, unsigned v) { return __hip_atomic_fetch_add(p, v, __ATOMIC_RELAXED, __HIP_MEMORY_SCOPE_AGENT); }
__device__ __forceinline__ unsigned xb_xcc_id() { return (unsigned)__builtin_amdgcn_s_getreg((3 << 11) | 20) & 0xFu; }
#define XB_SPIN(cond, bar) do { unsigned _sp = 0; while (cond) { __builtin_amdgcn_s_sleep(1); \
    if ((++_sp & 255u) == 0u) { if (xb_ld(&(bar)[XB_TMO])) break; if (_sp > XB_SPIN_CAP) { atomicAdd(&(bar)[XB_TMO], 1u); break; } } } } while (0)
struct XcdBarrier { unsigned* bar; unsigned x; volatile LAS unsigned* st; };
__device__ __forceinline__ XcdBarrier xcd_barrier_post(unsigned* bar, volatile LAS unsigned* st) {
    XcdBarrier b; b.bar = bar; b.x = xb_xcc_id(); b.st = st;
    if (threadIdx.x == 0) (void)xb_add(&bar[XB_XCNT(b.x)], 1u);
    return b;
}
__device__ __forceinline__ void xcd_barrier_complete(unsigned* bar, unsigned x, unsigned& nloc, unsigned& nx) {
    const unsigned G = gridDim.x * gridDim.y * gridDim.z;
    unsigned sum, cnt, mine, sp = 0u;
    for (;;) {
        sum = 0u; cnt = 0u; mine = 0u;
#pragma unroll
        for (unsigned j = 0; j < 16; ++j) { const unsigned c = xb_ld(&bar[XB_XCNT(j)]); sum += c; cnt += (c > 0u) ? 1u : 0u; mine = (j == x) ? c : mine; }
        if (sum == G) break;
        __builtin_amdgcn_s_sleep(1);
        if ((++sp & 255u) == 0u) { if (xb_ld(&bar[XB_TMO])) break; if (sp > XB_SPIN_CAP) { atomicAdd(&bar[XB_TMO], 1u); break; } }
    }
    nloc = mine > 0u ? mine : 1u; nx = cnt > 0u ? cnt : 1u;
}
__device__ __forceinline__ void xcd_barrier(const XcdBarrier& b) {
    asm volatile("s_waitcnt vmcnt(0)" ::: "memory");
    __syncthreads();
    if (threadIdx.x == 0) {
        unsigned* bar = b.bar;
        __builtin_amdgcn_s_waitcnt(0);
        unsigned nloc = b.st[0], nx = b.st[1];
        if (nloc == 0u) { xcd_barrier_complete(bar, b.x, nloc, nx); b.st[0] = nloc; b.st[1] = nx; }
        const unsigned old = xb_add(&bar[XB_XSUB(b.x)], 1u);
        const unsigned gen = old / nloc;
        if (old + 1u == (gen + 1u) * nloc) {
            __builtin_amdgcn_fence(__ATOMIC_RELEASE, "agent");
            asm volatile("s_waitcnt vmcnt(0)" ::: "memory");
            const unsigned og = xb_add(&bar[XB_TOP], 1u);
            const unsigned tg = og / nx;
            if (og + 1u == (tg + 1u) * nx) xb_add(&bar[XB_TOPGEN], 1u);
            else XB_SPIN(xb_ld(&bar[XB_TOPGEN]) == tg, bar);
            __builtin_amdgcn_fence(__ATOMIC_ACQUIRE, "agent");
            xb_add(&bar[XB_XGEN(b.x)], 1u);
            asm volatile("s_waitcnt vmcnt(0)" ::: "memory");
        } else {
            XB_SPIN(xb_ld(&bar[XB_XGEN(b.x)]) == gen, bar);
            __builtin_amdgcn_fence(__ATOMIC_ACQUIRE, "agent");
            asm volatile("s_waitcnt vmcnt(0)" ::: "memory");
        }
    }
    __syncthreads();
}

struct GrpBarrier { unsigned* cnt; unsigned size, gen; };
__device__ __forceinline__ void grp_barrier(GrpBarrier& b, unsigned* tmo) {
    asm volatile("s_waitcnt vmcnt(0)" ::: "memory");
    __syncthreads();
    if (threadIdx.x == 0) {
        __builtin_amdgcn_fence(__ATOMIC_RELEASE, "agent");
        asm volatile("s_waitcnt vmcnt(0)" ::: "memory");
        (void)xb_add(b.cnt, 1u);
        const unsigned target = b.size * (b.gen + 1u); unsigned sp = 0u;
        while (xb_ld(b.cnt) < target) { __builtin_amdgcn_s_sleep(1); if ((++sp & 255u) == 0u) { if (xb_ld(tmo)) break; if (sp > XB_SPIN_CAP) { atomicAdd(tmo, 1u); break; } } }
        __builtin_amdgcn_fence(__ATOMIC_ACQUIRE, "agent");
        asm volatile("s_waitcnt vmcnt(0)" ::: "memory");
    }
    b.gen += 1u;
    __syncthreads();
}

__device__ __forceinline__ void p0_item(const float* W, int ldw, int col0, int ksrc0, const float* gain, bf16_t* WT, int Kdst, int rowdst0, int kdst0, LAS float* scr, int lane) {
    const int c = lane & 7;
    if (W == nullptr) {
#pragma unroll
        for (int j = 0; j < 4; ++j) { const int n = (lane >> 3) + 8 * j; *(GAS v4u*)(WT + (size_t)(rowdst0 + n) * Kdst + kdst0 + 8 * c) = (v4u){0u, 0u, 0u, 0u}; }
        return; }
    const float gvec = gain ? gain[ksrc0 + lane] : 1.0f;
    float wv[32];
#pragma unroll
    for (int i = 0; i < 32; ++i) wv[i] = __builtin_nontemporal_load(W + (size_t)(ksrc0 + 2 * i + (lane >> 5)) * ldw + col0 + (lane & 31));
#pragma unroll
    for (int i = 0; i < 32; ++i) { const int kk = 2 * i + (lane >> 5); scr[kk * 33 + (lane & 31)] = wv[i] * __shfl(gvec, kk); }
    LDS_WAIT(); asm volatile("" ::: "memory");
#pragma unroll
    for (int j = 0; j < 4; ++j) { const int n = (lane >> 3) + 8 * j; const LAS float* s = scr + (8 * c) * 33 + n;
        v4u o; o.x = pg8::cvt_pk_bf16(s[0 * 33], s[1 * 33]); o.y = pg8::cvt_pk_bf16(s[2 * 33], s[3 * 33]); o.z = pg8::cvt_pk_bf16(s[4 * 33], s[5 * 33]); o.w = pg8::cvt_pk_bf16(s[6 * 33], s[7 * 33]);
        *(GAS v4u*)(WT + (size_t)(rowdst0 + n) * Kdst + kdst0 + 8 * c) = o; }
    LDS_WAIT(); asm volatile("" ::: "memory");
}
__device__ __forceinline__ float wave_sum(float v) {
#pragma unroll
    for (int o = 1; o < 64; o <<= 1) v += __shfl_xor(v, o);
    return v;
}

struct Args { float* out; unsigned char* ws; int ph_lo, ph_hi, li, pad; const float* in[16]; };
__global__ void __launch_bounds__(NWAVES * 64, 2) fwd_mega(Args args) {
    extern __shared__ __attribute__((aligned(16))) unsigned char lds_raw[];
    LAS unsigned char* lds = (LAS unsigned char*)lds_raw;
    volatile LAS unsigned* MISC = (volatile LAS unsigned*)(lds + MISC_OFF);
    const int tid = threadIdx.x, lane = tid & 63, wave = __builtin_amdgcn_readfirstlane(tid >> 6);
    const int G = gridDim.x, bx = blockIdx.x, vcu = (G % 8 == 0) ? (bx % 8) * (G / 8) + bx / 8 : bx;
    unsigned char* ws = args.ws; Ctx B; B.x = nullptr; B.out = args.out; B.ws = ws;
    const float* const* inp = (const float* const*)((const char*)__builtin_amdgcn_kernarg_segment_ptr() + __builtin_offsetof(Args, in));
    gu32* ctl = (gu32*)(ws + WS_CTL);
    for (int u = tid; u < (LDS_BYTES - LDSCTL_OFF) / 4; u += NWAVES * 64) ((LAS unsigned*)(lds + LDSCTL_OFF))[u] = 0u;
    __syncthreads();
    XcdBarrier bar = xcd_barrier_post((unsigned*)(ctl + CW_BAR) + args.li * XCD_BAR_WORDS, MISC + 8);
#ifndef GROUPED_SEAMS
#define GROUPED_SEAMS 1
#endif
    const bool grouped = GROUPED_SEAMS && (G == 256);
    GrpBarrier gbar; gbar.cnt = (unsigned*)(ctl + CW_GRP) + (args.li * 8 + (bx & 7)) * 64; gbar.size = (unsigned)(G / 8); gbar.gen = 0u;
    const int lo = args.ph_lo, hi = args.ph_hi;
#ifndef PHASE_MASK
#define PHASE_MASK 0x7f
#endif
#define IN(k) (((PHASE_MASK >> (k)) & 1) && lo <= (k) && (k) < hi)
#ifndef REP0
#define REP0 1
#endif
#ifndef REP1
#define REP1 1
#endif
#ifndef REP2
#define REP2 1
#endif
#ifndef REP3
#define REP3 1
#endif
#ifndef REP4
#define REP4 1
#endif
#ifndef REP5
#define REP5 1
#endif
#ifndef DUPU1
#define DUPU1 0
#endif
#ifndef DUPU5
#define DUPU5 0
#endif
#ifndef DUPU6
#define DUPU6 0
#endif
#ifndef REPG
#define REPG 1
#endif
#ifndef REPB
#define REPB 1
#endif
#define SEAM(k) do { if (IN(k) && IN((k) + 1)) { for (int rb_ = 0; rb_ < REPB; ++rb_) { if ((k) == 0 || !grouped) xcd_barrier(bar); else grp_barrier(gbar, (unsigned*)(ctl + CW_BAR) + args.li * XCD_BAR_WORDS + XB_TMO); } } } while (0)

    if (IN(0)) { B.x = inp[0]; for (int rep_ = 0; rep_ < REP0; ++rep_) {
        LAS float* scr = (LAS float*)(lds + RING_OFF + wave * 16384);
        const int hw = wave & 3, gw = vcu * 4 + hw, NGW = G * 4;
        constexpr int I_IN = 64 * 16, I_QU = 32 * 4, I_KVU = 32 * 2, I_O = 32 * 16, I_GU = 176 * 16, I_D = 32 * 44, NITEMS = I_IN + I_QU + I_KVU + I_O + I_GU + I_D;
#ifndef REPW
#define REPW 1
#endif
#ifndef REPX
#define REPX 1
#endif
        if (wave >= 4)
        for (int rw_ = 0; rw_ < REPW; ++rw_)
        for (int it = gw; it < NITEMS; it += NGW) {
            int r = it;
            if (r < I_IN) { const int Gp = r >> 4, kb = r & 15, pn = Gp >> 3, bj = (Gp >> 2) & 1, wc = Gp & 3, col0 = pn * 256 + wc * 64 + bj * 32;
                p0_item(col0 < INW ? inp[nv::I_WIN] : nullptr, INW, col0, kb * 64, inp[nv::I_GATT], B.WIN(), DM, Gp * 32, kb * 64, scr, lane); continue; } r -= I_IN;
            if (r < I_QU) { const int Gp = r >> 2, kb = r & 3, pn = Gp >> 3, bj = (Gp >> 2) & 1, wc = Gp & 3, head = 2 * pn + (wc >> 1); const bool z = (wc & 1) && bj; const int col0 = head * 96 + ((wc & 1) ? 64 : bj * 32);
                p0_item(z ? nullptr : inp[nv::I_WQUP], 768, col0, kb * 64, inp[nv::I_GQA], B.WQUP(), 256, Gp * 32, kb * 64, scr, lane); continue; } r -= I_QU;
            if (r < I_KVU) { const int Gp = r >> 1, kb = r & 1, pn = Gp >> 3, bj = (Gp >> 2) & 1, wc = Gp & 3, col0 = pn * 256 + wc * 64 + bj * 32;
                p0_item(inp[nv::I_WKVUP], 1024, col0, kb * 64, inp[nv::I_GKVA], B.WKVUP(), 128, Gp * 32, kb * 64, scr, lane); continue; } r -= I_KVU;
            if (r < I_O) { const int Gp = r >> 4, kb = r & 15, pn = Gp >> 3, bj = (Gp >> 2) & 1, wc = Gp & 3, col0 = pn * 256 + wc * 64 + bj * 32;
                p0_item(inp[nv::I_WO], DM, col0, kb * 64, nullptr, B.WO(), DM, Gp * 32, kb * 64, scr, lane); continue; } r -= I_O;
            if (r < I_GU) { const int Gp = r >> 4, kb = r & 15, pn = Gp >> 3, bj = (Gp >> 2) & 1, wc = Gp & 3, col0 = pn * 128 + wc * 32;
                p0_item(inp[bj ? nv::I_WU : nv::I_WG], DFF, col0, kb * 64, inp[nv::I_GFFN], B.WGU(), DM, Gp * 32, kb * 64, scr, lane); continue; } r -= I_GU;
            { const int Gp = r / 44, kb = r % 44, pn = Gp >> 3, bj = (Gp >> 2) & 1, wc = Gp & 3, col0 = pn * 256 + wc * 64 + bj * 32;
                p0_item(inp[nv::I_WD], DM, col0, kb * 64, nullptr, B.WD(), DFF, Gp * 32, kb * 64, scr, lane); }
        }
        if (wave < 4)
        for (int rx_ = 0; rx_ < REPX; ++rx_)
        for (int m0 = gw; m0 < M; m0 += 4 * NGW) {
            f32x4 v[4][4]; float ssq[4];
#pragma unroll
            for (int q = 0; q < 4; ++q) { const int m = m0 + q * NGW; if (m < M) { const GAS f32x4* xr = (const GAS f32x4*)(B.x + (size_t)m * DM) + 2 * lane;
#pragma unroll
                for (int j = 0; j < 2; ++j) { v[q][2 * j] = __builtin_nontemporal_load(xr + 128 * j); v[q][2 * j + 1] = __builtin_nontemporal_load(xr + 128 * j + 1); } } }
#pragma unroll
            for (int q = 0; q < 4; ++q) { float sq = 0.f;
#pragma unroll
                for (int j = 0; j < 4; ++j) sq += (v[q][j].x * v[q][j].x + v[q][j].y * v[q][j].y) + (v[q][j].z * v[q][j].z + v[q][j].w * v[q][j].w);
                ssq[q] = wave_sum(sq); }
#pragma unroll
            for (int q = 0; q < 4; ++q) { const int m = m0 + q * NGW; if (m < M) { if (lane == 0) B.RX()[m] = 1.0f / sqrtf(ssq[q] * (1.0f / DM) + EPS);
                GAS v4u* o16 = (GAS v4u*)(B.XB() + (size_t)m * DM) + lane;
#pragma unroll
                for (int j = 0; j < 2; ++j) { const pg8::u32x4 w = pg8::pack8(v[q][2 * j], v[q][2 * j + 1]); o16[64 * j] = (v4u){w.x, w.y, w.z, w.w}; } } }
        }
        for (int i = vcu * NWAVES * 64 + tid; i < 2048 * 48; i += G * NWAVES * 64) rope_table_entry(i, B.COSA());
        if (bx == 0 && tid < 320) { const int t = tid; B.gmq()[t] = t < 64 ? inp[nv::I_GMQ][t] : t < 128 ? inp[nv::I_GMK][t - 64] : t < 224 ? inp[nv::I_GLQ][t - 128] : inp[nv::I_GLK][t - 224]; } }
        SEAM(0);
    }
    if (IN(1)) { for (int rep_ = 0; rep_ < REP1; ++rep_) {
        pg8::ProgOne<pg8::EpiInProj, DUPU1> P1; P1.init(B, pg8::GDesc{B.XB(), B.WIN(), DM, DM}, 2048, G, bx, P1_WGM); pg8::gemm_stream(lds + RING_OFF, P1); }
        SEAM(1);
    }
    if (IN(2)) { for (int rep_ = 0; rep_ < REP2; ++rep_) {
        for (int it = vcu; it < 256; it += G) { const int tile = it >> 1, c0 = (it & 1) * 256 + lane * 4; const bf16_t* kp = B.KA() + ((size_t)tile * 256 + wave * 32) * MW + c0; float a0 = 0.f, a1 = 0.f, a2 = 0.f, a3 = 0.f;
#pragma unroll 8
            for (int r = 0; r < 32; ++r) { const unsigned long long w = *(const GAS unsigned long long*)(kp + (size_t)r * MW); const unsigned lo = (unsigned)w, hi2 = (unsigned)(w >> 32);
                a0 += __uint_as_float(lo << 16); a1 += __uint_as_float(lo & 0xffff0000u); a2 += __uint_as_float(hi2 << 16); a3 += __uint_as_float(hi2 & 0xffff0000u); }
            LAS f32x4* red = (LAS f32x4*)(lds + RING_OFF); red[wave * 64 + lane] = (f32x4){a0, a1, a2, a3};
            LDS_WAIT(); __syncthreads();
            if (wave < 4) { const f32x4 s0 = red[(2 * wave) * 64 + lane], s1 = red[(2 * wave + 1) * 64 + lane]; *(GAS f32x4*)(B.KMEANP() + ((size_t)tile * 4 + wave) * MW + c0) = s0 + s1; }
            __syncthreads(); }
        pg8::ProgP2 P2; P2.init(B, G, bx); pg8::gemm_stream(lds + RING_OFF, P2); }
        SEAM(2);
    }
    if (IN(3)) { for (int rep_ = 0; rep_ < REP3; ++rep_) {
        { const int rpc = (M + G - 1) / G; for (int i = vcu * rpc + tid; i < (vcu + 1) * rpc && i < M; i += NWAVES * 64) B.H1SS()[i] = 0.f; }
        const int nit = (G == 256) ? 4 : (1024 - vcu + G - 1) / G;
        for (int it = 0; it < nit; ++it) { int bh, ty, s;
            if (G == 256) { const int c = vcu >> 2; s = vcu & 3; bh = (2 * (c >> 3) + (it & 1)) * 8 + (c & 7); ty = (it >> 1) ^ (c & 1); }
            const int b = bh >> 3, h = bh & 7; const size_t rb = (size_t)b * SEQ;
#ifndef REPU0
#define REPU0 1
#endif
            for (int e = 0; e < 2; ++e) { const int n = e ? 7 - s : s;
              for (int ru_ = 0; ru_ < ((n == 0) ? REPU0 : 1); ++ru_) {
                if (ty) attl::attn_unit<8>(n, B.QM() + rb * 768 + h * 96, B.KM() + rb * 768 + h * 96, B.VM() + rb * MW + h * 64, B.AO() + rb * DM + 512 + h * 64, B, (char*)lds_raw + RING_OFF);
                else attm::attn_unit<8>(n, b * 8, h, B.QA() + rb * MW + h * 64, B.KA() + rb * MW + h * 64, B.VA() + rb * MW + h * 64, B.AO() + rb * DM + h * 64, B, (char*)lds_raw + RING_OFF); } } } }
        SEAM(3);
    }
    for (int repg_ = 0; repg_ < REPG; ++repg_) {
    if (repg_ > 0) xcd_barrier(bar);
#ifndef P6_A_AUX
#define P6_A_AUX 0
#endif
#ifndef FFN_STREAM
#define FFN_STREAM 0
#endif
    if (FFN_STREAM && G == 256 && IN(4) && IN(5) && IN(6)) {
        pg8::ProgFFN PF; PF.init(B, G, bx, (unsigned*)(ctl + CW_DEP4), (unsigned*)(ctl + CW_DEP5), (unsigned*)(ctl + CW_BAR) + args.li * XCD_BAR_WORDS + XB_TMO); for (PF.seg = 0; PF.seg < 3; ++PF.seg) pg8::gemm_stream(lds + RING_OFF, PF);
    } else {
    if (IN(4)) { for (int rep_ = 0; rep_ < REP4; ++rep_) {
        pg8::ProgOne<pg8::EpiOProj, 0> P4; P4.init(B, pg8::GDesc{B.AO(), B.WO(), DM, DM}, DM, G, bx); pg8::gemm_stream(lds + RING_OFF, P4); }
        SEAM(4);
    }
    if (IN(5)) { for (int rep_ = 0; rep_ < REP5; ++rep_) {
        pg8::ProgOne<pg8::EpiFfn1, DUPU5> P5; P5.init(B, pg8::GDesc{B.H1B(), B.WGU(), DM, DM}, 2 * DFF, G, bx); pg8::gemm_stream(lds + RING_OFF, P5); }
        SEAM(5);
    }
    if (IN(6)) {
        pg8::ProgOne<pg8::EpiFfn2, DUPU6> P6; P6.init(B, pg8::GDesc{B.ACT(), B.WD(), DFF, DFF}, DM, G, bx); pg8::gemm_stream<decltype(P6), P6_A_AUX>(lds + RING_OFF, P6);
    }
    }
    }
#undef IN
#undef SEAM
}
#ifndef OPT_MASK
#define OPT_MASK 0x7e
#endif
static nv::Bufs make_bufs(void* const* d_in, void* d_out, void* d_ws) {
    nv::Bufs B{}; unsigned char* ws = (unsigned char*)d_ws;
    B.x = (const float*)d_in[0]; for (int i = 0; i < 16; ++i) B.in[i] = (const float*)d_in[i]; B.out = (float*)d_out;
    B.RX = (float*)(ws + WS_RX); B.CQSS = (float*)(ws + WS_CQSS); B.CKVSS = (float*)(ws + WS_CKVSS); B.KPESS = (float*)(ws + WS_KPESS); B.KR = (float*)(ws + WS_KR);
    B.KMEANP = (float*)(ws + WS_KMEANP); B.H1SS = (float*)(ws + WS_H1SS);
    float* tab = (float*)(ws + WS_TAB); B.COSA = tab; B.SINA = tab + 2048 * 32; B.COSB = tab + 2 * 2048 * 32; B.SINB = tab + 2 * 2048 * 32 + 2048 * 16;
    B.QA = (bf16_t*)(ws + WS_QA); B.KA = (bf16_t*)(ws + WS_KA); B.VA = (bf16_t*)(ws + WS_VA); B.CQKV = (bf16_t*)(ws + WS_CQKV); B.QM = (bf16_t*)(ws + WS_QM); B.KM = (bf16_t*)(ws + WS_KM);
    B.VM = (bf16_t*)(ws + WS_VM); B.AO = (bf16_t*)(ws + WS_AO); B.H1B = (bf16_t*)(ws + WS_H1B); B.ACT = (bf16_t*)(ws + WS_ACT);
    return B;
}
static void naive_stage(int p, const nv::Bufs& B, hipStream_t stream) {
    switch (p) {
    case 1: hipLaunchKernelGGL(nv::ngemm<nv::OpInProj>, dim3(31, M / 64), dim3(256), 0, stream, nv::OpInProj{B}); break;
    case 2: hipLaunchKernelGGL(nv::ngemm<nv::OpQUp>, dim3(12, M / 64), dim3(256), 0, stream, nv::OpQUp{B});
            hipLaunchKernelGGL(nv::ngemm<nv::OpKvUp>, dim3(16, M / 64), dim3(256), 0, stream, nv::OpKvUp{B}); break;
    case 3: hipLaunchKernelGGL(nv::n_attn_moba, dim3(M * NH / 256), dim3(256), 0, stream, B);
            hipLaunchKernelGGL(nv::n_attn_mla, dim3(M * NH / 256), dim3(256), 0, stream, B); break;
    case 4: hipLaunchKernelGGL(nv::ngemm<nv::OpOProj>, dim3(16, M / 64), dim3(256), 0, stream, nv::OpOProj{B}); break;
    case 5: hipLaunchKernelGGL(nv::ngemm<nv::OpFfn1>, dim3(44, M / 64), dim3(256), 0, stream, nv::OpFfn1{B}); break;
    case 6: hipLaunchKernelGGL(nv::ngemm<nv::OpFfn2>, dim3(16, M / 64), dim3(256), 0, stream, nv::OpFfn2{B}); break;
    }
}
extern "C" void kernel_launch(void* const* d_in, const int* in_sizes, int n_in, void* d_out, int out_size, void* d_ws, size_t ws_size, hipStream_t stream) {
    static int grid = 0;
    if (grid == 0) {
        if (n_in != 16 || in_sizes[0] != M * DM || out_size != M * DM || ws_size < WS_END) { fprintf(stderr, "kernel_launch: shape mismatch (n_in %d, in0 %d, out %d, ws %zu; need ws >= %zu)\n", n_in, n_in > 0 ? in_sizes[0] : -1, out_size, ws_size, (size_t)WS_END); grid = -1; return; }
        int dev = 0, cus = 0, per_cu = 0;
        if (hipGetDevice(&dev) != hipSuccess || hipDeviceGetAttribute(&cus, hipDeviceAttributeMultiprocessorCount, dev) != hipSuccess) { fprintf(stderr, "kernel_launch: device query failed\n"); grid = -1; return; }
        if (hipFuncSetAttribute((const void*)fwd_mega, hipFuncAttributeMaxDynamicSharedMemorySize, LDS_BYTES) != hipSuccess) { fprintf(stderr, "kernel_launch: hipFuncSetAttribute(%d B LDS) failed\n", LDS_BYTES); grid = -1; return; }
        if (hipOccupancyMaxActiveBlocksPerMultiprocessor(&per_cu, (const void*)fwd_mega, NWAVES * 64, LDS_BYTES) != hipSuccess || per_cu < 1) { fprintf(stderr, "kernel_launch: occupancy query says %d workgroups per CU; nothing launched\n", per_cu); (void)hipGetLastError(); grid = -1; return; }
        grid = cus;
    }
    if (grid < 0) return;
    if (hipMemsetAsync((char*)d_ws + WS_CTL, 0, CTL_ZERO_BYTES, stream) != hipSuccess) { fprintf(stderr, "kernel_launch: hipMemsetAsync failed\n"); return; }
    nv::Bufs B = make_bufs(d_in, d_out, d_ws);
    constexpr unsigned mask = (unsigned)(OPT_MASK) & 0x7eu; constexpr bool any_opt = mask != 0u, any_naive = mask != 0x7eu;
    if (any_naive) { hipLaunchKernelGGL(n_tables, dim3(384), dim3(256), 0, stream, (float*)((unsigned char*)d_ws + WS_TAB)); hipLaunchKernelGGL(nv::n_rowstat, dim3(M / 4), dim3(256), 0, stream, B.x, B.RX); }
#ifdef PROBE_DUP
    { const int cut[2][2] = {{0, PROBE_DUP + 1}, {PROBE_DUP2, 7}};
      for (int l = 0; l < 2; ++l) { Args a{}; for (int i = 0; i < 16; ++i) a.in[i] = (const float*)d_in[i]; a.out = (float*)d_out; a.ws = (unsigned char*)d_ws; a.ph_lo = cut[l][0]; a.ph_hi = cut[l][1]; a.li = l; a.pad = 0;
        hipLaunchKernelGGL(fwd_mega, dim3(grid), dim3(NWAVES * 64), LDS_BYTES, stream, a); }
      return; }
#endif
    int li = 0, p = any_opt ? 0 : 1;
    while (p <= 6) {
        const bool opt = (p == 0) || ((mask >> p) & 1u);
        if (opt) { int q = p; while (q + 1 <= 6 && ((mask >> (q + 1)) & 1u)) ++q;
            Args a{}; for (int i = 0; i < 16; ++i) a.in[i] = (const float*)d_in[i]; a.out = (float*)d_out; a.ws = (unsigned char*)d_ws; a.ph_lo = p; a.ph_hi = q + 1; a.li = li++; a.pad = 0;
            hipLaunchKernelGGL(fwd_mega, dim3(grid), dim3(NWAVES * 64), LDS_BYTES, stream, a);
            const hipError_t le = hipPeekAtLastError(); if (le != hipSuccess) { fprintf(stderr, "kernel_launch: launch failed: %s\n", hipGetErrorName(le)); return; }
            p = q + 1; }
        else { naive_stage(p, B, stream); ++p; }
    }
}
```

```cpp
#include <hip/hip_runtime.h>
#include <cstdio>
#include <cstdint>

typedef unsigned short bf16_t;
constexpr int BATCH = 16, SEQ = 2048, DM = 1024, M = BATCH * SEQ;
constexpr int NH = 8, HD = 64, MW = 512;
constexpr int QR = 256, KVR = 128, ROPE = 32, NOPE = 64, QKD = 96;
constexpr int INW = 1952, DFF = 2816;
constexpr float EPS = 1e-6f, LOG2E = 1.4426950408889634f;
constexpr float C2A = 0.125f * LOG2E;
constexpr float C2B = 0.10206207261596577f * LOG2E;

constexpr size_t MiB = 1u << 20;
constexpr size_t WS_CTL = 0, CTL_ZERO_BYTES = 1 * MiB;
constexpr size_t WS_TAB = 1 * MiB;
constexpr size_t WS_WIN = 2 * MiB;
constexpr size_t WS_WQUP = 6 * MiB;
constexpr size_t WS_WKVUP = 6 * MiB + 512 * 1024;
constexpr size_t WS_WO = 7 * MiB;
constexpr size_t WS_WGU = 9 * MiB;
constexpr size_t WS_WD = 20 * MiB;
constexpr size_t WS_RX = 26 * MiB;
constexpr size_t WS_KPESS = WS_RX + 128 * 1024;
constexpr size_t WS_CKVSS = WS_KPESS + 128 * 1024;
constexpr size_t WS_CQSS = WS_CKVSS + 256 * 1024;
constexpr size_t WS_KMEANP = WS_CQSS + 512 * 1024;
constexpr size_t WS_H1SS = WS_CTL + 512 * 1024;
constexpr size_t WS_KR = WS_KMEANP + 1024 * 1024;
constexpr size_t WS_XB = 34 * MiB;
constexpr size_t WS_H1B = WS_XB;
constexpr size_t WS_QA = 98 * MiB, WS_KA = 130 * MiB, WS_VA = 162 * MiB;
constexpr size_t WS_CQKV = 194 * MiB;
constexpr size_t WS_QM = 218 * MiB, WS_KM = 266 * MiB;
constexpr size_t WS_VM = 314 * MiB;
constexpr size_t WS_AO = 346 * MiB;
constexpr size_t WS_ACT = 98 * MiB;
constexpr size_t WS_END = 410 * MiB;
static_assert(WS_KR + (size_t)M * 32 * 4 <= WS_XB && WS_ACT + (size_t)M * DFF * 2 <= WS_AO && WS_WD + (size_t)DM * DFF * 2 <= WS_RX, "d_ws map");

constexpr int EPI_LDS_OFF = 131072 + 512;
__device__ __forceinline__ void sincos_d(double a, double& s, double& c) {
    const double kd = __builtin_rint(a * 0.63661977236758134308);
    double r = __builtin_fma(-kd, 1.57079632679489655800e+00, a); r = __builtin_fma(-kd, 6.12323399573676603587e-17, r);
    const int k = (int)kd & 3; const double r2 = r * r;
    const double sp = r * (1.0 + r2 * (-1.0 / 6 + r2 * (1.0 / 120 + r2 * (-1.0 / 5040 + r2 * (1.0 / 362880 + r2 * (-1.0 / 39916800 + r2 * (1.0 / 6227020800.0 + r2 * (-1.0 / 1307674368000.0))))))));
    const double cp = 1.0 + r2 * (-0.5 + r2 * (1.0 / 24 + r2 * (-1.0 / 720 + r2 * (1.0 / 40320 + r2 * (-1.0 / 3628800 + r2 * (1.0 / 479001600 + r2 * (-1.0 / 87178291200.0 + r2 * (1.0 / 20922789888000.0))))))));
    s = (k == 0) ? sp : (k == 1) ? cp : (k == 2) ? -sp : -cp;
    c = (k == 0) ? cp : (k == 1) ? -sp : (k == 2) ? -cp : sp;
}
__device__ __forceinline__ void rope_table_entry(int i, float* tab) {
    const int pos = i / 48, f = i % 48, steps = f < 32 ? f : 2 * (f - 32);
    double inv = 1.0; for (int j = 0; j < steps; ++j) inv *= 0.7498942093324558;
    const float ang = (float)pos * (float)inv;
    double s, c; sincos_d((double)ang, s, c);
    if (f < 32) { tab[pos * 32 + f] = (float)c; tab[2048 * 32 + pos * 32 + f] = (float)s; }
    else { tab[2 * 2048 * 32 + pos * 16 + (f - 32)] = (float)c; tab[2 * 2048 * 32 + 2048 * 16 + pos * 16 + (f - 32)] = (float)s; }
}
__global__ __launch_bounds__(256) void n_tables(float* tab) { const int i = blockIdx.x * 256 + threadIdx.x; if (i < 2048 * 48) rope_table_entry(i, tab); }
#define OPT_MASK 0x7e
#define ACT_STORE_MODE 2
#define OUT_STORE_NT 1
namespace nv {
__device__ __forceinline__ float bf2f(bf16_t v) { return __uint_as_float((unsigned)v << 16); }
__device__ __forceinline__ bf16_t f2bf(float f) { unsigned u = __float_as_uint(f); return (bf16_t)((u + 0x7fffu + ((u >> 16) & 1u)) >> 16); }

__global__ __launch_bounds__(256) void n_rowstat(const float* __restrict__ x, float* __restrict__ RX) {
    const int row = blockIdx.x * 4 + (threadIdx.x >> 6), lane = threadIdx.x & 63;
    const float* xr = x + (size_t)row * DM; float s = 0.f;
    for (int i = lane; i < DM; i += 64) { const float v = xr[i]; s += v * v; }
    for (int o = 1; o < 64; o <<= 1) s += __shfl_xor(s, o);
    if (lane == 0) RX[row] = 1.0f / sqrtf(s * (1.0f / DM) + EPS);
}

template <class OP> __global__ __launch_bounds__(256) void ngemm(OP op) {
    __shared__ float As[16][64], Bs[16][64], B2s[OP::DUAL ? 16 : 1][64], T[64][65], T2[OP::DUAL ? 64 : 1][65];
    const int tid = threadIdx.x, ty = tid >> 4, tx = tid & 15, row0 = blockIdx.y * 64, col0 = blockIdx.x * 64;
    float acc[4][4] = {}, acc2[4][4] = {};
    for (int k0 = 0; k0 < OP::K; k0 += 16) {
#pragma unroll
        for (int l = 0; l < 4; ++l) { const int idx = tid + 256 * l;
            { const int m = idx >> 4, k = idx & 15; As[k][m] = op.a(row0 + m, k0 + k); }
            { const int k = idx >> 6, n = idx & 63; const bool in = (col0 + n) < OP::N; Bs[k][n] = in ? op.b(k0 + k, col0 + n) : 0.f; if (OP::DUAL) B2s[k][n] = in ? op.b2(k0 + k, col0 + n) : 0.f; } }
        __syncthreads();
#pragma unroll
        for (int k = 0; k < 16; ++k) { float a[4], b[4], c[4];
#pragma unroll
            for (int i = 0; i < 4; ++i) { a[i] = As[k][ty * 4 + i]; b[i] = Bs[k][tx * 4 + i]; c[i] = OP::DUAL ? B2s[k][tx * 4 + i] : 0.f; }
#pragma unroll
            for (int i = 0; i < 4; ++i)
#pragma unroll
                for (int j = 0; j < 4; ++j) { acc[i][j] = fmaf(a[i], b[j], acc[i][j]); if (OP::DUAL) acc2[i][j] = fmaf(a[i], c[j], acc2[i][j]); } }
        __syncthreads();
    }
#pragma unroll
    for (int i = 0; i < 4; ++i)
#pragma unroll
        for (int j = 0; j < 4; ++j) { T[ty * 4 + i][tx * 4 + j] = acc[i][j]; if (OP::DUAL) T2[ty * 4 + i][tx * 4 + j] = acc2[i][j]; }
    __syncthreads();
    op.epi(T, T2, row0, col0, tid);
}

struct Bufs {
    const float* x; const float* in[16]; float* out;
    float *RX, *CQSS, *CKVSS, *KPESS, *KR, *KMEANP, *H1SS, *COSA, *SINA, *COSB, *SINB;
    bf16_t *QA, *KA, *VA, *CQKV, *QM, *KM, *VM, *AO, *H1B, *ACT;
};
enum { I_X = 0, I_GATT = 1, I_WIN = 2, I_GMQ = 3, I_GMK = 4, I_GQA = 5, I_WQUP = 6, I_GKVA = 7, I_WKVUP = 8, I_GLQ = 9, I_GLK = 10, I_WO = 11, I_GFFN = 12, I_WG = 13, I_WU = 14, I_WD = 15 };

struct OpInProj { static constexpr int K = DM, N = INW; static constexpr bool DUAL = false; Bufs B;
    __device__ float a(int m, int k) const { return B.x[(size_t)m * DM + k] * B.RX[m] * B.in[I_GATT][k]; }
    __device__ float b(int k, int n) const { return B.in[I_WIN][(size_t)k * INW + n]; }
    __device__ float b2(int, int) const { return 0.f; }
    __device__ void epi(float (*T)[65], float (*)[65], int row0, int col0, int tid) const {
        const int r = tid & 63, row = row0 + r, pos = row & (SEQ - 1);
        if (col0 < 1024) {
            const bool isq = col0 < 512; const float* g = B.in[isq ? I_GMQ : I_GMK];
            if (tid < 64) { float ss = 0.f; for (int d = 0; d < 64; ++d) ss += T[r][d] * T[r][d];
                const float rn = 1.0f / sqrtf(ss * (1.0f / 64) + EPS); float o[64];
#pragma unroll
                for (int d = 0; d < 32; ++d) { const float x1 = T[r][d] * rn * g[d], x2 = T[r][d + 32] * rn * g[d + 32], c = B.COSA[pos * 32 + d], s = B.SINA[pos * 32 + d]; o[d] = x1 * c - x2 * s; o[d + 32] = x2 * c + x1 * s; }
#pragma unroll
                for (int d = 0; d < 64; ++d) { T[r][d] = o[d]; if (isq) B.QA[(size_t)row * MW + col0 + d] = f2bf(o[d] * C2A); else B.KA[(size_t)row * MW + (col0 - 512) + d] = f2bf(o[d]); } }
            __syncthreads();
            if (!isq && tid < 64) { float cs = 0.f; for (int rr = 0; rr < 64; ++rr) cs += T[rr][tid];
                B.KMEANP[((size_t)(row0 >> 8) * 4 + ((row0 & 255) >> 6)) * MW + (col0 - 512) + tid] = cs; }
        } else if (col0 < 1536) { if (tid < 64) for (int d = 0; d < 64; ++d) B.VA[(size_t)row * MW + (col0 - 1024) + d] = f2bf(T[r][d]);
        } else if (col0 < 1792) { if (tid < 64) { float ss = 0.f; for (int d = 0; d < 64; ++d) { ss += T[r][d] * T[r][d]; B.CQKV[(size_t)row * 384 + (col0 - 1536) + d] = f2bf(T[r][d]); } B.CQSS[(size_t)row * 4 + ((col0 - 1536) >> 6)] = ss; }
        } else if (col0 < 1920) { if (tid < 64) { float ss = 0.f; for (int d = 0; d < 64; ++d) { ss += T[r][d] * T[r][d]; B.CQKV[(size_t)row * 384 + 256 + (col0 - 1792) + d] = f2bf(T[r][d]); } B.CKVSS[(size_t)row * 2 + ((col0 - 1792) >> 6)] = ss; }
        } else { if (tid < 64) { float ss = 0.f; for (int d = 0; d < 32; ++d) ss += T[r][d] * T[r][d]; B.KPESS[row] = ss; const float* g = B.in[I_GLK] + 64;
                for (int i = 0; i < 16; ++i) { const float x1 = T[r][i] * g[i], x2 = T[r][i + 16] * g[i + 16], c = B.COSB[pos * 16 + i], s = B.SINB[pos * 16 + i];
                    B.KR[(size_t)row * 32 + i] = x1 * c - x2 * s; B.KR[(size_t)row * 32 + i + 16] = x2 * c + x1 * s; } } }
    }
};
struct OpQUp { static constexpr int K = QR, N = 768; static constexpr bool DUAL = false; Bufs B;
    __device__ float a(int m, int k) const { return bf2f(B.CQKV[(size_t)m * 384 + k]) * B.in[I_GQA][k]; }
    __device__ float b(int k, int n) const { return B.in[I_WQUP][(size_t)k * 768 + n]; }
    __device__ float b2(int, int) const { return 0.f; }
    __device__ void epi(float (*T)[65], float (*)[65], int row0, int col0, int tid) const {
        if (tid < 64) { const int r = tid, row = row0 + r; const float* s4 = B.CQSS + (size_t)row * 4; const float rc = 1.0f / sqrtf((s4[0] + s4[1] + s4[2] + s4[3]) * (1.0f / QR) + EPS);
            for (int d = 0; d < 64; ++d) B.QM[(size_t)row * 768 + col0 + d] = f2bf(T[r][d] * rc); }
    }
};
struct OpKvUp { static constexpr int K = KVR, N = 1024; static constexpr bool DUAL = false; Bufs B;
    __device__ float a(int m, int k) const { return bf2f(B.CQKV[(size_t)m * 384 + 256 + k]) * B.in[I_GKVA][k]; }
    __device__ float b(int k, int n) const { return B.in[I_WKVUP][(size_t)k * 1024 + n]; }
    __device__ float b2(int, int) const { return 0.f; }
    __device__ void epi(float (*T)[65], float (*)[65], int row0, int col0, int tid) const {
        if (tid < 64) { const int r = tid, row = row0 + r, head = col0 >> 7; const float* s2 = B.CKVSS + (size_t)row * 2; const float rc = 1.0f / sqrtf((s2[0] + s2[1]) * (1.0f / KVR) + EPS);
            if ((col0 >> 6) & 1) { for (int d = 0; d < 64; ++d) B.VM[(size_t)row * MW + head * 64 + d] = f2bf(T[r][d] * rc); }
            else { float ss = B.KPESS[row]; for (int d = 0; d < 64; ++d) { const float v = T[r][d] * rc; ss += v * v; }
                const float rk = 1.0f / sqrtf(ss * (1.0f / QKD) + EPS); const float* g = B.in[I_GLK];
                for (int d = 0; d < 64; ++d) B.KM[(size_t)row * 768 + head * 96 + d] = f2bf(T[r][d] * rc * rk * g[d]);
                for (int d = 0; d < 32; ++d) B.KM[(size_t)row * 768 + head * 96 + 64 + d] = f2bf(B.KR[(size_t)row * 32 + d] * rk); } }
    }
};
struct OpOProj { static constexpr int K = DM, N = DM; static constexpr bool DUAL = false; Bufs B;
    __device__ float a(int m, int k) const { return bf2f(B.AO[(size_t)m * DM + k]); }
    __device__ float b(int k, int n) const { return B.in[I_WO][(size_t)k * DM + n]; }
    __device__ float b2(int, int) const { return 0.f; }
    __device__ void epi(float (*T)[65], float (*)[65], int row0, int col0, int tid) const {
        if (tid < 64) { const int r = tid, row = row0 + r; float ss = 0.f;
            for (int d = 0; d < 64; ++d) { const float h = B.x[(size_t)row * DM + col0 + d] + T[r][d]; ss += h * h; B.H1B[(size_t)row * DM + col0 + d] = f2bf(h); }
            atomicAdd(B.H1SS + row, ss); }
    }
};
struct OpFfn1 { static constexpr int K = DM, N = DFF; static constexpr bool DUAL = true; Bufs B;
    __device__ float a(int m, int k) const { return bf2f(B.H1B[(size_t)m * DM + k]) * B.in[I_GFFN][k]; }
    __device__ float b(int k, int n) const { return B.in[I_WG][(size_t)k * DFF + n]; }
    __device__ float b2(int k, int n) const { return B.in[I_WU][(size_t)k * DFF + n]; }
    __device__ void epi(float (*T)[65], float (*T2)[65], int row0, int col0, int tid) const {
        if (tid < 64) { const int r = tid, row = row0 + r; const float t = B.H1SS[row];
            const float rh = 1.0f / sqrtf(t * (1.0f / DM) + EPS);
            for (int d = 0; d < 64; ++d) { const float g = T[r][d] * rh, u = T2[r][d] * rh; B.ACT[(size_t)row * DFF + col0 + d] = f2bf(g / (1.0f + __expf(-g)) * u); } }
    }
};
struct OpFfn2 { static constexpr int K = DFF, N = DM; static constexpr bool DUAL = false; Bufs B;
    __device__ float a(int m, int k) const { return bf2f(B.ACT[(size_t)m * DFF + k]); }
    __device__ float b(int k, int n) const { return B.in[I_WD][(size_t)k * DM + n]; }
    __device__ float b2(int, int) const { return 0.f; }
    __device__ void epi(float (*T)[65], float (*)[65], int row0, int col0, int tid) const {
        if (tid < 64) { const int r = tid, row = row0 + r; for (int d = 0; d < 64; ++d) B.out[(size_t)row * DM + col0 + d] = bf2f(B.H1B[(size_t)row * DM + col0 + d]) + T[r][d]; }
    }
};

__global__ __launch_bounds__(256) void n_attn_moba(Bufs B) {
    const int gid = blockIdx.x * 256 + threadIdx.x, q = gid & (SEQ - 1), h = (gid >> 11) & 7, b = gid >> 14, row = b * SEQ + q, n = q >> 8;
    float qv[64];
#pragma unroll
    for (int d = 0; d < 64; ++d) qv[d] = bf2f(B.QA[(size_t)row * MW + h * 64 + d]);
    unsigned sel = (1u << n) - 1u;
    if (n > 3) { float gate[8];
#pragma unroll
        for (int j = 0; j < 8; ++j) { gate[j] = -INFINITY; if (j < n) { float g = 0.f; const float* kp = B.KMEANP + (size_t)(b * 8 + j) * 4 * MW + h * 64;
#pragma unroll
                for (int d = 0; d < 64; ++d) g += qv[d] * ((kp[d] + kp[MW + d]) + (kp[2 * MW + d] + kp[3 * MW + d])); gate[j] = g; } }
        sel = 0u;
#pragma unroll
        for (int j = 0; j < 8; ++j) { int rank = 0;
#pragma unroll
            for (int i = 0; i < 8; ++i) rank += (gate[i] > gate[j] || (gate[i] == gate[j] && i < j)) ? 1 : 0;
            if (j < n && rank < 3) sel |= 1u << j; } }
    float m = -INFINITY, l = 0.f, o[64];
#pragma unroll
    for (int d = 0; d < 64; ++d) o[d] = 0.f;
    for (int j = 0; j <= n; ++j) {
        const bool mine = (j == n) || ((sel >> j) & 1u);
        for (int kk = 0; kk < 256; ++kk) { const int key = j * 256 + kk; if (!mine || key > q) continue;
            const bf16_t* kr = B.KA + (size_t)(b * SEQ + key) * MW + h * 64; float s = 0.f;
#pragma unroll
            for (int d = 0; d < 64; ++d) s += qv[d] * bf2f(kr[d]);
            const float mn = fmaxf(m, s), al = exp2f(m - mn), p = exp2f(s - mn); m = mn; l = l * al + p;
            const bf16_t* vr = B.VA + (size_t)(b * SEQ + key) * MW + h * 64;
#pragma unroll
            for (int d = 0; d < 64; ++d) o[d] = o[d] * al + p * bf2f(vr[d]); } }
    const float il = 1.0f / l;
#pragma unroll
    for (int d = 0; d < 64; ++d) B.AO[(size_t)row * DM + h * 64 + d] = f2bf(o[d] * il);
}
__global__ __launch_bounds__(256) void n_attn_mla(Bufs B) {
    const int gid = blockIdx.x * 256 + threadIdx.x, q = gid & (SEQ - 1), h = (gid >> 11) & 7, b = gid >> 14, row = b * SEQ + q;
    float qv[96]; float ss = 0.f;
#pragma unroll
    for (int d = 0; d < 96; ++d) { qv[d] = bf2f(B.QM[(size_t)row * 768 + h * 96 + d]); ss += qv[d] * qv[d]; }
    const float rq = 1.0f / sqrtf(ss * (1.0f / QKD) + EPS); const float* g = B.in[I_GLQ];
#pragma unroll
    for (int d = 0; d < 96; ++d) qv[d] = qv[d] * rq * g[d];
#pragma unroll
    for (int i = 0; i < 16; ++i) { const float x1 = qv[64 + i], x2 = qv[80 + i], c = B.COSB[q * 16 + i], s = B.SINB[q * 16 + i]; qv[64 + i] = x1 * c - x2 * s; qv[80 + i] = x2 * c + x1 * s; }
#pragma unroll
    for (int d = 0; d < 96; ++d) qv[d] *= C2B;
    float m = -INFINITY, l = 0.f, o[64];
#pragma unroll
    for (int d = 0; d < 64; ++d) o[d] = 0.f;
    const int qmax = q | 63;
    for (int key = 0; key <= qmax; ++key) { if (key > q) continue;
        const bf16_t* kr = B.KM + (size_t)(b * SEQ + key) * 768 + h * 96; float s = 0.f;
#pragma unroll
        for (int d = 0; d < 96; ++d) s += qv[d] * bf2f(kr[d]);
        const float mn = fmaxf(m, s), al = exp2f(m - mn), p = exp2f(s - mn); m = mn; l = l * al + p;
        const bf16_t* vr = B.VM + (size_t)(b * SEQ + key) * MW + h * 64;
#pragma unroll
        for (int d = 0; d < 64; ++d) o[d] = o[d] * al + p * bf2f(vr[d]); }
    const float il = 1.0f / l;
#pragma unroll
    for (int d = 0; d < 64; ++d) B.AO[(size_t)row * DM + 512 + h * 64 + d] = f2bf(o[d] * il);
}
}
constexpr size_t WS_GAIN = WS_TAB + 768 * 1024;
struct Ctx { const float* x; float* out; unsigned char* ws;
#define CTX_F(NAME, OFF) __device__ __forceinline__ float* NAME() const { return (float*)(ws + (OFF)); }
#define CTX_H(NAME, OFF) __device__ __forceinline__ bf16_t* NAME() const { return (bf16_t*)(ws + (OFF)); }
    CTX_F(RX, WS_RX) CTX_F(CQSS, WS_CQSS) CTX_F(CKVSS, WS_CKVSS) CTX_F(KPESS, WS_KPESS) CTX_F(KR, WS_KR) CTX_F(KMEANP, WS_KMEANP) CTX_F(H1SS, WS_H1SS)
    CTX_F(COSA, WS_TAB) CTX_F(SINA, WS_TAB + 2048 * 32 * 4) CTX_F(COSB, WS_TAB + 2 * 2048 * 32 * 4) CTX_F(SINB, WS_TAB + 2 * 2048 * 32 * 4 + 2048 * 16 * 4)
    CTX_F(gmq, WS_GAIN) CTX_F(gmk, WS_GAIN + 256) CTX_F(glq, WS_GAIN + 512) CTX_F(glk, WS_GAIN + 896)
    CTX_H(QA, WS_QA) CTX_H(KA, WS_KA) CTX_H(VA, WS_VA) CTX_H(CQKV, WS_CQKV) CTX_H(QM, WS_QM) CTX_H(KM, WS_KM) CTX_H(VM, WS_VM) CTX_H(AO, WS_AO) CTX_H(H1B, WS_H1B) CTX_H(ACT, WS_ACT)
    CTX_H(XB, WS_XB) CTX_H(WIN, WS_WIN) CTX_H(WQUP, WS_WQUP) CTX_H(WKVUP, WS_WKVUP) CTX_H(WO, WS_WO) CTX_H(WGU, WS_WGU) CTX_H(WD, WS_WD)
#undef CTX_F
#undef CTX_H
};
#ifndef WGM_SET
#define WGM_SET 8
#endif
namespace pg8 {
#define PG8_LAS __attribute__((address_space(3)))
typedef short bf16x8 __attribute__((ext_vector_type(8)));
typedef float f32x4 __attribute__((ext_vector_type(4)));
typedef float f32x2 __attribute__((ext_vector_type(2)));
typedef unsigned u32x4 __attribute__((ext_vector_type(4)));
constexpr int BM = 256, BK = 64, HALF = 128, HTB = HALF * BK * 2  , STAGE_BYTES = 8 * HTB, NXCD = 8, WGM = WGM_SET;

__host__ __device__ __forceinline__ int lds_byte(int r, int c) { const int st = (r >> 4) * 2 + (c >> 5), rr = r & 15, cc = c & 31, ob = rr * 64 + cc * 2; return st * 1024 + (ob ^ (((ob >> 9) & 1) << 5)); }
__host__ __device__ __forceinline__ void stage_rc(int b, int& R, int& C) { const int st = b / 1024, sb = b % 1024, swz = sb ^ (((sb >> 9) & 1) << 5); R = (st >> 1) * 16 + swz / 64; C = (st & 1) * 32 + (swz % 64) / 2; }
__host__ __device__ __forceinline__ int perm32(int rho) { const int n = rho >> 4, i = rho & 15; return 8 * (i >> 2) + 4 * n + (i & 3); }

struct Unit { int pm, pn; };
struct Gemm { const bf16_t* A; const bf16_t* Bt; int M, N, K, lda; };

struct StaticOrder {
    int nM, nN, nwg, G, c;
    __host__ __device__ void init(int M_, int N_, int G_, int c_) { nM = M_ / BM; nN = N_ / BM; nwg = nM * nN; G = G_; c = c_; }
    __host__ __device__ bool next(int i, Unit& u) const {
        const long L = (long)i * G + c; if (L >= nwg) return false;
        int wgid = (int)L; { const int q = nwg / NXCD, r = nwg % NXCD, xcd = wgid % NXCD, off = wgid / NXCD; wgid = (xcd < r ? xcd * (q + 1) : r * (q + 1) + (xcd - r) * q) + off; }
        const int nig = WGM * nN, gid = wgid / nig, fm = gid * WGM, gsz = (nM - fm) < WGM ? (nM - fm) : WGM;
        u.pm = fm + ((wgid % nig) % gsz); u.pn = (wgid % nig) / gsz; return true;
    }
    __device__ __forceinline__ void a_ready(const Unit&) const {}
    __device__ __forceinline__ void done(const Unit&) const {}
};

typedef float f32x2_c __attribute__((ext_vector_type(2))); typedef __bf16 bf16x2_c __attribute__((ext_vector_type(2)));
__device__ __forceinline__ unsigned cvt_pk_bf16(float lo, float hi) { f32x2_c v = {lo, hi}; bf16x2_c b = __builtin_convertvector(v, bf16x2_c); return __builtin_bit_cast(unsigned, b); }
__device__ __forceinline__ u32x4 pack8(const f32x4 a, const f32x4 b) { u32x4 w; w.x = cvt_pk_bf16(a[0], a[1]); w.y = cvt_pk_bf16(a[2], a[3]); w.z = cvt_pk_bf16(b[0], b[1]); w.w = cvt_pk_bf16(b[2], b[3]); return w; }
__device__ __forceinline__ float hsum4(const f32x4 a) { return (a[0] + a[1]) + (a[2] + a[3]); }
__device__ __forceinline__ float dot4(const f32x4 a) { return (a[0] * a[0] + a[1] * a[1]) + (a[2] * a[2] + a[3] * a[3]); }
__device__ __forceinline__ float fq_sum(float s) { s += __shfl_xor(s, 16); s += __shfl_xor(s, 32); return s; }
__device__ __forceinline__ float rsq(float v) { return __builtin_amdgcn_rsqf(v); }
#define EPI_FENCE() asm volatile("" ::: "memory")
template <int MODE> __device__ __forceinline__ void st16(void* p, const u32x4 v) {
    if constexpr (MODE == 1) asm volatile("global_store_dwordx4 %0, %1, off sc1\n\ts_nop 1" :: "v"(p), "v"(v) : "memory");
    else if constexpr (MODE == 2) __builtin_nontemporal_store(v, (u32x4*)p);
    else *(u32x4*)p = v; }
#define OPAQUE(x) asm volatile("" : "+v"(x))


#ifndef P1_STORE_MODE
#define P1_STORE_MODE 0
#endif
struct EpiInProj { static constexpr bool PERM = true, AFTER_DRAIN = false, HAS_PRE = false; Ctx B;
    __device__ __forceinline__ void qk(const f32x4 (&acc)[2][2][4][2], const Unit& u, int wc, int fq, int rbase, bool isq) const {
        const int head = (u.pn & 1) * 4 + wc; const float* g = isq ? B.gmq() : B.gmk();
        f32x4 g0[2], g1[2], cd[2], sd[2];
#pragma unroll
        for (int n = 0; n < 2; ++n) { g0[n] = *(const f32x4*)(g + fq * 8 + n * 4); g1[n] = *(const f32x4*)(g + 32 + fq * 8 + n * 4);
            cd[n] = *(const f32x4*)(B.COSA() + 16 * 32 + fq * 8 + n * 4); sd[n] = *(const f32x4*)(B.SINA() + 16 * 32 + fq * 8 + n * 4); }
        bf16_t* dst = (isq ? B.QA() : B.KA()) + head * 64 + fq * 8; const float osc = isq ? C2A : 1.0f;
#pragma unroll
        for (int ai = 0; ai < 2; ++ai) { f32x4 c[2], sn[2]; float rx[4]; int rb = rbase + ai * HALF; OPAQUE(rb); const int pos0 = rb & (SEQ - 1);
#pragma unroll
            for (int m = 0; m < 4; ++m) rx[m] = B.RX()[rb + m * 16];
#pragma unroll
            for (int n = 0; n < 2; ++n) { c[n] = *(const f32x4*)(B.COSA() + pos0 * 32 + fq * 8 + n * 4); sn[n] = *(const f32x4*)(B.SINA() + pos0 * 32 + fq * 8 + n * 4); }
#pragma unroll
            for (int m = 0; m < 4; ++m) { const int row = rb + m * 16; float ss = 0.f;
#pragma unroll
                for (int bj = 0; bj < 2; ++bj)
#pragma unroll
                    for (int n = 0; n < 2; ++n) ss += dot4(acc[ai][bj][m][n]);
                const float rxv = rx[m]; ss = fq_sum(ss) * rxv * rxv; const float rn = rsq(ss * (1.0f / 64) + EPS) * rxv * osc; f32x4 o1[2], o2[2];
#pragma unroll
                for (int n = 0; n < 2; ++n) { const f32x4 x1 = acc[ai][0][m][n] * rn * g0[n], x2 = acc[ai][1][m][n] * rn * g1[n]; o1[n] = x1 * c[n] - x2 * sn[n]; o2[n] = x2 * c[n] + x1 * sn[n];
                    const f32x4 cn = c[n] * cd[n] - sn[n] * sd[n]; sn[n] = sn[n] * cd[n] + c[n] * sd[n]; c[n] = cn; }
                st16<P1_STORE_MODE>(dst + (size_t)row * MW, pack8(o1[0], o1[1])); st16<P1_STORE_MODE>(dst + (size_t)row * MW + 32, pack8(o2[0], o2[1])); } }
    }
    __device__ __forceinline__ void operator()(const f32x4 (&acc)[2][2][4][2], const Unit& u, int wr, int wc, int fr, int fq) const {
        const int pn = u.pn; int rbase = u.pm * BM + wr * 64 + fr; OPAQUE(rbase);
        if (pn < 4) { qk(acc, u, wc, fq, rbase, pn < 2); return; }
        float rx[2][4];
#pragma unroll
        for (int ai = 0; ai < 2; ++ai)
#pragma unroll
            for (int m = 0; m < 4; ++m) rx[ai][m] = B.RX()[rbase + ai * HALF + m * 16];
        if (pn < 6) {
            bf16_t* dst = B.VA() + ((pn - 4) * 4 + wc) * 64 + fq * 8;
#pragma unroll
            for (int ai = 0; ai < 2; ++ai)
#pragma unroll
                for (int m = 0; m < 4; ++m) { const int row = rbase + ai * HALF + m * 16; const float rxv = rx[ai][m];
#pragma unroll
                    for (int bj = 0; bj < 2; ++bj) st16<P1_STORE_MODE>(dst + (size_t)row * MW + bj * 32, pack8(acc[ai][bj][m][0] * rxv, acc[ai][bj][m][1] * rxv)); }
        } else if (pn == 6 || wc < 2) {
            const int cb = (pn == 6 ? 0 : 256) + wc * 64 + fq * 8; float* ssp = pn == 6 ? B.CQSS() + wc : B.CKVSS() + wc; const int sstr = pn == 6 ? 4 : 2;
#pragma unroll
            for (int ai = 0; ai < 2; ++ai)
#pragma unroll
                for (int m = 0; m < 4; ++m) { const int row = rbase + ai * HALF + m * 16; const float rxv = rx[ai][m]; float ss = 0.f;
#pragma unroll
                    for (int bj = 0; bj < 2; ++bj) { const f32x4 a = acc[ai][bj][m][0] * rxv, b = acc[ai][bj][m][1] * rxv; ss += dot4(a) + dot4(b); st16<P1_STORE_MODE>(B.CQKV() + (size_t)row * 384 + cb + bj * 32, pack8(a, b)); }
                    ss = fq_sum(ss); if (fq == 0) ssp[(size_t)row * sstr] = ss; }
        } else if (wc == 2) {
            const float* g = B.glk() + 64 + fq * 8; const f32x4 ga = *(const f32x4*)g, gb = *(const f32x4*)(g + 4); const float sg = fq < 2 ? -1.f : 1.f;
#pragma unroll
            for (int ai = 0; ai < 2; ++ai)
#pragma unroll
                for (int m = 0; m < 4; ++m) { int row = rbase + ai * HALF + m * 16; OPAQUE(row); const int pos = row & (SEQ - 1); const float rxv = rx[ai][m];
                    const f32x4 a = acc[ai][0][m][0] * rxv, b = acc[ai][0][m][1] * rxv; float ss = fq_sum(dot4(a) + dot4(b)); if (fq == 0) B.KPESS()[row] = ss;
                    const f32x4 xa = a * ga, xb = b * gb; f32x4 pa, pb;
#pragma unroll
                    for (int j = 0; j < 4; ++j) { pa[j] = __shfl_xor(xa[j], 32); pb[j] = __shfl_xor(xb[j], 32); }
                    const int ci = pos * 16 + (fq & 1) * 8; const f32x4 ca = *(const f32x4*)(B.COSB() + ci), cb = *(const f32x4*)(B.COSB() + ci + 4), sa = *(const f32x4*)(B.SINB() + ci), sb = *(const f32x4*)(B.SINB() + ci + 4);
                    *(f32x4*)(B.KR() + (size_t)row * 32 + fq * 8) = xa * ca + pa * sa * sg; *(f32x4*)(B.KR() + (size_t)row * 32 + fq * 8 + 4) = xb * cb + pb * sb * sg; }
        }
    }
};
struct EpiQUp { static constexpr bool PERM = true, AFTER_DRAIN = false, HAS_PRE = false; Ctx B;
    __device__ __forceinline__ void operator()(const f32x4 (&acc)[2][2][4][2], const Unit& u, int wr, int wc, int fr, int fq) const {
        int rbase = u.pm * BM + wr * 64 + fr; OPAQUE(rbase); const int head = 2 * u.pn + (wc >> 1), dbase = (wc & 1) ? 64 : 0; bf16_t* dst = B.QM() + head * 96 + dbase + fq * 8;
#pragma unroll
        for (int ai = 0; ai < 2; ++ai) { int rb = rbase + ai * HALF; OPAQUE(rb); f32x4 s4[4];
#pragma unroll
            for (int m = 0; m < 4; ++m) s4[m] = *(const f32x4*)(B.CQSS() + (size_t)(rb + m * 16) * 4);
#pragma unroll
            for (int m = 0; m < 4; ++m) { const int row = rb + m * 16; const float rc = rsq(hsum4(s4[m]) * (1.0f / QR) + EPS);
                *(u32x4*)(dst + (size_t)row * 768) = pack8(acc[ai][0][m][0] * rc, acc[ai][0][m][1] * rc);
                if (!(wc & 1)) *(u32x4*)(dst + (size_t)row * 768 + 32) = pack8(acc[ai][1][m][0] * rc, acc[ai][1][m][1] * rc); } }
    }
};
struct EpiKvUp { static constexpr bool PERM = true, AFTER_DRAIN = false, HAS_PRE = false; Ctx B;
    __device__ __forceinline__ void operator()(const f32x4 (&acc)[2][2][4][2], const Unit& u, int wr, int wc, int fr, int fq) const {
        int rbase = u.pm * BM + wr * 64 + fr; OPAQUE(rbase); const int head = 2 * u.pn + (wc >> 1);
        if (wc & 1) { bf16_t* dst = B.VM() + head * 64 + fq * 8; f32x2 s2[2][4];
#pragma unroll
            for (int ai = 0; ai < 2; ++ai)
#pragma unroll
                for (int m = 0; m < 4; ++m) s2[ai][m] = *(const f32x2*)(B.CKVSS() + (size_t)(rbase + ai * HALF + m * 16) * 2);
#pragma unroll
            for (int ai = 0; ai < 2; ++ai)
#pragma unroll
                for (int m = 0; m < 4; ++m) { const int row = rbase + ai * HALF + m * 16; const float rc = rsq((s2[ai][m][0] + s2[ai][m][1]) * (1.0f / KVR) + EPS);
#pragma unroll
                    for (int bj = 0; bj < 2; ++bj) *(u32x4*)(dst + (size_t)row * MW + bj * 32) = pack8(acc[ai][bj][m][0] * rc, acc[ai][bj][m][1] * rc); }
        } else { int fqo = fq; OPAQUE(fqo); const float* g = B.glk() + fqo * 8; f32x4 gg[2][2];
#pragma unroll
            for (int bj = 0; bj < 2; ++bj)
#pragma unroll
                for (int n = 0; n < 2; ++n) gg[bj][n] = *(const f32x4*)(g + bj * 32 + n * 4);
            bf16_t* dst = B.KM() + head * 96 + fq * 8;
#pragma unroll
            for (int ai = 0; ai < 2; ++ai) { int rb = rbase + ai * HALF; OPAQUE(rb); float kp[4]; f32x4 ka[4], kb[4]; f32x2 s2v[4];
#pragma unroll
                for (int m = 0; m < 4; ++m) { const int row = rb + m * 16; kp[m] = B.KPESS()[row]; s2v[m] = *(const f32x2*)(B.CKVSS() + (size_t)row * 2); ka[m] = *(const f32x4*)(B.KR() + (size_t)row * 32 + fq * 8); kb[m] = *(const f32x4*)(B.KR() + (size_t)row * 32 + fq * 8 + 4); }
#pragma unroll
                for (int m = 0; m < 4; ++m) { const int row = rb + m * 16; const float rc = rsq((s2v[m][0] + s2v[m][1]) * (1.0f / KVR) + EPS);
                    f32x4 v[2][2]; float ss = 0.f;
#pragma unroll
                    for (int bj = 0; bj < 2; ++bj)
#pragma unroll
                        for (int n = 0; n < 2; ++n) { v[bj][n] = acc[ai][bj][m][n] * rc; ss += dot4(v[bj][n]); }
                    ss = fq_sum(ss) + kp[m]; const float rk = rsq(ss * (1.0f / QKD) + EPS);
#pragma unroll
                    for (int bj = 0; bj < 2; ++bj) *(u32x4*)(dst + (size_t)row * 768 + bj * 32) = pack8(v[bj][0] * rk * gg[bj][0], v[bj][1] * rk * gg[bj][1]);
                    *(u32x4*)(dst + (size_t)row * 768 + 64) = pack8(ka[m] * rk, kb[m] * rk); } }
        }
    }
};
template <int WT = 0> struct EpiOProjT { static constexpr bool PERM = true, AFTER_DRAIN = false, HAS_PRE = false; Ctx B;
    __device__ __forceinline__ void operator()(const f32x4 (&acc)[2][2][4][2], const Unit& u, int wr, int wc, int fr, int fq) const {
        const int rbase = u.pm * BM + wr * 64 + fr, col = u.pn * BM + wc * 64 + fq * 8;
#pragma unroll
        for (int ai = 0; ai < 2; ++ai) { int rb = rbase + ai * HALF; OPAQUE(rb); u32x4 xw[4][2];
#pragma unroll
            for (int m = 0; m < 4; ++m)
#pragma unroll
                for (int bj = 0; bj < 2; ++bj) xw[m][bj] = *(const u32x4*)(B.H1B() + (size_t)(rb + m * 16) * DM + col + bj * 32);
#pragma unroll
            for (int m = 0; m < 4; ++m) { const int row = rb + m * 16; const size_t off = (size_t)row * DM + col; float ss = 0.f;
#pragma unroll
                for (int bj = 0; bj < 2; ++bj) { const u32x4 w = xw[m][bj];
                    const f32x4 x0 = {__uint_as_float(w.x << 16), __uint_as_float(w.x & 0xffff0000u), __uint_as_float(w.y << 16), __uint_as_float(w.y & 0xffff0000u)};
                    const f32x4 x1 = {__uint_as_float(w.z << 16), __uint_as_float(w.z & 0xffff0000u), __uint_as_float(w.w << 16), __uint_as_float(w.w & 0xffff0000u)};
                    const f32x4 a = x0 + acc[ai][bj][m][0], b = x1 + acc[ai][bj][m][1];
                    ss += dot4(a) + dot4(b); st16<WT>(B.H1B() + off + bj * 32, pack8(a, b)); }
                ss = fq_sum(ss); if (fq == 0) atomicAdd(B.H1SS() + row, ss); } }
    }
};
typedef EpiOProjT<0> EpiOProj;
template <int WT = 0> struct EpiFfn1T { static constexpr bool PERM = true, AFTER_DRAIN = false, HAS_PRE = (WT != 1); Ctx B;
    __device__ __forceinline__ void pre(const Unit& u, int wid, int wr, int fr) const { const int rbase = u.pm * BM + wr * 64 + fr;
#pragma unroll
        for (int ai = 0; ai < 2; ++ai)
#pragma unroll
            for (int m = 0; m < 4; ++m) __builtin_amdgcn_global_load_lds((const unsigned*)(B.H1SS() + rbase + ai * HALF + m * 16), (PG8_LAS unsigned*)(EPI_LDS_OFF + wid * 2048 + (ai * 4 + m) * 256), 4, 0, 0);
    }
    __device__ __forceinline__ void operator()(const f32x4 (&acc)[2][2][4][2], const Unit& u, int wr, int wc, int fr, int fq) const {
        const int rbase = u.pm * BM + wr * 64 + fr, col = u.pn * HALF + wc * 32 + fq * 8; float ssv[2][4];
        if constexpr (HAS_PRE) { asm volatile("" ::: "memory"); const int wid = wr * 4 + wc, ln = fq * 16 + fr;
#pragma unroll
            for (int ai = 0; ai < 2; ++ai)
#pragma unroll
                for (int m = 0; m < 4; ++m) ssv[ai][m] = *(const PG8_LAS float*)(EPI_LDS_OFF + wid * 2048 + (ai * 4 + m) * 256 + ln * 4);
        } else {
#pragma unroll
        for (int ai = 0; ai < 2; ++ai)
#pragma unroll
            for (int m = 0; m < 4; ++m) ssv[ai][m] = B.H1SS()[rbase + ai * HALF + m * 16]; }
#pragma unroll
        for (int ai = 0; ai < 2; ++ai)
#pragma unroll
            for (int m = 0; m < 4; ++m) { int row = rbase + ai * HALF + m * 16; OPAQUE(row);
                const float rh = rsq(ssv[ai][m] * (1.0f / DM) + EPS), nrl = -LOG2E * rh, rh2 = rh * rh; f32x4 o[2];
#pragma unroll
                for (int n = 0; n < 2; ++n) { const f32x4 ga = acc[ai][0][m][n], gu = ga * acc[ai][1][m][n];
#pragma unroll
                    for (int j = 0; j < 4; ++j) o[n][j] = gu[j] * (rh2 * __builtin_amdgcn_rcpf(1.0f + __builtin_amdgcn_exp2f(ga[j] * nrl))); }
                st16<WT>(B.ACT() + (size_t)row * DFF + col, pack8(o[0], o[1])); }
    }
};
#ifndef ACT_STORE_MODE
#define ACT_STORE_MODE 0
#endif
typedef EpiFfn1T<ACT_STORE_MODE> EpiFfn1;
#ifndef OUT_STORE_NT
#define OUT_STORE_NT 0
#endif
struct EpiFfn2 { static constexpr bool PERM = true, AFTER_DRAIN = false, HAS_PRE = false; Ctx B;
    __device__ __forceinline__ void operator()(const f32x4 (&acc)[2][2][4][2], const Unit& u, int wr, int wc, int fr, int fq) const {
        const int rbase = u.pm * BM + wr * 64 + fr, col = u.pn * BM + wc * 64 + fq * 8;
#pragma unroll
        for (int ai = 0; ai < 2; ++ai) { int rb = rbase + ai * HALF; OPAQUE(rb); u32x4 hw[4][2];
#pragma unroll
            for (int m = 0; m < 4; ++m)
#pragma unroll
                for (int bj = 0; bj < 2; ++bj) hw[m][bj] = __builtin_nontemporal_load((const u32x4*)(B.H1B() + (size_t)(rb + m * 16) * DM + col + bj * 32));
#pragma unroll
            for (int m = 0; m < 4; ++m) { const size_t off = (size_t)(rb + m * 16) * DM + col;
#pragma unroll
                for (int bj = 0; bj < 2; ++bj) { const u32x4 w = hw[m][bj];
                    const f32x4 h0 = {__uint_as_float(w.x << 16), __uint_as_float(w.x & 0xffff0000u), __uint_as_float(w.y << 16), __uint_as_float(w.y & 0xffff0000u)};
                    const f32x4 h1 = {__uint_as_float(w.z << 16), __uint_as_float(w.z & 0xffff0000u), __uint_as_float(w.w << 16), __uint_as_float(w.w & 0xffff0000u)};
                    const f32x4 o0 = h0 + acc[ai][bj][m][0], o1 = h1 + acc[ai][bj][m][1];
#if OUT_STORE_NT
                    __builtin_nontemporal_store(o0, (f32x4*)(B.out + off + bj * 32)); __builtin_nontemporal_store(o1, (f32x4*)(B.out + off + bj * 32 + 4)); } } }
#else
                    *(f32x4*)(B.out + off + bj * 32) = o0; *(f32x4*)(B.out + off + bj * 32 + 4) = o1; } } }
#endif
    }
};

template <class Epi, class Sched, bool ALIGN_EPI>
__device__ __forceinline__ void gemm_phase(PG8_LAS unsigned char* lds, const Gemm g, const Sched& S, const Epi& E) {
    const int tid = threadIdx.x, wid = __builtin_amdgcn_readfirstlane(tid >> 6), lane = tid & 63, wr = wid >> 2, wc = wid & 3, fr = lane & 15, fq = lane >> 4;
    const int K = g.K, nt = K / BK, lda = g.lda;
    unsigned voffA[2], voffB[2];
#pragma unroll
    for (int i = 0; i < 2; ++i) { int R, C; stage_rc(tid * 16 + i * 8192, R, C); const int Rb = Epi::PERM ? ((R & ~31) + perm32(R & 31)) : R;
        voffA[i] = (unsigned)(R * lda + C) * 2u; voffB[i] = (unsigned)(Rb * K + C) * 2u; }
    const size_t kstep = (size_t)(BK * 2);
    const size_t hstepA = (size_t)HALF * lda * 2, hstepB = (size_t)HALF * K * 2;
    const size_t tstepA = 2 * hstepA, tstepB = 2 * hstepB;
    const unsigned ldsw = (unsigned)wid * 1024u;
    const int aoff = lds_byte(wr * 64 + fr, fq * 8), boff = lds_byte(wc * 32 + fr, fq * 8);
#define PG8_SA(b, h) (((b) * 2 + (h)) * HTB)
#define PG8_SB(b, h) ((4 + (b) * 2 + (h)) * HTB)
#define PG8_STAGE(bufoff, gbase, voff) do { _Pragma("unroll") for (int _i = 0; _i < 2; ++_i) \
        __builtin_amdgcn_global_load_lds((const unsigned*)((const char*)(gbase) + (voff)[_i]), (PG8_LAS unsigned*)(lds + (bufoff) + ldsw + _i * 8192), 16, 0, 0); } while (0)
#define PG8_LDA(dst, b, h) do { _Pragma("unroll") for (int m = 0; m < 4; ++m) _Pragma("unroll") for (int k = 0; k < 2; ++k) dst[m][k] = *(const PG8_LAS bf16x8*)(lds + PG8_SA(b, h) + aoff + m * 2048 + k * 1024); } while (0)
#define PG8_LDB(dst, b, h) do { _Pragma("unroll") for (int n = 0; n < 2; ++n) _Pragma("unroll") for (int k = 0; k < 2; ++k) dst[n][k] = *(const PG8_LAS bf16x8*)(lds + PG8_SB(b, h) + boff + n * 2048 + k * 1024); } while (0)
#define PG8_MMA(ai, bj, At, Bt) do { __builtin_amdgcn_s_setprio(1); _Pragma("unroll") for (int m = 0; m < 4; ++m) _Pragma("unroll") for (int n = 0; n < 2; ++n) _Pragma("unroll") for (int k = 0; k < 2; ++k) \
        acc[ai][bj][m][n] = __builtin_amdgcn_mfma_f32_16x16x32_bf16(Bt[n][k], At[m][k], acc[ai][bj][m][n], 0, 0, 0); __builtin_amdgcn_s_setprio(0); } while (0)
#define PG8_WAIT_V(n) asm volatile("s_waitcnt vmcnt(" #n ")" ::: "memory")
#define PG8_WAIT_L(n) asm volatile("s_waitcnt lgkmcnt(" #n ")" ::: "memory")
#define PG8_BAR __builtin_amdgcn_s_barrier()
#define PG8_SCHED __builtin_amdgcn_sched_barrier(0)
    Unit cur, nxt; int ui = 0;
    if (!S.next(0, cur)) return;
    f32x4 acc[2][2][4][2];
#pragma unroll
    for (int a = 0; a < 2; ++a)
#pragma unroll
        for (int b = 0; b < 2; ++b)
#pragma unroll
            for (int m = 0; m < 4; ++m)
#pragma unroll
                for (int n = 0; n < 2; ++n) acc[a][b][m][n] = (f32x4){0.f, 0.f, 0.f, 0.f};
    bf16x8 At[4][2], B0[2][2], B1[2][2];
    const char* cA = (const char*)g.A + (size_t)cur.pm * tstepA; const char* cB = (const char*)g.Bt + (size_t)cur.pn * tstepB;
    S.a_ready(cur);
    PG8_STAGE(PG8_SB(0, 0), cB, voffB); PG8_STAGE(PG8_SB(0, 1), cB + hstepB, voffB); PG8_STAGE(PG8_SA(0, 0), cA, voffA); PG8_STAGE(PG8_SA(0, 1), cA + hstepA, voffA);
    if (wr == 1) PG8_BAR;
    PG8_WAIT_V(2); PG8_BAR;
    PG8_STAGE(PG8_SB(1, 0), cB + kstep, voffB); PG8_STAGE(PG8_SA(1, 0), cA + kstep, voffA); PG8_STAGE(PG8_SB(1, 1), cB + hstepB + kstep, voffB);
    PG8_WAIT_V(6); PG8_BAR;
    for (;;) {
        const bool has_next = S.next(ui + 1, nxt);
        const char* nA = has_next ? (const char*)g.A + (size_t)nxt.pm * tstepA : cA; const char* nB = has_next ? (const char*)g.Bt + (size_t)nxt.pn * tstepB : cB;
#pragma unroll 1
        for (int t = 0; t < nt; t += 2) {
            const bool last = (t == nt - 2);
            const char* a1 = cA + (size_t)(t + 1) * kstep;
            const char* a2 = last ? nA : cA + (size_t)(t + 2) * kstep; const char* b2 = last ? nB : cB + (size_t)(t + 2) * kstep;
            const char* a3 = a2 + kstep; const char* b3 = b2 + kstep;
            if (last && has_next) S.a_ready(nxt);
            PG8_LDB(B0, 0, 0); PG8_LDB(B1, 0, 1); PG8_SCHED; PG8_LDA(At, 0, 0); PG8_STAGE(PG8_SA(1, 1), a1 + hstepA, voffA);
            PG8_WAIT_V(8); PG8_WAIT_L(0); PG8_BAR; PG8_MMA(0, 0, At, B0); PG8_MMA(0, 1, At, B1); PG8_BAR; PG8_SCHED;
            PG8_LDA(At, 0, 1); PG8_STAGE(PG8_SB(0, 0), b2, voffB); PG8_STAGE(PG8_SB(0, 1), b2 + hstepB, voffB); PG8_STAGE(PG8_SA(0, 0), a2, voffA);
            PG8_WAIT_V(8); PG8_WAIT_L(0); PG8_BAR; PG8_MMA(1, 0, At, B0); PG8_MMA(1, 1, At, B1); PG8_BAR; PG8_SCHED;
            PG8_LDB(B0, 1, 0); PG8_LDB(B1, 1, 1); PG8_SCHED; PG8_LDA(At, 1, 0); PG8_STAGE(PG8_SA(0, 1), a2 + hstepA, voffA);
            PG8_WAIT_V(8); PG8_WAIT_L(0); PG8_BAR; PG8_MMA(0, 0, At, B0); PG8_MMA(0, 1, At, B1); PG8_BAR; PG8_SCHED;
            PG8_LDA(At, 1, 1); PG8_STAGE(PG8_SB(1, 0), b3, voffB); PG8_STAGE(PG8_SB(1, 1), b3 + hstepB, voffB); PG8_STAGE(PG8_SA(1, 0), a3, voffA);
            PG8_WAIT_V(8); PG8_WAIT_L(0); PG8_BAR; PG8_MMA(1, 0, At, B0); PG8_MMA(1, 1, At, B1); PG8_BAR; PG8_SCHED;
        }
        if constexpr (ALIGN_EPI) { if (wr == 0) PG8_BAR; }
        { int fr_ = fr, fq_ = fq; OPAQUE(fr_); OPAQUE(fq_); E(acc, cur, wr, wc, fr_, fq_); } S.done(cur);
        if (!has_next) break;
#pragma unroll
        for (int a = 0; a < 2; ++a)
#pragma unroll
            for (int b = 0; b < 2; ++b)
#pragma unroll
                for (int m = 0; m < 4; ++m)
#pragma unroll
                    for (int n = 0; n < 2; ++n) acc[a][b][m][n] = (f32x4){0.f, 0.f, 0.f, 0.f};
        cur = nxt; cA = nA; cB = nB; ++ui;
        if constexpr (ALIGN_EPI) { if (wr == 1) PG8_BAR; }
    }
    PG8_WAIT_V(0);
    if constexpr (!ALIGN_EPI) { if (wr == 0) PG8_BAR; }
    PG8_BAR;
#undef PG8_SA
#undef PG8_SB
#undef PG8_STAGE
#undef PG8_LDA
#undef PG8_LDB
#undef PG8_MMA
#undef PG8_WAIT_V
#undef PG8_WAIT_L
#undef PG8_BAR
#undef PG8_SCHED
}

#ifndef STREAM_ALIGN_EPI
#define STREAM_ALIGN_EPI 1
#endif
struct GDesc { const bf16_t* A; const bf16_t* Bt; int K, lda; };
struct UnitX { int pm, pn, kind; };
template <class Prog, int A_AUX = 0>
__device__ __forceinline__ void gemm_stream(PG8_LAS unsigned char* lds, Prog& P) {
    const int tid = threadIdx.x, wid = __builtin_amdgcn_readfirstlane(tid >> 6), lane = tid & 63, wr = wid >> 2, wc = wid & 3, fr = lane & 15, fq = lane >> 4;
    int R_[2], C_[2], Rb_[2];
#pragma unroll
    for (int i = 0; i < 2; ++i) { stage_rc(tid * 16 + i * 8192, R_[i], C_[i]); Rb_[i] = (R_[i] & ~31) + perm32(R_[i] & 31); }
    const size_t kstep = (size_t)(BK * 2);
    const unsigned ldsw = (unsigned)wid * 1024u;
    const int aoff = lds_byte(wr * 64 + fr, fq * 8), boff = lds_byte(wc * 32 + fr, fq * 8);
#define PG8_SA(b, h) (((b) * 2 + (h)) * HTB)
#define PG8_SB(b, h) ((4 + (b) * 2 + (h)) * HTB)
#define PG8_STAGE2(bufoff, gbase, v0, v1) do { \
        __builtin_amdgcn_global_load_lds((const unsigned*)((const char*)(gbase) + (v0)), (PG8_LAS unsigned*)(lds + (bufoff) + ldsw), 16, 0, 0); \
        __builtin_amdgcn_global_load_lds((const unsigned*)((const char*)(gbase) + (v1)), (PG8_LAS unsigned*)(lds + (bufoff) + ldsw + 8192), 16, 0, 0); } while (0)
#define PG8_STAGE2A(bufoff, gbase, v0, v1) do { \
        __builtin_amdgcn_global_load_lds((const unsigned*)((const char*)(gbase) + (v0)), (PG8_LAS unsigned*)(lds + (bufoff) + ldsw), 16, 0, A_AUX); \
        __builtin_amdgcn_global_load_lds((const unsigned*)((const char*)(gbase) + (v1)), (PG8_LAS unsigned*)(lds + (bufoff) + ldsw + 8192), 16, 0, A_AUX); } while (0)
#define PG8_LDA(dst, b, h) do { _Pragma("unroll") for (int m = 0; m < 4; ++m) _Pragma("unroll") for (int k = 0; k < 2; ++k) dst[m][k] = *(const PG8_LAS bf16x8*)(lds + PG8_SA(b, h) + aoff + m * 2048 + k * 1024); } while (0)
#define PG8_LDB(dst, b, h) do { _Pragma("unroll") for (int n = 0; n < 2; ++n) _Pragma("unroll") for (int k = 0; k < 2; ++k) dst[n][k] = *(const PG8_LAS bf16x8*)(lds + PG8_SB(b, h) + boff + n * 2048 + k * 1024); } while (0)
#define PG8_MMA(ai, bj, At, Bt) do { __builtin_amdgcn_s_setprio(1); _Pragma("unroll") for (int m = 0; m < 4; ++m) _Pragma("unroll") for (int n = 0; n < 2; ++n) _Pragma("unroll") for (int k = 0; k < 2; ++k) \
        acc[ai][bj][m][n] = __builtin_amdgcn_mfma_f32_16x16x32_bf16(Bt[n][k], At[m][k], acc[ai][bj][m][n], 0, 0, 0); __builtin_amdgcn_s_setprio(0); } while (0)
#define PG8_WAIT_V(n) asm volatile("s_waitcnt vmcnt(" #n ")" ::: "memory")
#define PG8_WAIT_L(n) asm volatile("s_waitcnt lgkmcnt(" #n ")" ::: "memory")
#define PG8_BAR __builtin_amdgcn_s_barrier()
#define PG8_SCHED __builtin_amdgcn_sched_barrier(0)
#define PG8_SETUP(u, pA, pB, vA0, vA1, vB0, vB1, hA, hB, ntv) do { const GDesc d_ = P.desc((u).kind); (ntv) = d_.K / BK; (hA) = (size_t)HALF * d_.lda * 2; (hB) = (size_t)HALF * d_.K * 2; \
        (pA) = (const char*)d_.A + (size_t)(u).pm * 2 * (hA); (pB) = (const char*)d_.Bt + (size_t)(u).pn * 2 * (hB); \
        (vA0) = (unsigned)(R_[0] * d_.lda + C_[0]) * 2u; (vA1) = (unsigned)(R_[1] * d_.lda + C_[1]) * 2u; (vB0) = (unsigned)(Rb_[0] * d_.K + C_[0]) * 2u; (vB1) = (unsigned)(Rb_[1] * d_.K + C_[1]) * 2u; } while (0)
    UnitX cur, nxt; int ui = 0;
    if (!P.next(0, cur)) return;
    const char *cA, *cB, *nA, *nB; unsigned cvA0, cvA1, cvB0, cvB1, nvA0, nvA1, nvB0, nvB1; size_t chA, chB, nhA, nhB; int cnt, nnt;
    PG8_SETUP(cur, cA, cB, cvA0, cvA1, cvB0, cvB1, chA, chB, cnt);
    f32x4 acc[2][2][4][2];
#pragma unroll
    for (int a = 0; a < 2; ++a)
#pragma unroll
        for (int b = 0; b < 2; ++b)
#pragma unroll
            for (int m = 0; m < 4; ++m)
#pragma unroll
                for (int n = 0; n < 2; ++n) acc[a][b][m][n] = (f32x4){0.f, 0.f, 0.f, 0.f};
    bf16x8 At[4][2], B0[2][2], B1[2][2];
    P.a_ready(cur);
    PG8_STAGE2(PG8_SB(0, 0), cB, cvB0, cvB1); PG8_STAGE2(PG8_SB(0, 1), cB + chB, cvB0, cvB1); PG8_STAGE2A(PG8_SA(0, 0), cA, cvA0, cvA1); PG8_STAGE2A(PG8_SA(0, 1), cA + chA, cvA0, cvA1);
    if (wr == 1) PG8_BAR;
    PG8_WAIT_V(2); PG8_BAR;
    PG8_STAGE2(PG8_SB(1, 0), cB + kstep, cvB0, cvB1); PG8_STAGE2A(PG8_SA(1, 0), cA + kstep, cvA0, cvA1); PG8_STAGE2(PG8_SB(1, 1), cB + chB + kstep, cvB0, cvB1);
    PG8_WAIT_V(6); PG8_BAR;
    for (;;) {
        const bool has_next = P.next(ui + 1, nxt);
        if (has_next) { PG8_SETUP(nxt, nA, nB, nvA0, nvA1, nvB0, nvB1, nhA, nhB, nnt); }
        else { nA = cA; nB = cB; nvA0 = cvA0; nvA1 = cvA1; nvB0 = cvB0; nvB1 = cvB1; nhA = chA; nhB = chB; nnt = cnt; }
#pragma unroll 1
        for (int t = 0; t < cnt; t += 2) {
            const bool last = (t == cnt - 2);
            const char* a1 = cA + (size_t)(t + 1) * kstep;
            const char* a2 = last ? nA : cA + (size_t)(t + 2) * kstep; const char* b2 = last ? nB : cB + (size_t)(t + 2) * kstep;
            const char* a3 = a2 + kstep; const char* b3 = b2 + kstep;
            const unsigned xA0 = last ? nvA0 : cvA0, xA1 = last ? nvA1 : cvA1, xB0 = last ? nvB0 : cvB0, xB1 = last ? nvB1 : cvB1; const size_t xhA = last ? nhA : chA, xhB = last ? nhB : chB;
            if (last && has_next) P.a_ready(nxt);
            { int tl = t; asm volatile("" : "+s"(tl)); if (tl == cnt - 2) P.pre(cur, wid, wr, fr); }
            PG8_LDB(B0, 0, 0); PG8_LDB(B1, 0, 1); PG8_SCHED; PG8_LDA(At, 0, 0); PG8_STAGE2A(PG8_SA(1, 1), a1 + chA, cvA0, cvA1);
            PG8_WAIT_V(8); PG8_WAIT_L(0); PG8_BAR; PG8_MMA(0, 0, At, B0); PG8_MMA(0, 1, At, B1); PG8_BAR; PG8_SCHED;
            PG8_LDA(At, 0, 1); PG8_STAGE2(PG8_SB(0, 0), b2, xB0, xB1); PG8_STAGE2(PG8_SB(0, 1), b2 + xhB, xB0, xB1); PG8_STAGE2A(PG8_SA(0, 0), a2, xA0, xA1);
            PG8_WAIT_V(8); PG8_WAIT_L(0); PG8_BAR; PG8_MMA(1, 0, At, B0); PG8_MMA(1, 1, At, B1); PG8_BAR; PG8_SCHED;
            PG8_LDB(B0, 1, 0); PG8_LDB(B1, 1, 1); PG8_SCHED; PG8_LDA(At, 1, 0); PG8_STAGE2A(PG8_SA(0, 1), a2 + xhA, xA0, xA1);
            PG8_WAIT_V(8); if (t == 0) P.publish();
            PG8_WAIT_L(0); PG8_BAR; PG8_MMA(0, 0, At, B0); PG8_MMA(0, 1, At, B1); PG8_BAR; PG8_SCHED;
            PG8_LDA(At, 1, 1); PG8_STAGE2(PG8_SB(1, 0), b3, xB0, xB1); PG8_STAGE2(PG8_SB(1, 1), b3 + xhB, xB0, xB1); PG8_STAGE2A(PG8_SA(1, 0), a3, xA0, xA1);
            PG8_WAIT_V(8); PG8_WAIT_L(0); PG8_BAR; PG8_MMA(1, 0, At, B0); PG8_MMA(1, 1, At, B1); PG8_BAR; PG8_SCHED;
        }
#if STREAM_ALIGN_EPI
        if (wr == 0) PG8_BAR;
#endif
        { int fr_ = fr, fq_ = fq; OPAQUE(fr_); OPAQUE(fq_); P.epi(acc, cur, wr, wc, fr_, fq_); } P.done(cur);
        if (!has_next) break;
#pragma unroll
        for (int a = 0; a < 2; ++a)
#pragma unroll
            for (int b = 0; b < 2; ++b)
#pragma unroll
                for (int m = 0; m < 4; ++m)
#pragma unroll
                    for (int n = 0; n < 2; ++n) acc[a][b][m][n] = (f32x4){0.f, 0.f, 0.f, 0.f};
        cur = nxt; cA = nA; cB = nB; cvA0 = nvA0; cvA1 = nvA1; cvB0 = nvB0; cvB1 = nvB1; chA = nhA; chB = nhB; cnt = nnt; ++ui;
#if STREAM_ALIGN_EPI
        if (wr == 1) PG8_BAR;
#endif
    }
    PG8_WAIT_V(0); P.publish();
#if !STREAM_ALIGN_EPI
    if (wr == 0) PG8_BAR;
#endif
    PG8_BAR;
#undef PG8_SA
#undef PG8_SB
#undef PG8_STAGE2
#undef PG8_STAGE2A
#undef PG8_LDA
#undef PG8_LDB
#undef PG8_MMA
#undef PG8_WAIT_V
#undef PG8_WAIT_L
#undef PG8_BAR
#undef PG8_SCHED
#undef PG8_SETUP
}
struct ProgP2 { Ctx B; StaticOrder S;
    __device__ __forceinline__ void init(const Ctx& b, int G, int c) { B = b; S.init(M, 1024, G, c); }
    __device__ __forceinline__ bool next(int i, UnitX& u) const { Unit t; const int per = (S.nwg - S.c + S.G - 1) / S.G; const bool q = i < per; if (!S.next(q ? i : i - per, t)) return false; u.pm = t.pm; u.pn = t.pn; u.kind = q ? 0 : 1; return true; }
    __device__ __forceinline__ GDesc desc(int kind) const { return kind == 0 ? GDesc{B.CQKV(), B.WQUP(), 256, 384} : GDesc{B.CQKV() + 256, B.WKVUP(), 128, 384}; }
    __device__ __forceinline__ void epi(const f32x4 (&acc)[2][2][4][2], const UnitX& u, int wr, int wc, int fr, int fq) const { const Unit t{u.pm, u.pn};
        if (u.kind == 0) EpiQUp{B}(acc, t, wr, wc, fr, fq); else EpiKvUp{B}(acc, t, wr, wc, fr, fq); }
    __device__ __forceinline__ void a_ready(const UnitX&) const {}
    __device__ __forceinline__ void done(const UnitX&) const {}
    __device__ __forceinline__ void publish() const {}
    __device__ __forceinline__ void pre(const UnitX&, int, int, int) const {}
};

template <class Epi, int DUPMODE = 0> struct ProgOne { Ctx B; StaticOrder S; GDesc d;
    __device__ __forceinline__ void init(const Ctx& b, const GDesc& g, int N, int G, int c) { B = b; d = g; S.init(M, N, G, c); }
    __device__ __forceinline__ bool next(int i, UnitX& u) const { Unit t; if (!S.next(DUPMODE ? (i >> 1) : i, t)) return false; u.pm = t.pm; u.pn = t.pn; u.kind = (DUPMODE == 2 && !(i & 1)) ? 1 : 0; return true; }
    __device__ __forceinline__ GDesc desc(int) const { return d; }
    __device__ __forceinline__ void epi(const f32x4 (&acc)[2][2][4][2], const UnitX& u, int wr, int wc, int fr, int fq) const { if (DUPMODE == 2 && u.kind == 1) return; const Unit t{u.pm, u.pn}; Epi{B}(acc, t, wr, wc, fr, fq); }
    __device__ __forceinline__ void a_ready(const UnitX&) const {}
    __device__ __forceinline__ void done(const UnitX&) const {}
    __device__ __forceinline__ void publish() const {}
    __device__ __forceinline__ void pre(const UnitX& u, int wid, int wr, int fr) const { if constexpr (Epi::HAS_PRE) { if (!(DUPMODE == 2 && u.kind == 1)) { const Unit t{u.pm, u.pn}; Epi{B}.pre(t, wid, wr, fr); } } }
};

struct ProgFFN { Ctx B; StaticOrder S4, S5; unsigned* cnt4; unsigned* cnt5; unsigned* tmo; int seg, p6, acq4; unsigned* pend;
    enum { K_P4 = 0, K_P5 = 1, K_P6 = 2 };
    __device__ __forceinline__ void init(const Ctx& b, int G, int c, unsigned* c4, unsigned* c5, unsigned* t) { B = b; S4.init(M, DM, G, c); S5.init(M, 2 * DFF, G, c); cnt4 = c4; cnt5 = c5; tmo = t; seg = 0; p6 = 1 + (c >> 3) % 5; acq4 = -1; pend = nullptr; }
    __device__ __forceinline__ bool next(int i, UnitX& u) const { Unit t; int kind, r;
        if (seg == 0) { if (i > 1) return false; kind = K_P4; r = i; }
        else if (seg == 1) { if (i < 6) { kind = K_P5; r = i; } else if (i < 12) { const int k = i - 6; if (k == p6) { kind = K_P6; r = 0; } else { kind = K_P5; r = 6 + (k < p6 ? k : k - 1); } } else return false; }
        else { if (i > 0) return false; kind = K_P6; r = 1; }
        if (!(kind == K_P5 ? S5.next(r, t) : S4.next(r, t))) return false;
        u.pm = t.pm; u.pn = t.pn; u.kind = kind; return true; }
    __device__ __forceinline__ GDesc desc(int kind) const { return kind == K_P4 ? GDesc{B.AO(), B.WO(), DM, DM} : kind == K_P5 ? GDesc{B.H1B(), B.WGU(), DM, DM} : GDesc{B.ACT(), B.WD(), DFF, DFF}; }
    __device__ __forceinline__ void epi(const f32x4 (&acc)[2][2][4][2], const UnitX& u, int wr, int wc, int fr, int fq) const { const Unit t{u.pm, u.pn};
        if (u.kind == K_P4) EpiOProjT<1>{B}(acc, t, wr, wc, fr, fq); else if (u.kind == K_P5) EpiFfn1T<1>{B}(acc, t, wr, wc, fr, fq); else EpiFfn2{B}(acc, t, wr, wc, fr, fq); }
    __device__ __forceinline__ void a_ready(const UnitX& u) {
        if (u.kind == K_P4 || (u.kind == K_P5 && u.pm == acq4)) return;
        if (threadIdx.x < 64) {
            unsigned* c = u.kind == K_P5 ? cnt4 + 64 * u.pm : cnt5 + 64 * u.pm; const unsigned need = u.kind == K_P5 ? 4u * 8u : 22u * 8u; unsigned sp = 0u;
            while ((unsigned)__builtin_amdgcn_readfirstlane(__hip_atomic_load(c, __ATOMIC_RELAXED, __HIP_MEMORY_SCOPE_AGENT)) < need) { __builtin_amdgcn_s_sleep(2);
                if ((++sp & 255u) == 0u) { if (__builtin_amdgcn_readfirstlane(__hip_atomic_load(tmo, __ATOMIC_RELAXED, __HIP_MEMORY_SCOPE_AGENT)) != 0u) break; if (sp > (1u << 18)) { if (threadIdx.x == 0) atomicAdd(tmo, 1u); break; } } }
            __builtin_amdgcn_fence(__ATOMIC_ACQUIRE, "agent");
            asm volatile("s_waitcnt vmcnt(0)" ::: "memory");
        }
        asm volatile("" ::: "memory"); __builtin_amdgcn_s_barrier(); asm volatile("" ::: "memory");
        if (u.kind == K_P5) acq4 = u.pm;
    }
    __device__ __forceinline__ void done(const UnitX& u) { pend = u.kind == K_P4 ? cnt4 + 64 * u.pm : u.kind == K_P5 ? cnt5 + 64 * u.pm : nullptr; }
    __device__ __forceinline__ void pre(const UnitX&, int, int, int) const {}
    __device__ __forceinline__ void publish() { if (pend) { if ((threadIdx.x & 63) == 0) (void)__hip_atomic_fetch_add(pend, 1u, __ATOMIC_RELAXED, __HIP_MEMORY_SCOPE_AGENT); pend = nullptr; } }
};
}
namespace attm {
using bf16=bf16_t;
using bf16x8=__attribute__((ext_vector_type(8)))short;
using s16x4=__attribute__((ext_vector_type(4)))short;
using f32x16=__attribute__((ext_vector_type(16)))float;
using u32x4=__attribute__((ext_vector_type(4)))unsigned;
using f32x4=__attribute__((ext_vector_type(4)))float;
constexpr int D=64,DM=512,DMO=1024;
constexpr int NW=8,QBLK=32,QB=QBLK*NW,KVBLK=64;
__device__ __forceinline__ int crow(int r,int hi){return (r&3)+8*(r>>2)+4*hi;}
#define SBAR() __builtin_amdgcn_sched_barrier(0)
__device__ __forceinline__ void cmask(f32x16&p0,f32x16&p1,int jb,int qrel,int hi){
  const float NEG=-INFINITY; int kb=64*jb+4*hi;
  #pragma unroll
  for(int r=0;r<16;++r){int kv=kb+(r&3)+8*(r>>2); if(kv>qrel)p0[r]=NEG; if(kv+32>qrel)p1[r]=NEG;}
}

constexpr int NSLOT=3, SLOTB=8192;
constexpr int LDS_K=0, LDS_V=NSLOT*SLOTB, LDS_WS=2*NSLOT*SLOTB, LDS_OST=LDS_WS+NW*64*4, LDS_BYTES=LDS_OST+NW*4096;
constexpr float C2=0.125f*1.4426950408889634f;
__device__ __forceinline__ void glds16(const void*gsrc,unsigned lds_dst){unsigned keep;
  asm volatile("s_mov_b32 %0, m0\n\ts_mov_b32 m0, %2\n\ts_nop 0\n\tglobal_load_lds_dwordx4 %1, off\n\ts_mov_b32 m0, %0":"=&s"(keep):"v"(gsrc),"s"(lds_dst):"memory");}
__device__ __forceinline__ float max3f(float a,float b,float c){float r;asm("v_max3_f32 %0, %1, %2, %3":"=v"(r):"v"(a),"v"(b),"v"(c));return r;}
__device__ __forceinline__ float max2f(float a,float b){float r;asm("v_max_f32_e32 %0, %1, %2":"=v"(r):"v"(a),"v"(b));return r;}
__device__ __forceinline__ float fadd_s(float a,float b){float r;asm("v_add_f32_e32 %0, %1, %2":"=v"(r):"v"(a),"v"(b));return r;}
__device__ __forceinline__ float fsub_s(float a,float b){float r;asm("v_sub_f32_e32 %0, %1, %2":"=v"(r):"v"(a),"v"(b));return r;}
typedef float f32x2_t __attribute__((ext_vector_type(2))); typedef __bf16 bf16x2_t __attribute__((ext_vector_type(2)));
__device__ __forceinline__ unsigned cvtpk_s(float lo,float hi){f32x2_t v={lo,hi};bf16x2_t b=__builtin_convertvector(v,bf16x2_t);return __builtin_bit_cast(unsigned,b);}
__device__ __forceinline__ void glds16s(const void*sbase,unsigned voff,unsigned lds_dst){unsigned keep;
  asm volatile("s_mov_b32 %0, m0\n\ts_mov_b32 m0, %3\n\ts_nop 0\n\tglobal_load_lds_dwordx4 %1, %2\n\ts_mov_b32 m0, %0":"=&s"(keep):"v"(voff),"s"(sbase),"s"(lds_dst):"memory");}
__device__ __forceinline__ const bf16_t* uptr(const bf16_t*p){ const unsigned long long v=(unsigned long long)p; const unsigned lo=__builtin_amdgcn_readfirstlane((unsigned)v),hi=__builtin_amdgcn_readfirstlane((unsigned)(v>>32)); return (const bf16_t*)(((unsigned long long)hi<<32)|lo); }
#define WAIT_BAR(N) asm volatile("s_waitcnt vmcnt(" #N ") lgkmcnt(0)\n\ts_barrier":::"memory")

__device__ __forceinline__ void qkt(f32x16&p0,f32x16&p1,const char*Kslot,const bf16x8*qr,const f32x16&negm,int r32,int hi){
  const char*kb=Kslot+hi*1024+r32*16;
  #pragma unroll
  for(int d0=0;d0<4;++d0){
    const bf16x8 b0=*reinterpret_cast<const bf16x8*>(kb+d0*2048);
    const bf16x8 b1=*reinterpret_cast<const bf16x8*>(kb+d0*2048+512);
    if(d0==0){p0=__builtin_amdgcn_mfma_f32_32x32x16_bf16(b0,qr[0],negm,0,0,0);p1=__builtin_amdgcn_mfma_f32_32x32x16_bf16(b1,qr[0],negm,0,0,0);}
    else{p0=__builtin_amdgcn_mfma_f32_32x32x16_bf16(b0,qr[d0],p0,0,0,0);p1=__builtin_amdgcn_mfma_f32_32x32x16_bf16(b1,qr[d0],p1,0,0,0);}}
}
typedef __attribute__((address_space(3))) const char* lds_cptr;
typedef short v4i16_t __attribute__((ext_vector_type(4)));
__device__ __forceinline__ void kload8(bf16x8*kf,lds_cptr kp){
  kf[0]=*(const __attribute__((address_space(3))) bf16x8*)(kp);      kf[1]=*(const __attribute__((address_space(3))) bf16x8*)(kp+512);
  kf[2]=*(const __attribute__((address_space(3))) bf16x8*)(kp+2048); kf[3]=*(const __attribute__((address_space(3))) bf16x8*)(kp+2560);
  kf[4]=*(const __attribute__((address_space(3))) bf16x8*)(kp+4096); kf[5]=*(const __attribute__((address_space(3))) bf16x8*)(kp+4608);
  kf[6]=*(const __attribute__((address_space(3))) bf16x8*)(kp+6144); kf[7]=*(const __attribute__((address_space(3))) bf16x8*)(kp+6656);
}
__device__ __forceinline__ void kload2(bf16x8*kf,lds_cptr kp,int j){ kf[2*j]=*(const __attribute__((address_space(3))) bf16x8*)(kp+j*2048); kf[2*j+1]=*(const __attribute__((address_space(3))) bf16x8*)(kp+j*2048+512); }
__device__ __forceinline__ s16x4 vtr(lds_cptr p){ return __builtin_bit_cast(s16x4,__builtin_amdgcn_ds_read_tr16_b64_v4i16((__attribute__((address_space(3))) v4i16_t*)p)); }
__device__ __forceinline__ float rowmax(const f32x16&p0,const f32x16&p1){
  float a=max3f(p0[0],p0[1],p1[0]),b=max3f(p0[2],p0[3],p1[1]);a=max3f(a,p1[2],p1[3]);
  #pragma unroll
  for(int r=4;r<16;r+=4){a=max3f(a,p0[r],p0[r+1]);b=max3f(b,p0[r+2],p0[r+3]);a=max3f(a,p1[r],p1[r+1]);b=max3f(b,p1[r+2],p1[r+3]);}
  const float m=max2f(a,b);
  auto rr=__builtin_amdgcn_permlane32_swap(__float_as_uint(m),__float_as_uint(m),false,false);
  return max2f(__uint_as_float(rr[0]),__uint_as_float(rr[1]));
}
__device__ __forceinline__ void pv(f32x16*o,int vb,bf16x8 pa0,bf16x8 pa1,bf16x8 pa2,bf16x8 pa3){
  #pragma unroll
  for(int d0=0;d0<2;++d0){s16x4 lo[4],hi[4];
    #pragma unroll
    for(int ks=0;ks<4;++ks){
      asm volatile("ds_read_b64_tr_b16 %0,%1 offset:%c2":"=&v"(lo[ks]):"v"(vb),"i"(d0*4096+ks*1024):"memory");
      asm volatile("ds_read_b64_tr_b16 %0,%1 offset:%c2":"=&v"(hi[ks]):"v"(vb),"i"(d0*4096+ks*1024+512):"memory");}
    asm volatile("s_waitcnt lgkmcnt(0)":::"memory");SBAR();
    #define PK(k) (bf16x8){lo[k][0],lo[k][1],lo[k][2],lo[k][3],hi[k][0],hi[k][1],hi[k][2],hi[k][3]}
    o[d0]=__builtin_amdgcn_mfma_f32_32x32x16_bf16(pa0,PK(0),o[d0],0,0,0);
    o[d0]=__builtin_amdgcn_mfma_f32_32x32x16_bf16(pa1,PK(1),o[d0],0,0,0);
    o[d0]=__builtin_amdgcn_mfma_f32_32x32x16_bf16(pa2,PK(2),o[d0],0,0,0);
    o[d0]=__builtin_amdgcn_mfma_f32_32x32x16_bf16(pa3,PK(3),o[d0],0,0,0);
    #undef PK
  }
}

#ifndef ATTN_STORE16
#define ATTN_STORE16(p,v) (*(u32x4*)(p)=(v))
#endif
template<int THRL> __device__ __forceinline__ void attn_unit(int qb,int b8,int h,const bf16*Q,const bf16*__restrict__ K,const bf16*__restrict__ V,bf16*O,const Ctx&B,char*shm){
  const int tid=threadIdx.x; int lane=tid&63; asm volatile("":"+v"(lane));
  const int r32=lane&31,hi=lane>>5; const int wid=__builtin_amdgcn_readfirstlane(tid>>6);
  const int q0=qb*QB;
  const bf16*Qw=Q+(long)(q0+wid*QBLK)*DM;
  const bf16*Kh=K,*Vh=V;
  const unsigned lds0=(unsigned)(uintptr_t)shm;
  float*wsf=(float*)(shm+LDS_WS)+wid*64;
  const unsigned koff=(unsigned)(lane*DM+wid*8)*2u;
  const unsigned voffv=(unsigned)((16*(wid&3)+(lane>>2))*DM+(wid>>2)*32+(lane&3)*8)*2u;
  const unsigned kdst=lds0+LDS_K+wid*1024, vdst=lds0+LDS_V+wid*1024;
  #define DMA_K(t,slot) glds16s(uptr(Kh+(long)(t)*KVBLK*DM),koff,(unsigned)__builtin_amdgcn_readfirstlane(kdst+(slot)))
  #define DMA_V(t,slot) glds16s(uptr(Vh+(long)(t)*KVBLK*DM),voffv,(unsigned)__builtin_amdgcn_readfirstlane(vdst+(slot)))
  const int vb0=(int)(lds0+LDS_V)+((lane>>4)&1)*32+(lane&3)*8+(4*hi+((lane&15)>>2))*64;
  const char*Kbase=shm+LDS_K; bf16x8 kf[8];
  const lds_cptr shm3=(lds_cptr)shm; const lds_cptr kp0=shm3+LDS_K+hi*1024+r32*16; const lds_cptr vp0=shm3+LDS_V+((lane>>4)&1)*32+(lane&3)*8+(4*hi+((lane&15)>>2))*64;
  const int NT=(q0+QB)/KVBLK;
  DMA_K(0,0);DMA_V(0,0);DMA_K(1,SLOTB);
  bf16x8 qr[4];
  #pragma unroll
  for(int d0=0;d0<4;++d0)qr[d0]=__builtin_nontemporal_load(reinterpret_cast<const bf16x8*>(&Qw[(long)r32*DM+d0*16+hi*8]));
  unsigned sel=0xffu;
  if(qb>3){
    int r32o=r32; asm volatile("":"+v"(r32o));
    f32x16 G=f32x16{};
    #pragma unroll
    for(int d0=0;d0<4;++d0){ float km[8];
      #pragma unroll
      for(int j=0;j<8;++j)km[j]=0.f;
      if(r32o<qb){ const float*kpp=B.KMEANP()+(size_t)(b8+r32o)*4*512+h*64+d0*16+hi*8;
        #pragma unroll
        for(int qq=0;qq<4;++qq){ const f32x4 a=*(const f32x4*)(kpp+qq*512),bb=*(const f32x4*)(kpp+qq*512+4);
          #pragma unroll
          for(int j=0;j<4;++j){km[j]+=a[j];km[4+j]+=bb[j];} } }
      unsigned whi[4],wlo[4];
      #pragma unroll
      for(int w=0;w<4;++w){ whi[w]=cvtpk_s(km[2*w],km[2*w+1]); wlo[w]=cvtpk_s(km[2*w]-__uint_as_float(whi[w]<<16),km[2*w+1]-__uint_as_float(whi[w]&0xffff0000u)); }
      const u32x4 vh={whi[0],whi[1],whi[2],whi[3]},vl={wlo[0],wlo[1],wlo[2],wlo[3]};
      G=__builtin_amdgcn_mfma_f32_32x32x16_bf16(__builtin_bit_cast(bf16x8,vh),qr[d0],G,0,0,0);
      G=__builtin_amdgcn_mfma_f32_32x32x16_bf16(__builtin_bit_cast(bf16x8,vl),qr[d0],G,0,0,0); }
    float gate[8];
    #pragma unroll
    for(int r=0;r<4;++r){ auto rr=__builtin_amdgcn_permlane32_swap(__float_as_uint(G[r]),__float_as_uint(G[r]),false,false); gate[r]=__uint_as_float(rr[0]); gate[4+r]=__uint_as_float(rr[1]); }
    #pragma unroll
    for(int j=0;j<8;++j)if(j>=qb)gate[j]=-INFINITY;
    sel=0u;
    #pragma unroll
    for(int j=0;j<8;++j){ int rank=0;
      #pragma unroll
      for(int i=0;i<8;++i)rank+=(gate[i]>gate[j]||(gate[i]==gate[j]&&i<j))?1:0;
      if(j<qb&&rank<3)sel|=1u<<j; }
  }
  float mhat=0.f,l_reg=0.f;f32x16 o[2];o[0]=f32x16{};o[1]=f32x16{};f32x16 negm;
  #define SETNEGM(tt) do{ const float nm_=((tt)>=NT-4||((sel>>((tt)>>2))&1u))?-mhat:-INFINITY; _Pragma("unroll") for(int r=0;r<16;++r)negm[r]=nm_; asm volatile("":"+v"(negm)); }while(0)
  const int qrel=wid*QBLK+r32;
  #define CMASK(P0,P1,t) do{int jb_=(t)-(NT-4); if(jb_>=0)cmask(P0,P1,jb_,qrel,hi);}while(0)
  bool resc=false;
  #define START(P0,P1) do{ const float rm=rowmax(P0,P1); resc=false; \
    { const float dl=(rm==-INFINITY)?0.f:rm; mhat=fadd_s(mhat,dl); \
      _Pragma("unroll") for(int r=0;r<16;++r){P0[r]=fsub_s(P0[r],dl);P1[r]=fsub_s(P1[r],dl);} \
      SETNEGM(1); } \
    _Pragma("unroll") for(int r=0;r<16;++r)P0[r]=__builtin_amdgcn_exp2f(P0[r]); }while(0)
  #define RESC() do{ if(resc){ asm volatile("s_waitcnt lgkmcnt(0)":::"memory"); \
      _Pragma("unroll") for(int d_=0;d_<2;++d_) _Pragma("unroll") for(int r=0;r<16;++r)o[d_][r]*=wsf[crow(r,hi)]; } }while(0)
  f32x16 pA0,pA1,pB0,pB1;
  int sl_prev=0,sl_cur=0,sl_next=SLOTB;
  #define ROT() do{sl_prev=sl_cur;sl_cur=sl_next;sl_next=(sl_next==(NSLOT-1)*SLOTB)?0:sl_next+SLOTB;}while(0)
  DMA_K(2,2*SLOTB);
  WAIT_BAR(3);
  SETNEGM(0);
  qkt(pA0,pA1,Kbase,qr,negm,r32,hi);asm volatile("s_nop 15\n\ts_nop 7":"+v"(pA0),"+v"(pA1));CMASK(pA0,pA1,0);
  START(pA0,pA1);
  _Pragma("unroll") for(int r=0;r<16;++r)pA1[r]=__builtin_amdgcn_exp2f(pA1[r]);
  WAIT_BAR(0);
  DMA_K(3,0);DMA_V(1,SLOTB);
  ROT();
  kload8(kf,kp0+sl_cur);
  WAIT_BAR(2);
  s16x4 vlo[8],vhi[8]; u32x4 pw0,pw1,pw2,pw3;
  #define PKW(P,B) cvtpk_s(P[B],P[B+1])
  #define PAF(k) __builtin_bit_cast(bf16x8,pw##k)
  #define VFR(i) (bf16x8){vlo[i][0],vlo[i][1],vlo[i][2],vlo[i][3],vhi[i][0],vhi[i][1],vhi[i][2],vhi[i][3]}
  #define PIN(x) asm volatile("":"+v"(x))
  #define MX3(a,b,c) __builtin_fmaxf(__builtin_fmaxf((a),(b)),(c))
  #define GAPA(MF,A0,A1,A2,A3,W0,W1,PW) do{ MF; sacc+=A0; sacc+=A1; sacc+=A2; sacc+=A3; PIN(sacc); W0; W1; PIN(PW); SBAR(); }while(0)
  #define EX(v) __builtin_amdgcn_exp2f(v)
  #define GAPB(MF,X,B) do{ MF; X[B]=EX(X[B]); X[B+1]=EX(X[B+1]); X[B+2]=EX(X[B+2]); X[B+3]=EX(X[B+3]); PIN(X); SBAR(); }while(0)
  #define VRD(i) do{ vlo[i]=vtr(vp_+(((i)>>2)*4096+((i)&3)*1024)); vhi[i]=vtr(vp_+(((i)>>2)*4096+((i)&3)*1024+512)); }while(0)
  #define KRD(G,j) do{ if(G){ kload2(kf,kp0+sl_next,j); SBAR(); } }while(0)
  #define STEP(C0,C1,P0,P1,t,GK,GV,GL) do{ SBAR(); \
    const lds_cptr vp_=vp0+sl_prev; \
    VRD(0); SBAR(); float sacc=(P0[0]+P0[1]); \
    GAPA(C0=__builtin_amdgcn_mfma_f32_32x32x16_bf16(kf[0],qr[0],negm,0,0,0), P0[2],P0[3],P0[4],P0[5],     pw0[0]=PKW(P0,0), pw0[1]=PKW(P0,2), pw0); \
    VRD(4); SBAR(); GAPA(C1=__builtin_amdgcn_mfma_f32_32x32x16_bf16(kf[1],qr[0],negm,0,0,0), P0[6],P0[7],P0[8],P0[9],     pw0[2]=PKW(P0,4), pw0[3]=PKW(P0,6), pw0); \
    VRD(1); SBAR(); GAPA(C0=__builtin_amdgcn_mfma_f32_32x32x16_bf16(kf[2],qr[1],C0,0,0,0),   P0[10],P0[11],P0[12],P0[13], pw1[0]=PKW(P0,8), pw1[1]=PKW(P0,10), pw1); \
    VRD(5); SBAR(); GAPA(C1=__builtin_amdgcn_mfma_f32_32x32x16_bf16(kf[3],qr[1],C1,0,0,0),   P0[14],P0[15],P1[0],P1[1],   pw1[2]=PKW(P0,12),pw1[3]=PKW(P0,14), pw1); \
    VRD(2); SBAR(); GAPA(C0=__builtin_amdgcn_mfma_f32_32x32x16_bf16(kf[4],qr[2],C0,0,0,0),   P1[2],P1[3],P1[4],P1[5],     pw2[0]=PKW(P1,0), pw2[1]=PKW(P1,2), pw2); \
    VRD(6); SBAR(); GAPA(C1=__builtin_amdgcn_mfma_f32_32x32x16_bf16(kf[5],qr[2],C1,0,0,0),   P1[6],P1[7],P1[8],P1[9],     pw2[2]=PKW(P1,4), pw2[3]=PKW(P1,6), pw2); \
    VRD(3); SBAR(); GAPA(C0=__builtin_amdgcn_mfma_f32_32x32x16_bf16(kf[6],qr[3],C0,0,0,0),   P1[10],P1[11],P1[12],P1[13], pw3[0]=PKW(P1,8), pw3[1]=PKW(P1,10), pw3); \
    VRD(7); SBAR(); GAPA(C1=__builtin_amdgcn_mfma_f32_32x32x16_bf16(kf[7],qr[3],C1,0,0,0),   P1[14],P1[15],0.f,0.f,       pw3[2]=PKW(P1,12),pw3[3]=PKW(P1,14), pw3); \
    l_reg+=sacc; \
    if(GK){DMA_K((t)+3,sl_cur);} if(GV){DMA_V((t)+1,sl_next);} \
    CMASK(C0,C1,t); \
    { float a=MX3(C0[0],C0[1],C1[0]),b=MX3(C0[2],C0[3],C1[1]); a=MX3(a,C1[2],C1[3]); \
      _Pragma("unroll") for(int r=4;r<16;r+=4){a=MX3(a,C0[r],C0[r+1]);b=MX3(b,C0[r+2],C0[r+3]);a=MX3(a,C1[r],C1[r+1]);b=MX3(b,C1[r+2],C1[r+3]);} \
      float rm=__builtin_fmaxf(a,b); { auto rr=__builtin_amdgcn_permlane32_swap(__float_as_uint(rm),__float_as_uint(rm),false,false); rm=__builtin_fmaxf(__uint_as_float(rr[0]),__uint_as_float(rr[1])); } \
      resc=false; \
      if(__builtin_expect(__any(rm>(float)THRL),0)){ const float dl=__builtin_fmaxf(rm,0.f); mhat+=dl; \
        _Pragma("unroll") for(int r=0;r<16;++r){C0[r]-=dl;C1[r]-=dl;} \
        const float f=__builtin_amdgcn_exp2f(-dl); l_reg*=f; if(hi==0)wsf[r32]=f; resc=true; } \
      SETNEGM((t)+1); } \
    SBAR(); \
    GAPB(o[0]=__builtin_amdgcn_mfma_f32_32x32x16_bf16(PAF(0),VFR(0),o[0],0,0,0), C0,0); \
    GAPB(o[1]=__builtin_amdgcn_mfma_f32_32x32x16_bf16(PAF(0),VFR(4),o[1],0,0,0), C0,4); \
    KRD(GL,0); GAPB(o[0]=__builtin_amdgcn_mfma_f32_32x32x16_bf16(PAF(1),VFR(1),o[0],0,0,0), C0,8); \
    KRD(GL,1); GAPB(o[1]=__builtin_amdgcn_mfma_f32_32x32x16_bf16(PAF(1),VFR(5),o[1],0,0,0), C0,12); \
    KRD(GL,2); GAPB(o[0]=__builtin_amdgcn_mfma_f32_32x32x16_bf16(PAF(2),VFR(2),o[0],0,0,0), C1,0); \
    KRD(GL,3); GAPB(o[1]=__builtin_amdgcn_mfma_f32_32x32x16_bf16(PAF(2),VFR(6),o[1],0,0,0), C1,4); \
    GAPB(o[0]=__builtin_amdgcn_mfma_f32_32x32x16_bf16(PAF(3),VFR(3),o[0],0,0,0), C1,8); \
    GAPB(o[1]=__builtin_amdgcn_mfma_f32_32x32x16_bf16(PAF(3),VFR(7),o[1],0,0,0), C1,12); \
    }while(0)
  int t=1;
  #undef CMASK
  #define CMASK(P0,P1,t) do{}while(0)
  for(;t+5<NT;t+=2){
    STEP(pB0,pB1,pA0,pA1,t,true,true,true);     WAIT_BAR(2); RESC(); ROT();
    STEP(pA0,pA1,pB0,pB1,t+1,true,true,true);   WAIT_BAR(2); RESC(); ROT();
  }
  #undef CMASK
  #define CMASK(P0,P1,t) do{int jb_=(t)-(NT-4); if(jb_>=0)cmask(P0,P1,jb_,qrel,hi);}while(0)
  #define ENDW(tt) do{ if((tt)+3<NT){WAIT_BAR(2);} else if((tt)+2<NT){WAIT_BAR(1);} else {WAIT_BAR(0);} }while(0)
  for(;t+1<NT;t+=2){
    STEP(pB0,pB1,pA0,pA1,t,(t+3<NT),(t+1<NT),(t+1<NT));       ENDW(t);   RESC(); ROT();
    STEP(pA0,pA1,pB0,pB1,t+1,(t+4<NT),(t+2<NT),(t+2<NT));     ENDW(t+1); RESC(); ROT();
  }
  STEP(pB0,pB1,pA0,pA1,NT-1,false,false,false); RESC();
  { float sacc=pB0[0]+pB0[1]; _Pragma("unroll") for(int r=2;r<16;++r)sacc+=pB0[r]; _Pragma("unroll") for(int r=0;r<16;++r)sacc+=pB1[r]; l_reg+=sacc;
    pw0=(u32x4){PKW(pB0,0),PKW(pB0,2),PKW(pB0,4),PKW(pB0,6)};pw1=(u32x4){PKW(pB0,8),PKW(pB0,10),PKW(pB0,12),PKW(pB0,14)};pw2=(u32x4){PKW(pB1,0),PKW(pB1,2),PKW(pB1,4),PKW(pB1,6)};pw3=(u32x4){PKW(pB1,8),PKW(pB1,10),PKW(pB1,12),PKW(pB1,14)};
    SBAR(); pv(o,vb0+sl_cur,PAF(0),PAF(1),PAF(2),PAF(3)); }
  #undef PKW
  #undef PAF
  #undef VFR
  #undef PIN
  #undef MX3
  #undef GAPA
  #undef GAPB
  #undef EX
  #undef VRD
  #undef KRD
  #undef STEP
  #undef ENDW
  {auto rr=__builtin_amdgcn_permlane32_swap(__float_as_uint(l_reg),__float_as_uint(l_reg),false,false);l_reg=__uint_as_float(rr[0])+__uint_as_float(rr[1]);}
  if(hi==0)wsf[32+r32]=l_reg;asm volatile("s_waitcnt lgkmcnt(0)":::"memory");
  float rli[16];
  #pragma unroll
  for(int r=0;r<16;++r)rli[r]=__builtin_amdgcn_rcpf(wsf[32+crow(r,hi)]);
  int lno=lane; asm volatile("":"+v"(lno));
  bf16*Ow=O+(long)(q0+wid*QBLK)*DMO;
  { bf16*stg=(bf16*)(shm+LDS_OST)+wid*2048;
    #pragma unroll
    for(int r=0;r<16;++r){const int orow=crow(r,hi);
      #pragma unroll
      for(int d0=0;d0<2;++d0)stg[orow*64+d0*32+r32]=(bf16)(cvtpk_s(o[d0][r]*rli[r],0.f)&0xffffu);}
    asm volatile("s_waitcnt lgkmcnt(0)":::"memory");
    #pragma unroll
    for(int i=0;i<4;++i){const int row=i*8+(lno>>3),ch=lno&7; const u32x4 v=*(const u32x4*)(stg+row*64+ch*8); ATTN_STORE16(Ow+(long)row*DMO+ch*8,v);} }
  asm volatile("s_waitcnt lgkmcnt(0)\n\ts_barrier":::"memory");
  #undef DMA_K
  #undef DMA_V
  #undef CMASK
  #undef START
  #undef RESC
  #undef ROT
}
constexpr int ATTN_LDS_BYTES=LDS_BYTES;
#undef SBAR
#undef WAIT_BAR
#undef SETNEGM
}
namespace attl {
using bf16=bf16_t;
using bf16x8=__attribute__((ext_vector_type(8)))short;
using s16x4=__attribute__((ext_vector_type(4)))short;
using f32x16=__attribute__((ext_vector_type(16)))float;
using u32x4=__attribute__((ext_vector_type(4)))unsigned;
using f32x4=__attribute__((ext_vector_type(4)))float;
constexpr int DMK=768,DMV=512,DMO=1024;
constexpr int NW=8,QBLK=32,QB=QBLK*NW,KVBLK=64;
__device__ __forceinline__ int crow(int r,int hi){return (r&3)+8*(r>>2)+4*hi;}
#define SBAR() __builtin_amdgcn_sched_barrier(0)
__device__ __forceinline__ void cmask(f32x16&p0,f32x16&p1,int jb,int qrel,int hi){
  const float NEG=-INFINITY; int kb=64*jb+4*hi;
  #pragma unroll
  for(int r=0;r<16;++r){int kv=kb+(r&3)+8*(r>>2); if(kv>qrel)p0[r]=NEG; if(kv+32>qrel)p1[r]=NEG;}
}

constexpr int NSLOT=3, SLOTK=12288, SLOTV=8192;
constexpr int LDS_K=0, LDS_V=NSLOT*SLOTK, LDS_WS=LDS_V+NSLOT*SLOTV, LDS_OST=LDS_WS+NW*64*4, LDS_BYTES=LDS_OST+NW*4096;
constexpr float C2=0.125f*1.4426950408889634f;
__device__ __forceinline__ void glds16(const void*gsrc,unsigned lds_dst){unsigned keep;
  asm volatile("s_mov_b32 %0, m0\n\ts_mov_b32 m0, %2\n\ts_nop 0\n\tglobal_load_lds_dwordx4 %1, off\n\ts_mov_b32 m0, %0":"=&s"(keep):"v"(gsrc),"s"(lds_dst):"memory");}
__device__ __forceinline__ float max3f(float a,float b,float c){float r;asm("v_max3_f32 %0, %1, %2, %3":"=v"(r):"v"(a),"v"(b),"v"(c));return r;}
__device__ __forceinline__ float max2f(float a,float b){float r;asm("v_max_f32_e32 %0, %1, %2":"=v"(r):"v"(a),"v"(b));return r;}
__device__ __forceinline__ float fadd_s(float a,float b){float r;asm("v_add_f32_e32 %0, %1, %2":"=v"(r):"v"(a),"v"(b));return r;}
__device__ __forceinline__ float fsub_s(float a,float b){float r;asm("v_sub_f32_e32 %0, %1, %2":"=v"(r):"v"(a),"v"(b));return r;}
typedef float f32x2_t __attribute__((ext_vector_type(2))); typedef __bf16 bf16x2_t __attribute__((ext_vector_type(2)));
__device__ __forceinline__ unsigned cvtpk_s(float lo,float hi){f32x2_t v={lo,hi};bf16x2_t b=__builtin_convertvector(v,bf16x2_t);return __builtin_bit_cast(unsigned,b);}
__device__ __forceinline__ void glds16s(const void*sbase,unsigned voff,unsigned lds_dst){unsigned keep;
  asm volatile("s_mov_b32 %0, m0\n\ts_mov_b32 m0, %3\n\ts_nop 0\n\tglobal_load_lds_dwordx4 %1, %2\n\ts_mov_b32 m0, %0":"=&s"(keep):"v"(voff),"s"(sbase),"s"(lds_dst):"memory");}
__device__ __forceinline__ const bf16_t* uptr(const bf16_t*p){ const unsigned long long v=(unsigned long long)p; const unsigned lo=__builtin_amdgcn_readfirstlane((unsigned)v),hi=__builtin_amdgcn_readfirstlane((unsigned)(v>>32)); return (const bf16_t*)(((unsigned long long)hi<<32)|lo); }
#define WAIT_BAR(N) asm volatile("s_waitcnt vmcnt(" #N ") lgkmcnt(0)\n\ts_barrier":::"memory")

__device__ __forceinline__ void qkt(f32x16&p0,f32x16&p1,const char*Kslot,const bf16x8*qr,const f32x16&negm,int r32,int hi){
  const char*kb=Kslot+hi*1024+r32*16;
  #pragma unroll
  for(int d0=0;d0<6;++d0){
    const bf16x8 b0=*reinterpret_cast<const bf16x8*>(kb+d0*2048);
    const bf16x8 b1=*reinterpret_cast<const bf16x8*>(kb+d0*2048+512);
    if(d0==0){p0=__builtin_amdgcn_mfma_f32_32x32x16_bf16(b0,qr[0],negm,0,0,0);p1=__builtin_amdgcn_mfma_f32_32x32x16_bf16(b1,qr[0],negm,0,0,0);}
    else{p0=__builtin_amdgcn_mfma_f32_32x32x16_bf16(b0,qr[d0],p0,0,0,0);p1=__builtin_amdgcn_mfma_f32_32x32x16_bf16(b1,qr[d0],p1,0,0,0);}}
}
typedef __attribute__((address_space(3))) const char* lds_cptr;
typedef short v4i16_t __attribute__((ext_vector_type(4)));
__device__ __forceinline__ void kload8(bf16x8*kf,lds_cptr kp){
  kf[0]=*(const __attribute__((address_space(3))) bf16x8*)(kp);      kf[1]=*(const __attribute__((address_space(3))) bf16x8*)(kp+512);
  kf[2]=*(const __attribute__((address_space(3))) bf16x8*)(kp+2048); kf[3]=*(const __attribute__((address_space(3))) bf16x8*)(kp+2560);
  kf[4]=*(const __attribute__((address_space(3))) bf16x8*)(kp+4096); kf[5]=*(const __attribute__((address_space(3))) bf16x8*)(kp+4608);
  kf[6]=*(const __attribute__((address_space(3))) bf16x8*)(kp+6144); kf[7]=*(const __attribute__((address_space(3))) bf16x8*)(kp+6656);
  kf[8]=*(const __attribute__((address_space(3))) bf16x8*)(kp+8192); kf[9]=*(const __attribute__((address_space(3))) bf16x8*)(kp+8704);
  kf[10]=*(const __attribute__((address_space(3))) bf16x8*)(kp+10240); kf[11]=*(const __attribute__((address_space(3))) bf16x8*)(kp+10752);
}
__device__ __forceinline__ void kload2(bf16x8*kf,lds_cptr kp,int j){ kf[2*j]=*(const __attribute__((address_space(3))) bf16x8*)(kp+j*2048); kf[2*j+1]=*(const __attribute__((address_space(3))) bf16x8*)(kp+j*2048+512); }
__device__ __forceinline__ s16x4 vtr(lds_cptr p){ return __builtin_bit_cast(s16x4,__builtin_amdgcn_ds_read_tr16_b64_v4i16((__attribute__((address_space(3))) v4i16_t*)p)); }
__device__ __forceinline__ float rowmax(const f32x16&p0,const f32x16&p1){
  float a=max3f(p0[0],p0[1],p1[0]),b=max3f(p0[2],p0[3],p1[1]);a=max3f(a,p1[2],p1[3]);
  #pragma unroll
  for(int r=4;r<16;r+=4){a=max3f(a,p0[r],p0[r+1]);b=max3f(b,p0[r+2],p0[r+3]);a=max3f(a,p1[r],p1[r+1]);b=max3f(b,p1[r+2],p1[r+3]);}
  const float m=max2f(a,b);
  auto rr=__builtin_amdgcn_permlane32_swap(__float_as_uint(m),__float_as_uint(m),false,false);
  return max2f(__uint_as_float(rr[0]),__uint_as_float(rr[1]));
}
__device__ __forceinline__ void pv(f32x16*o,int vb,bf16x8 pa0,bf16x8 pa1,bf16x8 pa2,bf16x8 pa3){
  #pragma unroll
  for(int d0=0;d0<2;++d0){s16x4 lo[4],hi[4];
    #pragma unroll
    for(int ks=0;ks<4;++ks){
      asm volatile("ds_read_b64_tr_b16 %0,%1 offset:%c2":"=&v"(lo[ks]):"v"(vb),"i"(d0*4096+ks*1024):"memory");
      asm volatile("ds_read_b64_tr_b16 %0,%1 offset:%c2":"=&v"(hi[ks]):"v"(vb),"i"(d0*4096+ks*1024+512):"memory");}
    asm volatile("s_waitcnt lgkmcnt(0)":::"memory");SBAR();
    #define PK(k) (bf16x8){lo[k][0],lo[k][1],lo[k][2],lo[k][3],hi[k][0],hi[k][1],hi[k][2],hi[k][3]}
    o[d0]=__builtin_amdgcn_mfma_f32_32x32x16_bf16(pa0,PK(0),o[d0],0,0,0);
    o[d0]=__builtin_amdgcn_mfma_f32_32x32x16_bf16(pa1,PK(1),o[d0],0,0,0);
    o[d0]=__builtin_amdgcn_mfma_f32_32x32x16_bf16(pa2,PK(2),o[d0],0,0,0);
    o[d0]=__builtin_amdgcn_mfma_f32_32x32x16_bf16(pa3,PK(3),o[d0],0,0,0);
    #undef PK
  }
}

#ifndef ATTN_STORE16
#define ATTN_STORE16(p,v) (*(u32x4*)(p)=(v))
#endif
template<int THRL> __device__ __forceinline__ void attn_unit(int qb,const bf16*Q,const bf16*__restrict__ K,const bf16*__restrict__ V,bf16*O,const Ctx&B,char*shm){
  const int tid=threadIdx.x; int lane=tid&63; asm volatile("":"+v"(lane));
  const int r32=lane&31,hi=lane>>5; const int wid=__builtin_amdgcn_readfirstlane(tid>>6);
  const int q0=qb*QB;
  const bf16*Qw=Q+(long)(q0+wid*QBLK)*DMK;
  const bf16*Kh=K,*Vh=V;
  const unsigned lds0=(unsigned)(uintptr_t)shm;
  float*wsf=(float*)(shm+LDS_WS)+wid*64;
  const unsigned koff=(unsigned)(lane*DMK+wid*8)*2u, koff2=(unsigned)(lane*DMK+(8+(wid&3))*8)*2u;
  const unsigned voffv=(unsigned)((16*(wid&3)+(lane>>2))*DMV+(wid>>2)*32+(lane&3)*8)*2u;
  const unsigned kdst=lds0+LDS_K+wid*1024, kdst2=lds0+LDS_K+(8+(wid&3))*1024, vdst=lds0+LDS_V+wid*1024;
  #define DMA_K(t,slot) do{ const bf16*kb_=uptr(Kh+(long)(t)*KVBLK*DMK); glds16s(kb_,koff,(unsigned)__builtin_amdgcn_readfirstlane(kdst+(slot)*SLOTK)); glds16s(kb_,koff2,(unsigned)__builtin_amdgcn_readfirstlane(kdst2+(slot)*SLOTK)); }while(0)
  #define DMA_V(t,slot) glds16s(uptr(Vh+(long)(t)*KVBLK*DMV),voffv,(unsigned)__builtin_amdgcn_readfirstlane(vdst+(slot)*SLOTV))
  const int vb0=(int)(lds0+LDS_V)+((lane>>4)&1)*32+(lane&3)*8+(4*hi+((lane&15)>>2))*64;
  const char*Kbase=shm+LDS_K; bf16x8 kf[12];
  const lds_cptr shm3=(lds_cptr)shm; const lds_cptr kp0=shm3+LDS_K+hi*1024+r32*16; const lds_cptr vp0=shm3+LDS_V+((lane>>4)&1)*32+(lane&3)*8+(4*hi+((lane&15)>>2))*64;
  const int NT=(q0+QB)/KVBLK;
  DMA_K(0,0);DMA_V(0,0);DMA_K(1,1);
  bf16x8 qr[6];
  { u32x4 raw[6]; float ss=0.f; const bf16*Ql=Qw+(long)r32*DMK+hi*8;
    #pragma unroll
    for(int d0=0;d0<6;++d0){ raw[d0]=__builtin_nontemporal_load(reinterpret_cast<const u32x4*>(Ql+d0*16));
      #pragma unroll
      for(int w=0;w<4;++w){ const float a=__uint_as_float(raw[d0][w]<<16),bb=__uint_as_float(raw[d0][w]&0xffff0000u); ss+=a*a+bb*bb; } }
    { auto rr=__builtin_amdgcn_permlane32_swap(__float_as_uint(ss),__float_as_uint(ss),false,false); ss=__uint_as_float(rr[0])+__uint_as_float(rr[1]); }
    const float rq=(1.0f/sqrtf(ss*(1.0f/96)+EPS))*C2B; const float*g=B.glq()+hi*8;
    float qf[6][8];
    #pragma unroll
    for(int d0=0;d0<6;++d0){ const f32x4 ga=*(const f32x4*)(g+d0*16),gb=*(const f32x4*)(g+d0*16+4);
      #pragma unroll
      for(int w=0;w<4;++w){ qf[d0][2*w]=__uint_as_float(raw[d0][w]<<16)*rq*(w<2?ga[2*w]:gb[2*w-4]); qf[d0][2*w+1]=__uint_as_float(raw[d0][w]&0xffff0000u)*rq*(w<2?ga[2*w+1]:gb[2*w-3]); } }
    { const int pos=q0+wid*QBLK+r32; const f32x4 ca=*(const f32x4*)(B.COSB()+pos*16+hi*8),cb=*(const f32x4*)(B.COSB()+pos*16+hi*8+4),sa=*(const f32x4*)(B.SINB()+pos*16+hi*8),sb=*(const f32x4*)(B.SINB()+pos*16+hi*8+4);
      #pragma unroll
      for(int j=0;j<8;++j){ const float c=j<4?ca[j]:cb[j-4],sn=j<4?sa[j]:sb[j-4],x1=qf[4][j],x2=qf[5][j]; qf[4][j]=x1*c-x2*sn; qf[5][j]=x2*c+x1*sn; } }
    #pragma unroll
    for(int d0=0;d0<6;++d0){ const u32x4 w={cvtpk_s(qf[d0][0],qf[d0][1]),cvtpk_s(qf[d0][2],qf[d0][3]),cvtpk_s(qf[d0][4],qf[d0][5]),cvtpk_s(qf[d0][6],qf[d0][7])}; qr[d0]=__builtin_bit_cast(bf16x8,w); } }
  float mhat=0.f,l_reg=0.f;f32x16 o[2];o[0]=f32x16{};o[1]=f32x16{};
  #define MSUB(tt) (mhat)
  const int qrel=wid*QBLK+r32;
  #define CMASK(P0,P1,t) do{int jb_=(t)-(NT-4); if(jb_>=0)cmask(P0,P1,jb_,qrel,hi);}while(0)
  bool resc=false;
  #define START(P0,P1) do{ const float rm=fsub_s(rowmax(P0,P1),MSUB(0)); resc=false; \
    { const float dl=(rm==-INFINITY)?0.f:rm; mhat=fadd_s(mhat,dl); } \
    msub0=MSUB(0); \
    _Pragma("unroll") for(int r=0;r<16;++r)P0[r]=__builtin_amdgcn_exp2f(fsub_s(P0[r],msub0)); }while(0)
  #define RESC() do{ if(resc){ asm volatile("s_waitcnt lgkmcnt(0)":::"memory"); \
      _Pragma("unroll") for(int d_=0;d_<2;++d_) _Pragma("unroll") for(int r=0;r<16;++r)o[d_][r]*=wsf[crow(r,hi)]; } }while(0)
  f32x16 pA0,pA1,pB0,pB1;
  int sl_prev=0,sl_cur=0,sl_next=1;
  #define ROT() do{sl_prev=sl_cur;sl_cur=sl_next;sl_next=(sl_next==NSLOT-1)?0:sl_next+1;}while(0)
  DMA_K(2,2);
  WAIT_BAR(5);
  const f32x16 zc=f32x16{}; float msub0;
  qkt(pA0,pA1,Kbase,qr,zc,r32,hi);asm volatile("s_nop 15\n\ts_nop 7":"+v"(pA0),"+v"(pA1));CMASK(pA0,pA1,0);
  START(pA0,pA1);
  _Pragma("unroll") for(int r=0;r<16;++r)pA1[r]=__builtin_amdgcn_exp2f(fsub_s(pA1[r],msub0));
  WAIT_BAR(0);
  DMA_K(3,0);DMA_V(1,1);
  ROT();
  kload8(kf,kp0+sl_cur*SLOTK);
  WAIT_BAR(3);
  s16x4 vlo[8],vhi[8]; u32x4 pw0,pw1,pw2,pw3;
  #define PKW(P,B) cvtpk_s(P[B],P[B+1])
  #define PAF(k) __builtin_bit_cast(bf16x8,pw##k)
  #define VFR(i) (bf16x8){vlo[i][0],vlo[i][1],vlo[i][2],vlo[i][3],vhi[i][0],vhi[i][1],vhi[i][2],vhi[i][3]}
  #define PIN(x) asm volatile("":"+v"(x))
  #define MX3(a,b,c) __builtin_fmaxf(__builtin_fmaxf((a),(b)),(c))
  #define GAPA(MF,A0,A1,A2,A3,W0,W1,PW) do{ MF; sacc+=A0; sacc+=A1; sacc+=A2; sacc+=A3; PIN(sacc); W0; W1; PIN(PW); SBAR(); }while(0)
  #define EX(v) __builtin_amdgcn_exp2f((v)-msub)
  #define GAPB(MF,X,B) do{ MF; X[B]=EX(X[B]); X[B+1]=EX(X[B+1]); X[B+2]=EX(X[B+2]); X[B+3]=EX(X[B+3]); PIN(X); SBAR(); }while(0)
  #define VRD(i) do{ vlo[i]=vtr(vp_+(((i)>>2)*4096+((i)&3)*1024)); vhi[i]=vtr(vp_+(((i)>>2)*4096+((i)&3)*1024+512)); }while(0)
  #define KRD(G,j) do{ if(G){ kload2(kf,kp0+sl_next*SLOTK,j); SBAR(); } }while(0)
  #define STEP(C0,C1,P0,P1,t,GK,GV,GL) do{ SBAR(); float msub; \
    const lds_cptr vp_=vp0+sl_prev*SLOTV; \
    C0=__builtin_amdgcn_mfma_f32_32x32x16_bf16(kf[8],qr[4],zc,0,0,0); C1=__builtin_amdgcn_mfma_f32_32x32x16_bf16(kf[9],qr[4],zc,0,0,0); SBAR(); \
    C0=__builtin_amdgcn_mfma_f32_32x32x16_bf16(kf[10],qr[5],C0,0,0,0); C1=__builtin_amdgcn_mfma_f32_32x32x16_bf16(kf[11],qr[5],C1,0,0,0); SBAR(); \
    VRD(0); SBAR(); float sacc=(P0[0]+P0[1]); \
    GAPA(C0=__builtin_amdgcn_mfma_f32_32x32x16_bf16(kf[0],qr[0],C0,0,0,0), P0[2],P0[3],P0[4],P0[5],     pw0[0]=PKW(P0,0), pw0[1]=PKW(P0,2), pw0); \
    VRD(4); SBAR(); GAPA(C1=__builtin_amdgcn_mfma_f32_32x32x16_bf16(kf[1],qr[0],C1,0,0,0), P0[6],P0[7],P0[8],P0[9],     pw0[2]=PKW(P0,4), pw0[3]=PKW(P0,6), pw0); \
    VRD(1); SBAR(); GAPA(C0=__builtin_amdgcn_mfma_f32_32x32x16_bf16(kf[2],qr[1],C0,0,0,0),   P0[10],P0[11],P0[12],P0[13], pw1[0]=PKW(P0,8), pw1[1]=PKW(P0,10), pw1); \
    VRD(5); SBAR(); GAPA(C1=__builtin_amdgcn_mfma_f32_32x32x16_bf16(kf[3],qr[1],C1,0,0,0),   P0[14],P0[15],P1[0],P1[1],   pw1[2]=PKW(P0,12),pw1[3]=PKW(P0,14), pw1); \
    VRD(2); SBAR(); GAPA(C0=__builtin_amdgcn_mfma_f32_32x32x16_bf16(kf[4],qr[2],C0,0,0,0),   P1[2],P1[3],P1[4],P1[5],     pw2[0]=PKW(P1,0), pw2[1]=PKW(P1,2), pw2); \
    VRD(6); SBAR(); GAPA(C1=__builtin_amdgcn_mfma_f32_32x32x16_bf16(kf[5],qr[2],C1,0,0,0),   P1[6],P1[7],P1[8],P1[9],     pw2[2]=PKW(P1,4), pw2[3]=PKW(P1,6), pw2); \
    VRD(3); SBAR(); GAPA(C0=__builtin_amdgcn_mfma_f32_32x32x16_bf16(kf[6],qr[3],C0,0,0,0),   P1[10],P1[11],P1[12],P1[13], pw3[0]=PKW(P1,8), pw3[1]=PKW(P1,10), pw3); \
    VRD(7); SBAR(); GAPA(C1=__builtin_amdgcn_mfma_f32_32x32x16_bf16(kf[7],qr[3],C1,0,0,0),   P1[14],P1[15],0.f,0.f,       pw3[2]=PKW(P1,12),pw3[3]=PKW(P1,14), pw3); \
    l_reg+=sacc; \
    if(GK){DMA_K((t)+3,sl_cur);} if(GV){DMA_V((t)+1,sl_next);} \
    CMASK(C0,C1,t); \
    { float a=MX3(C0[0],C0[1],C1[0]),b=MX3(C0[2],C0[3],C1[1]); a=MX3(a,C1[2],C1[3]); \
      _Pragma("unroll") for(int r=4;r<16;r+=4){a=MX3(a,C0[r],C0[r+1]);b=MX3(b,C0[r+2],C0[r+3]);a=MX3(a,C1[r],C1[r+1]);b=MX3(b,C1[r+2],C1[r+3]);} \
      float rm=__builtin_fmaxf(a,b); { auto rr=__builtin_amdgcn_permlane32_swap(__float_as_uint(rm),__float_as_uint(rm),false,false); rm=__builtin_fmaxf(__uint_as_float(rr[0]),__uint_as_float(rr[1])); } \
      msub=MSUB(t); rm-=msub; \
      resc=false; \
      if(__builtin_expect(__any(rm>(float)THRL),0)){ const float dl=__builtin_fmaxf(rm,0.f); mhat+=dl; msub+=dl; \
        const float f=__builtin_amdgcn_exp2f(-dl); l_reg*=f; if(hi==0)wsf[r32]=f; resc=true; } } \
    SBAR(); \
    GAPB(o[0]=__builtin_amdgcn_mfma_f32_32x32x16_bf16(PAF(0),VFR(0),o[0],0,0,0), C0,0); \
    KRD(GL,0); GAPB(o[1]=__builtin_amdgcn_mfma_f32_32x32x16_bf16(PAF(0),VFR(4),o[1],0,0,0), C0,4); \
    KRD(GL,1); GAPB(o[0]=__builtin_amdgcn_mfma_f32_32x32x16_bf16(PAF(1),VFR(1),o[0],0,0,0), C0,8); \
    KRD(GL,2); GAPB(o[1]=__builtin_amdgcn_mfma_f32_32x32x16_bf16(PAF(1),VFR(5),o[1],0,0,0), C0,12); \
    KRD(GL,3); GAPB(o[0]=__builtin_amdgcn_mfma_f32_32x32x16_bf16(PAF(2),VFR(2),o[0],0,0,0), C1,0); \
    KRD(GL,4); GAPB(o[1]=__builtin_amdgcn_mfma_f32_32x32x16_bf16(PAF(2),VFR(6),o[1],0,0,0), C1,4); \
    KRD(GL,5); GAPB(o[0]=__builtin_amdgcn_mfma_f32_32x32x16_bf16(PAF(3),VFR(3),o[0],0,0,0), C1,8); \
    GAPB(o[1]=__builtin_amdgcn_mfma_f32_32x32x16_bf16(PAF(3),VFR(7),o[1],0,0,0), C1,12); \
    }while(0)
  int t=1;
  #undef CMASK
  #define CMASK(P0,P1,t) do{}while(0)
  for(;t+5<NT;t+=2){
    STEP(pB0,pB1,pA0,pA1,t,true,true,true);     WAIT_BAR(3); RESC(); ROT();
    STEP(pA0,pA1,pB0,pB1,t+1,true,true,true);   WAIT_BAR(3); RESC(); ROT();
  }
  #undef CMASK
  #define CMASK(P0,P1,t) do{int jb_=(t)-(NT-4); if(jb_>=0)cmask(P0,P1,jb_,qrel,hi);}while(0)
  #define ENDW(tt) do{ if((tt)+3<NT){WAIT_BAR(3);} else if((tt)+2<NT){WAIT_BAR(1);} else {WAIT_BAR(0);} }while(0)
  for(;t+1<NT;t+=2){
    STEP(pB0,pB1,pA0,pA1,t,(t+3<NT),(t+1<NT),(t+1<NT));       ENDW(t);   RESC(); ROT();
    STEP(pA0,pA1,pB0,pB1,t+1,(t+4<NT),(t+2<NT),(t+2<NT));     ENDW(t+1); RESC(); ROT();
  }
  STEP(pB0,pB1,pA0,pA1,NT-1,false,false,false); RESC();
  { float sacc=pB0[0]+pB0[1]; _Pragma("unroll") for(int r=2;r<16;++r)sacc+=pB0[r]; _Pragma("unroll") for(int r=0;r<16;++r)sacc+=pB1[r]; l_reg+=sacc;
    pw0=(u32x4){PKW(pB0,0),PKW(pB0,2),PKW(pB0,4),PKW(pB0,6)};pw1=(u32x4){PKW(pB0,8),PKW(pB0,10),PKW(pB0,12),PKW(pB0,14)};pw2=(u32x4){PKW(pB1,0),PKW(pB1,2),PKW(pB1,4),PKW(pB1,6)};pw3=(u32x4){PKW(pB1,8),PKW(pB1,10),PKW(pB1,12),PKW(pB1,14)};
    SBAR(); pv(o,vb0+sl_cur*SLOTV,PAF(0),PAF(1),PAF(2),PAF(3)); }
  #undef PKW
  #undef PAF
  #undef VFR
  #undef PIN
  #undef MX3
  #undef GAPA
  #undef GAPB
  #undef EX
  #undef VRD
  #undef KRD
  #undef STEP
  #undef ENDW
  {auto rr=__builtin_amdgcn_permlane32_swap(__float_as_uint(l_reg),__float_as_uint(l_reg),false,false);l_reg=__uint_as_float(rr[0])+__uint_as_float(rr[1]);}
  if(hi==0)wsf[32+r32]=l_reg;asm volatile("s_waitcnt lgkmcnt(0)":::"memory");
  float rli[16];
  #pragma unroll
  for(int r=0;r<16;++r)rli[r]=__builtin_amdgcn_rcpf(wsf[32+crow(r,hi)]);
  int lno=lane; asm volatile("":"+v"(lno));
  bf16*Ow=O+(long)(q0+wid*QBLK)*DMO;
  { bf16*stg=(bf16*)(shm+LDS_OST)+wid*2048;
    #pragma unroll
    for(int r=0;r<16;++r){const int orow=crow(r,hi);
      #pragma unroll
      for(int d0=0;d0<2;++d0)stg[orow*64+d0*32+r32]=(bf16)(cvtpk_s(o[d0][r]*rli[r],0.f)&0xffffu);}
    asm volatile("s_waitcnt lgkmcnt(0)":::"memory");
    #pragma unroll
    for(int i=0;i<4;++i){const int row=i*8+(lno>>3),ch=lno&7; const u32x4 v=*(const u32x4*)(stg+row*64+ch*8); ATTN_STORE16(Ow+(long)row*DMO+ch*8,v);} }
  asm volatile("s_waitcnt lgkmcnt(0)\n\ts_barrier":::"memory");
  #undef DMA_K
  #undef DMA_V
  #undef CMASK
  #undef START
  #undef RESC
  #undef ROT
}
constexpr int ATTN_LDS_BYTES=LDS_BYTES;
#undef SBAR
#undef WAIT_BAR
#undef MSUB
}
constexpr int NWAVES = 8;
constexpr int N_PHASES = 7;
constexpr int CW_TMO = 0, CW_CODE = 1;
constexpr int CW_BAR = 4096;
constexpr int CW_DEP4 = 65536, CW_DEP5 = CW_DEP4 + 128 * 64;
constexpr int CW_GRP = 32768;
constexpr int RING_OFF = 0, RING_BYTES = 131072;
constexpr int LDSCTL_OFF = RING_BYTES, MISC_OFF = LDSCTL_OFF + 320;
constexpr int LDS_BYTES = 163840;
static_assert(EPI_LDS_OFF == MISC_OFF + 192 && EPI_LDS_OFF + 8 * 2048 <= LDS_BYTES, "LDS map");
static_assert(attm::ATTN_LDS_BYTES <= RING_BYTES && attl::ATTN_LDS_BYTES <= RING_BYTES && pg8::STAGE_BYTES <= RING_BYTES, "LDS map");

#define GAS __attribute__((address_space(1)))
#define LAS __attribute__((address_space(3)))
typedef unsigned v4u __attribute__((ext_vector_type(4)));
typedef float f32x4 __attribute__((ext_vector_type(4)));
typedef GAS unsigned gu32;
#define RLX_AGENT __ATOMIC_RELAXED, __HIP_MEMORY_SCOPE_AGENT
#define LDS_WAIT() asm volatile("s_waitcnt lgkmcnt(0)" ::: "memory")
#define VM_WAIT() asm volatile("s_waitcnt vmcnt(0)" ::: "memory")
__device__ __forceinline__ unsigned f2bf(float f) { unsigned u = __builtin_bit_cast(unsigned, f); return (u + 0x7fffu + ((u >> 16) & 1u)) >> 16; }
__device__ __forceinline__ unsigned pk2(float lo, float hi) { return f2bf(lo) | (f2bf(hi) << 16); }

#define XB_TMO      128
#define XB_XCNT(j)  (256  + 64 * (j))
#define XB_XSUB(j)  (1280 + 64 * (j))
#define XB_XGEN(j)  (2304 + 64 * (j))
#define XB_TOP      3328
#define XB_TOPGEN   3392
#define XCD_BAR_WORDS 3456
#define XB_SPIN_CAP (1u << 18)
__device__ __forceinline__ unsigned xb_ld(unsigned* p)              { return __hip_atomic_load(p, __ATOMIC_RELAXED, __HIP_MEMORY_SCOPE_AGENT); }
__device__ __forceinline__ unsigned xb_add(unsigned* p, unsigned v) { return __hip_atomic_fetch_add(p, v, __ATOMIC_RELAXED, __HIP_MEMORY_SCOPE_AGENT); }
__device__ __forceinline__ unsigned xb_xcc_id() { return (unsigned)__builtin_amdgcn_s_getreg((3 << 11) | 20) & 0xFu; }
#define XB_SPIN(cond, bar) do { unsigned _sp = 0; while (cond) { __builtin_amdgcn_s_sleep(1); \
    if ((++_sp & 255u) == 0u) { if (xb_ld(&(bar)[XB_TMO])) break; if (_sp > XB_SPIN_CAP) { atomicAdd(&(bar)[XB_TMO], 1u); break; } } } } while (0)
struct XcdBarrier { unsigned* bar; unsigned x; volatile LAS unsigned* st; };
__device__ __forceinline__ XcdBarrier xcd_barrier_post(unsigned* bar, volatile LAS unsigned* st) {
    XcdBarrier b; b.bar = bar; b.x = xb_xcc_id(); b.st = st;
    if (threadIdx.x == 0) (void)xb_add(&bar[XB_XCNT(b.x)], 1u);
    return b;
}
__device__ __forceinline__ void xcd_barrier_complete(unsigned* bar, unsigned x, unsigned& nloc, unsigned& nx) {
    const unsigned G = gridDim.x * gridDim.y * gridDim.z;
    unsigned sum, cnt, mine, sp = 0u;
    for (;;) {
        sum = 0u; cnt = 0u; mine = 0u;
#pragma unroll
        for (unsigned j = 0; j < 16; ++j) { const unsigned c = xb_ld(&bar[XB_XCNT(j)]); sum += c; cnt += (c > 0u) ? 1u : 0u; mine = (j == x) ? c : mine; }
        if (sum == G) break;
        __builtin_amdgcn_s_sleep(1);
        if ((++sp & 255u) == 0u) { if (xb_ld(&bar[XB_TMO])) break; if (sp > XB_SPIN_CAP) { atomicAdd(&bar[XB_TMO], 1u); break; } }
    }
    nloc = mine > 0u ? mine : 1u; nx = cnt > 0u ? cnt : 1u;
}
__device__ __forceinline__ void xcd_barrier(const XcdBarrier& b) {
    asm volatile("s_waitcnt vmcnt(0)" ::: "memory");
    __syncthreads();
    if (threadIdx.x == 0) {
        unsigned* bar = b.bar;
        __builtin_amdgcn_s_waitcnt(0);
        unsigned nloc = b.st[0], nx = b.st[1];
        if (nloc == 0u) { xcd_barrier_complete(bar, b.x, nloc, nx); b.st[0] = nloc; b.st[1] = nx; }
        const unsigned old = xb_add(&bar[XB_XSUB(b.x)], 1u);
        const unsigned gen = old / nloc;
        if (old + 1u == (gen + 1u) * nloc) {
            __builtin_amdgcn_fence(__ATOMIC_RELEASE, "agent");
            asm volatile("s_waitcnt vmcnt(0)" ::: "memory");
            const unsigned og = xb_add(&bar[XB_TOP], 1u);
            const unsigned tg = og / nx;
            if (og + 1u == (tg + 1u) * nx) xb_add(&bar[XB_TOPGEN], 1u);
            else XB_SPIN(xb_ld(&bar[XB_TOPGEN]) == tg, bar);
            __builtin_amdgcn_fence(__ATOMIC_ACQUIRE, "agent");
            xb_add(&bar[XB_XGEN(b.x)], 1u);
            asm volatile("s_waitcnt vmcnt(0)" ::: "memory");
        } else {
            XB_SPIN(xb_ld(&bar[XB_XGEN(b.x)]) == gen, bar);
            __builtin_amdgcn_fence(__ATOMIC_ACQUIRE, "agent");
            asm volatile("s_waitcnt vmcnt(0)" ::: "memory");
        }
    }
    __syncthreads();
}

struct GrpBarrier { unsigned* cnt; unsigned size, gen; };
__device__ __forceinline__ void grp_barrier(GrpBarrier& b, unsigned* tmo) {
    asm volatile("s_waitcnt vmcnt(0)" ::: "memory");
    __syncthreads();
    if (threadIdx.x == 0) {
        __builtin_amdgcn_fence(__ATOMIC_RELEASE, "agent");
        asm volatile("s_waitcnt vmcnt(0)" ::: "memory");
        (void)xb_add(b.cnt, 1u);
        const unsigned target = b.size * (b.gen + 1u); unsigned sp = 0u;
        while (xb_ld(b.cnt) < target) { __builtin_amdgcn_s_sleep(1); if ((++sp & 255u) == 0u) { if (xb_ld(tmo)) break; if (sp > XB_SPIN_CAP) { atomicAdd(tmo, 1u); break; } } }
        __builtin_amdgcn_fence(__ATOMIC_ACQUIRE, "agent");
        asm volatile("s_waitcnt vmcnt(0)" ::: "memory");
    }
    b.gen += 1u;
    __syncthreads();
}

__device__ __forceinline__ void p0_item(const float* W, int ldw, int col0, int ksrc0, const float* gain, bf16_t* WT, int Kdst, int rowdst0, int kdst0, LAS float* scr, int lane) {
    const int c = lane & 7;
    if (W == nullptr) {
#pragma unroll
        for (int j = 0; j < 4; ++j) { const int n = (lane >> 3) + 8 * j; *(GAS v4u*)(WT + (size_t)(rowdst0 + n) * Kdst + kdst0 + 8 * c) = (v4u){0u, 0u, 0u, 0u}; }
        return; }
    const float gvec = gain ? gain[ksrc0 + lane] : 1.0f;
    float wv[32];
#pragma unroll
    for (int i = 0; i < 32; ++i) wv[i] = __builtin_nontemporal_load(W + (size_t)(ksrc0 + 2 * i + (lane >> 5)) * ldw + col0 + (lane & 31));
#pragma unroll
    for (int i = 0; i < 32; ++i) { const int kk = 2 * i + (lane >> 5); scr[kk * 33 + (lane & 31)] = wv[i] * __shfl(gvec, kk); }
    LDS_WAIT(); asm volatile("" ::: "memory");
#pragma unroll
    for (int j = 0; j < 4; ++j) { const int n = (lane >> 3) + 8 * j; const LAS float* s = scr + (8 * c) * 33 + n;
        v4u o; o.x = pg8::cvt_pk_bf16(s[0 * 33], s[1 * 33]); o.y = pg8::cvt_pk_bf16(s[2 * 33], s[3 * 33]); o.z = pg8::cvt_pk_bf16(s[4 * 33], s[5 * 33]); o.w = pg8::cvt_pk_bf16(s[6 * 33], s[7 * 33]);
        *(GAS v4u*)(WT + (size_t)(rowdst0 + n) * Kdst + kdst0 + 8 * c) = o; }
    LDS_WAIT(); asm volatile("" ::: "memory");
}
__device__ __forceinline__ float wave_sum(float v) {
#pragma unroll
    for (int o = 1; o < 64; o <<= 1) v += __shfl_xor(v, o);
    return v;
}

struct Args { float* out; unsigned char* ws; int ph_lo, ph_hi, li, pad; const float* in[16]; };
__global__ void __launch_bounds__(NWAVES * 64, 2) fwd_mega(Args args) {
    extern __shared__ __attribute__((aligned(16))) unsigned char lds_raw[];
    LAS unsigned char* lds = (LAS unsigned char*)lds_raw;
    volatile LAS unsigned* MISC = (volatile LAS unsigned*)(lds + MISC_OFF);
    const int tid = threadIdx.x, lane = tid & 63, wave = __builtin_amdgcn_readfirstlane(tid >> 6);
    const int G = gridDim.x, bx = blockIdx.x, vcu = (G % 8 == 0) ? (bx % 8) * (G / 8) + bx / 8 : bx;
    unsigned char* ws = args.ws; Ctx B; B.x = nullptr; B.out = args.out; B.ws = ws;
    const float* const* inp = (const float* const*)((const char*)__builtin_amdgcn_kernarg_segment_ptr() + __builtin_offsetof(Args, in));
    gu32* ctl = (gu32*)(ws + WS_CTL);
    for (int u = tid; u < (LDS_BYTES - LDSCTL_OFF) / 4; u += NWAVES * 64) ((LAS unsigned*)(lds + LDSCTL_OFF))[u] = 0u;
    __syncthreads();
    XcdBarrier bar = xcd_barrier_post((unsigned*)(ctl + CW_BAR) + args.li * XCD_BAR_WORDS, MISC + 8);
#ifndef GROUPED_SEAMS
#define GROUPED_SEAMS 1
#endif
    const bool grouped = GROUPED_SEAMS && (G == 256);
    GrpBarrier gbar; gbar.cnt = (unsigned*)(ctl + CW_GRP) + (args.li * 8 + (bx & 7)) * 64; gbar.size = (unsigned)(G / 8); gbar.gen = 0u;
    const int lo = args.ph_lo, hi = args.ph_hi;
#ifndef PHASE_MASK
#define PHASE_MASK 0x7f
#endif
#define IN(k) (((PHASE_MASK >> (k)) & 1) && lo <= (k) && (k) < hi)
#ifndef REP0
#define REP0 1
#endif
#ifndef REP1
#define REP1 1
#endif
#ifndef REP2
#define REP2 1
#endif
#ifndef REP3
#define REP3 1
#endif
#ifndef REP4
#define REP4 1
#endif
#ifndef REP5
#define REP5 1
#endif
#ifndef DUPU1
#define DUPU1 0
#endif
#ifndef DUPU5
#define DUPU5 0
#endif
#ifndef DUPU6
#define DUPU6 0
#endif
#ifndef REPG
#define REPG 1
#endif
#ifndef REPB
#define REPB 1
#endif
#define SEAM(k) do { if (IN(k) && IN((k) + 1)) { for (int rb_ = 0; rb_ < REPB; ++rb_) { if ((k) == 0 || !grouped) xcd_barrier(bar); else grp_barrier(gbar, (unsigned*)(ctl + CW_BAR) + args.li * XCD_BAR_WORDS + XB_TMO); } } } while (0)

    if (IN(0)) { B.x = inp[0]; for (int rep_ = 0; rep_ < REP0; ++rep_) {
        LAS float* scr = (LAS float*)(lds + RING_OFF + wave * 16384);
        const int hw = wave & 3, gw = vcu * 4 + hw, NGW = G * 4;
        constexpr int I_IN = 64 * 16, I_QU = 32 * 4, I_KVU = 32 * 2, I_O = 32 * 16, I_GU = 176 * 16, I_D = 32 * 44, NITEMS = I_IN + I_QU + I_KVU + I_O + I_GU + I_D;
#ifndef REPW
#define REPW 1
#endif
#ifndef REPX
#define REPX 1
#endif
        if (wave >= 4)
        for (int rw_ = 0; rw_ < REPW; ++rw_)
        for (int it = gw; it < NITEMS; it += NGW) {
            int r = it;
            if (r < I_IN) { const int Gp = r >> 4, kb = r & 15, pn = Gp >> 3, bj = (Gp >> 2) & 1, wc = Gp & 3, col0 = pn * 256 + wc * 64 + bj * 32;
                p0_item(col0 < INW ? inp[nv::I_WIN] : nullptr, INW, col0, kb * 64, inp[nv::I_GATT], B.WIN(), DM, Gp * 32, kb * 64, scr, lane); continue; } r -= I_IN;
            if (r < I_QU) { const int Gp = r >> 2, kb = r & 3, pn = Gp >> 3, bj = (Gp >> 2) & 1, wc = Gp & 3, head = 2 * pn + (wc >> 1); const bool z = (wc & 1) && bj; const int col0 = head * 96 + ((wc & 1) ? 64 : bj * 32);
                p0_item(z ? nullptr : inp[nv::I_WQUP], 768, col0, kb * 64, inp[nv::I_GQA], B.WQUP(), 256, Gp * 32, kb * 64, scr, lane); continue; } r -= I_QU;
            if (r < I_KVU) { const int Gp = r >> 1, kb = r & 1, pn = Gp >> 3, bj = (Gp >> 2) & 1, wc = Gp & 3, col0 = pn * 256 + wc * 64 + bj * 32;
                p0_item(inp[nv::I_WKVUP], 1024, col0, kb * 64, inp[nv::I_GKVA], B.WKVUP(), 128, Gp * 32, kb * 64, scr, lane); continue; } r -= I_KVU;
            if (r < I_O) { const int Gp = r >> 4, kb = r & 15, pn = Gp >> 3, bj = (Gp >> 2) & 1, wc = Gp & 3, col0 = pn * 256 + wc * 64 + bj * 32;
                p0_item(inp[nv::I_WO], DM, col0, kb * 64, nullptr, B.WO(), DM, Gp * 32, kb * 64, scr, lane); continue; } r -= I_O;
            if (r < I_GU) { const int Gp = r >> 4, kb = r & 15, pn = Gp >> 3, bj = (Gp >> 2) & 1, wc = Gp & 3, col0 = pn * 128 + wc * 32;
                p0_item(inp[bj ? nv::I_WU : nv::I_WG], DFF, col0, kb * 64, inp[nv::I_GFFN], B.WGU(), DM, Gp * 32, kb * 64, scr, lane); continue; } r -= I_GU;
            { const int Gp = r / 44, kb = r % 44, pn = Gp >> 3, bj = (Gp >> 2) & 1, wc = Gp & 3, col0 = pn * 256 + wc * 64 + bj * 32;
                p0_item(inp[nv::I_WD], DM, col0, kb * 64, nullptr, B.WD(), DFF, Gp * 32, kb * 64, scr, lane); }
        }
        if (wave < 4)
        for (int rx_ = 0; rx_ < REPX; ++rx_)
        for (int m0 = gw; m0 < M; m0 += 4 * NGW) {
            f32x4 v[4][4]; float ssq[4];
#pragma unroll
            for (int q = 0; q < 4; ++q) { const int m = m0 + q * NGW; if (m < M) { const GAS f32x4* xr = (const GAS f32x4*)(B.x + (size_t)m * DM) + 2 * lane;
#pragma unroll
                for (int j = 0; j < 2; ++j) { v[q][2 * j] = __builtin_nontemporal_load(xr + 128 * j); v[q][2 * j + 1] = __builtin_nontemporal_load(xr + 128 * j + 1); } } }
#pragma unroll
            for (int q = 0; q < 4; ++q) { float sq = 0.f;
#pragma unroll
                for (int j = 0; j < 4; ++j) sq += (v[q][j].x * v[q][j].x + v[q][j].y * v[q][j].y) + (v[q][j].z * v[q][j].z + v[q][j].w * v[q][j].w);
                ssq[q] = wave_sum(sq); }
#pragma unroll
            for (int q = 0; q < 4; ++q) { const int m = m0 + q * NGW; if (m < M) { if (lane == 0) B.RX()[m] = 1.0f / sqrtf(ssq[q] * (1.0f / DM) + EPS);
                GAS v4u* o16 = (GAS v4u*)(B.XB() + (size_t)m * DM) + lane;
#pragma unroll
                for (int j = 0; j < 2; ++j) { const pg8::u32x4 w = pg8::pack8(v[q][2 * j], v[q][2 * j + 1]); o16[64 * j] = (v4u){w.x, w.y, w.z, w.w}; } } }
        }
        for (int i = vcu * NWAVES * 64 + tid; i < 2048 * 48; i += G * NWAVES * 64) rope_table_entry(i, B.COSA());
        if (bx == 0 && tid < 320) { const int t = tid; B.gmq()[t] = t < 64 ? inp[nv::I_GMQ][t] : t < 128 ? inp[nv::I_GMK][t - 64] : t < 224 ? inp[nv::I_GLQ][t - 128] : inp[nv::I_GLK][t - 224]; } }
        SEAM(0);
    }
    if (IN(1)) { for (int rep_ = 0; rep_ < REP1; ++rep_) {
        pg8::ProgOne<pg8::EpiInProj, DUPU1> P1; P1.init(B, pg8::GDesc{B.XB(), B.WIN(), DM, DM}, 2048, G, bx); pg8::gemm_stream(lds + RING_OFF, P1); }
        SEAM(1);
    }
    if (IN(2)) { for (int rep_ = 0; rep_ < REP2; ++rep_) {
        for (int it = vcu; it < 256; it += G) { const int tile = it >> 1, c0 = (it & 1) * 256 + lane * 4; const bf16_t* kp = B.KA() + ((size_t)tile * 256 + wave * 32) * MW + c0; float a0 = 0.f, a1 = 0.f, a2 = 0.f, a3 = 0.f;
#pragma unroll 8
            for (int r = 0; r < 32; ++r) { const unsigned long long w = *(const GAS unsigned long long*)(kp + (size_t)r * MW); const unsigned lo = (unsigned)w, hi2 = (unsigned)(w >> 32);
                a0 += __uint_as_float(lo << 16); a1 += __uint_as_float(lo & 0xffff0000u); a2 += __uint_as_float(hi2 << 16); a3 += __uint_as_float(hi2 & 0xffff0000u); }
            LAS f32x4* red = (LAS f32x4*)(lds + RING_OFF); red[wave * 64 + lane] = (f32x4){a0, a1, a2, a3};
            LDS_WAIT(); __syncthreads();
            if (wave < 4) { const f32x4 s0 = red[(2 * wave) * 64 + lane], s1 = red[(2 * wave + 1) * 64 + lane]; *(GAS f32x4*)(B.KMEANP() + ((size_t)tile * 4 + wave) * MW + c0) = s0 + s1; }
            __syncthreads(); }
        pg8::ProgP2 P2; P2.init(B, G, bx); pg8::gemm_stream(lds + RING_OFF, P2); }
        SEAM(2);
    }
    if (IN(3)) { for (int rep_ = 0; rep_ < REP3; ++rep_) {
        { const int rpc = (M + G - 1) / G; for (int i = vcu * rpc + tid; i < (vcu + 1) * rpc && i < M; i += NWAVES * 64) B.H1SS()[i] = 0.f; }
        const int nit = (G == 256) ? 4 : (1024 - vcu + G - 1) / G;
        for (int it = 0; it < nit; ++it) { int bh, ty, s;
            if (G == 256) { const int c = vcu >> 2; s = vcu & 3; bh = (2 * (c >> 3) + (it & 1)) * 8 + (c & 7); ty = (it >> 1) ^ (c & 1); }
            const int b = bh >> 3, h = bh & 7; const size_t rb = (size_t)b * SEQ;
#ifndef REPU0
#define REPU0 1
#endif
            for (int e = 0; e < 2; ++e) { const int n = e ? 7 - s : s;
              for (int ru_ = 0; ru_ < ((n == 0) ? REPU0 : 1); ++ru_) {
                if (ty) attl::attn_unit<8>(n, B.QM() + rb * 768 + h * 96, B.KM() + rb * 768 + h * 96, B.VM() + rb * MW + h * 64, B.AO() + rb * DM + 512 + h * 64, B, (char*)lds_raw + RING_OFF);
                else attm::attn_unit<8>(n, b * 8, h, B.QA() + rb * MW + h * 64, B.KA() + rb * MW + h * 64, B.VA() + rb * MW + h * 64, B.AO() + rb * DM + h * 64, B, (char*)lds_raw + RING_OFF); } } } }
        SEAM(3);
    }
    for (int repg_ = 0; repg_ < REPG; ++repg_) {
    if (repg_ > 0) xcd_barrier(bar);
#ifndef P6_A_AUX
#define P6_A_AUX 0
#endif
#ifndef FFN_STREAM
#define FFN_STREAM 0
#endif
    if (FFN_STREAM && G == 256 && IN(4) && IN(5) && IN(6)) {
        pg8::ProgFFN PF; PF.init(B, G, bx, (unsigned*)(ctl + CW_DEP4), (unsigned*)(ctl + CW_DEP5), (unsigned*)(ctl + CW_BAR) + args.li * XCD_BAR_WORDS + XB_TMO); for (PF.seg = 0; PF.seg < 3; ++PF.seg) pg8::gemm_stream(lds + RING_OFF, PF);
    } else {
    if (IN(4)) { for (int rep_ = 0; rep_ < REP4; ++rep_) {
        pg8::ProgOne<pg8::EpiOProj, 0> P4; P4.init(B, pg8::GDesc{B.AO(), B.WO(), DM, DM}, DM, G, bx); pg8::gemm_stream(lds + RING_OFF, P4); }
        SEAM(4);
    }
    if (IN(5)) { for (int rep_ = 0; rep_ < REP5; ++rep_) {
        pg8::ProgOne<pg8::EpiFfn1, DUPU5> P5; P5.init(B, pg8::GDesc{B.H1B(), B.WGU(), DM, DM}, 2 * DFF, G, bx); pg8::gemm_stream(lds + RING_OFF, P5); }
        SEAM(5);
    }
    if (IN(6)) {
        pg8::ProgOne<pg8::EpiFfn2, DUPU6> P6; P6.init(B, pg8::GDesc{B.ACT(), B.WD(), DFF, DFF}, DM, G, bx); pg8::gemm_stream<decltype(P6), P6_A_AUX>(lds + RING_OFF, P6);
    }
    }
    }
#undef IN
#undef SEAM
}
#ifndef OPT_MASK
#define OPT_MASK 0x7e
#endif
static nv::Bufs make_bufs(void* const* d_in, void* d_out, void* d_ws) {
    nv::Bufs B{}; unsigned char* ws = (unsigned char*)d_ws;
    B.x = (const float*)d_in[0]; for (int i = 0; i < 16; ++i) B.in[i] = (const float*)d_in[i]; B.out = (float*)d_out;
    B.RX = (float*)(ws + WS_RX); B.CQSS = (float*)(ws + WS_CQSS); B.CKVSS = (float*)(ws + WS_CKVSS); B.KPESS = (float*)(ws + WS_KPESS); B.KR = (float*)(ws + WS_KR);
    B.KMEANP = (float*)(ws + WS_KMEANP); B.H1SS = (float*)(ws + WS_H1SS);
    float* tab = (float*)(ws + WS_TAB); B.COSA = tab; B.SINA = tab + 2048 * 32; B.COSB = tab + 2 * 2048 * 32; B.SINB = tab + 2 * 2048 * 32 + 2048 * 16;
    B.QA = (bf16_t*)(ws + WS_QA); B.KA = (bf16_t*)(ws + WS_KA); B.VA = (bf16_t*)(ws + WS_VA); B.CQKV = (bf16_t*)(ws + WS_CQKV); B.QM = (bf16_t*)(ws + WS_QM); B.KM = (bf16_t*)(ws + WS_KM);
    B.VM = (bf16_t*)(ws + WS_VM); B.AO = (bf16_t*)(ws + WS_AO); B.H1B = (bf16_t*)(ws + WS_H1B); B.ACT = (bf16_t*)(ws + WS_ACT);
    return B;
}
static void naive_stage(int p, const nv::Bufs& B, hipStream_t stream) {
    switch (p) {
    case 1: hipLaunchKernelGGL(nv::ngemm<nv::OpInProj>, dim3(31, M / 64), dim3(256), 0, stream, nv::OpInProj{B}); break;
    case 2: hipLaunchKernelGGL(nv::ngemm<nv::OpQUp>, dim3(12, M / 64), dim3(256), 0, stream, nv::OpQUp{B});
            hipLaunchKernelGGL(nv::ngemm<nv::OpKvUp>, dim3(16, M / 64), dim3(256), 0, stream, nv::OpKvUp{B}); break;
    case 3: hipLaunchKernelGGL(nv::n_attn_moba, dim3(M * NH / 256), dim3(256), 0, stream, B);
            hipLaunchKernelGGL(nv::n_attn_mla, dim3(M * NH / 256), dim3(256), 0, stream, B); break;
    case 4: hipLaunchKernelGGL(nv::ngemm<nv::OpOProj>, dim3(16, M / 64), dim3(256), 0, stream, nv::OpOProj{B}); break;
    case 5: hipLaunchKernelGGL(nv::ngemm<nv::OpFfn1>, dim3(44, M / 64), dim3(256), 0, stream, nv::OpFfn1{B}); break;
    case 6: hipLaunchKernelGGL(nv::ngemm<nv::OpFfn2>, dim3(16, M / 64), dim3(256), 0, stream, nv::OpFfn2{B}); break;
    }
}
extern "C" void kernel_launch(void* const* d_in, const int* in_sizes, int n_in, void* d_out, int out_size, void* d_ws, size_t ws_size, hipStream_t stream) {
    static int grid = 0;
    if (grid == 0) {
        if (n_in != 16 || in_sizes[0] != M * DM || out_size != M * DM || ws_size < WS_END) { fprintf(stderr, "kernel_launch: shape mismatch (n_in %d, in0 %d, out %d, ws %zu; need ws >= %zu)\n", n_in, n_in > 0 ? in_sizes[0] : -1, out_size, ws_size, (size_t)WS_END); grid = -1; return; }
        int dev = 0, cus = 0, per_cu = 0;
        if (hipGetDevice(&dev) != hipSuccess || hipDeviceGetAttribute(&cus, hipDeviceAttributeMultiprocessorCount, dev) != hipSuccess) { fprintf(stderr, "kernel_launch: device query failed\n"); grid = -1; return; }
        if (hipFuncSetAttribute((const void*)fwd_mega, hipFuncAttributeMaxDynamicSharedMemorySize, LDS_BYTES) != hipSuccess) { fprintf(stderr, "kernel_launch: hipFuncSetAttribute(%d B LDS) failed\n", LDS_BYTES); grid = -1; return; }
        if (hipOccupancyMaxActiveBlocksPerMultiprocessor(&per_cu, (const void*)fwd_mega, NWAVES * 64, LDS_BYTES) != hipSuccess || per_cu < 1) { fprintf(stderr, "kernel_launch: occupancy query says %d workgroups per CU; nothing launched\n", per_cu); (void)hipGetLastError(); grid = -1; return; }
        grid = cus;
    }
    if (grid < 0) return;
    if (hipMemsetAsync((char*)d_ws + WS_CTL, 0, CTL_ZERO_BYTES, stream) != hipSuccess) { fprintf(stderr, "kernel_launch: hipMemsetAsync failed\n"); return; }
    nv::Bufs B = make_bufs(d_in, d_out, d_ws);
    constexpr unsigned mask = (unsigned)(OPT_MASK) & 0x7eu; constexpr bool any_opt = mask != 0u, any_naive = mask != 0x7eu;
    if (any_naive) { hipLaunchKernelGGL(n_tables, dim3(384), dim3(256), 0, stream, (float*)((unsigned char*)d_ws + WS_TAB)); hipLaunchKernelGGL(nv::n_rowstat, dim3(M / 4), dim3(256), 0, stream, B.x, B.RX); }
#ifdef PROBE_DUP
    { const int cut[2][2] = {{0, PROBE_DUP + 1}, {PROBE_DUP2, 7}};
      for (int l = 0; l < 2; ++l) { Args a{}; for (int i = 0; i < 16; ++i) a.in[i] = (const float*)d_in[i]; a.out = (float*)d_out; a.ws = (unsigned char*)d_ws; a.ph_lo = cut[l][0]; a.ph_hi = cut[l][1]; a.li = l; a.pad = 0;
        hipLaunchKernelGGL(fwd_mega, dim3(grid), dim3(NWAVES * 64), LDS_BYTES, stream, a); }
      return; }
#endif
    int li = 0, p = any_opt ? 0 : 1;
    while (p <= 6) {
        const bool opt = (p == 0) || ((mask >> p) & 1u);
        if (opt) { int q = p; while (q + 1 <= 6 && ((mask >> (q + 1)) & 1u)) ++q;
            Args a{}; for (int i = 0; i < 16; ++i) a.in[i] = (const float*)d_in[i]; a.out = (float*)d_out; a.ws = (unsigned char*)d_ws; a.ph_lo = p; a.ph_hi = q + 1; a.li = li++; a.pad = 0;
            hipLaunchKernelGGL(fwd_mega, dim3(grid), dim3(NWAVES * 64), LDS_BYTES, stream, a);
            const hipError_t le = hipPeekAtLastError(); if (le != hipSuccess) { fprintf(stderr, "kernel_launch: launch failed: %s\n", hipGetErrorName(le)); return; }
            p = q + 1; }
        else { naive_stage(p, B, stream); ++p; }
    }
}
```

```cpp
#include <hip/hip_runtime.h>
#include <cstdio>
#include <cstdint>

typedef unsigned short bf16_t;
constexpr int BATCH = 16, SEQ = 2048, DM = 1024, M = BATCH * SEQ;
constexpr int NH = 8, HD = 64, MW = 512;
constexpr int QR = 256, KVR = 128, ROPE = 32, NOPE = 64, QKD = 96;
constexpr int INW = 1952, DFF = 2816;
constexpr float EPS = 1e-6f, LOG2E = 1.4426950408889634f;
constexpr float C2A = 0.125f * LOG2E;
constexpr float C2B = 0.10206207261596577f * LOG2E;

constexpr size_t MiB = 1u << 20;
constexpr size_t WS_CTL = 0, CTL_ZERO_BYTES = 1 * MiB;
constexpr size_t WS_TAB = 1 * MiB;
constexpr size_t WS_WIN = 2 * MiB;
constexpr size_t WS_WQUP = 6 * MiB;
constexpr size_t WS_WKVUP = 6 * MiB + 512 * 1024;
constexpr size_t WS_WO = 7 * MiB;
constexpr size_t WS_WGU = 9 * MiB;
constexpr size_t WS_WD = 20 * MiB;
constexpr size_t WS_RX = 26 * MiB;
constexpr size_t WS_KPESS = WS_RX + 128 * 1024;
constexpr size_t WS_CKVSS = WS_KPESS + 128 * 1024;
constexpr size_t WS_CQSS = WS_CKVSS + 256 * 1024;
constexpr size_t WS_KMEANP = WS_CQSS + 512 * 1024;
constexpr size_t WS_H1SS = WS_CTL + 512 * 1024;
constexpr size_t WS_KR = WS_KMEANP + 1024 * 1024;
constexpr size_t WS_XB = 34 * MiB;
constexpr size_t WS_H1B = WS_XB;
constexpr size_t WS_QA = 98 * MiB, WS_KA = 130 * MiB, WS_VA = 162 * MiB;
constexpr size_t WS_CQKV = 194 * MiB;
constexpr size_t WS_QM = 218 * MiB, WS_KM = 266 * MiB;
constexpr size_t WS_VM = 314 * MiB;
constexpr size_t WS_AO = 346 * MiB;
constexpr size_t WS_ACT = 98 * MiB;
constexpr size_t WS_END = 410 * MiB;
static_assert(WS_KR + (size_t)M * 32 * 4 <= WS_XB && WS_ACT + (size_t)M * DFF * 2 <= WS_AO && WS_WD + (size_t)DM * DFF * 2 <= WS_RX, "d_ws map");

__device__ __forceinline__ void sincos_d(double a, double& s, double& c) {
    const double kd = __builtin_rint(a * 0.63661977236758134308);
    double r = __builtin_fma(-kd, 1.57079632679489655800e+00, a); r = __builtin_fma(-kd, 6.12323399573676603587e-17, r);
    const int k = (int)kd & 3; const double r2 = r * r;
    const double sp = r * (1.0 + r2 * (-1.0 / 6 + r2 * (1.0 / 120 + r2 * (-1.0 / 5040 + r2 * (1.0 / 362880 + r2 * (-1.0 / 39916800 + r2 * (1.0 / 6227020800.0 + r2 * (-1.0 / 1307674368000.0))))))));
    const double cp = 1.0 + r2 * (-0.5 + r2 * (1.0 / 24 + r2 * (-1.0 / 720 + r2 * (1.0 / 40320 + r2 * (-1.0 / 3628800 + r2 * (1.0 / 479001600 + r2 * (-1.0 / 87178291200.0 + r2 * (1.0 / 20922789888000.0))))))));
    s = (k == 0) ? sp : (k == 1) ? cp : (k == 2) ? -sp : -cp;
    c = (k == 0) ? cp : (k == 1) ? -sp : (k == 2) ? -cp : sp;
}
__device__ __forceinline__ void rope_table_entry(int i, float* tab) {
    const int pos = i / 48, f = i % 48, steps = f < 32 ? f : 2 * (f - 32);
    double inv = 1.0; for (int j = 0; j < steps; ++j) inv *= 0.7498942093324558;
    const float ang = (float)pos * (float)inv;
    double s, c; sincos_d((double)ang, s, c);
    if (f < 32) { tab[pos * 32 + f] = (float)c; tab[2048 * 32 + pos * 32 + f] = (float)s; }
    else { tab[2 * 2048 * 32 + pos * 16 + (f - 32)] = (float)c; tab[2 * 2048 * 32 + 2048 * 16 + pos * 16 + (f - 32)] = (float)s; }
}
__global__ __launch_bounds__(256) void n_tables(float* tab) { const int i = blockIdx.x * 256 + threadIdx.x; if (i < 2048 * 48) rope_table_entry(i, tab); }
#define OPT_MASK 0x7e
#define ACT_STORE_MODE 2
#define OUT_STORE_NT 1
#define ATT_PRIO 1
namespace nv {
__device__ __forceinline__ float bf2f(bf16_t v) { return __uint_as_float((unsigned)v << 16); }
__device__ __forceinline__ bf16_t f2bf(float f) { unsigned u = __float_as_uint(f); return (bf16_t)((u + 0x7fffu + ((u >> 16) & 1u)) >> 16); }

__global__ __launch_bounds__(256) void n_rowstat(const float* __restrict__ x, float* __restrict__ RX) {
    const int row = blockIdx.x * 4 + (threadIdx.x >> 6), lane = threadIdx.x & 63;
    const float* xr = x + (size_t)row * DM; float s = 0.f;
    for (int i = lane; i < DM; i += 64) { const float v = xr[i]; s += v * v; }
    for (int o = 1; o < 64; o <<= 1) s += __shfl_xor(s, o);
    if (lane == 0) RX[row] = 1.0f / sqrtf(s * (1.0f / DM) + EPS);
}

template <class OP> __global__ __launch_bounds__(256) void ngemm(OP op) {
    __shared__ float As[16][64], Bs[16][64], B2s[OP::DUAL ? 16 : 1][64], T[64][65], T2[OP::DUAL ? 64 : 1][65];
    const int tid = threadIdx.x, ty = tid >> 4, tx = tid & 15, row0 = blockIdx.y * 64, col0 = blockIdx.x * 64;
    float acc[4][4] = {}, acc2[4][4] = {};
    for (int k0 = 0; k0 < OP::K; k0 += 16) {
#pragma unroll
        for (int l = 0; l < 4; ++l) { const int idx = tid + 256 * l;
            { const int m = idx >> 4, k = idx & 15; As[k][m] = op.a(row0 + m, k0 + k); }
            { const int k = idx >> 6, n = idx & 63; const bool in = (col0 + n) < OP::N; Bs[k][n] = in ? op.b(k0 + k, col0 + n) : 0.f; if (OP::DUAL) B2s[k][n] = in ? op.b2(k0 + k, col0 + n) : 0.f; } }
        __syncthreads();
#pragma unroll
        for (int k = 0; k < 16; ++k) { float a[4], b[4], c[4];
#pragma unroll
            for (int i = 0; i < 4; ++i) { a[i] = As[k][ty * 4 + i]; b[i] = Bs[k][tx * 4 + i]; c[i] = OP::DUAL ? B2s[k][tx * 4 + i] : 0.f; }
#pragma unroll
            for (int i = 0; i < 4; ++i)
#pragma unroll
                for (int j = 0; j < 4; ++j) { acc[i][j] = fmaf(a[i], b[j], acc[i][j]); if (OP::DUAL) acc2[i][j] = fmaf(a[i], c[j], acc2[i][j]); } }
        __syncthreads();
    }
#pragma unroll
    for (int i = 0; i < 4; ++i)
#pragma unroll
        for (int j = 0; j < 4; ++j) { T[ty * 4 + i][tx * 4 + j] = acc[i][j]; if (OP::DUAL) T2[ty * 4 + i][tx * 4 + j] = acc2[i][j]; }
    __syncthreads();
    op.epi(T, T2, row0, col0, tid);
}

struct Bufs {
    const float* x; const float* in[16]; float* out;
    float *RX, *CQSS, *CKVSS, *KPESS, *KR, *KMEANP, *H1SS, *COSA, *SINA, *COSB, *SINB;
    bf16_t *QA, *KA, *VA, *CQKV, *QM, *KM, *VM, *AO, *H1B, *ACT;
};
enum { I_X = 0, I_GATT = 1, I_WIN = 2, I_GMQ = 3, I_GMK = 4, I_GQA = 5, I_WQUP = 6, I_GKVA = 7, I_WKVUP = 8, I_GLQ = 9, I_GLK = 10, I_WO = 11, I_GFFN = 12, I_WG = 13, I_WU = 14, I_WD = 15 };

struct OpInProj { static constexpr int K = DM, N = INW; static constexpr bool DUAL = false; Bufs B;
    __device__ float a(int m, int k) const { return B.x[(size_t)m * DM + k] * B.RX[m] * B.in[I_GATT][k]; }
    __device__ float b(int k, int n) const { return B.in[I_WIN][(size_t)k * INW + n]; }
    __device__ float b2(int, int) const { return 0.f; }
    __device__ void epi(float (*T)[65], float (*)[65], int row0, int col0, int tid) const {
        const int r = tid & 63, row = row0 + r, pos = row & (SEQ - 1);
        if (col0 < 1024) {
            const bool isq = col0 < 512; const float* g = B.in[isq ? I_GMQ : I_GMK];
            if (tid < 64) { float ss = 0.f; for (int d = 0; d < 64; ++d) ss += T[r][d] * T[r][d];
                const float rn = 1.0f / sqrtf(ss * (1.0f / 64) + EPS); float o[64];
#pragma unroll
                for (int d = 0; d < 32; ++d) { const float x1 = T[r][d] * rn * g[d], x2 = T[r][d + 32] * rn * g[d + 32], c = B.COSA[pos * 32 + d], s = B.SINA[pos * 32 + d]; o[d] = x1 * c - x2 * s; o[d + 32] = x2 * c + x1 * s; }
#pragma unroll
                for (int d = 0; d < 64; ++d) { T[r][d] = o[d]; if (isq) B.QA[(size_t)row * MW + col0 + d] = f2bf(o[d] * C2A); else B.KA[(size_t)row * MW + (col0 - 512) + d] = f2bf(o[d]); } }
            __syncthreads();
            if (!isq && tid < 64) { float cs = 0.f; for (int rr = 0; rr < 64; ++rr) cs += T[rr][tid];
                B.KMEANP[((size_t)(row0 >> 8) * 4 + ((row0 & 255) >> 6)) * MW + (col0 - 512) + tid] = cs; }
        } else if (col0 < 1536) { if (tid < 64) for (int d = 0; d < 64; ++d) B.VA[(size_t)row * MW + (col0 - 1024) + d] = f2bf(T[r][d]);
        } else if (col0 < 1792) { if (tid < 64) { float ss = 0.f; for (int d = 0; d < 64; ++d) { ss += T[r][d] * T[r][d]; B.CQKV[(size_t)row * 384 + (col0 - 1536) + d] = f2bf(T[r][d]); } B.CQSS[(size_t)row * 4 + ((col0 - 1536) >> 6)] = ss; }
        } else if (col0 < 1920) { if (tid < 64) { float ss = 0.f; for (int d = 0; d < 64; ++d) { ss += T[r][d] * T[r][d]; B.CQKV[(size_t)row * 384 + 256 + (col0 - 1792) + d] = f2bf(T[r][d]); } B.CKVSS[(size_t)row * 2 + ((col0 - 1792) >> 6)] = ss; }
        } else { if (tid < 64) { float ss = 0.f; for (int d = 0; d < 32; ++d) ss += T[r][d] * T[r][d]; B.KPESS[row] = ss; const float* g = B.in[I_GLK] + 64;
                for (int i = 0; i < 16; ++i) { const float x1 = T[r][i] * g[i], x2 = T[r][i + 16] * g[i + 16], c = B.COSB[pos * 16 + i], s = B.SINB[pos * 16 + i];
                    B.KR[(size_t)row * 32 + i] = x1 * c - x2 * s; B.KR[(size_t)row * 32 + i + 16] = x2 * c + x1 * s; } } }
    }
};
struct OpQUp { static constexpr int K = QR, N = 768; static constexpr bool DUAL = false; Bufs B;
    __device__ float a(int m, int k) const { return bf2f(B.CQKV[(size_t)m * 384 + k]) * B.in[I_GQA][k]; }
    __device__ float b(int k, int n) const { return B.in[I_WQUP][(size_t)k * 768 + n]; }
    __device__ float b2(int, int) const { return 0.f; }
    __device__ void epi(float (*T)[65], float (*)[65], int row0, int col0, int tid) const {
        if (tid < 64) { const int r = tid, row = row0 + r; const float* s4 = B.CQSS + (size_t)row * 4; const float rc = 1.0f / sqrtf((s4[0] + s4[1] + s4[2] + s4[3]) * (1.0f / QR) + EPS);
            for (int d = 0; d < 64; ++d) B.QM[(size_t)row * 768 + col0 + d] = f2bf(T[r][d] * rc); }
    }
};
struct OpKvUp { static constexpr int K = KVR, N = 1024; static constexpr bool DUAL = false; Bufs B;
    __device__ float a(int m, int k) const { return bf2f(B.CQKV[(size_t)m * 384 + 256 + k]) * B.in[I_GKVA][k]; }
    __device__ float b(int k, int n) const { return B.in[I_WKVUP][(size_t)k * 1024 + n]; }
    __device__ float b2(int, int) const { return 0.f; }
    __device__ void epi(float (*T)[65], float (*)[65], int row0, int col0, int tid) const {
        if (tid < 64) { const int r = tid, row = row0 + r, head = col0 >> 7; const float* s2 = B.CKVSS + (size_t)row * 2; const float rc = 1.0f / sqrtf((s2[0] + s2[1]) * (1.0f / KVR) + EPS);
            if ((col0 >> 6) & 1) { for (int d = 0; d < 64; ++d) B.VM[(size_t)row * MW + head * 64 + d] = f2bf(T[r][d] * rc); }
            else { float ss = B.KPESS[row]; for (int d = 0; d < 64; ++d) { const float v = T[r][d] * rc; ss += v * v; }
                const float rk = 1.0f / sqrtf(ss * (1.0f / QKD) + EPS); const float* g = B.in[I_GLK];
                for (int d = 0; d < 64; ++d) B.KM[(size_t)row * 768 + head * 96 + d] = f2bf(T[r][d] * rc * rk * g[d]);
                for (int d = 0; d < 32; ++d) B.KM[(size_t)row * 768 + head * 96 + 64 + d] = f2bf(B.KR[(size_t)row * 32 + d] * rk); } }
    }
};
struct OpOProj { static constexpr int K = DM, N = DM; static constexpr bool DUAL = false; Bufs B;
    __device__ float a(int m, int k) const { return bf2f(B.AO[(size_t)m * DM + k]); }
    __device__ float b(int k, int n) const { return B.in[I_WO][(size_t)k * DM + n]; }
    __device__ float b2(int, int) const { return 0.f; }
    __device__ void epi(float (*T)[65], float (*)[65], int row0, int col0, int tid) const {
        if (tid < 64) { const int r = tid, row = row0 + r; float ss = 0.f;
            for (int d = 0; d < 64; ++d) { const float h = B.x[(size_t)row * DM + col0 + d] + T[r][d]; ss += h * h; B.H1B[(size_t)row * DM + col0 + d] = f2bf(h); }
            atomicAdd(B.H1SS + row, ss); }
    }
};
struct OpFfn1 { static constexpr int K = DM, N = DFF; static constexpr bool DUAL = true; Bufs B;
    __device__ float a(int m, int k) const { return bf2f(B.H1B[(size_t)m * DM + k]) * B.in[I_GFFN][k]; }
    __device__ float b(int k, int n) const { return B.in[I_WG][(size_t)k * DFF + n]; }
    __device__ float b2(int k, int n) const { return B.in[I_WU][(size_t)k * DFF + n]; }
    __device__ void epi(float (*T)[65], float (*T2)[65], int row0, int col0, int tid) const {
        if (tid < 64) { const int r = tid, row = row0 + r; const float t = B.H1SS[row];
            const float rh = 1.0f / sqrtf(t * (1.0f / DM) + EPS);
            for (int d = 0; d < 64; ++d) { const float g = T[r][d] * rh, u = T2[r][d] * rh; B.ACT[(size_t)row * DFF + col0 + d] = f2bf(g / (1.0f + __expf(-g)) * u); } }
    }
};
struct OpFfn2 { static constexpr int K = DFF, N = DM; static constexpr bool DUAL = false; Bufs B;
    __device__ float a(int m, int k) const { return bf2f(B.ACT[(size_t)m * DFF + k]); }
    __device__ float b(int k, int n) const { return B.in[I_WD][(size_t)k * DM + n]; }
    __device__ float b2(int, int) const { return 0.f; }
    __device__ void epi(float (*T)[65], float (*)[65], int row0, int col0, int tid) const {
        if (tid < 64) { const int r = tid, row = row0 + r; for (int d = 0; d < 64; ++d) B.out[(size_t)row * DM + col0 + d] = bf2f(B.H1B[(size_t)row * DM + col0 + d]) + T[r][d]; }
    }
};

__global__ __launch_bounds__(256) void n_attn_moba(Bufs B) {
    const int gid = blockIdx.x * 256 + threadIdx.x, q = gid & (SEQ - 1), h = (gid >> 11) & 7, b = gid >> 14, row = b * SEQ + q, n = q >> 8;
    float qv[64];
#pragma unroll
    for (int d = 0; d < 64; ++d) qv[d] = bf2f(B.QA[(size_t)row * MW + h * 64 + d]);
    unsigned sel = (1u << n) - 1u;
    if (n > 3) { float gate[8];
#pragma unroll
        for (int j = 0; j < 8; ++j) { gate[j] = -INFINITY; if (j < n) { float g = 0.f; const float* kp = B.KMEANP + (size_t)(b * 8 + j) * 4 * MW + h * 64;
#pragma unroll
                for (int d = 0; d < 64; ++d) g += qv[d] * ((kp[d] + kp[MW + d]) + (kp[2 * MW + d] + kp[3 * MW + d])); gate[j] = g; } }
        sel = 0u;
#pragma unroll
        for (int j = 0; j < 8; ++j) { int rank = 0;
#pragma unroll
            for (int i = 0; i < 8; ++i) rank += (gate[i] > gate[j] || (gate[i] == gate[j] && i < j)) ? 1 : 0;
            if (j < n && rank < 3) sel |= 1u << j; } }
    float m = -INFINITY, l = 0.f, o[64];
#pragma unroll
    for (int d = 0; d < 64; ++d) o[d] = 0.f;
    for (int j = 0; j <= n; ++j) {
        const bool mine = (j == n) || ((sel >> j) & 1u);
        for (int kk = 0; kk < 256; ++kk) { const int key = j * 256 + kk; if (!mine || key > q) continue;
            const bf16_t* kr = B.KA + (size_t)(b * SEQ + key) * MW + h * 64; float s = 0.f;
#pragma unroll
            for (int d = 0; d < 64; ++d) s += qv[d] * bf2f(kr[d]);
            const float mn = fmaxf(m, s), al = exp2f(m - mn), p = exp2f(s - mn); m = mn; l = l * al + p;
            const bf16_t* vr = B.VA + (size_t)(b * SEQ + key) * MW + h * 64;
#pragma unroll
            for (int d = 0; d < 64; ++d) o[d] = o[d] * al + p * bf2f(vr[d]); } }
    const float il = 1.0f / l;
#pragma unroll
    for (int d = 0; d < 64; ++d) B.AO[(size_t)row * DM + h * 64 + d] = f2bf(o[d] * il);
}
__global__ __launch_bounds__(256) void n_attn_mla(Bufs B) {
    const int gid = blockIdx.x * 256 + threadIdx.x, q = gid & (SEQ - 1), h = (gid >> 11) & 7, b = gid >> 14, row = b * SEQ + q;
    float qv[96]; float ss = 0.f;
#pragma unroll
    for (int d = 0; d < 96; ++d) { qv[d] = bf2f(B.QM[(size_t)row * 768 + h * 96 + d]); ss += qv[d] * qv[d]; }
    const float rq = 1.0f / sqrtf(ss * (1.0f / QKD) + EPS); const float* g = B.in[I_GLQ];
#pragma unroll
    for (int d = 0; d < 96; ++d) qv[d] = qv[d] * rq * g[d];
#pragma unroll
    for (int i = 0; i < 16; ++i) { const float x1 = qv[64 + i], x2 = qv[80 + i], c = B.COSB[q * 16 + i], s = B.SINB[q * 16 + i]; qv[64 + i] = x1 * c - x2 * s; qv[80 + i] = x2 * c + x1 * s; }
#pragma unroll
    for (int d = 0; d < 96; ++d) qv[d] *= C2B;
    float m = -INFINITY, l = 0.f, o[64];
#pragma unroll
    for (int d = 0; d < 64; ++d) o[d] = 0.f;
    const int qmax = q | 63;
    for (int key = 0; key <= qmax; ++key) { if (key > q) continue;
        const bf16_t* kr = B.KM + (size_t)(b * SEQ + key) * 768 + h * 96; float s = 0.f;
#pragma unroll
        for (int d = 0; d < 96; ++d) s += qv[d] * bf2f(kr[d]);
        const float mn = fmaxf(m, s), al = exp2f(m - mn), p = exp2f(s - mn); m = mn; l = l * al + p;
        const bf16_t* vr = B.VM + (size_t)(b * SEQ + key) * MW + h * 64;
#pragma unroll
        for (int d = 0; d < 64; ++d) o[d] = o[d] * al + p * bf2f(vr[d]); }
    const float il = 1.0f / l;
#pragma unroll
    for (int d = 0; d < 64; ++d) B.AO[(size_t)row * DM + 512 + h * 64 + d] = f2bf(o[d] * il);
}
}
constexpr size_t WS_GAIN = WS_TAB + 768 * 1024;
struct Ctx { const float* x; float* out; unsigned char* ws;
#define CTX_F(NAME, OFF) __device__ __forceinline__ float* NAME() const { return (float*)(ws + (OFF)); }
#define CTX_H(NAME, OFF) __device__ __forceinline__ bf16_t* NAME() const { return (bf16_t*)(ws + (OFF)); }
    CTX_F(RX, WS_RX) CTX_F(CQSS, WS_CQSS) CTX_F(CKVSS, WS_CKVSS) CTX_F(KPESS, WS_KPESS) CTX_F(KR, WS_KR) CTX_F(KMEANP, WS_KMEANP) CTX_F(H1SS, WS_H1SS)
    CTX_F(COSA, WS_TAB) CTX_F(SINA, WS_TAB + 2048 * 32 * 4) CTX_F(COSB, WS_TAB + 2 * 2048 * 32 * 4) CTX_F(SINB, WS_TAB + 2 * 2048 * 32 * 4 + 2048 * 16 * 4)
    CTX_F(gmq, WS_GAIN) CTX_F(gmk, WS_GAIN + 256) CTX_F(glq, WS_GAIN + 512) CTX_F(glk, WS_GAIN + 896)
    CTX_H(QA, WS_QA) CTX_H(KA, WS_KA) CTX_H(VA, WS_VA) CTX_H(CQKV, WS_CQKV) CTX_H(QM, WS_QM) CTX_H(KM, WS_KM) CTX_H(VM, WS_VM) CTX_H(AO, WS_AO) CTX_H(H1B, WS_H1B) CTX_H(ACT, WS_ACT)
    CTX_H(XB, WS_XB) CTX_H(WIN, WS_WIN) CTX_H(WQUP, WS_WQUP) CTX_H(WKVUP, WS_WKVUP) CTX_H(WO, WS_WO) CTX_H(WGU, WS_WGU) CTX_H(WD, WS_WD)
#undef CTX_F
#undef CTX_H
};
#ifndef WGM_SET
#define WGM_SET 8
#endif
namespace pg8 {
#define PG8_LAS __attribute__((address_space(3)))
typedef short bf16x8 __attribute__((ext_vector_type(8)));
typedef float f32x4 __attribute__((ext_vector_type(4)));
typedef float f32x2 __attribute__((ext_vector_type(2)));
typedef unsigned u32x4 __attribute__((ext_vector_type(4)));
constexpr int BM = 256, BK = 64, HALF = 128, HTB = HALF * BK * 2  , STAGE_BYTES = 8 * HTB, NXCD = 8, WGM = WGM_SET;

__host__ __device__ __forceinline__ int lds_byte(int r, int c) { const int st = (r >> 4) * 2 + (c >> 5), rr = r & 15, cc = c & 31, ob = rr * 64 + cc * 2; return st * 1024 + (ob ^ (((ob >> 9) & 1) << 5)); }
__host__ __device__ __forceinline__ void stage_rc(int b, int& R, int& C) { const int st = b / 1024, sb = b % 1024, swz = sb ^ (((sb >> 9) & 1) << 5); R = (st >> 1) * 16 + swz / 64; C = (st & 1) * 32 + (swz % 64) / 2; }
__host__ __device__ __forceinline__ int perm32(int rho) { const int n = rho >> 4, i = rho & 15; return 8 * (i >> 2) + 4 * n + (i & 3); }

struct Unit { int pm, pn; };
struct Gemm { const bf16_t* A; const bf16_t* Bt; int M, N, K, lda; };

struct StaticOrder {
    int nM, nN, nwg, G, c;
    __host__ __device__ void init(int M_, int N_, int G_, int c_) { nM = M_ / BM; nN = N_ / BM; nwg = nM * nN; G = G_; c = c_; }
    __host__ __device__ bool next(int i, Unit& u) const {
        const long L = (long)i * G + c; if (L >= nwg) return false;
        int wgid = (int)L; { const int q = nwg / NXCD, r = nwg % NXCD, xcd = wgid % NXCD, off = wgid / NXCD; wgid = (xcd < r ? xcd * (q + 1) : r * (q + 1) + (xcd - r) * q) + off; }
        const int nig = WGM * nN, gid = wgid / nig, fm = gid * WGM, gsz = (nM - fm) < WGM ? (nM - fm) : WGM;
        u.pm = fm + ((wgid % nig) % gsz); u.pn = (wgid % nig) / gsz; return true;
    }
    __device__ __forceinline__ void a_ready(const Unit&) const {}
    __device__ __forceinline__ void done(const Unit&) const {}
};

typedef float f32x2_c __attribute__((ext_vector_type(2))); typedef __bf16 bf16x2_c __attribute__((ext_vector_type(2)));
__device__ __forceinline__ unsigned cvt_pk_bf16(float lo, float hi) { f32x2_c v = {lo, hi}; bf16x2_c b = __builtin_convertvector(v, bf16x2_c); return __builtin_bit_cast(unsigned, b); }
__device__ __forceinline__ u32x4 pack8(const f32x4 a, const f32x4 b) { u32x4 w; w.x = cvt_pk_bf16(a[0], a[1]); w.y = cvt_pk_bf16(a[2], a[3]); w.z = cvt_pk_bf16(b[0], b[1]); w.w = cvt_pk_bf16(b[2], b[3]); return w; }
__device__ __forceinline__ float hsum4(const f32x4 a) { return (a[0] + a[1]) + (a[2] + a[3]); }
__device__ __forceinline__ float dot4(const f32x4 a) { return (a[0] * a[0] + a[1] * a[1]) + (a[2] * a[2] + a[3] * a[3]); }
__device__ __forceinline__ float fq_sum(float s) { s += __shfl_xor(s, 16); s += __shfl_xor(s, 32); return s; }
__device__ __forceinline__ float rsq(float v) { return __builtin_amdgcn_rsqf(v); }
#define EPI_FENCE() asm volatile("" ::: "memory")
template <int MODE> __device__ __forceinline__ void st16(void* p, const u32x4 v) {
    if constexpr (MODE == 1) asm volatile("global_store_dwordx4 %0, %1, off sc1\n\ts_nop 1" :: "v"(p), "v"(v) : "memory");
    else if constexpr (MODE == 2) __builtin_nontemporal_store(v, (u32x4*)p);
    else *(u32x4*)p = v; }
#define OPAQUE(x) asm volatile("" : "+v"(x))


#ifndef P1_STORE_MODE
#define P1_STORE_MODE 0
#endif
struct EpiInProj { static constexpr bool PERM = true, AFTER_DRAIN = false; Ctx B;
    __device__ __forceinline__ void qk(const f32x4 (&acc)[2][2][4][2], const Unit& u, int wc, int fq, int rbase, bool isq) const {
        const int head = (u.pn & 1) * 4 + wc; const float* g = isq ? B.gmq() : B.gmk();
        f32x4 g0[2], g1[2], cd[2], sd[2];
#pragma unroll
        for (int n = 0; n < 2; ++n) { g0[n] = *(const f32x4*)(g + fq * 8 + n * 4); g1[n] = *(const f32x4*)(g + 32 + fq * 8 + n * 4);
            cd[n] = *(const f32x4*)(B.COSA() + 16 * 32 + fq * 8 + n * 4); sd[n] = *(const f32x4*)(B.SINA() + 16 * 32 + fq * 8 + n * 4); }
        bf16_t* dst = (isq ? B.QA() : B.KA()) + head * 64 + fq * 8; const float osc = isq ? C2A : 1.0f;
#pragma unroll
        for (int ai = 0; ai < 2; ++ai) { f32x4 c[2], sn[2]; float rx[4]; int rb = rbase + ai * HALF; OPAQUE(rb); const int pos0 = rb & (SEQ - 1);
#pragma unroll
            for (int m = 0; m < 4; ++m) rx[m] = B.RX()[rb + m * 16];
#pragma unroll
            for (int n = 0; n < 2; ++n) { c[n] = *(const f32x4*)(B.COSA() + pos0 * 32 + fq * 8 + n * 4); sn[n] = *(const f32x4*)(B.SINA() + pos0 * 32 + fq * 8 + n * 4); }
#pragma unroll
            for (int m = 0; m < 4; ++m) { const int row = rb + m * 16; float ss = 0.f;
#pragma unroll
                for (int bj = 0; bj < 2; ++bj)
#pragma unroll
                    for (int n = 0; n < 2; ++n) ss += dot4(acc[ai][bj][m][n]);
                const float rxv = rx[m]; ss = fq_sum(ss) * rxv * rxv; const float rn = rsq(ss * (1.0f / 64) + EPS) * rxv * osc; f32x4 o1[2], o2[2];
#pragma unroll
                for (int n = 0; n < 2; ++n) { const f32x4 x1 = acc[ai][0][m][n] * rn * g0[n], x2 = acc[ai][1][m][n] * rn * g1[n]; o1[n] = x1 * c[n] - x2 * sn[n]; o2[n] = x2 * c[n] + x1 * sn[n];
                    const f32x4 cn = c[n] * cd[n] - sn[n] * sd[n]; sn[n] = sn[n] * cd[n] + c[n] * sd[n]; c[n] = cn; }
                st16<P1_STORE_MODE>(dst + (size_t)row * MW, pack8(o1[0], o1[1])); st16<P1_STORE_MODE>(dst + (size_t)row * MW + 32, pack8(o2[0], o2[1])); } }
    }
    __device__ __forceinline__ void operator()(const f32x4 (&acc)[2][2][4][2], const Unit& u, int wr, int wc, int fr, int fq) const {
        const int pn = u.pn; int rbase = u.pm * BM + wr * 64 + fr; OPAQUE(rbase);
        if (pn < 4) { qk(acc, u, wc, fq, rbase, pn < 2); return; }
        float rx[2][4];
#pragma unroll
        for (int ai = 0; ai < 2; ++ai)
#pragma unroll
            for (int m = 0; m < 4; ++m) rx[ai][m] = B.RX()[rbase + ai * HALF + m * 16];
        if (pn < 6) {
            bf16_t* dst = B.VA() + ((pn - 4) * 4 + wc) * 64 + fq * 8;
#pragma unroll
            for (int ai = 0; ai < 2; ++ai)
#pragma unroll
                for (int m = 0; m < 4; ++m) { const int row = rbase + ai * HALF + m * 16; const float rxv = rx[ai][m];
#pragma unroll
                    for (int bj = 0; bj < 2; ++bj) st16<P1_STORE_MODE>(dst + (size_t)row * MW + bj * 32, pack8(acc[ai][bj][m][0] * rxv, acc[ai][bj][m][1] * rxv)); }
        } else if (pn == 6 || wc < 2) {
            const int cb = (pn == 6 ? 0 : 256) + wc * 64 + fq * 8; float* ssp = pn == 6 ? B.CQSS() + wc : B.CKVSS() + wc; const int sstr = pn == 6 ? 4 : 2;
#pragma unroll
            for (int ai = 0; ai < 2; ++ai)
#pragma unroll
                for (int m = 0; m < 4; ++m) { const int row = rbase + ai * HALF + m * 16; const float rxv = rx[ai][m]; float ss = 0.f;
#pragma unroll
                    for (int bj = 0; bj < 2; ++bj) { const f32x4 a = acc[ai][bj][m][0] * rxv, b = acc[ai][bj][m][1] * rxv; ss += dot4(a) + dot4(b); st16<P1_STORE_MODE>(B.CQKV() + (size_t)row * 384 + cb + bj * 32, pack8(a, b)); }
                    ss = fq_sum(ss); if (fq == 0) ssp[(size_t)row * sstr] = ss; }
        } else if (wc == 2) {
            const float* g = B.glk() + 64 + fq * 8; const f32x4 ga = *(const f32x4*)g, gb = *(const f32x4*)(g + 4); const float sg = fq < 2 ? -1.f : 1.f;
#pragma unroll
            for (int ai = 0; ai < 2; ++ai)
#pragma unroll
                for (int m = 0; m < 4; ++m) { int row = rbase + ai * HALF + m * 16; OPAQUE(row); const int pos = row & (SEQ - 1); const float rxv = rx[ai][m];
                    const f32x4 a = acc[ai][0][m][0] * rxv, b = acc[ai][0][m][1] * rxv; float ss = fq_sum(dot4(a) + dot4(b)); if (fq == 0) B.KPESS()[row] = ss;
                    const f32x4 xa = a * ga, xb = b * gb; f32x4 pa, pb;
#pragma unroll
                    for (int j = 0; j < 4; ++j) { pa[j] = __shfl_xor(xa[j], 32); pb[j] = __shfl_xor(xb[j], 32); }
                    const int ci = pos * 16 + (fq & 1) * 8; const f32x4 ca = *(const f32x4*)(B.COSB() + ci), cb = *(const f32x4*)(B.COSB() + ci + 4), sa = *(const f32x4*)(B.SINB() + ci), sb = *(const f32x4*)(B.SINB() + ci + 4);
                    *(f32x4*)(B.KR() + (size_t)row * 32 + fq * 8) = xa * ca + pa * sa * sg; *(f32x4*)(B.KR() + (size_t)row * 32 + fq * 8 + 4) = xb * cb + pb * sb * sg; }
        }
    }
};
struct EpiQUp { static constexpr bool PERM = true, AFTER_DRAIN = false; Ctx B;
    __device__ __forceinline__ void operator()(const f32x4 (&acc)[2][2][4][2], const Unit& u, int wr, int wc, int fr, int fq) const {
        int rbase = u.pm * BM + wr * 64 + fr; OPAQUE(rbase); const int head = 2 * u.pn + (wc >> 1), dbase = (wc & 1) ? 64 : 0; bf16_t* dst = B.QM() + head * 96 + dbase + fq * 8;
#pragma unroll
        for (int ai = 0; ai < 2; ++ai) { int rb = rbase + ai * HALF; OPAQUE(rb); f32x4 s4[4];
#pragma unroll
            for (int m = 0; m < 4; ++m) s4[m] = *(const f32x4*)(B.CQSS() + (size_t)(rb + m * 16) * 4);
#pragma unroll
            for (int m = 0; m < 4; ++m) { const int row = rb + m * 16; const float rc = rsq(hsum4(s4[m]) * (1.0f / QR) + EPS);
                *(u32x4*)(dst + (size_t)row * 768) = pack8(acc[ai][0][m][0] * rc, acc[ai][0][m][1] * rc);
                if (!(wc & 1)) *(u32x4*)(dst + (size_t)row * 768 + 32) = pack8(acc[ai][1][m][0] * rc, acc[ai][1][m][1] * rc); } }
    }
};
struct EpiKvUp { static constexpr bool PERM = true, AFTER_DRAIN = false; Ctx B;
    __device__ __forceinline__ void operator()(const f32x4 (&acc)[2][2][4][2], const Unit& u, int wr, int wc, int fr, int fq) const {
        int rbase = u.pm * BM + wr * 64 + fr; OPAQUE(rbase); const int head = 2 * u.pn + (wc >> 1);
        if (wc & 1) { bf16_t* dst = B.VM() + head * 64 + fq * 8; f32x2 s2[2][4];
#pragma unroll
            for (int ai = 0; ai < 2; ++ai)
#pragma unroll
                for (int m = 0; m < 4; ++m) s2[ai][m] = *(const f32x2*)(B.CKVSS() + (size_t)(rbase + ai * HALF + m * 16) * 2);
#pragma unroll
            for (int ai = 0; ai < 2; ++ai)
#pragma unroll
                for (int m = 0; m < 4; ++m) { const int row = rbase + ai * HALF + m * 16; const float rc = rsq((s2[ai][m][0] + s2[ai][m][1]) * (1.0f / KVR) + EPS);
#pragma unroll
                    for (int bj = 0; bj < 2; ++bj) *(u32x4*)(dst + (size_t)row * MW + bj * 32) = pack8(acc[ai][bj][m][0] * rc, acc[ai][bj][m][1] * rc); }
        } else { int fqo = fq; OPAQUE(fqo); const float* g = B.glk() + fqo * 8; f32x4 gg[2][2];
#pragma unroll
            for (int bj = 0; bj < 2; ++bj)
#pragma unroll
                for (int n = 0; n < 2; ++n) gg[bj][n] = *(const f32x4*)(g + bj * 32 + n * 4);
            bf16_t* dst = B.KM() + head * 96 + fq * 8;
#pragma unroll
            for (int ai = 0; ai < 2; ++ai) { int rb = rbase + ai * HALF; OPAQUE(rb); float kp[4]; f32x4 ka[4], kb[4]; f32x2 s2v[4];
#pragma unroll
                for (int m = 0; m < 4; ++m) { const int row = rb + m * 16; kp[m] = B.KPESS()[row]; s2v[m] = *(const f32x2*)(B.CKVSS() + (size_t)row * 2); ka[m] = *(const f32x4*)(B.KR() + (size_t)row * 32 + fq * 8); kb[m] = *(const f32x4*)(B.KR() + (size_t)row * 32 + fq * 8 + 4); }
#pragma unroll
                for (int m = 0; m < 4; ++m) { const int row = rb + m * 16; const float rc = rsq((s2v[m][0] + s2v[m][1]) * (1.0f / KVR) + EPS);
                    f32x4 v[2][2]; float ss = 0.f;
#pragma unroll
                    for (int bj = 0; bj < 2; ++bj)
#pragma unroll
                        for (int n = 0; n < 2; ++n) { v[bj][n] = acc[ai][bj][m][n] * rc; ss += dot4(v[bj][n]); }
                    ss = fq_sum(ss) + kp[m]; const float rk = rsq(ss * (1.0f / QKD) + EPS);
#pragma unroll
                    for (int bj = 0; bj < 2; ++bj) *(u32x4*)(dst + (size_t)row * 768 + bj * 32) = pack8(v[bj][0] * rk * gg[bj][0], v[bj][1] * rk * gg[bj][1]);
                    *(u32x4*)(dst + (size_t)row * 768 + 64) = pack8(ka[m] * rk, kb[m] * rk); } }
        }
    }
};
template <int WT = 0> struct EpiOProjT { static constexpr bool PERM = true, AFTER_DRAIN = false; Ctx B;
    __device__ __forceinline__ void operator()(const f32x4 (&acc)[2][2][4][2], const Unit& u, int wr, int wc, int fr, int fq) const {
        const int rbase = u.pm * BM + wr * 64 + fr, col = u.pn * BM + wc * 64 + fq * 8;
#pragma unroll
        for (int ai = 0; ai < 2; ++ai) { int rb = rbase + ai * HALF; OPAQUE(rb); u32x4 xw[4][2];
#pragma unroll
            for (int m = 0; m < 4; ++m)
#pragma unroll
                for (int bj = 0; bj < 2; ++bj) xw[m][bj] = *(const u32x4*)(B.H1B() + (size_t)(rb + m * 16) * DM + col + bj * 32);
#pragma unroll
            for (int m = 0; m < 4; ++m) { const int row = rb + m * 16; const size_t off = (size_t)row * DM + col; float ss = 0.f;
#pragma unroll
                for (int bj = 0; bj < 2; ++bj) { const u32x4 w = xw[m][bj];
                    const f32x4 x0 = {__uint_as_float(w.x << 16), __uint_as_float(w.x & 0xffff0000u), __uint_as_float(w.y << 16), __uint_as_float(w.y & 0xffff0000u)};
                    const f32x4 x1 = {__uint_as_float(w.z << 16), __uint_as_float(w.z & 0xffff0000u), __uint_as_float(w.w << 16), __uint_as_float(w.w & 0xffff0000u)};
                    const f32x4 a = x0 + acc[ai][bj][m][0], b = x1 + acc[ai][bj][m][1];
                    ss += dot4(a) + dot4(b); st16<WT>(B.H1B() + off + bj * 32, pack8(a, b)); }
                ss = fq_sum(ss); if (fq == 0) atomicAdd(B.H1SS() + row, ss); } }
    }
};
typedef EpiOProjT<0> EpiOProj;
template <int WT = 0> struct EpiFfn1T { static constexpr bool PERM = true, AFTER_DRAIN = false; Ctx B;
    __device__ __forceinline__ void operator()(const f32x4 (&acc)[2][2][4][2], const Unit& u, int wr, int wc, int fr, int fq) const {
        const int rbase = u.pm * BM + wr * 64 + fr, col = u.pn * HALF + wc * 32 + fq * 8; float ssv[2][4];
#pragma unroll
        for (int ai = 0; ai < 2; ++ai)
#pragma unroll
            for (int m = 0; m < 4; ++m) ssv[ai][m] = B.H1SS()[rbase + ai * HALF + m * 16];
#pragma unroll
        for (int ai = 0; ai < 2; ++ai)
#pragma unroll
            for (int m = 0; m < 4; ++m) { int row = rbase + ai * HALF + m * 16; OPAQUE(row);
                const float rh = rsq(ssv[ai][m] * (1.0f / DM) + EPS), nrl = -LOG2E * rh, rh2 = rh * rh; f32x4 o[2];
#pragma unroll
                for (int n = 0; n < 2; ++n) { const f32x4 ga = acc[ai][0][m][n], gu = ga * acc[ai][1][m][n];
#pragma unroll
                    for (int j = 0; j < 4; ++j) o[n][j] = gu[j] * (rh2 * __builtin_amdgcn_rcpf(1.0f + __builtin_amdgcn_exp2f(ga[j] * nrl))); }
                st16<WT>(B.ACT() + (size_t)row * DFF + col, pack8(o[0], o[1])); }
    }
};
#ifndef ACT_STORE_MODE
#define ACT_STORE_MODE 0
#endif
typedef EpiFfn1T<ACT_STORE_MODE> EpiFfn1;
#ifndef OUT_STORE_NT
#define OUT_STORE_NT 0
#endif
struct EpiFfn2 { static constexpr bool PERM = true, AFTER_DRAIN = false; Ctx B;
    __device__ __forceinline__ void operator()(const f32x4 (&acc)[2][2][4][2], const Unit& u, int wr, int wc, int fr, int fq) const {
        const int rbase = u.pm * BM + wr * 64 + fr, col = u.pn * BM + wc * 64 + fq * 8;
#pragma unroll
        for (int ai = 0; ai < 2; ++ai) { int rb = rbase + ai * HALF; OPAQUE(rb); u32x4 hw[4][2];
#pragma unroll
            for (int m = 0; m < 4; ++m)
#pragma unroll
                for (int bj = 0; bj < 2; ++bj) hw[m][bj] = __builtin_nontemporal_load((const u32x4*)(B.H1B() + (size_t)(rb + m * 16) * DM + col + bj * 32));
#pragma unroll
            for (int m = 0; m < 4; ++m) { const size_t off = (size_t)(rb + m * 16) * DM + col;
#pragma unroll
                for (int bj = 0; bj < 2; ++bj) { const u32x4 w = hw[m][bj];
                    const f32x4 h0 = {__uint_as_float(w.x << 16), __uint_as_float(w.x & 0xffff0000u), __uint_as_float(w.y << 16), __uint_as_float(w.y & 0xffff0000u)};
                    const f32x4 h1 = {__uint_as_float(w.z << 16), __uint_as_float(w.z & 0xffff0000u), __uint_as_float(w.w << 16), __uint_as_float(w.w & 0xffff0000u)};
                    const f32x4 o0 = h0 + acc[ai][bj][m][0], o1 = h1 + acc[ai][bj][m][1];
#if OUT_STORE_NT
                    __builtin_nontemporal_store(o0, (f32x4*)(B.out + off + bj * 32)); __builtin_nontemporal_store(o1, (f32x4*)(B.out + off + bj * 32 + 4)); } } }
#else
                    *(f32x4*)(B.out + off + bj * 32) = o0; *(f32x4*)(B.out + off + bj * 32 + 4) = o1; } } }
#endif
    }
};

template <class Epi, class Sched, bool ALIGN_EPI>
__device__ __forceinline__ void gemm_phase(PG8_LAS unsigned char* lds, const Gemm g, const Sched& S, const Epi& E) {
    const int tid = threadIdx.x, wid = __builtin_amdgcn_readfirstlane(tid >> 6), lane = tid & 63, wr = wid >> 2, wc = wid & 3, fr = lane & 15, fq = lane >> 4;
    const int K = g.K, nt = K / BK, lda = g.lda;
    unsigned voffA[2], voffB[2];
#pragma unroll
    for (int i = 0; i < 2; ++i) { int R, C; stage_rc(tid * 16 + i * 8192, R, C); const int Rb = Epi::PERM ? ((R & ~31) + perm32(R & 31)) : R;
        voffA[i] = (unsigned)(R * lda + C) * 2u; voffB[i] = (unsigned)(Rb * K + C) * 2u; }
    const size_t kstep = (size_t)(BK * 2);
    const size_t hstepA = (size_t)HALF * lda * 2, hstepB = (size_t)HALF * K * 2;
    const size_t tstepA = 2 * hstepA, tstepB = 2 * hstepB;
    const unsigned ldsw = (unsigned)wid * 1024u;
    const int aoff = lds_byte(wr * 64 + fr, fq * 8), boff = lds_byte(wc * 32 + fr, fq * 8);
#define PG8_SA(b, h) (((b) * 2 + (h)) * HTB)
#define PG8_SB(b, h) ((4 + (b) * 2 + (h)) * HTB)
#define PG8_STAGE(bufoff, gbase, voff) do { _Pragma("unroll") for (int _i = 0; _i < 2; ++_i) \
        __builtin_amdgcn_global_load_lds((const unsigned*)((const char*)(gbase) + (voff)[_i]), (PG8_LAS unsigned*)(lds + (bufoff) + ldsw + _i * 8192), 16, 0, 0); } while (0)
#define PG8_LDA(dst, b, h) do { _Pragma("unroll") for (int m = 0; m < 4; ++m) _Pragma("unroll") for (int k = 0; k < 2; ++k) dst[m][k] = *(const PG8_LAS bf16x8*)(lds + PG8_SA(b, h) + aoff + m * 2048 + k * 1024); } while (0)
#define PG8_LDB(dst, b, h) do { _Pragma("unroll") for (int n = 0; n < 2; ++n) _Pragma("unroll") for (int k = 0; k < 2; ++k) dst[n][k] = *(const PG8_LAS bf16x8*)(lds + PG8_SB(b, h) + boff + n * 2048 + k * 1024); } while (0)
#define PG8_MMA(ai, bj, At, Bt) do { __builtin_amdgcn_s_setprio(1); _Pragma("unroll") for (int m = 0; m < 4; ++m) _Pragma("unroll") for (int n = 0; n < 2; ++n) _Pragma("unroll") for (int k = 0; k < 2; ++k) \
        acc[ai][bj][m][n] = __builtin_amdgcn_mfma_f32_16x16x32_bf16(Bt[n][k], At[m][k], acc[ai][bj][m][n], 0, 0, 0); __builtin_amdgcn_s_setprio(0); } while (0)
#define PG8_WAIT_V(n) asm volatile("s_waitcnt vmcnt(" #n ")" ::: "memory")
#define PG8_WAIT_L(n) asm volatile("s_waitcnt lgkmcnt(" #n ")" ::: "memory")
#define PG8_BAR __builtin_amdgcn_s_barrier()
#define PG8_SCHED __builtin_amdgcn_sched_barrier(0)
    Unit cur, nxt; int ui = 0;
    if (!S.next(0, cur)) return;
    f32x4 acc[2][2][4][2];
#pragma unroll
    for (int a = 0; a < 2; ++a)
#pragma unroll
        for (int b = 0; b < 2; ++b)
#pragma unroll
            for (int m = 0; m < 4; ++m)
#pragma unroll
                for (int n = 0; n < 2; ++n) acc[a][b][m][n] = (f32x4){0.f, 0.f, 0.f, 0.f};
    bf16x8 At[4][2], B0[2][2], B1[2][2];
    const char* cA = (const char*)g.A + (size_t)cur.pm * tstepA; const char* cB = (const char*)g.Bt + (size_t)cur.pn * tstepB;
    S.a_ready(cur);
    PG8_STAGE(PG8_SB(0, 0), cB, voffB); PG8_STAGE(PG8_SB(0, 1), cB + hstepB, voffB); PG8_STAGE(PG8_SA(0, 0), cA, voffA); PG8_STAGE(PG8_SA(0, 1), cA + hstepA, voffA);
    if (wr == 1) PG8_BAR;
    PG8_WAIT_V(2); PG8_BAR;
    PG8_STAGE(PG8_SB(1, 0), cB + kstep, voffB); PG8_STAGE(PG8_SA(1, 0), cA + kstep, voffA); PG8_STAGE(PG8_SB(1, 1), cB + hstepB + kstep, voffB);
    PG8_WAIT_V(6); PG8_BAR;
    for (;;) {
        const bool has_next = S.next(ui + 1, nxt);
        const char* nA = has_next ? (const char*)g.A + (size_t)nxt.pm * tstepA : cA; const char* nB = has_next ? (const char*)g.Bt + (size_t)nxt.pn * tstepB : cB;
#pragma unroll 1
        for (int t = 0; t < nt; t += 2) {
            const bool last = (t == nt - 2);
            const char* a1 = cA + (size_t)(t + 1) * kstep;
            const char* a2 = last ? nA : cA + (size_t)(t + 2) * kstep; const char* b2 = last ? nB : cB + (size_t)(t + 2) * kstep;
            const char* a3 = a2 + kstep; const char* b3 = b2 + kstep;
            if (last && has_next) S.a_ready(nxt);
            PG8_LDB(B0, 0, 0); PG8_LDB(B1, 0, 1); PG8_SCHED; PG8_LDA(At, 0, 0); PG8_STAGE(PG8_SA(1, 1), a1 + hstepA, voffA);
            PG8_WAIT_V(8); PG8_WAIT_L(0); PG8_BAR; PG8_MMA(0, 0, At, B0); PG8_MMA(0, 1, At, B1); PG8_BAR; PG8_SCHED;
            PG8_LDA(At, 0, 1); PG8_STAGE(PG8_SB(0, 0), b2, voffB); PG8_STAGE(PG8_SB(0, 1), b2 + hstepB, voffB); PG8_STAGE(PG8_SA(0, 0), a2, voffA);
            PG8_WAIT_V(8); PG8_WAIT_L(0); PG8_BAR; PG8_MMA(1, 0, At, B0); PG8_MMA(1, 1, At, B1); PG8_BAR; PG8_SCHED;
            PG8_LDB(B0, 1, 0); PG8_LDB(B1, 1, 1); PG8_SCHED; PG8_LDA(At, 1, 0); PG8_STAGE(PG8_SA(0, 1), a2 + hstepA, voffA);
            PG8_WAIT_V(8); PG8_WAIT_L(0); PG8_BAR; PG8_MMA(0, 0, At, B0); PG8_MMA(0, 1, At, B1); PG8_BAR; PG8_SCHED;
            PG8_LDA(At, 1, 1); PG8_STAGE(PG8_SB(1, 0), b3, voffB); PG8_STAGE(PG8_SB(1, 1), b3 + hstepB, voffB); PG8_STAGE(PG8_SA(1, 0), a3, voffA);
            PG8_WAIT_V(8); PG8_WAIT_L(0); PG8_BAR; PG8_MMA(1, 0, At, B0); PG8_MMA(1, 1, At, B1); PG8_BAR; PG8_SCHED;
        }
        if constexpr (ALIGN_EPI) { if (wr == 0) PG8_BAR; }
        { int fr_ = fr, fq_ = fq; OPAQUE(fr_); OPAQUE(fq_); E(acc, cur, wr, wc, fr_, fq_); } S.done(cur);
        if (!has_next) break;
#pragma unroll
        for (int a = 0; a < 2; ++a)
#pragma unroll
            for (int b = 0; b < 2; ++b)
#pragma unroll
                for (int m = 0; m < 4; ++m)
#pragma unroll
                    for (int n = 0; n < 2; ++n) acc[a][b][m][n] = (f32x4){0.f, 0.f, 0.f, 0.f};
        cur = nxt; cA = nA; cB = nB; ++ui;
        if constexpr (ALIGN_EPI) { if (wr == 1) PG8_BAR; }
    }
    PG8_WAIT_V(0);
    if constexpr (!ALIGN_EPI) { if (wr == 0) PG8_BAR; }
    PG8_BAR;
#undef PG8_SA
#undef PG8_SB
#undef PG8_STAGE
#undef PG8_LDA
#undef PG8_LDB
#undef PG8_MMA
#undef PG8_WAIT_V
#undef PG8_WAIT_L
#undef PG8_BAR
#undef PG8_SCHED
}

#ifndef STREAM_ALIGN_EPI
#define STREAM_ALIGN_EPI 1
#endif
struct GDesc { const bf16_t* A; const bf16_t* Bt; int K, lda; };
struct UnitX { int pm, pn, kind; };
template <class Prog, int A_AUX = 0>
__device__ __forceinline__ void gemm_stream(PG8_LAS unsigned char* lds, Prog& P) {
    const int tid = threadIdx.x, wid = __builtin_amdgcn_readfirstlane(tid >> 6), lane = tid & 63, wr = wid >> 2, wc = wid & 3, fr = lane & 15, fq = lane >> 4;
    int R_[2], C_[2], Rb_[2];
#pragma unroll
    for (int i = 0; i < 2; ++i) { stage_rc(tid * 16 + i * 8192, R_[i], C_[i]); Rb_[i] = (R_[i] & ~31) + perm32(R_[i] & 31); }
    const size_t kstep = (size_t)(BK * 2);
    const unsigned ldsw = (unsigned)wid * 1024u;
    const int aoff = lds_byte(wr * 64 + fr, fq * 8), boff = lds_byte(wc * 32 + fr, fq * 8);
#define PG8_SA(b, h) (((b) * 2 + (h)) * HTB)
#define PG8_SB(b, h) ((4 + (b) * 2 + (h)) * HTB)
#define PG8_STAGE2(bufoff, gbase, v0, v1) do { \
        __builtin_amdgcn_global_load_lds((const unsigned*)((const char*)(gbase) + (v0)), (PG8_LAS unsigned*)(lds + (bufoff) + ldsw), 16, 0, 0); \
        __builtin_amdgcn_global_load_lds((const unsigned*)((const char*)(gbase) + (v1)), (PG8_LAS unsigned*)(lds + (bufoff) + ldsw + 8192), 16, 0, 0); } while (0)
#define PG8_STAGE2A(bufoff, gbase, v0, v1) do { \
        __builtin_amdgcn_global_load_lds((const unsigned*)((const char*)(gbase) + (v0)), (PG8_LAS unsigned*)(lds + (bufoff) + ldsw), 16, 0, A_AUX); \
        __builtin_amdgcn_global_load_lds((const unsigned*)((const char*)(gbase) + (v1)), (PG8_LAS unsigned*)(lds + (bufoff) + ldsw + 8192), 16, 0, A_AUX); } while (0)
#define PG8_LDA(dst, b, h) do { _Pragma("unroll") for (int m = 0; m < 4; ++m) _Pragma("unroll") for (int k = 0; k < 2; ++k) dst[m][k] = *(const PG8_LAS bf16x8*)(lds + PG8_SA(b, h) + aoff + m * 2048 + k * 1024); } while (0)
#define PG8_LDB(dst, b, h) do { _Pragma("unroll") for (int n = 0; n < 2; ++n) _Pragma("unroll") for (int k = 0; k < 2; ++k) dst[n][k] = *(const PG8_LAS bf16x8*)(lds + PG8_SB(b, h) + boff + n * 2048 + k * 1024); } while (0)
#define PG8_MMA(ai, bj, At, Bt) do { __builtin_amdgcn_s_setprio(1); _Pragma("unroll") for (int m = 0; m < 4; ++m) _Pragma("unroll") for (int n = 0; n < 2; ++n) _Pragma("unroll") for (int k = 0; k < 2; ++k) \
        acc[ai][bj][m][n] = __builtin_amdgcn_mfma_f32_16x16x32_bf16(Bt[n][k], At[m][k], acc[ai][bj][m][n], 0, 0, 0); __builtin_amdgcn_s_setprio(0); } while (0)
#define PG8_WAIT_V(n) asm volatile("s_waitcnt vmcnt(" #n ")" ::: "memory")
#define PG8_WAIT_L(n) asm volatile("s_waitcnt lgkmcnt(" #n ")" ::: "memory")
#define PG8_BAR __builtin_amdgcn_s_barrier()
#define PG8_SCHED __builtin_amdgcn_sched_barrier(0)
#define PG8_SETUP(u, pA, pB, vA0, vA1, vB0, vB1, hA, hB, ntv) do { const GDesc d_ = P.desc((u).kind); (ntv) = d_.K / BK; (hA) = (size_t)HALF * d_.lda * 2; (hB) = (size_t)HALF * d_.K * 2; \
        (pA) = (const char*)d_.A + (size_t)(u).pm * 2 * (hA); (pB) = (const char*)d_.Bt + (size_t)(u).pn * 2 * (hB); \
        (vA0) = (unsigned)(R_[0] * d_.lda + C_[0]) * 2u; (vA1) = (unsigned)(R_[1] * d_.lda + C_[1]) * 2u; (vB0) = (unsigned)(Rb_[0] * d_.K + C_[0]) * 2u; (vB1) = (unsigned)(Rb_[1] * d_.K + C_[1]) * 2u; } while (0)
    UnitX cur, nxt; int ui = 0;
    if (!P.next(0, cur)) return;
    const char *cA, *cB, *nA, *nB; unsigned cvA0, cvA1, cvB0, cvB1, nvA0, nvA1, nvB0, nvB1; size_t chA, chB, nhA, nhB; int cnt, nnt;
    PG8_SETUP(cur, cA, cB, cvA0, cvA1, cvB0, cvB1, chA, chB, cnt);
    f32x4 acc[2][2][4][2];
#pragma unroll
    for (int a = 0; a < 2; ++a)
#pragma unroll
        for (int b = 0; b < 2; ++b)
#pragma unroll
            for (int m = 0; m < 4; ++m)
#pragma unroll
                for (int n = 0; n < 2; ++n) acc[a][b][m][n] = (f32x4){0.f, 0.f, 0.f, 0.f};
    bf16x8 At[4][2], B0[2][2], B1[2][2];
    P.a_ready(cur);
    PG8_STAGE2(PG8_SB(0, 0), cB, cvB0, cvB1); PG8_STAGE2(PG8_SB(0, 1), cB + chB, cvB0, cvB1); PG8_STAGE2A(PG8_SA(0, 0), cA, cvA0, cvA1); PG8_STAGE2A(PG8_SA(0, 1), cA + chA, cvA0, cvA1);
    if (wr == 1) PG8_BAR;
    PG8_WAIT_V(2); PG8_BAR;
    PG8_STAGE2(PG8_SB(1, 0), cB + kstep, cvB0, cvB1); PG8_STAGE2A(PG8_SA(1, 0), cA + kstep, cvA0, cvA1); PG8_STAGE2(PG8_SB(1, 1), cB + chB + kstep, cvB0, cvB1);
    PG8_WAIT_V(6); PG8_BAR;
    for (;;) {
        const bool has_next = P.next(ui + 1, nxt);
        if (has_next) { PG8_SETUP(nxt, nA, nB, nvA0, nvA1, nvB0, nvB1, nhA, nhB, nnt); }
        else { nA = cA; nB = cB; nvA0 = cvA0; nvA1 = cvA1; nvB0 = cvB0; nvB1 = cvB1; nhA = chA; nhB = chB; nnt = cnt; }
#pragma unroll 1
        for (int t = 0; t < cnt; t += 2) {
            const bool last = (t == cnt - 2);
            const char* a1 = cA + (size_t)(t + 1) * kstep;
            const char* a2 = last ? nA : cA + (size_t)(t + 2) * kstep; const char* b2 = last ? nB : cB + (size_t)(t + 2) * kstep;
            const char* a3 = a2 + kstep; const char* b3 = b2 + kstep;
            const unsigned xA0 = last ? nvA0 : cvA0, xA1 = last ? nvA1 : cvA1, xB0 = last ? nvB0 : cvB0, xB1 = last ? nvB1 : cvB1; const size_t xhA = last ? nhA : chA, xhB = last ? nhB : chB;
            if (last && has_next) P.a_ready(nxt);
            PG8_LDB(B0, 0, 0); PG8_LDB(B1, 0, 1); PG8_SCHED; PG8_LDA(At, 0, 0); PG8_STAGE2A(PG8_SA(1, 1), a1 + chA, cvA0, cvA1);
            PG8_WAIT_V(8); PG8_WAIT_L(0); PG8_BAR; PG8_MMA(0, 0, At, B0); PG8_MMA(0, 1, At, B1); PG8_BAR; PG8_SCHED;
            PG8_LDA(At, 0, 1); PG8_STAGE2(PG8_SB(0, 0), b2, xB0, xB1); PG8_STAGE2(PG8_SB(0, 1), b2 + xhB, xB0, xB1); PG8_STAGE2A(PG8_SA(0, 0), a2, xA0, xA1);
            PG8_WAIT_V(8); PG8_WAIT_L(0); PG8_BAR; PG8_MMA(1, 0, At, B0); PG8_MMA(1, 1, At, B1); PG8_BAR; PG8_SCHED;
            PG8_LDB(B0, 1, 0); PG8_LDB(B1, 1, 1); PG8_SCHED; PG8_LDA(At, 1, 0); PG8_STAGE2A(PG8_SA(0, 1), a2 + xhA, xA0, xA1);
            PG8_WAIT_V(8); if (t == 0) P.publish();
            PG8_WAIT_L(0); PG8_BAR; PG8_MMA(0, 0, At, B0); PG8_MMA(0, 1, At, B1); PG8_BAR; PG8_SCHED;
            PG8_LDA(At, 1, 1); PG8_STAGE2(PG8_SB(1, 0), b3, xB0, xB1); PG8_STAGE2(PG8_SB(1, 1), b3 + xhB, xB0, xB1); PG8_STAGE2A(PG8_SA(1, 0), a3, xA0, xA1);
            PG8_WAIT_V(8); PG8_WAIT_L(0); PG8_BAR; PG8_MMA(1, 0, At, B0); PG8_MMA(1, 1, At, B1); PG8_BAR; PG8_SCHED;
        }
#if STREAM_ALIGN_EPI
        if (wr == 0) PG8_BAR;
#endif
        { int fr_ = fr, fq_ = fq; OPAQUE(fr_); OPAQUE(fq_); P.epi(acc, cur, wr, wc, fr_, fq_); } P.done(cur);
        if (!has_next) break;
#pragma unroll
        for (int a = 0; a < 2; ++a)
#pragma unroll
            for (int b = 0; b < 2; ++b)
#pragma unroll
                for (int m = 0; m < 4; ++m)
#pragma unroll
                    for (int n = 0; n < 2; ++n) acc[a][b][m][n] = (f32x4){0.f, 0.f, 0.f, 0.f};
        cur = nxt; cA = nA; cB = nB; cvA0 = nvA0; cvA1 = nvA1; cvB0 = nvB0; cvB1 = nvB1; chA = nhA; chB = nhB; cnt = nnt; ++ui;
#if STREAM_ALIGN_EPI
        if (wr == 1) PG8_BAR;
#endif
    }
    PG8_WAIT_V(0); P.publish();
#if !STREAM_ALIGN_EPI
    if (wr == 0) PG8_BAR;
#endif
    PG8_BAR;
#undef PG8_SA
#undef PG8_SB
#undef PG8_STAGE2
#undef PG8_STAGE2A
#undef PG8_LDA
#undef PG8_LDB
#undef PG8_MMA
#undef PG8_WAIT_V
#undef PG8_WAIT_L
#undef PG8_BAR
#undef PG8_SCHED
#undef PG8_SETUP
}
struct ProgP2 { Ctx B; StaticOrder S;
    __device__ __forceinline__ void init(const Ctx& b, int G, int c) { B = b; S.init(M, 1024, G, c); }
    __device__ __forceinline__ bool next(int i, UnitX& u) const { Unit t; const int per = (S.nwg - S.c + S.G - 1) / S.G; const bool q = i < per; if (!S.next(q ? i : i - per, t)) return false; u.pm = t.pm; u.pn = t.pn; u.kind = q ? 0 : 1; return true; }
    __device__ __forceinline__ GDesc desc(int kind) const { return kind == 0 ? GDesc{B.CQKV(), B.WQUP(), 256, 384} : GDesc{B.CQKV() + 256, B.WKVUP(), 128, 384}; }
    __device__ __forceinline__ void epi(const f32x4 (&acc)[2][2][4][2], const UnitX& u, int wr, int wc, int fr, int fq) const { const Unit t{u.pm, u.pn};
        if (u.kind == 0) EpiQUp{B}(acc, t, wr, wc, fr, fq); else EpiKvUp{B}(acc, t, wr, wc, fr, fq); }
    __device__ __forceinline__ void a_ready(const UnitX&) const {}
    __device__ __forceinline__ void done(const UnitX&) const {}
    __device__ __forceinline__ void publish() const {}
};

template <class Epi, int DUPMODE = 0> struct ProgOne { Ctx B; StaticOrder S; GDesc d;
    __device__ __forceinline__ void init(const Ctx& b, const GDesc& g, int N, int G, int c) { B = b; d = g; S.init(M, N, G, c); }
    __device__ __forceinline__ bool next(int i, UnitX& u) const { Unit t; if (!S.next(DUPMODE ? (i >> 1) : i, t)) return false; u.pm = t.pm; u.pn = t.pn; u.kind = (DUPMODE == 2 && !(i & 1)) ? 1 : 0; return true; }
    __device__ __forceinline__ GDesc desc(int) const { return d; }
    __device__ __forceinline__ void epi(const f32x4 (&acc)[2][2][4][2], const UnitX& u, int wr, int wc, int fr, int fq) const { if (DUPMODE == 2 && u.kind == 1) return; const Unit t{u.pm, u.pn}; Epi{B}(acc, t, wr, wc, fr, fq); }
    __device__ __forceinline__ void a_ready(const UnitX&) const {}
    __device__ __forceinline__ void done(const UnitX&) const {}
    __device__ __forceinline__ void publish() const {}
};

struct ProgFFN { Ctx B; StaticOrder S4, S5; unsigned* cnt4; unsigned* cnt5; unsigned* tmo; int seg, p6, acq4; unsigned* pend;
    enum { K_P4 = 0, K_P5 = 1, K_P6 = 2 };
    __device__ __forceinline__ void init(const Ctx& b, int G, int c, unsigned* c4, unsigned* c5, unsigned* t) { B = b; S4.init(M, DM, G, c); S5.init(M, 2 * DFF, G, c); cnt4 = c4; cnt5 = c5; tmo = t; seg = 0; p6 = 1 + (c >> 3) % 5; acq4 = -1; pend = nullptr; }
    __device__ __forceinline__ bool next(int i, UnitX& u) const { Unit t; int kind, r;
        if (seg == 0) { if (i > 1) return false; kind = K_P4; r = i; }
        else if (seg == 1) { if (i < 6) { kind = K_P5; r = i; } else if (i < 12) { const int k = i - 6; if (k == p6) { kind = K_P6; r = 0; } else { kind = K_P5; r = 6 + (k < p6 ? k : k - 1); } } else return false; }
        else { if (i > 0) return false; kind = K_P6; r = 1; }
        if (!(kind == K_P5 ? S5.next(r, t) : S4.next(r, t))) return false;
        u.pm = t.pm; u.pn = t.pn; u.kind = kind; return true; }
    __device__ __forceinline__ GDesc desc(int kind) const { return kind == K_P4 ? GDesc{B.AO(), B.WO(), DM, DM} : kind == K_P5 ? GDesc{B.H1B(), B.WGU(), DM, DM} : GDesc{B.ACT(), B.WD(), DFF, DFF}; }
    __device__ __forceinline__ void epi(const f32x4 (&acc)[2][2][4][2], const UnitX& u, int wr, int wc, int fr, int fq) const { const Unit t{u.pm, u.pn};
        if (u.kind == K_P4) EpiOProjT<1>{B}(acc, t, wr, wc, fr, fq); else if (u.kind == K_P5) EpiFfn1T<1>{B}(acc, t, wr, wc, fr, fq); else EpiFfn2{B}(acc, t, wr, wc, fr, fq); }
    __device__ __forceinline__ void a_ready(const UnitX& u) {
        if (u.kind == K_P4 || (u.kind == K_P5 && u.pm == acq4)) return;
        if (threadIdx.x < 64) {
            unsigned* c = u.kind == K_P5 ? cnt4 + 64 * u.pm : cnt5 + 64 * u.pm; const unsigned need = u.kind == K_P5 ? 4u * 8u : 22u * 8u; unsigned sp = 0u;
            while ((unsigned)__builtin_amdgcn_readfirstlane(__hip_atomic_load(c, __ATOMIC_RELAXED, __HIP_MEMORY_SCOPE_AGENT)) < need) { __builtin_amdgcn_s_sleep(2);
                if ((++sp & 255u) == 0u) { if (__builtin_amdgcn_readfirstlane(__hip_atomic_load(tmo, __ATOMIC_RELAXED, __HIP_MEMORY_SCOPE_AGENT)) != 0u) break; if (sp > (1u << 18)) { if (threadIdx.x == 0) atomicAdd(tmo, 1u); break; } } }
            __builtin_amdgcn_fence(__ATOMIC_ACQUIRE, "agent");
            asm volatile("s_waitcnt vmcnt(0)" ::: "memory");
        }
        asm volatile("" ::: "memory"); __builtin_amdgcn_s_barrier(); asm volatile("" ::: "memory");
        if (u.kind == K_P5) acq4 = u.pm;
    }
    __device__ __forceinline__ void done(const UnitX& u) { pend = u.kind == K_P4 ? cnt4 + 64 * u.pm : u.kind == K_P5 ? cnt5 + 64 * u.pm : nullptr; }
    __device__ __forceinline__ void publish() { if (pend) { if ((threadIdx.x & 63) == 0) (void)__hip_atomic_fetch_add(pend, 1u, __ATOMIC_RELAXED, __HIP_MEMORY_SCOPE_AGENT); pend = nullptr; } }
};
}
namespace attm {
using bf16=bf16_t;
using bf16x8=__attribute__((ext_vector_type(8)))short;
using s16x4=__attribute__((ext_vector_type(4)))short;
using f32x16=__attribute__((ext_vector_type(16)))float;
using u32x4=__attribute__((ext_vector_type(4)))unsigned;
using f32x4=__attribute__((ext_vector_type(4)))float;
constexpr int D=64,DM=512,DMO=1024;
constexpr int NW=8,QBLK=32,QB=QBLK*NW,KVBLK=64;
__device__ __forceinline__ int crow(int r,int hi){return (r&3)+8*(r>>2)+4*hi;}
#define SBAR() __builtin_amdgcn_sched_barrier(0)
__device__ __forceinline__ void cmask(f32x16&p0,f32x16&p1,int jb,int qrel,int hi){
  const float NEG=-INFINITY; int kb=64*jb+4*hi;
  #pragma unroll
  for(int r=0;r<16;++r){int kv=kb+(r&3)+8*(r>>2); if(kv>qrel)p0[r]=NEG; if(kv+32>qrel)p1[r]=NEG;}
}

constexpr int NSLOT=3, SLOTB=8192;
constexpr int LDS_K=0, LDS_V=NSLOT*SLOTB, LDS_WS=2*NSLOT*SLOTB, LDS_OST=LDS_WS+NW*64*4, LDS_BYTES=LDS_OST+NW*4096;
constexpr float C2=0.125f*1.4426950408889634f;
__device__ __forceinline__ void glds16(const void*gsrc,unsigned lds_dst){unsigned keep;
  asm volatile("s_mov_b32 %0, m0\n\ts_mov_b32 m0, %2\n\ts_nop 0\n\tglobal_load_lds_dwordx4 %1, off\n\ts_mov_b32 m0, %0":"=&s"(keep):"v"(gsrc),"s"(lds_dst):"memory");}
__device__ __forceinline__ float max3f(float a,float b,float c){float r;asm("v_max3_f32 %0, %1, %2, %3":"=v"(r):"v"(a),"v"(b),"v"(c));return r;}
__device__ __forceinline__ float max2f(float a,float b){float r;asm("v_max_f32_e32 %0, %1, %2":"=v"(r):"v"(a),"v"(b));return r;}
__device__ __forceinline__ float fadd_s(float a,float b){float r;asm("v_add_f32_e32 %0, %1, %2":"=v"(r):"v"(a),"v"(b));return r;}
__device__ __forceinline__ float fsub_s(float a,float b){float r;asm("v_sub_f32_e32 %0, %1, %2":"=v"(r):"v"(a),"v"(b));return r;}
typedef float f32x2_t __attribute__((ext_vector_type(2))); typedef __bf16 bf16x2_t __attribute__((ext_vector_type(2)));
__device__ __forceinline__ unsigned cvtpk_s(float lo,float hi){f32x2_t v={lo,hi};bf16x2_t b=__builtin_convertvector(v,bf16x2_t);return __builtin_bit_cast(unsigned,b);}
__device__ __forceinline__ void glds16s(const void*sbase,unsigned voff,unsigned lds_dst){unsigned keep;
  asm volatile("s_mov_b32 %0, m0\n\ts_mov_b32 m0, %3\n\ts_nop 0\n\tglobal_load_lds_dwordx4 %1, %2\n\ts_mov_b32 m0, %0":"=&s"(keep):"v"(voff),"s"(sbase),"s"(lds_dst):"memory");}
__device__ __forceinline__ const bf16_t* uptr(const bf16_t*p){ const unsigned long long v=(unsigned long long)p; const unsigned lo=__builtin_amdgcn_readfirstlane((unsigned)v),hi=__builtin_amdgcn_readfirstlane((unsigned)(v>>32)); return (const bf16_t*)(((unsigned long long)hi<<32)|lo); }
#define WAIT_BAR(N) asm volatile("s_waitcnt vmcnt(" #N ") lgkmcnt(0)\n\ts_barrier":::"memory")

__device__ __forceinline__ void qkt(f32x16&p0,f32x16&p1,const char*Kslot,const bf16x8*qr,const f32x16&negm,int r32,int hi){
  const char*kb=Kslot+hi*1024+r32*16;
  #pragma unroll
  for(int d0=0;d0<4;++d0){
    const bf16x8 b0=*reinterpret_cast<const bf16x8*>(kb+d0*2048);
    const bf16x8 b1=*reinterpret_cast<const bf16x8*>(kb+d0*2048+512);
    if(d0==0){p0=__builtin_amdgcn_mfma_f32_32x32x16_bf16(b0,qr[0],negm,0,0,0);p1=__builtin_amdgcn_mfma_f32_32x32x16_bf16(b1,qr[0],negm,0,0,0);}
    else{p0=__builtin_amdgcn_mfma_f32_32x32x16_bf16(b0,qr[d0],p0,0,0,0);p1=__builtin_amdgcn_mfma_f32_32x32x16_bf16(b1,qr[d0],p1,0,0,0);}}
}
typedef __attribute__((address_space(3))) const char* lds_cptr;
typedef short v4i16_t __attribute__((ext_vector_type(4)));
__device__ __forceinline__ void kload8(bf16x8*kf,lds_cptr kp){
  kf[0]=*(const __attribute__((address_space(3))) bf16x8*)(kp);      kf[1]=*(const __attribute__((address_space(3))) bf16x8*)(kp+512);
  kf[2]=*(const __attribute__((address_space(3))) bf16x8*)(kp+2048); kf[3]=*(const __attribute__((address_space(3))) bf16x8*)(kp+2560);
  kf[4]=*(const __attribute__((address_space(3))) bf16x8*)(kp+4096); kf[5]=*(const __attribute__((address_space(3))) bf16x8*)(kp+4608);
  kf[6]=*(const __attribute__((address_space(3))) bf16x8*)(kp+6144); kf[7]=*(const __attribute__((address_space(3))) bf16x8*)(kp+6656);
}
__device__ __forceinline__ void kload2(bf16x8*kf,lds_cptr kp,int j){ kf[2*j]=*(const __attribute__((address_space(3))) bf16x8*)(kp+j*2048); kf[2*j+1]=*(const __attribute__((address_space(3))) bf16x8*)(kp+j*2048+512); }
__device__ __forceinline__ s16x4 vtr(lds_cptr p){ return __builtin_bit_cast(s16x4,__builtin_amdgcn_ds_read_tr16_b64_v4i16((__attribute__((address_space(3))) v4i16_t*)p)); }
__device__ __forceinline__ float rowmax(const f32x16&p0,const f32x16&p1){
  float a=max3f(p0[0],p0[1],p1[0]),b=max3f(p0[2],p0[3],p1[1]);a=max3f(a,p1[2],p1[3]);
  #pragma unroll
  for(int r=4;r<16;r+=4){a=max3f(a,p0[r],p0[r+1]);b=max3f(b,p0[r+2],p0[r+3]);a=max3f(a,p1[r],p1[r+1]);b=max3f(b,p1[r+2],p1[r+3]);}
  const float m=max2f(a,b);
  auto rr=__builtin_amdgcn_permlane32_swap(__float_as_uint(m),__float_as_uint(m),false,false);
  return max2f(__uint_as_float(rr[0]),__uint_as_float(rr[1]));
}
__device__ __forceinline__ void pv(f32x16*o,int vb,bf16x8 pa0,bf16x8 pa1,bf16x8 pa2,bf16x8 pa3){
  #pragma unroll
  for(int d0=0;d0<2;++d0){s16x4 lo[4],hi[4];
    #pragma unroll
    for(int ks=0;ks<4;++ks){
      asm volatile("ds_read_b64_tr_b16 %0,%1 offset:%c2":"=&v"(lo[ks]):"v"(vb),"i"(d0*4096+ks*1024):"memory");
      asm volatile("ds_read_b64_tr_b16 %0,%1 offset:%c2":"=&v"(hi[ks]):"v"(vb),"i"(d0*4096+ks*1024+512):"memory");}
    asm volatile("s_waitcnt lgkmcnt(0)":::"memory");SBAR();
    #define PK(k) (bf16x8){lo[k][0],lo[k][1],lo[k][2],lo[k][3],hi[k][0],hi[k][1],hi[k][2],hi[k][3]}
    o[d0]=__builtin_amdgcn_mfma_f32_32x32x16_bf16(pa0,PK(0),o[d0],0,0,0);
    o[d0]=__builtin_amdgcn_mfma_f32_32x32x16_bf16(pa1,PK(1),o[d0],0,0,0);
    o[d0]=__builtin_amdgcn_mfma_f32_32x32x16_bf16(pa2,PK(2),o[d0],0,0,0);
    o[d0]=__builtin_amdgcn_mfma_f32_32x32x16_bf16(pa3,PK(3),o[d0],0,0,0);
    #undef PK
  }
}

#ifndef ATTN_STORE16
#define ATTN_STORE16(p,v) (*(u32x4*)(p)=(v))
#endif
template<int THRL> __device__ __forceinline__ void attn_unit(int qb,int b8,int h,const bf16*Q,const bf16*__restrict__ K,const bf16*__restrict__ V,bf16*O,const Ctx&B,char*shm){
  const int tid=threadIdx.x; int lane=tid&63; asm volatile("":"+v"(lane));
  const int r32=lane&31,hi=lane>>5; const int wid=__builtin_amdgcn_readfirstlane(tid>>6);
  const int q0=qb*QB;
  const bf16*Qw=Q+(long)(q0+wid*QBLK)*DM;
  const bf16*Kh=K,*Vh=V;
  const unsigned lds0=(unsigned)(uintptr_t)shm;
  float*wsf=(float*)(shm+LDS_WS)+wid*64;
  const unsigned koff=(unsigned)(lane*DM+wid*8)*2u;
  const unsigned voffv=(unsigned)((16*(wid&3)+(lane>>2))*DM+(wid>>2)*32+(lane&3)*8)*2u;
  const unsigned kdst=lds0+LDS_K+wid*1024, vdst=lds0+LDS_V+wid*1024;
  #define DMA_K(t,slot) glds16s(uptr(Kh+(long)(t)*KVBLK*DM),koff,(unsigned)__builtin_amdgcn_readfirstlane(kdst+(slot)))
  #define DMA_V(t,slot) glds16s(uptr(Vh+(long)(t)*KVBLK*DM),voffv,(unsigned)__builtin_amdgcn_readfirstlane(vdst+(slot)))
  const int vb0=(int)(lds0+LDS_V)+((lane>>4)&1)*32+(lane&3)*8+(4*hi+((lane&15)>>2))*64;
  const char*Kbase=shm+LDS_K; bf16x8 kf[8];
  const lds_cptr shm3=(lds_cptr)shm; const lds_cptr kp0=shm3+LDS_K+hi*1024+r32*16; const lds_cptr vp0=shm3+LDS_V+((lane>>4)&1)*32+(lane&3)*8+(4*hi+((lane&15)>>2))*64;
  const int NT=(q0+QB)/KVBLK;
  DMA_K(0,0);DMA_V(0,0);DMA_K(1,SLOTB);
  bf16x8 qr[4];
  #pragma unroll
  for(int d0=0;d0<4;++d0)qr[d0]=__builtin_nontemporal_load(reinterpret_cast<const bf16x8*>(&Qw[(long)r32*DM+d0*16+hi*8]));
  unsigned sel=0xffu;
  if(qb>3){
    int r32o=r32; asm volatile("":"+v"(r32o));
    f32x16 G=f32x16{};
    #pragma unroll
    for(int d0=0;d0<4;++d0){ float km[8];
      #pragma unroll
      for(int j=0;j<8;++j)km[j]=0.f;
      if(r32o<qb){ const float*kpp=B.KMEANP()+(size_t)(b8+r32o)*4*512+h*64+d0*16+hi*8;
        #pragma unroll
        for(int qq=0;qq<4;++qq){ const f32x4 a=*(const f32x4*)(kpp+qq*512),bb=*(const f32x4*)(kpp+qq*512+4);
          #pragma unroll
          for(int j=0;j<4;++j){km[j]+=a[j];km[4+j]+=bb[j];} } }
      unsigned whi[4],wlo[4];
      #pragma unroll
      for(int w=0;w<4;++w){ whi[w]=cvtpk_s(km[2*w],km[2*w+1]); wlo[w]=cvtpk_s(km[2*w]-__uint_as_float(whi[w]<<16),km[2*w+1]-__uint_as_float(whi[w]&0xffff0000u)); }
      const u32x4 vh={whi[0],whi[1],whi[2],whi[3]},vl={wlo[0],wlo[1],wlo[2],wlo[3]};
      G=__builtin_amdgcn_mfma_f32_32x32x16_bf16(__builtin_bit_cast(bf16x8,vh),qr[d0],G,0,0,0);
      G=__builtin_amdgcn_mfma_f32_32x32x16_bf16(__builtin_bit_cast(bf16x8,vl),qr[d0],G,0,0,0); }
    float gate[8];
    #pragma unroll
    for(int r=0;r<4;++r){ auto rr=__builtin_amdgcn_permlane32_swap(__float_as_uint(G[r]),__float_as_uint(G[r]),false,false); gate[r]=__uint_as_float(rr[0]); gate[4+r]=__uint_as_float(rr[1]); }
    #pragma unroll
    for(int j=0;j<8;++j)if(j>=qb)gate[j]=-INFINITY;
    sel=0u;
    #pragma unroll
    for(int j=0;j<8;++j){ int rank=0;
      #pragma unroll
      for(int i=0;i<8;++i)rank+=(gate[i]>gate[j]||(gate[i]==gate[j]&&i<j))?1:0;
      if(j<qb&&rank<3)sel|=1u<<j; }
  }
  float mhat=0.f,l_reg=0.f;f32x16 o[2];o[0]=f32x16{};o[1]=f32x16{};f32x16 negm;
  #define SETNEGM(tt) do{ const float nm_=((tt)>=NT-4||((sel>>((tt)>>2))&1u))?-mhat:-INFINITY; _Pragma("unroll") for(int r=0;r<16;++r)negm[r]=nm_; asm volatile("":"+v"(negm)); }while(0)
  const int qrel=wid*QBLK+r32;
  #define CMASK(P0,P1,t) do{int jb_=(t)-(NT-4); if(jb_>=0)cmask(P0,P1,jb_,qrel,hi);}while(0)
  bool resc=false;
  #define START(P0,P1) do{ const float rm=rowmax(P0,P1); resc=false; \
    { const float dl=(rm==-INFINITY)?0.f:rm; mhat=fadd_s(mhat,dl); \
      _Pragma("unroll") for(int r=0;r<16;++r){P0[r]=fsub_s(P0[r],dl);P1[r]=fsub_s(P1[r],dl);} \
      SETNEGM(1); } \
    _Pragma("unroll") for(int r=0;r<16;++r)P0[r]=__builtin_amdgcn_exp2f(P0[r]); }while(0)
  #define RESC() do{ if(resc){ asm volatile("s_waitcnt lgkmcnt(0)":::"memory"); \
      _Pragma("unroll") for(int d_=0;d_<2;++d_) _Pragma("unroll") for(int r=0;r<16;++r)o[d_][r]*=wsf[crow(r,hi)]; } }while(0)
  f32x16 pA0,pA1,pB0,pB1;
  int sl_prev=0,sl_cur=0,sl_next=SLOTB;
  #define ROT() do{sl_prev=sl_cur;sl_cur=sl_next;sl_next=(sl_next==(NSLOT-1)*SLOTB)?0:sl_next+SLOTB;}while(0)
  DMA_K(2,2*SLOTB);
  WAIT_BAR(3);
  SETNEGM(0);
  qkt(pA0,pA1,Kbase,qr,negm,r32,hi);asm volatile("s_nop 15\n\ts_nop 7":"+v"(pA0),"+v"(pA1));CMASK(pA0,pA1,0);
  START(pA0,pA1);
  _Pragma("unroll") for(int r=0;r<16;++r)pA1[r]=__builtin_amdgcn_exp2f(pA1[r]);
  WAIT_BAR(0);
  DMA_K(3,0);DMA_V(1,SLOTB);
  ROT();
  kload8(kf,kp0+sl_cur);
  WAIT_BAR(2);
  s16x4 vlo[8],vhi[8]; u32x4 pw0,pw1,pw2,pw3;
  #define PKW(P,B) cvtpk_s(P[B],P[B+1])
  #define PAF(k) __builtin_bit_cast(bf16x8,pw##k)
  #define VFR(i) (bf16x8){vlo[i][0],vlo[i][1],vlo[i][2],vlo[i][3],vhi[i][0],vhi[i][1],vhi[i][2],vhi[i][3]}
  #define PIN(x) asm volatile("":"+v"(x))
  #define MX3(a,b,c) __builtin_fmaxf(__builtin_fmaxf((a),(b)),(c))
  #define GAPA(MF,A0,A1,A2,A3,W0,W1,PW) do{ MF; sacc+=A0; sacc+=A1; sacc+=A2; sacc+=A3; PIN(sacc); W0; W1; PIN(PW); SBAR(); }while(0)
  #define EX(v) __builtin_amdgcn_exp2f(v)
  #define GAPB(MF,X,B) do{ MF; X[B]=EX(X[B]); X[B+1]=EX(X[B+1]); X[B+2]=EX(X[B+2]); X[B+3]=EX(X[B+3]); PIN(X); SBAR(); }while(0)
  #define VRD(i) do{ vlo[i]=vtr(vp_+(((i)>>2)*4096+((i)&3)*1024)); vhi[i]=vtr(vp_+(((i)>>2)*4096+((i)&3)*1024+512)); }while(0)
  #define KRD(G,j) do{ if(G){ kload2(kf,kp0+sl_next,j); SBAR(); } }while(0)
  #define STEP(C0,C1,P0,P1,t,GK,GV,GL) do{ SBAR(); \
    const lds_cptr vp_=vp0+sl_prev; \
    VRD(0); SBAR(); float sacc=(P0[0]+P0[1]); \
    GAPA(C0=__builtin_amdgcn_mfma_f32_32x32x16_bf16(kf[0],qr[0],negm,0,0,0), P0[2],P0[3],P0[4],P0[5],     pw0[0]=PKW(P0,0), pw0[1]=PKW(P0,2), pw0); \
    VRD(4); SBAR(); GAPA(C1=__builtin_amdgcn_mfma_f32_32x32x16_bf16(kf[1],qr[0],negm,0,0,0), P0[6],P0[7],P0[8],P0[9],     pw0[2]=PKW(P0,4), pw0[3]=PKW(P0,6), pw0); \
    VRD(1); SBAR(); GAPA(C0=__builtin_amdgcn_mfma_f32_32x32x16_bf16(kf[2],qr[1],C0,0,0,0),   P0[10],P0[11],P0[12],P0[13], pw1[0]=PKW(P0,8), pw1[1]=PKW(P0,10), pw1); \
    VRD(5); SBAR(); GAPA(C1=__builtin_amdgcn_mfma_f32_32x32x16_bf16(kf[3],qr[1],C1,0,0,0),   P0[14],P0[15],P1[0],P1[1],   pw1[2]=PKW(P0,12),pw1[3]=PKW(P0,14), pw1); \
    VRD(2); SBAR(); GAPA(C0=__builtin_amdgcn_mfma_f32_32x32x16_bf16(kf[4],qr[2],C0,0,0,0),   P1[2],P1[3],P1[4],P1[5],     pw2[0]=PKW(P1,0), pw2[1]=PKW(P1,2), pw2); \
    VRD(6); SBAR(); GAPA(C1=__builtin_amdgcn_mfma_f32_32x32x16_bf16(kf[5],qr[2],C1,0,0,0),   P1[6],P1[7],P1[8],P1[9],     pw2[2]=PKW(P1,4), pw2[3]=PKW(P1,6), pw2); \
    VRD(3); SBAR(); GAPA(C0=__builtin_amdgcn_mfma_f32_32x32x16_bf16(kf[6],qr[3],C0,0,0,0),   P1[10],P1[11],P1[12],P1[13], pw3[0]=PKW(P1,8), pw3[1]=PKW(P1,10), pw3); \
    VRD(7); SBAR(); GAPA(C1=__builtin_amdgcn_mfma_f32_32x32x16_bf16(kf[7],qr[3],C1,0,0,0),   P1[14],P1[15],0.f,0.f,       pw3[2]=PKW(P1,12),pw3[3]=PKW(P1,14), pw3); \
    l_reg+=sacc; \
    if(GK){DMA_K((t)+3,sl_cur);} if(GV){DMA_V((t)+1,sl_next);} \
    CMASK(C0,C1,t); \
    { float a=MX3(C0[0],C0[1],C1[0]),b=MX3(C0[2],C0[3],C1[1]); a=MX3(a,C1[2],C1[3]); \
      _Pragma("unroll") for(int r=4;r<16;r+=4){a=MX3(a,C0[r],C0[r+1]);b=MX3(b,C0[r+2],C0[r+3]);a=MX3(a,C1[r],C1[r+1]);b=MX3(b,C1[r+2],C1[r+3]);} \
      float rm=__builtin_fmaxf(a,b); { auto rr=__builtin_amdgcn_permlane32_swap(__float_as_uint(rm),__float_as_uint(rm),false,false); rm=__builtin_fmaxf(__uint_as_float(rr[0]),__uint_as_float(rr[1])); } \
      resc=false; \
      if(__builtin_expect(__any(rm>(float)THRL),0)){ const float dl=__builtin_fmaxf(rm,0.f); mhat+=dl; \
        _Pragma("unroll") for(int r=0;r<16;++r){C0[r]-=dl;C1[r]-=dl;} \
        const float f=__builtin_amdgcn_exp2f(-dl); l_reg*=f; if(hi==0)wsf[r32]=f; resc=true; } \
      SETNEGM((t)+1); } \
    SBAR(); \
    GAPB(o[0]=__builtin_amdgcn_mfma_f32_32x32x16_bf16(PAF(0),VFR(0),o[0],0,0,0), C0,0); \
    GAPB(o[1]=__builtin_amdgcn_mfma_f32_32x32x16_bf16(PAF(0),VFR(4),o[1],0,0,0), C0,4); \
    KRD(GL,0); GAPB(o[0]=__builtin_amdgcn_mfma_f32_32x32x16_bf16(PAF(1),VFR(1),o[0],0,0,0), C0,8); \
    KRD(GL,1); GAPB(o[1]=__builtin_amdgcn_mfma_f32_32x32x16_bf16(PAF(1),VFR(5),o[1],0,0,0), C0,12); \
    KRD(GL,2); GAPB(o[0]=__builtin_amdgcn_mfma_f32_32x32x16_bf16(PAF(2),VFR(2),o[0],0,0,0), C1,0); \
    KRD(GL,3); GAPB(o[1]=__builtin_amdgcn_mfma_f32_32x32x16_bf16(PAF(2),VFR(6),o[1],0,0,0), C1,4); \
    GAPB(o[0]=__builtin_amdgcn_mfma_f32_32x32x16_bf16(PAF(3),VFR(3),o[0],0,0,0), C1,8); \
    GAPB(o[1]=__builtin_amdgcn_mfma_f32_32x32x16_bf16(PAF(3),VFR(7),o[1],0,0,0), C1,12); \
    }while(0)
  int t=1;
  #undef CMASK
  #define CMASK(P0,P1,t) do{}while(0)
  for(;t+5<NT;t+=2){
    STEP(pB0,pB1,pA0,pA1,t,true,true,true);     WAIT_BAR(2); RESC(); ROT();
    STEP(pA0,pA1,pB0,pB1,t+1,true,true,true);   WAIT_BAR(2); RESC(); ROT();
  }
  #undef CMASK
  #define CMASK(P0,P1,t) do{int jb_=(t)-(NT-4); if(jb_>=0)cmask(P0,P1,jb_,qrel,hi);}while(0)
  #define ENDW(tt) do{ if((tt)+3<NT){WAIT_BAR(2);} else if((tt)+2<NT){WAIT_BAR(1);} else {WAIT_BAR(0);} }while(0)
  for(;t+1<NT;t+=2){
    STEP(pB0,pB1,pA0,pA1,t,(t+3<NT),(t+1<NT),(t+1<NT));       ENDW(t);   RESC(); ROT();
    STEP(pA0,pA1,pB0,pB1,t+1,(t+4<NT),(t+2<NT),(t+2<NT));     ENDW(t+1); RESC(); ROT();
  }
  STEP(pB0,pB1,pA0,pA1,NT-1,false,false,false); RESC();
  { float sacc=pB0[0]+pB0[1]; _Pragma("unroll") for(int r=2;r<16;++r)sacc+=pB0[r]; _Pragma("unroll") for(int r=0;r<16;++r)sacc+=pB1[r]; l_reg+=sacc;
    pw0=(u32x4){PKW(pB0,0),PKW(pB0,2),PKW(pB0,4),PKW(pB0,6)};pw1=(u32x4){PKW(pB0,8),PKW(pB0,10),PKW(pB0,12),PKW(pB0,14)};pw2=(u32x4){PKW(pB1,0),PKW(pB1,2),PKW(pB1,4),PKW(pB1,6)};pw3=(u32x4){PKW(pB1,8),PKW(pB1,10),PKW(pB1,12),PKW(pB1,14)};
    SBAR(); pv(o,vb0+sl_cur,PAF(0),PAF(1),PAF(2),PAF(3)); }
  #undef PKW
  #undef PAF
  #undef VFR
  #undef PIN
  #undef MX3
  #undef GAPA
  #undef GAPB
  #undef EX
  #undef VRD
  #undef KRD
  #undef STEP
  #undef ENDW
  {auto rr=__builtin_amdgcn_permlane32_swap(__float_as_uint(l_reg),__float_as_uint(l_reg),false,false);l_reg=__uint_as_float(rr[0])+__uint_as_float(rr[1]);}
  if(hi==0)wsf[32+r32]=l_reg;asm volatile("s_waitcnt lgkmcnt(0)":::"memory");
  float rli[16];
  #pragma unroll
  for(int r=0;r<16;++r)rli[r]=__builtin_amdgcn_rcpf(wsf[32+crow(r,hi)]);
  int lno=lane; asm volatile("":"+v"(lno));
  bf16*Ow=O+(long)(q0+wid*QBLK)*DMO;
  { bf16*stg=(bf16*)(shm+LDS_OST)+wid*2048;
    #pragma unroll
    for(int r=0;r<16;++r){const int orow=crow(r,hi);
      #pragma unroll
      for(int d0=0;d0<2;++d0)stg[orow*64+d0*32+r32]=(bf16)(cvtpk_s(o[d0][r]*rli[r],0.f)&0xffffu);}
    asm volatile("s_waitcnt lgkmcnt(0)":::"memory");
    #pragma unroll
    for(int i=0;i<4;++i){const int row=i*8+(lno>>3),ch=lno&7; const u32x4 v=*(const u32x4*)(stg+row*64+ch*8); ATTN_STORE16(Ow+(long)row*DMO+ch*8,v);} }
  asm volatile("s_waitcnt lgkmcnt(0)\n\ts_barrier":::"memory");
  #undef DMA_K
  #undef DMA_V
  #undef CMASK
  #undef START
  #undef RESC
  #undef ROT
}
constexpr int ATTN_LDS_BYTES=LDS_BYTES;
#undef SBAR
#undef WAIT_BAR
#undef SETNEGM
}
namespace attl {
using bf16=bf16_t;
using bf16x8=__attribute__((ext_vector_type(8)))short;
using s16x4=__attribute__((ext_vector_type(4)))short;
using f32x16=__attribute__((ext_vector_type(16)))float;
using u32x4=__attribute__((ext_vector_type(4)))unsigned;
using f32x4=__attribute__((ext_vector_type(4)))float;
constexpr int DMK=768,DMV=512,DMO=1024;
constexpr int NW=8,QBLK=32,QB=QBLK*NW,KVBLK=64;
__device__ __forceinline__ int crow(int r,int hi){return (r&3)+8*(r>>2)+4*hi;}
#define SBAR() __builtin_amdgcn_sched_barrier(0)
__device__ __forceinline__ void cmask(f32x16&p0,f32x16&p1,int jb,int qrel,int hi){
  const float NEG=-INFINITY; int kb=64*jb+4*hi;
  #pragma unroll
  for(int r=0;r<16;++r){int kv=kb+(r&3)+8*(r>>2); if(kv>qrel)p0[r]=NEG; if(kv+32>qrel)p1[r]=NEG;}
}

constexpr int NSLOT=3, SLOTK=12288, SLOTV=8192;
constexpr int LDS_K=0, LDS_V=NSLOT*SLOTK, LDS_WS=LDS_V+NSLOT*SLOTV, LDS_OST=LDS_WS+NW*64*4, LDS_BYTES=LDS_OST+NW*4096;
constexpr float C2=0.125f*1.4426950408889634f;
__device__ __forceinline__ void glds16(const void*gsrc,unsigned lds_dst){unsigned keep;
  asm volatile("s_mov_b32 %0, m0\n\ts_mov_b32 m0, %2\n\ts_nop 0\n\tglobal_load_lds_dwordx4 %1, off\n\ts_mov_b32 m0, %0":"=&s"(keep):"v"(gsrc),"s"(lds_dst):"memory");}
__device__ __forceinline__ float max3f(float a,float b,float c){float r;asm("v_max3_f32 %0, %1, %2, %3":"=v"(r):"v"(a),"v"(b),"v"(c));return r;}
__device__ __forceinline__ float max2f(float a,float b){float r;asm("v_max_f32_e32 %0, %1, %2":"=v"(r):"v"(a),"v"(b));return r;}
__device__ __forceinline__ float fadd_s(float a,float b){float r;asm("v_add_f32_e32 %0, %1, %2":"=v"(r):"v"(a),"v"(b));return r;}
__device__ __forceinline__ float fsub_s(float a,float b){float r;asm("v_sub_f32_e32 %0, %1, %2":"=v"(r):"v"(a),"v"(b));return r;}
typedef float f32x2_t __attribute__((ext_vector_type(2))); typedef __bf16 bf16x2_t __attribute__((ext_vector_type(2)));
__device__ __forceinline__ unsigned cvtpk_s(float lo,float hi){f32x2_t v={lo,hi};bf16x2_t b=__builtin_convertvector(v,bf16x2_t);return __builtin_bit_cast(unsigned,b);}
__device__ __forceinline__ void glds16s(const void*sbase,unsigned voff,unsigned lds_dst){unsigned keep;
  asm volatile("s_mov_b32 %0, m0\n\ts_mov_b32 m0, %3\n\ts_nop 0\n\tglobal_load_lds_dwordx4 %1, %2\n\ts_mov_b32 m0, %0":"=&s"(keep):"v"(voff),"s"(sbase),"s"(lds_dst):"memory");}
__device__ __forceinline__ const bf16_t* uptr(const bf16_t*p){ const unsigned long long v=(unsigned long long)p; const unsigned lo=__builtin_amdgcn_readfirstlane((unsigned)v),hi=__builtin_amdgcn_readfirstlane((unsigned)(v>>32)); return (const bf16_t*)(((unsigned long long)hi<<32)|lo); }
#define WAIT_BAR(N) asm volatile("s_waitcnt vmcnt(" #N ") lgkmcnt(0)\n\ts_barrier":::"memory")

__device__ __forceinline__ void qkt(f32x16&p0,f32x16&p1,const char*Kslot,const bf16x8*qr,const f32x16&negm,int r32,int hi){
  const char*kb=Kslot+hi*1024+r32*16;
  #pragma unroll
  for(int d0=0;d0<6;++d0){
    const bf16x8 b0=*reinterpret_cast<const bf16x8*>(kb+d0*2048);
    const bf16x8 b1=*reinterpret_cast<const bf16x8*>(kb+d0*2048+512);
    if(d0==0){p0=__builtin_amdgcn_mfma_f32_32x32x16_bf16(b0,qr[0],negm,0,0,0);p1=__builtin_amdgcn_mfma_f32_32x32x16_bf16(b1,qr[0],negm,0,0,0);}
    else{p0=__builtin_amdgcn_mfma_f32_32x32x16_bf16(b0,qr[d0],p0,0,0,0);p1=__builtin_amdgcn_mfma_f32_32x32x16_bf16(b1,qr[d0],p1,0,0,0);}}
}
typedef __attribute__((address_space(3))) const char* lds_cptr;
typedef short v4i16_t __attribute__((ext_vector_type(4)));
__device__ __forceinline__ void kload8(bf16x8*kf,lds_cptr kp){
  kf[0]=*(const __attribute__((address_space(3))) bf16x8*)(kp);      kf[1]=*(const __attribute__((address_space(3))) bf16x8*)(kp+512);
  kf[2]=*(const __attribute__((address_space(3))) bf16x8*)(kp+2048); kf[3]=*(const __attribute__((address_space(3))) bf16x8*)(kp+2560);
  kf[4]=*(const __attribute__((address_space(3))) bf16x8*)(kp+4096); kf[5]=*(const __attribute__((address_space(3))) bf16x8*)(kp+4608);
  kf[6]=*(const __attribute__((address_space(3))) bf16x8*)(kp+6144); kf[7]=*(const __attribute__((address_space(3))) bf16x8*)(kp+6656);
  kf[8]=*(const __attribute__((address_space(3))) bf16x8*)(kp+8192); kf[9]=*(const __attribute__((address_space(3))) bf16x8*)(kp+8704);
  kf[10]=*(const __attribute__((address_space(3))) bf16x8*)(kp+10240); kf[11]=*(const __attribute__((address_space(3))) bf16x8*)(kp+10752);
}
__device__ __forceinline__ void kload2(bf16x8*kf,lds_cptr kp,int j){ kf[2*j]=*(const __attribute__((address_space(3))) bf16x8*)(kp+j*2048); kf[2*j+1]=*(const __attribute__((address_space(3))) bf16x8*)(kp+j*2048+512); }
__device__ __forceinline__ s16x4 vtr(lds_cptr p){ return __builtin_bit_cast(s16x4,__builtin_amdgcn_ds_read_tr16_b64_v4i16((__attribute__((address_space(3))) v4i16_t*)p)); }
__device__ __forceinline__ float rowmax(const f32x16&p0,const f32x16&p1){
  float a=max3f(p0[0],p0[1],p1[0]),b=max3f(p0[2],p0[3],p1[1]);a=max3f(a,p1[2],p1[3]);
  #pragma unroll
  for(int r=4;r<16;r+=4){a=max3f(a,p0[r],p0[r+1]);b=max3f(b,p0[r+2],p0[r+3]);a=max3f(a,p1[r],p1[r+1]);b=max3f(b,p1[r+2],p1[r+3]);}
  const float m=max2f(a,b);
  auto rr=__builtin_amdgcn_permlane32_swap(__float_as_uint(m),__float_as_uint(m),false,false);
  return max2f(__uint_as_float(rr[0]),__uint_as_float(rr[1]));
}
__device__ __forceinline__ void pv(f32x16*o,int vb,bf16x8 pa0,bf16x8 pa1,bf16x8 pa2,bf16x8 pa3){
  #pragma unroll
  for(int d0=0;d0<2;++d0){s16x4 lo[4],hi[4];
    #pragma unroll
    for(int ks=0;ks<4;++ks){
      asm volatile("ds_read_b64_tr_b16 %0,%1 offset:%c2":"=&v"(lo[ks]):"v"(vb),"i"(d0*4096+ks*1024):"memory");
      asm volatile("ds_read_b64_tr_b16 %0,%1 offset:%c2":"=&v"(hi[ks]):"v"(vb),"i"(d0*4096+ks*1024+512):"memory");}
    asm volatile("s_waitcnt lgkmcnt(0)":::"memory");SBAR();
    #define PK(k) (bf16x8){lo[k][0],lo[k][1],lo[k][2],lo[k][3],hi[k][0],hi[k][1],hi[k][2],hi[k][3]}
    o[d0]=__builtin_amdgcn_mfma_f32_32x32x16_bf16(pa0,PK(0),o[d0],0,0,0);
    o[d0]=__builtin_amdgcn_mfma_f32_32x32x16_bf16(pa1,PK(1),o[d0],0,0,0);
    o[d0]=__builtin_amdgcn_mfma_f32_32x32x16_bf16(pa2,PK(2),o[d0],0,0,0);
    o[d0]=__builtin_amdgcn_mfma_f32_32x32x16_bf16(pa3,PK(3),o[d0],0,0,0);
    #undef PK
  }
}

#ifndef ATTN_STORE16
#define ATTN_STORE16(p,v) (*(u32x4*)(p)=(v))
#endif
template<int THRL> __device__ __forceinline__ void attn_unit(int qb,const bf16*Q,const bf16*__restrict__ K,const bf16*__restrict__ V,bf16*O,const Ctx&B,char*shm){
  const int tid=threadIdx.x; int lane=tid&63; asm volatile("":"+v"(lane));
  const int r32=lane&31,hi=lane>>5; const int wid=__builtin_amdgcn_readfirstlane(tid>>6);
  const int q0=qb*QB;
  const bf16*Qw=Q+(long)(q0+wid*QBLK)*DMK;
  const bf16*Kh=K,*Vh=V;
  const unsigned lds0=(unsigned)(uintptr_t)shm;
  float*wsf=(float*)(shm+LDS_WS)+wid*64;
  const unsigned koff=(unsigned)(lane*DMK+wid*8)*2u, koff2=(unsigned)(lane*DMK+(8+(wid&3))*8)*2u;
  const unsigned voffv=(unsigned)((16*(wid&3)+(lane>>2))*DMV+(wid>>2)*32+(lane&3)*8)*2u;
  const unsigned kdst=lds0+LDS_K+wid*1024, kdst2=lds0+LDS_K+(8+(wid&3))*1024, vdst=lds0+LDS_V+wid*1024;
  #define DMA_K(t,slot) do{ const bf16*kb_=uptr(Kh+(long)(t)*KVBLK*DMK); glds16s(kb_,koff,(unsigned)__builtin_amdgcn_readfirstlane(kdst+(slot)*SLOTK)); glds16s(kb_,koff2,(unsigned)__builtin_amdgcn_readfirstlane(kdst2+(slot)*SLOTK)); }while(0)
  #define DMA_V(t,slot) glds16s(uptr(Vh+(long)(t)*KVBLK*DMV),voffv,(unsigned)__builtin_amdgcn_readfirstlane(vdst+(slot)*SLOTV))
  const int vb0=(int)(lds0+LDS_V)+((lane>>4)&1)*32+(lane&3)*8+(4*hi+((lane&15)>>2))*64;
  const char*Kbase=shm+LDS_K; bf16x8 kf[12];
  const lds_cptr shm3=(lds_cptr)shm; const lds_cptr kp0=shm3+LDS_K+hi*1024+r32*16; const lds_cptr vp0=shm3+LDS_V+((lane>>4)&1)*32+(lane&3)*8+(4*hi+((lane&15)>>2))*64;
  const int NT=(q0+QB)/KVBLK;
  DMA_K(0,0);DMA_V(0,0);DMA_K(1,1);
  bf16x8 qr[6];
  { u32x4 raw[6]; float ss=0.f; const bf16*Ql=Qw+(long)r32*DMK+hi*8;
    #pragma unroll
    for(int d0=0;d0<6;++d0){ raw[d0]=__builtin_nontemporal_load(reinterpret_cast<const u32x4*>(Ql+d0*16));
      #pragma unroll
      for(int w=0;w<4;++w){ const float a=__uint_as_float(raw[d0][w]<<16),bb=__uint_as_float(raw[d0][w]&0xffff0000u); ss+=a*a+bb*bb; } }
    { auto rr=__builtin_amdgcn_permlane32_swap(__float_as_uint(ss),__float_as_uint(ss),false,false); ss=__uint_as_float(rr[0])+__uint_as_float(rr[1]); }
    const float rq=(1.0f/sqrtf(ss*(1.0f/96)+EPS))*C2B; const float*g=B.glq()+hi*8;
    float qf[6][8];
    #pragma unroll
    for(int d0=0;d0<6;++d0){ const f32x4 ga=*(const f32x4*)(g+d0*16),gb=*(const f32x4*)(g+d0*16+4);
      #pragma unroll
      for(int w=0;w<4;++w){ qf[d0][2*w]=__uint_as_float(raw[d0][w]<<16)*rq*(w<2?ga[2*w]:gb[2*w-4]); qf[d0][2*w+1]=__uint_as_float(raw[d0][w]&0xffff0000u)*rq*(w<2?ga[2*w+1]:gb[2*w-3]); } }
    { const int pos=q0+wid*QBLK+r32; const f32x4 ca=*(const f32x4*)(B.COSB()+pos*16+hi*8),cb=*(const f32x4*)(B.COSB()+pos*16+hi*8+4),sa=*(const f32x4*)(B.SINB()+pos*16+hi*8),sb=*(const f32x4*)(B.SINB()+pos*16+hi*8+4);
      #pragma unroll
      for(int j=0;j<8;++j){ const float c=j<4?ca[j]:cb[j-4],sn=j<4?sa[j]:sb[j-4],x1=qf[4][j],x2=qf[5][j]; qf[4][j]=x1*c-x2*sn; qf[5][j]=x2*c+x1*sn; } }
    #pragma unroll
    for(int d0=0;d0<6;++d0){ const u32x4 w={cvtpk_s(qf[d0][0],qf[d0][1]),cvtpk_s(qf[d0][2],qf[d0][3]),cvtpk_s(qf[d0][4],qf[d0][5]),cvtpk_s(qf[d0][6],qf[d0][7])}; qr[d0]=__builtin_bit_cast(bf16x8,w); } }
  float mhat=0.f,l_reg=0.f;f32x16 o[2];o[0]=f32x16{};o[1]=f32x16{};
  #define MSUB(tt) (mhat)
  const int qrel=wid*QBLK+r32;
  #define CMASK(P0,P1,t) do{int jb_=(t)-(NT-4); if(jb_>=0)cmask(P0,P1,jb_,qrel,hi);}while(0)
  bool resc=false;
  #define START(P0,P1) do{ const float rm=fsub_s(rowmax(P0,P1),MSUB(0)); resc=false; \
    { const float dl=(rm==-INFINITY)?0.f:rm; mhat=fadd_s(mhat,dl); } \
    msub0=MSUB(0); \
    _Pragma("unroll") for(int r=0;r<16;++r)P0[r]=__builtin_amdgcn_exp2f(fsub_s(P0[r],msub0)); }while(0)
  #define RESC() do{ if(resc){ asm volatile("s_waitcnt lgkmcnt(0)":::"memory"); \
      _Pragma("unroll") for(int d_=0;d_<2;++d_) _Pragma("unroll") for(int r=0;r<16;++r)o[d_][r]*=wsf[crow(r,hi)]; } }while(0)
  f32x16 pA0,pA1,pB0,pB1;
  int sl_prev=0,sl_cur=0,sl_next=1;
  #define ROT() do{sl_prev=sl_cur;sl_cur=sl_next;sl_next=(sl_next==NSLOT-1)?0:sl_next+1;}while(0)
  DMA_K(2,2);
  WAIT_BAR(5);
  const f32x16 zc=f32x16{}; float msub0;
  qkt(pA0,pA1,Kbase,qr,zc,r32,hi);asm volatile("s_nop 15\n\ts_nop 7":"+v"(pA0),"+v"(pA1));CMASK(pA0,pA1,0);
  START(pA0,pA1);
  _Pragma("unroll") for(int r=0;r<16;++r)pA1[r]=__builtin_amdgcn_exp2f(fsub_s(pA1[r],msub0));
  WAIT_BAR(0);
  DMA_K(3,0);DMA_V(1,1);
  ROT();
  kload8(kf,kp0+sl_cur*SLOTK);
  WAIT_BAR(3);
  s16x4 vlo[8],vhi[8]; u32x4 pw0,pw1,pw2,pw3;
  #define PKW(P,B) cvtpk_s(P[B],P[B+1])
  #define PAF(k) __builtin_bit_cast(bf16x8,pw##k)
  #define VFR(i) (bf16x8){vlo[i][0],vlo[i][1],vlo[i][2],vlo[i][3],vhi[i][0],vhi[i][1],vhi[i][2],vhi[i][3]}
  #define PIN(x) asm volatile("":"+v"(x))
  #define MX3(a,b,c) __builtin_fmaxf(__builtin_fmaxf((a),(b)),(c))
  #define GAPA(MF,A0,A1,A2,A3,W0,W1,PW) do{ MF; sacc+=A0; sacc+=A1; sacc+=A2; sacc+=A3; PIN(sacc); W0; W1; PIN(PW); SBAR(); }while(0)
  #define EX(v) __builtin_amdgcn_exp2f((v)-msub)
  #define GAPB(MF,X,B) do{ MF; X[B]=EX(X[B]); X[B+1]=EX(X[B+1]); X[B+2]=EX(X[B+2]); X[B+3]=EX(X[B+3]); PIN(X); SBAR(); }while(0)
  #define VRD(i) do{ vlo[i]=vtr(vp_+(((i)>>2)*4096+((i)&3)*1024)); vhi[i]=vtr(vp_+(((i)>>2)*4096+((i)&3)*1024+512)); }while(0)
  #define KRD(G,j) do{ if(G){ kload2(kf,kp0+sl_next*SLOTK,j); SBAR(); } }while(0)
  #define STEP(C0,C1,P0,P1,t,GK,GV,GL) do{ SBAR(); float msub; \
    const lds_cptr vp_=vp0+sl_prev*SLOTV; \
    C0=__builtin_amdgcn_mfma_f32_32x32x16_bf16(kf[8],qr[4],zc,0,0,0); C1=__builtin_amdgcn_mfma_f32_32x32x16_bf16(kf[9],qr[4],zc,0,0,0); SBAR(); \
    C0=__builtin_amdgcn_mfma_f32_32x32x16_bf16(kf[10],qr[5],C0,0,0,0); C1=__builtin_amdgcn_mfma_f32_32x32x16_bf16(kf[11],qr[5],C1,0,0,0); SBAR(); \
    VRD(0); SBAR(); float sacc=(P0[0]+P0[1]); \
    GAPA(C0=__builtin_amdgcn_mfma_f32_32x32x16_bf16(kf[0],qr[0],C0,0,0,0), P0[2],P0[3],P0[4],P0[5],     pw0[0]=PKW(P0,0), pw0[1]=PKW(P0,2), pw0); \
    VRD(4); SBAR(); GAPA(C1=__builtin_amdgcn_mfma_f32_32x32x16_bf16(kf[1],qr[0],C1,0,0,0), P0[6],P0[7],P0[8],P0[9],     pw0[2]=PKW(P0,4), pw0[3]=PKW(P0,6), pw0); \
    VRD(1); SBAR(); GAPA(C0=__builtin_amdgcn_mfma_f32_32x32x16_bf16(kf[2],qr[1],C0,0,0,0),   P0[10],P0[11],P0[12],P0[13], pw1[0]=PKW(P0,8), pw1[1]=PKW(P0,10), pw1); \
    VRD(5); SBAR(); GAPA(C1=__builtin_amdgcn_mfma_f32_32x32x16_bf16(kf[3],qr[1],C1,0,0,0),   P0[14],P0[15],P1[0],P1[1],   pw1[2]=PKW(P0,12),pw1[3]=PKW(P0,14), pw1); \
    VRD(2); SBAR(); GAPA(C0=__builtin_amdgcn_mfma_f32_32x32x16_bf16(kf[4],qr[2],C0,0,0,0),   P1[2],P1[3],P1[4],P1[5],     pw2[0]=PKW(P1,0), pw2[1]=PKW(P1,2), pw2); \
    VRD(6); SBAR(); GAPA(C1=__builtin_amdgcn_mfma_f32_32x32x16_bf16(kf[5],qr[2],C1,0,0,0),   P1[6],P1[7],P1[8],P1[9],     pw2[2]=PKW(P1,4), pw2[3]=PKW(P1,6), pw2); \
    VRD(3); SBAR(); GAPA(C0=__builtin_amdgcn_mfma_f32_32x32x16_bf16(kf[6],qr[3],C0,0,0,0),   P1[10],P1[11],P1[12],P1[13], pw3[0]=PKW(P1,8), pw3[1]=PKW(P1,10), pw3); \
    VRD(7); SBAR(); GAPA(C1=__builtin_amdgcn_mfma_f32_32x32x16_bf16(kf[7],qr[3],C1,0,0,0),   P1[14],P1[15],0.f,0.f,       pw3[2]=PKW(P1,12),pw3[3]=PKW(P1,14), pw3); \
    l_reg+=sacc; \
    if(GK){DMA_K((t)+3,sl_cur);} if(GV){DMA_V((t)+1,sl_next);} \
    CMASK(C0,C1,t); \
    { float a=MX3(C0[0],C0[1],C1[0]),b=MX3(C0[2],C0[3],C1[1]); a=MX3(a,C1[2],C1[3]); \
      _Pragma("unroll") for(int r=4;r<16;r+=4){a=MX3(a,C0[r],C0[r+1]);b=MX3(b,C0[r+2],C0[r+3]);a=MX3(a,C1[r],C1[r+1]);b=MX3(b,C1[r+2],C1[r+3]);} \
      float rm=__builtin_fmaxf(a,b); { auto rr=__builtin_amdgcn_permlane32_swap(__float_as_uint(rm),__float_as_uint(rm),false,false); rm=__builtin_fmaxf(__uint_as_float(rr[0]),__uint_as_float(rr[1])); } \
      msub=MSUB(t); rm-=msub; \
      resc=false; \
      if(__builtin_expect(__any(rm>(float)THRL),0)){ const float dl=__builtin_fmaxf(rm,0.f); mhat+=dl; msub+=dl; \
        const float f=__builtin_amdgcn_exp2f(-dl); l_reg*=f; if(hi==0)wsf[r32]=f; resc=true; } } \
    SBAR(); \
    GAPB(o[0]=__builtin_amdgcn_mfma_f32_32x32x16_bf16(PAF(0),VFR(0),o[0],0,0,0), C0,0); \
    KRD(GL,0); GAPB(o[1]=__builtin_amdgcn_mfma_f32_32x32x16_bf16(PAF(0),VFR(4),o[1],0,0,0), C0,4); \
    KRD(GL,1); GAPB(o[0]=__builtin_amdgcn_mfma_f32_32x32x16_bf16(PAF(1),VFR(1),o[0],0,0,0), C0,8); \
    KRD(GL,2); GAPB(o[1]=__builtin_amdgcn_mfma_f32_32x32x16_bf16(PAF(1),VFR(5),o[1],0,0,0), C0,12); \
    KRD(GL,3); GAPB(o[0]=__builtin_amdgcn_mfma_f32_32x32x16_bf16(PAF(2),VFR(2),o[0],0,0,0), C1,0); \
    KRD(GL,4); GAPB(o[1]=__builtin_amdgcn_mfma_f32_32x32x16_bf16(PAF(2),VFR(6),o[1],0,0,0), C1,4); \
    KRD(GL,5); GAPB(o[0]=__builtin_amdgcn_mfma_f32_32x32x16_bf16(PAF(3),VFR(3),o[0],0,0,0), C1,8); \
    GAPB(o[1]=__builtin_amdgcn_mfma_f32_32x32x16_bf16(PAF(3),VFR(7),o[1],0,0,0), C1,12); \
    }while(0)
  int t=1;
  #undef CMASK
  #define CMASK(P0,P1,t) do{}while(0)
  for(;t+5<NT;t+=2){
    STEP(pB0,pB1,pA0,pA1,t,true,true,true);     WAIT_BAR(3); RESC(); ROT();
    STEP(pA0,pA1,pB0,pB1,t+1,true,true,true);   WAIT_BAR(3); RESC(); ROT();
  }
  #undef CMASK
  #define CMASK(P0,P1,t) do{int jb_=(t)-(NT-4); if(jb_>=0)cmask(P0,P1,jb_,qrel,hi);}while(0)
  #define ENDW(tt) do{ if((tt)+3<NT){WAIT_BAR(3);} else if((tt)+2<NT){WAIT_BAR(1);} else {WAIT_BAR(0);} }while(0)
  for(;t+1<NT;t+=2){
    STEP(pB0,pB1,pA0,pA1,t,(t+3<NT),(t+1<NT),(t+1<NT));       ENDW(t);   RESC(); ROT();
    STEP(pA0,pA1,pB0,pB1,t+1,(t+4<NT),(t+2<NT),(t+2<NT));     ENDW(t+1); RESC(); ROT();
  }
  STEP(pB0,pB1,pA0,pA1,NT-1,false,false,false); RESC();
  { float sacc=pB0[0]+pB0[1]; _Pragma("unroll") for(int r=2;r<16;++r)sacc+=pB0[r]; _Pragma("unroll") for(int r=0;r<16;++r)sacc+=pB1[r]; l_reg+=sacc;
    pw0=(u32x4){PKW(pB0,0),PKW(pB0,2),PKW(pB0,4),PKW(pB0,6)};pw1=(u32x4){PKW(pB0,8),PKW(pB0,10),PKW(pB0,12),PKW(pB0,14)};pw2=(u32x4){PKW(pB1,0),PKW(pB1,2),PKW(pB1,4),PKW(pB1,6)};pw3=(u32x4){PKW(pB1,8),PKW(pB1,10),PKW(pB1,12),PKW(pB1,14)};
    SBAR(); pv(o,vb0+sl_cur*SLOTV,PAF(0),PAF(1),PAF(2),PAF(3)); }
  #undef PKW
  #undef PAF
  #undef VFR
  #undef PIN
  #undef MX3
  #undef GAPA
  #undef GAPB
  #undef EX
  #undef VRD
  #undef KRD
  #undef STEP
  #undef ENDW
  {auto rr=__builtin_amdgcn_permlane32_swap(__float_as_uint(l_reg),__float_as_uint(l_reg),false,false);l_reg=__uint_as_float(rr[0])+__uint_as_float(rr[1]);}
  if(hi==0)wsf[32+r32]=l_reg;asm volatile("s_waitcnt lgkmcnt(0)":::"memory");
  float rli[16];
  #pragma unroll
  for(int r=0;r<16;++r)rli[r]=__builtin_amdgcn_rcpf(wsf[32+crow(r,hi)]);
  int lno=lane; asm volatile("":"+v"(lno));
  bf16*Ow=O+(long)(q0+wid*QBLK)*DMO;
  { bf16*stg=(bf16*)(shm+LDS_OST)+wid*2048;
    #pragma unroll
    for(int r=0;r<16;++r){const int orow=crow(r,hi);
      #pragma unroll
      for(int d0=0;d0<2;++d0)stg[orow*64+d0*32+r32]=(bf16)(cvtpk_s(o[d0][r]*rli[r],0.f)&0xffffu);}
    asm volatile("s_waitcnt lgkmcnt(0)":::"memory");
    #pragma unroll
    for(int i=0;i<4;++i){const int row=i*8+(lno>>3),ch=lno&7; const u32x4 v=*(const u32x4*)(stg+row*64+ch*8); ATTN_STORE16(Ow+(long)row*DMO+ch*8,v);} }
  asm volatile("s_waitcnt lgkmcnt(0)\n\ts_barrier":::"memory");
  #undef DMA_K
  #undef DMA_V
  #undef CMASK
  #undef START
  #undef RESC
  #undef ROT
}
constexpr int ATTN_LDS_BYTES=LDS_BYTES;
#undef SBAR
#undef WAIT_BAR
#undef MSUB
}
constexpr int NWAVES = 8;
constexpr int N_PHASES = 7;
constexpr int CW_TMO = 0, CW_CODE = 1;
constexpr int CW_BAR = 4096;
constexpr int CW_DEP4 = 65536, CW_DEP5 = CW_DEP4 + 128 * 64;
constexpr int CW_GRP = 32768;
constexpr int RING_OFF = 0, RING_BYTES = 131072;
constexpr int LDSCTL_OFF = RING_BYTES, MISC_OFF = LDSCTL_OFF + 320;
constexpr int LDS_BYTES = 147456;
static_assert(attm::ATTN_LDS_BYTES <= RING_BYTES && attl::ATTN_LDS_BYTES <= RING_BYTES && pg8::STAGE_BYTES <= RING_BYTES, "LDS map");

#define GAS __attribute__((address_space(1)))
#define LAS __attribute__((address_space(3)))
typedef unsigned v4u __attribute__((ext_vector_type(4)));
typedef float f32x4 __attribute__((ext_vector_type(4)));
typedef GAS unsigned gu32;
#define RLX_AGENT __ATOMIC_RELAXED, __HIP_MEMORY_SCOPE_AGENT
#define LDS_WAIT() asm volatile("s_waitcnt lgkmcnt(0)" ::: "memory")
#define VM_WAIT() asm volatile("s_waitcnt vmcnt(0)" ::: "memory")
__device__ __forceinline__ unsigned f2bf(float f) { unsigned u = __builtin_bit_cast(unsigned, f); return (u + 0x7fffu + ((u >> 16) & 1u)) >> 16; }
__device__ __forceinline__ unsigned pk2(float lo, float hi) { return f2bf(lo) | (f2bf(hi) << 16); }

#define XB_TMO      128
#define XB_XCNT(j)  (256  + 64 * (j))
#define XB_XSUB(j)  (1280 + 64 * (j))
#define XB_XGEN(j)  (2304 + 64 * (j))
#define XB_TOP      3328
#define XB_TOPGEN   3392
#define XCD_BAR_WORDS 3456
#define XB_SPIN_CAP (1u << 18)
__device__ __forceinline__ unsigned xb_ld(unsigned* p)              { return __hip_atomic_load(p, __ATOMIC_RELAXED, __HIP_MEMORY_SCOPE_AGENT); }
__device__ __forceinline__ unsigned xb_add(unsigned* p, unsigned v) { return __hip_atomic_fetch_add(p, v, __ATOMIC_RELAXED, __HIP_MEMORY_SCOPE_AGENT); }
__device__ __forceinline__ unsigned xb_xcc_id() { return (unsigned)__builtin_amdgcn_s_getreg((3 << 11) | 20) & 0xFu; }
#define XB_SPIN(cond, bar) do { unsigned _sp = 0; while (cond) { __builtin_amdgcn_s_sleep(1); \
    if ((++_sp & 255u) == 0u) { if (xb_ld(&(bar)[XB_TMO])) break; if (_sp > XB_SPIN_CAP) { atomicAdd(&(bar)[XB_TMO], 1u); break; } } } } while (0)
struct XcdBarrier { unsigned* bar; unsigned x; volatile LAS unsigned* st; };
__device__ __forceinline__ XcdBarrier xcd_barrier_post(unsigned* bar, volatile LAS unsigned* st) {
    XcdBarrier b; b.bar = bar; b.x = xb_xcc_id(); b.st = st;
    if (threadIdx.x == 0) (void)xb_add(&bar[XB_XCNT(b.x)], 1u);
    return b;
}
__device__ __forceinline__ void xcd_barrier_complete(unsigned* bar, unsigned x, unsigned& nloc, unsigned& nx) {
    const unsigned G = gridDim.x * gridDim.y * gridDim.z;
    unsigned sum, cnt, mine, sp = 0u;
    for (;;) {
        sum = 0u; cnt = 0u; mine = 0u;
#pragma unroll
        for (unsigned j = 0; j < 16; ++j) { const unsigned c = xb_ld(&bar[XB_XCNT(j)]); sum += c; cnt += (c > 0u) ? 1u : 0u; mine = (j == x) ? c : mine; }
        if (sum == G) break;
        __builtin_amdgcn_s_sleep(1);
        if ((++sp & 255u) == 0u) { if (xb_ld(&bar[XB_TMO])) break; if (sp > XB_SPIN_CAP) { atomicAdd(&bar[XB_TMO], 1u); break; } }
    }
    nloc = mine > 0u ? mine : 1u; nx = cnt > 0u ? cnt : 1u;
}
__device__ __forceinline__ void xcd_barrier(const XcdBarrier& b) {
    asm volatile("s_waitcnt vmcnt(0)" ::: "memory");
    __syncthreads();
    if (threadIdx.x == 0) {
        unsigned* bar = b.bar;
        __builtin_amdgcn_s_waitcnt(0);
        unsigned nloc = b.st[0], nx = b.st[1];
        if (nloc == 0u) { xcd_barrier_complete(bar, b.x, nloc, nx); b.st[0] = nloc; b.st[1] = nx; }
        const unsigned old = xb_add(&bar[XB_XSUB(b.x)], 1u);
        const unsigned gen = old / nloc;
        if (old + 1u == (gen + 1u) * nloc) {
            __builtin_amdgcn_fence(__ATOMIC_RELEASE, "agent");
            asm volatile("s_waitcnt vmcnt(0)" ::: "memory");
            const unsigned og = xb_add(&bar[XB_TOP], 1u);
            const unsigned tg = og / nx;
            if (og + 1u == (tg + 1u) * nx) xb_add(&bar[XB_TOPGEN], 1u);
            else XB_SPIN(xb_ld(&bar[XB_TOPGEN]) == tg, bar);
            __builtin_amdgcn_fence(__ATOMIC_ACQUIRE, "agent");
            xb_add(&bar[XB_XGEN(b.x)], 1u);
            asm volatile("s_waitcnt vmcnt(0)" ::: "memory");
        } else {
            XB_SPIN(xb_ld(&bar[XB_XGEN(b.x)]) == gen, bar);
            __builtin_amdgcn_fence(__ATOMIC_ACQUIRE, "agent");
            asm volatile("s_waitcnt vmcnt(0)" ::: "memory");
        }
    }
    __syncthreads();
}

struct GrpBarrier { unsigned* cnt; unsigned size, gen; };
__device__ __forceinline__ void grp_barrier(GrpBarrier& b, unsigned* tmo) {
    asm volatile("s_waitcnt vmcnt(0)" ::: "memory");
    __syncthreads();
    if (threadIdx.x == 0) {
        __builtin_amdgcn_fence(__ATOMIC_RELEASE, "agent");
        asm volatile("s_waitcnt vmcnt(0)" ::: "memory");
        (void)xb_add(b.cnt, 1u);
        const unsigned target = b.size * (b.gen + 1u); unsigned sp = 0u;
        while (xb_ld(b.cnt) < target) { __builtin_amdgcn_s_sleep(1); if ((++sp & 255u) == 0u) { if (xb_ld(tmo)) break; if (sp > XB_SPIN_CAP) { atomicAdd(tmo, 1u); break; } } }
        __builtin_amdgcn_fence(__ATOMIC_ACQUIRE, "agent");
        asm volatile("s_waitcnt vmcnt(0)" ::: "memory");
    }
    b.gen += 1u;
    __syncthreads();
}

__device__ __forceinline__ void p0_item(const float* W, int ldw, int col0, int ksrc0, const float* gain, bf16_t* WT, int Kdst, int rowdst0, int kdst0, LAS float* scr, int lane) {
    const int c = lane & 7;
    if (W == nullptr) {
#pragma unroll
        for (int j = 0; j < 4; ++j) { const int n = (lane >> 3) + 8 * j; *(GAS v4u*)(WT + (size_t)(rowdst0 + n) * Kdst + kdst0 + 8 * c) = (v4u){0u, 0u, 0u, 0u}; }
        return; }
    const float gvec = gain ? gain[ksrc0 + lane] : 1.0f;
    float wv[32];
#pragma unroll
    for (int i = 0; i < 32; ++i) wv[i] = __builtin_nontemporal_load(W + (size_t)(ksrc0 + 2 * i + (lane >> 5)) * ldw + col0 + (lane & 31));
#pragma unroll
    for (int i = 0; i < 32; ++i) { const int kk = 2 * i + (lane >> 5); scr[kk * 33 + (lane & 31)] = wv[i] * __shfl(gvec, kk); }
    LDS_WAIT(); asm volatile("" ::: "memory");
#pragma unroll
    for (int j = 0; j < 4; ++j) { const int n = (lane >> 3) + 8 * j; const LAS float* s = scr + (8 * c) * 33 + n;
        v4u o; o.x = pg8::cvt_pk_bf16(s[0 * 33], s[1 * 33]); o.y = pg8::cvt_pk_bf16(s[2 * 33], s[3 * 33]); o.z = pg8::cvt_pk_bf16(s[4 * 33], s[5 * 33]); o.w = pg8::cvt_pk_bf16(s[6 * 33], s[7 * 33]);
        *(GAS v4u*)(WT + (size_t)(rowdst0 + n) * Kdst + kdst0 + 8 * c) = o; }
    LDS_WAIT(); asm volatile("" ::: "memory");
}
__device__ __forceinline__ float wave_sum(float v) {
#pragma unroll
    for (int o = 1; o < 64; o <<= 1) v += __shfl_xor(v, o);
    return v;
}

struct Args { float* out; unsigned char* ws; int ph_lo, ph_hi, li, pad; const float* in[16]; };
__global__ void __launch_bounds__(NWAVES * 64, 2) fwd_mega(Args args) {
    extern __shared__ __attribute__((aligned(16))) unsigned char lds_raw[];
    LAS unsigned char* lds = (LAS unsigned char*)lds_raw;
    volatile LAS unsigned* MISC = (volatile LAS unsigned*)(lds + MISC_OFF);
    const int tid = threadIdx.x, lane = tid & 63, wave = __builtin_amdgcn_readfirstlane(tid >> 6);
    const int G = gridDim.x, bx = blockIdx.x, vcu = (G % 8 == 0) ? (bx % 8) * (G / 8) + bx / 8 : bx;
    unsigned char* ws = args.ws; Ctx B; B.x = nullptr; B.out = args.out; B.ws = ws;
    const float* const* inp = (const float* const*)((const char*)__builtin_amdgcn_kernarg_segment_ptr() + __builtin_offsetof(Args, in));
    gu32* ctl = (gu32*)(ws + WS_CTL);
    for (int u = tid; u < (LDS_BYTES - LDSCTL_OFF) / 4; u += NWAVES * 64) ((LAS unsigned*)(lds + LDSCTL_OFF))[u] = 0u;
    __syncthreads();
    XcdBarrier bar = xcd_barrier_post((unsigned*)(ctl + CW_BAR) + args.li * XCD_BAR_WORDS, MISC + 8);
#ifndef GROUPED_SEAMS
#define GROUPED_SEAMS 1
#endif
    const bool grouped = GROUPED_SEAMS && (G == 256);
    GrpBarrier gbar; gbar.cnt = (unsigned*)(ctl + CW_GRP) + (args.li * 8 + (bx & 7)) * 64; gbar.size = (unsigned)(G / 8); gbar.gen = 0u;
    const int lo = args.ph_lo, hi = args.ph_hi;
#ifndef PHASE_MASK
#define PHASE_MASK 0x7f
#endif
#define IN(k) (((PHASE_MASK >> (k)) & 1) && lo <= (k) && (k) < hi)
#ifndef REP0
#define REP0 1
#endif
#ifndef REP1
#define REP1 1
#endif
#ifndef REP2
#define REP2 1
#endif
#ifndef REP3
#define REP3 1
#endif
#ifndef REP4
#define REP4 1
#endif
#ifndef REP5
#define REP5 1
#endif
#ifndef DUPU1
#define DUPU1 0
#endif
#ifndef DUPU5
#define DUPU5 0
#endif
#ifndef DUPU6
#define DUPU6 0
#endif
#ifndef REPG
#define REPG 1
#endif
#ifndef REPB
#define REPB 1
#endif
#define SEAM(k) do { if (IN(k) && IN((k) + 1)) { for (int rb_ = 0; rb_ < REPB; ++rb_) { if ((k) == 0 || !grouped) xcd_barrier(bar); else grp_barrier(gbar, (unsigned*)(ctl + CW_BAR) + args.li * XCD_BAR_WORDS + XB_TMO); } } } while (0)

    if (IN(0)) { B.x = inp[0]; for (int rep_ = 0; rep_ < REP0; ++rep_) {
        LAS float* scr = (LAS float*)(lds + RING_OFF + wave * 16384);
        const int hw = wave & 3, gw = vcu * 4 + hw, NGW = G * 4;
        constexpr int I_IN = 64 * 16, I_QU = 32 * 4, I_KVU = 32 * 2, I_O = 32 * 16, I_GU = 176 * 16, I_D = 32 * 44, NITEMS = I_IN + I_QU + I_KVU + I_O + I_GU + I_D;
#ifndef REPW
#define REPW 1
#endif
#ifndef REPX
#define REPX 1
#endif
        if (wave >= 4)
        for (int rw_ = 0; rw_ < REPW; ++rw_)
        for (int it = gw; it < NITEMS; it += NGW) {
            int r = it;
            if (r < I_IN) { const int Gp = r >> 4, kb = r & 15, pn = Gp >> 3, bj = (Gp >> 2) & 1, wc = Gp & 3, col0 = pn * 256 + wc * 64 + bj * 32;
                p0_item(col0 < INW ? inp[nv::I_WIN] : nullptr, INW, col0, kb * 64, inp[nv::I_GATT], B.WIN(), DM, Gp * 32, kb * 64, scr, lane); continue; } r -= I_IN;
            if (r < I_QU) { const int Gp = r >> 2, kb = r & 3, pn = Gp >> 3, bj = (Gp >> 2) & 1, wc = Gp & 3, head = 2 * pn + (wc >> 1); const bool z = (wc & 1) && bj; const int col0 = head * 96 + ((wc & 1) ? 64 : bj * 32);
                p0_item(z ? nullptr : inp[nv::I_WQUP], 768, col0, kb * 64, inp[nv::I_GQA], B.WQUP(), 256, Gp * 32, kb * 64, scr, lane); continue; } r -= I_QU;
            if (r < I_KVU) { const int Gp = r >> 1, kb = r & 1, pn = Gp >> 3, bj = (Gp >> 2) & 1, wc = Gp & 3, col0 = pn * 256 + wc * 64 + bj * 32;
                p0_item(inp[nv::I_WKVUP], 1024, col0, kb * 64, inp[nv::I_GKVA], B.WKVUP(), 128, Gp * 32, kb * 64, scr, lane); continue; } r -= I_KVU;
            if (r < I_O) { const int Gp = r >> 4, kb = r & 15, pn = Gp >> 3, bj = (Gp >> 2) & 1, wc = Gp & 3, col0 = pn * 256 + wc * 64 + bj * 32;
                p0_item(inp[nv::I_WO], DM, col0, kb * 64, nullptr, B.WO(), DM, Gp * 32, kb * 64, scr, lane); continue; } r -= I_O;
            if (r < I_GU) { const int Gp = r >> 4, kb = r & 15, pn = Gp >> 3, bj = (Gp >> 2) & 1, wc = Gp & 3, col0 = pn * 128 + wc * 32;
                p0_item(inp[bj ? nv::I_WU : nv::I_WG], DFF, col0, kb * 64, inp[nv::I_GFFN], B.WGU(), DM, Gp * 32, kb * 64, scr, lane); continue; } r -= I_GU;
            { const int Gp = r / 44, kb = r % 44, pn = Gp >> 3, bj = (Gp >> 2) & 1, wc = Gp & 3, col0 = pn * 256 + wc * 64 + bj * 32;
                p0_item(inp[nv::I_WD], DM, col0, kb * 64, nullptr, B.WD(), DFF, Gp * 32, kb * 64, scr, lane); }
        }
        if (wave < 4)
        for (int rx_ = 0; rx_ < REPX; ++rx_)
        for (int m0 = gw; m0 < M; m0 += 4 * NGW) {
            f32x4 v[4][4]; float ssq[4];
#pragma unroll
            for (int q = 0; q < 4; ++q) { const int m = m0 + q * NGW; if (m < M) { const GAS f32x4* xr = (const GAS f32x4*)(B.x + (size_t)m * DM) + 2 * lane;
#pragma unroll
                for (int j = 0; j < 2; ++j) { v[q][2 * j] = __builtin_nontemporal_load(xr + 128 * j); v[q][2 * j + 1] = __builtin_nontemporal_load(xr + 128 * j + 1); } } }
#pragma unroll
            for (int q = 0; q < 4; ++q) { float sq = 0.f;
#pragma unroll
                for (int j = 0; j < 4; ++j) sq += (v[q][j].x * v[q][j].x + v[q][j].y * v[q][j].y) + (v[q][j].z * v[q][j].z + v[q][j].w * v[q][j].w);
                ssq[q] = wave_sum(sq); }
#pragma unroll
            for (int q = 0; q < 4; ++q) { const int m = m0 + q * NGW; if (m < M) { if (lane == 0) B.RX()[m] = 1.0f / sqrtf(ssq[q] * (1.0f / DM) + EPS);
                GAS v4u* o16 = (GAS v4u*)(B.XB() + (size_t)m * DM) + lane;
#pragma unroll
                for (int j = 0; j < 2; ++j) { const pg8::u32x4 w = pg8::pack8(v[q][2 * j], v[q][2 * j + 1]); o16[64 * j] = (v4u){w.x, w.y, w.z, w.w}; } } }
        }
        for (int i = vcu * NWAVES * 64 + tid; i < 2048 * 48; i += G * NWAVES * 64) rope_table_entry(i, B.COSA());
        if (bx == 0 && tid < 320) { const int t = tid; B.gmq()[t] = t < 64 ? inp[nv::I_GMQ][t] : t < 128 ? inp[nv::I_GMK][t - 64] : t < 224 ? inp[nv::I_GLQ][t - 128] : inp[nv::I_GLK][t - 224]; } }
        SEAM(0);
    }
    if (IN(1)) { for (int rep_ = 0; rep_ < REP1; ++rep_) {
        pg8::ProgOne<pg8::EpiInProj, DUPU1> P1; P1.init(B, pg8::GDesc{B.XB(), B.WIN(), DM, DM}, 2048, G, bx); pg8::gemm_stream(lds + RING_OFF, P1); }
        SEAM(1);
    }
    if (IN(2)) { for (int rep_ = 0; rep_ < REP2; ++rep_) {
        for (int it = vcu; it < 256; it += G) { const int tile = it >> 1, c0 = (it & 1) * 256 + lane * 4; const bf16_t* kp = B.KA() + ((size_t)tile * 256 + wave * 32) * MW + c0; float a0 = 0.f, a1 = 0.f, a2 = 0.f, a3 = 0.f;
#pragma unroll 8
            for (int r = 0; r < 32; ++r) { const unsigned long long w = *(const GAS unsigned long long*)(kp + (size_t)r * MW); const unsigned lo = (unsigned)w, hi2 = (unsigned)(w >> 32);
                a0 += __uint_as_float(lo << 16); a1 += __uint_as_float(lo & 0xffff0000u); a2 += __uint_as_float(hi2 << 16); a3 += __uint_as_float(hi2 & 0xffff0000u); }
            LAS f32x4* red = (LAS f32x4*)(lds + RING_OFF); red[wave * 64 + lane] = (f32x4){a0, a1, a2, a3};
            LDS_WAIT(); __syncthreads();
            if (wave < 4) { const f32x4 s0 = red[(2 * wave) * 64 + lane], s1 = red[(2 * wave + 1) * 64 + lane]; *(GAS f32x4*)(B.KMEANP() + ((size_t)tile * 4 + wave) * MW + c0) = s0 + s1; }
            __syncthreads(); }
        pg8::ProgP2 P2; P2.init(B, G, bx); pg8::gemm_stream(lds + RING_OFF, P2); }
        SEAM(2);
    }
    if (IN(3)) { for (int rep_ = 0; rep_ < REP3; ++rep_) {
        { const int rpc = (M + G - 1) / G; for (int i = vcu * rpc + tid; i < (vcu + 1) * rpc && i < M; i += NWAVES * 64) B.H1SS()[i] = 0.f; }
#if ATT_PRIO
        if (wave >= 4) __builtin_amdgcn_s_setprio(1);
#endif
        const int nit = (G == 256) ? 4 : (1024 - vcu + G - 1) / G;
        for (int it = 0; it < nit; ++it) { int bh, ty, s;
            if (G == 256) { const int c = vcu >> 2; s = vcu & 3; bh = (2 * (c >> 3) + (it & 1)) * 8 + (c & 7); ty = (it >> 1) ^ (c & 1); }
            const int b = bh >> 3, h = bh & 7; const size_t rb = (size_t)b * SEQ;
#ifndef REPU0
#define REPU0 1
#endif
            for (int e = 0; e < 2; ++e) { const int n = e ? 7 - s : s;
              for (int ru_ = 0; ru_ < ((n == 0) ? REPU0 : 1); ++ru_) {
                if (ty) attl::attn_unit<8>(n, B.QM() + rb * 768 + h * 96, B.KM() + rb * 768 + h * 96, B.VM() + rb * MW + h * 64, B.AO() + rb * DM + 512 + h * 64, B, (char*)lds_raw + RING_OFF);
                else attm::attn_unit<8>(n, b * 8, h, B.QA() + rb * MW + h * 64, B.KA() + rb * MW + h * 64, B.VA() + rb * MW + h * 64, B.AO() + rb * DM + h * 64, B, (char*)lds_raw + RING_OFF); } } } }
#if ATT_PRIO
        __builtin_amdgcn_s_setprio(0);
#endif
        SEAM(3);
    }
    for (int repg_ = 0; repg_ < REPG; ++repg_) {
    if (repg_ > 0) xcd_barrier(bar);
#ifndef P6_A_AUX
#define P6_A_AUX 0
#endif
#ifndef FFN_STREAM
#define FFN_STREAM 0
#endif
    if (FFN_STREAM && G == 256 && IN(4) && IN(5) && IN(6)) {
        pg8::ProgFFN PF; PF.init(B, G, bx, (unsigned*)(ctl + CW_DEP4), (unsigned*)(ctl + CW_DEP5), (unsigned*)(ctl + CW_BAR) + args.li * XCD_BAR_WORDS + XB_TMO); for (PF.seg = 0; PF.seg < 3; ++PF.seg) pg8::gemm_stream(lds + RING_OFF, PF);
    } else {
    if (IN(4)) { for (int rep_ = 0; rep_ < REP4; ++rep_) {
        pg8::ProgOne<pg8::EpiOProj, 0> P4; P4.init(B, pg8::GDesc{B.AO(), B.WO(), DM, DM}, DM, G, bx); pg8::gemm_stream(lds + RING_OFF, P4); }
        SEAM(4);
    }
    if (IN(5)) { for (int rep_ = 0; rep_ < REP5; ++rep_) {
        pg8::ProgOne<pg8::EpiFfn1, DUPU5> P5; P5.init(B, pg8::GDesc{B.H1B(), B.WGU(), DM, DM}, 2 * DFF, G, bx); pg8::gemm_stream(lds + RING_OFF, P5); }
        SEAM(5);
    }
    if (IN(6)) {
        pg8::ProgOne<pg8::EpiFfn2, DUPU6> P6; P6.init(B, pg8::GDesc{B.ACT(), B.WD(), DFF, DFF}, DM, G, bx); pg8::gemm_stream<decltype(P6), P6_A_AUX>(lds + RING_OFF, P6);
    }
    }
    }
#undef IN
#undef SEAM
}
#ifndef OPT_MASK
#define OPT_MASK 0x7e
#endif
static nv::Bufs make_bufs(void* const* d_in, void* d_out, void* d_ws) {
    nv::Bufs B{}; unsigned char* ws = (unsigned char*)d_ws;
    B.x = (const float*)d_in[0]; for (int i = 0; i < 16; ++i) B.in[i] = (const float*)d_in[i]; B.out = (float*)d_out;
    B.RX = (float*)(ws + WS_RX); B.CQSS = (float*)(ws + WS_CQSS); B.CKVSS = (float*)(ws + WS_CKVSS); B.KPESS = (float*)(ws + WS_KPESS); B.KR = (float*)(ws + WS_KR);
    B.KMEANP = (float*)(ws + WS_KMEANP); B.H1SS = (float*)(ws + WS_H1SS);
    float* tab = (float*)(ws + WS_TAB); B.COSA = tab; B.SINA = tab + 2048 * 32; B.COSB = tab + 2 * 2048 * 32; B.SINB = tab + 2 * 2048 * 32 + 2048 * 16;
    B.QA = (bf16_t*)(ws + WS_QA); B.KA = (bf16_t*)(ws + WS_KA); B.VA = (bf16_t*)(ws + WS_VA); B.CQKV = (bf16_t*)(ws + WS_CQKV); B.QM = (bf16_t*)(ws + WS_QM); B.KM = (bf16_t*)(ws + WS_KM);
    B.VM = (bf16_t*)(ws + WS_VM); B.AO = (bf16_t*)(ws + WS_AO); B.H1B = (bf16_t*)(ws + WS_H1B); B.ACT = (bf16_t*)(ws + WS_ACT);
    return B;
}
static void naive_stage(int p, const nv::Bufs& B, hipStream_t stream) {
    switch (p) {
    case 1: hipLaunchKernelGGL(nv::ngemm<nv::OpInProj>, dim3(31, M / 64), dim3(256), 0, stream, nv::OpInProj{B}); break;
    case 2: hipLaunchKernelGGL(nv::ngemm<nv::OpQUp>, dim3(12, M / 64), dim3(256), 0, stream, nv::OpQUp{B});
            hipLaunchKernelGGL(nv::ngemm<nv::OpKvUp>, dim3(16, M / 64), dim3(256), 0, stream, nv::OpKvUp{B}); break;
    case 3: hipLaunchKernelGGL(nv::n_attn_moba, dim3(M * NH / 256), dim3(256), 0, stream, B);
            hipLaunchKernelGGL(nv::n_attn_mla, dim3(M * NH / 256), dim3(256), 0, stream, B); break;
    case 4: hipLaunchKernelGGL(nv::ngemm<nv::OpOProj>, dim3(16, M / 64), dim3(256), 0, stream, nv::OpOProj{B}); break;
    case 5: hipLaunchKernelGGL(nv::ngemm<nv::OpFfn1>, dim3(44, M / 64), dim3(256), 0, stream, nv::OpFfn1{B}); break;
    case 6: hipLaunchKernelGGL(nv::ngemm<nv::OpFfn2>, dim3(16, M / 64), dim3(256), 0, stream, nv::OpFfn2{B}); break;
    }
}
extern "C" void kernel_launch(void* const* d_in, const int* in_sizes, int n_in, void* d_out, int out_size, void* d_ws, size_t ws_size, hipStream_t stream) {
    static int grid = 0;
    if (grid == 0) {
        if (n_in != 16 || in_sizes[0] != M * DM || out_size != M * DM || ws_size < WS_END) { fprintf(stderr, "kernel_launch: shape mismatch (n_in %d, in0 %d, out %d, ws %zu; need ws >= %zu)\n", n_in, n_in > 0 ? in_sizes[0] : -1, out_size, ws_size, (size_t)WS_END); grid = -1; return; }
        int dev = 0, cus = 0, per_cu = 0;
        if (hipGetDevice(&dev) != hipSuccess || hipDeviceGetAttribute(&cus, hipDeviceAttributeMultiprocessorCount, dev) != hipSuccess) { fprintf(stderr, "kernel_launch: device query failed\n"); grid = -1; return; }
        if (hipFuncSetAttribute((const void*)fwd_mega, hipFuncAttributeMaxDynamicSharedMemorySize, LDS_BYTES) != hipSuccess) { fprintf(stderr, "kernel_launch: hipFuncSetAttribute(%d B LDS) failed\n", LDS_BYTES); grid = -1; return; }
        if (hipOccupancyMaxActiveBlocksPerMultiprocessor(&per_cu, (const void*)fwd_mega, NWAVES * 64, LDS_BYTES) != hipSuccess || per_cu < 1) { fprintf(stderr, "kernel_launch: occupancy query says %d workgroups per CU; nothing launched\n", per_cu); (void)hipGetLastError(); grid = -1; return; }
        grid = cus;
    }
    if (grid < 0) return;
    if (hipMemsetAsync((char*)d_ws + WS_CTL, 0, CTL_ZERO_BYTES, stream) != hipSuccess) { fprintf(stderr, "kernel_launch: hipMemsetAsync failed\n"); return; }
    nv::Bufs B = make_bufs(d_in, d_out, d_ws);
    constexpr unsigned mask = (unsigned)(OPT_MASK) & 0x7eu; constexpr bool any_opt = mask != 0u, any_naive = mask != 0x7eu;
    if (any_naive) { hipLaunchKernelGGL(n_tables, dim3(384), dim3(256), 0, stream, (float*)((unsigned char*)d_ws + WS_TAB)); hipLaunchKernelGGL(nv::n_rowstat, dim3(M / 4), dim3(256), 0, stream, B.x, B.RX); }
#ifdef PROBE_DUP
    { const int cut[2][2] = {{0, PROBE_DUP + 1}, {PROBE_DUP2, 7}};
      for (int l = 0; l < 2; ++l) { Args a{}; for (int i = 0; i < 16; ++i) a.in[i] = (const float*)d_in[i]; a.out = (float*)d_out; a.ws = (unsigned char*)d_ws; a.ph_lo = cut[l][0]; a.ph_hi = cut[l][1]; a.li = l; a.pad = 0;
        hipLaunchKernelGGL(fwd_mega, dim3(grid), dim3(NWAVES * 64), LDS_BYTES, stream, a); }
      return; }
#endif
    int li = 0, p = any_opt ? 0 : 1;
    while (p <= 6) {
        const bool opt = (p == 0) || ((mask >> p) & 1u);
        if (opt) { int q = p; while (q + 1 <= 6 && ((mask >> (q + 1)) & 1u)) ++q;
            Args a{}; for (int i = 0; i < 16; ++i) a.in[i] = (const float*)d_in[i]; a.out = (float*)d_out; a.ws = (unsigned char*)d_ws; a.ph_lo = p; a.ph_hi = q + 1; a.li = li++; a.pad = 0;
            hipLaunchKernelGGL(fwd_mega, dim3(grid), dim3(NWAVES * 64), LDS_BYTES, stream, a);
            const hipError_t le = hipPeekAtLastError(); if (le != hipSuccess) { fprintf(stderr, "kernel_launch: launch failed: %s\n", hipGetErrorName(le)); return; }
            p = q + 1; }
        else { naive_stage(p, B, stream); ++p; }
    }
}
```

```cpp
#define OPT_MASK 0x7e
#define QUP_PIPE 1
#define ATT_PRIO 1
#define WT_STORE16_ASM(p, v) asm volatile("global_store_dwordx4 %0, %1, off sc1\n\ts_nop 1" :: "v"(p), "v"(v) : "memory")
#define P1_STORE_MODE 1
#define P2_STORE_MODE 1
#define P4_WT 1
#define P0_WT 1
#define KSUM_EPI 1
#define ATTN_STORE16(p, v) WT_STORE16_ASM(p, v)
#define FFN1_FMA 1
#define MLA_NOMAX 1
#define MOBA_NOMAX 1
#define NEGM_PERIODIC 1
#define CMASK_SKIP 1
#define SMALL_WT 1
#define P1_SMALL_WT 0
#define WBL2_SEAMS 0x2
#define GRP_FLAGS 1
#define GRP_NO_WBL2 1
#define H1B_SEPARATE 1
#define QUP_FUSED 1
#ifndef OUT_SCRATCH
#define OUT_SCRATCH 1
#endif
#ifndef ACQ_MIN_SEAM
#define ACQ_MIN_SEAM (OUT_SCRATCH ? 6 : 5)
#endif
#define SEAM0_FLAGS 1
#ifndef ACT_STORE_MODE
#define ACT_STORE_MODE 1
#endif
#ifndef OUT_STORE_NT
#define OUT_STORE_NT 1
#endif
#include <hip/hip_runtime.h>
#include <cstdio>
#include <cstdint>

typedef unsigned short bf16_t;
constexpr int BATCH = 16, SEQ = 2048, DM = 1024, M = BATCH * SEQ;
constexpr int NH = 8, HD = 64, MW = 512;
constexpr int QR = 256, KVR = 128, ROPE = 32, NOPE = 64, QKD = 96;
constexpr int INW = 1952, DFF = 2816;
constexpr float EPS = 1e-6f, LOG2E = 1.4426950408889634f;
constexpr float C2A = 0.125f * LOG2E;
constexpr float C2B = 0.10206207261596577f * LOG2E;

constexpr size_t MiB = 1u << 20;
constexpr size_t WS_CTL = 0, CTL_ZERO_BYTES = 1 * MiB;
constexpr size_t WS_TAB = 1 * MiB;
constexpr size_t WS_WIN = 2 * MiB;
constexpr size_t WS_WQUP = 6 * MiB;
constexpr size_t WS_WKVUP = 6 * MiB + 512 * 1024;
constexpr size_t WS_WO = 7 * MiB;
constexpr size_t WS_WGU = 9 * MiB;
constexpr size_t WS_WD = 20 * MiB;
constexpr size_t WS_RX = 26 * MiB;
constexpr size_t WS_KPESS = WS_RX + 128 * 1024;
constexpr size_t WS_CKVSS = WS_KPESS + 128 * 1024;
constexpr size_t WS_CQSS = WS_CKVSS + 256 * 1024;
constexpr size_t WS_KMEANP = WS_CQSS + 512 * 1024;
constexpr size_t WS_H1SS = WS_CTL + 512 * 1024;
constexpr size_t WS_KR = WS_KMEANP + 1024 * 1024;
constexpr size_t WS_H1SSP = 32 * MiB;
constexpr size_t WS_XB = 34 * MiB;
#ifndef H1B_SEPARATE
#define H1B_SEPARATE 0
#endif
#ifndef OUT_SCRATCH
#define OUT_SCRATCH 0
#endif
#if OUT_SCRATCH
constexpr size_t OS_QA = 0, OS_KA = 32 * MiB, OS_VA = 64 * MiB, OS_CQKV = 96 * MiB;
constexpr size_t WS_QA = 0, WS_KA = 0, WS_VA = 0, WS_CQKV = 0, WS_QM = 0;
constexpr size_t WS_KM = 98 * MiB;
constexpr size_t WS_VM = 146 * MiB;
constexpr size_t WS_AO = 178 * MiB;
constexpr size_t WS_H1B = 242 * MiB;
constexpr size_t WS_ACT = 306 * MiB;
constexpr size_t WS_END = 482 * MiB;
static_assert(WS_ACT + (size_t)M * DFF * 2 <= WS_END && OS_CQKV + (size_t)M * 384 * 2 <= (size_t)M * DM * 4, "d_ws / d_out map");
#else
constexpr size_t WS_H1B = H1B_SEPARATE ? 410 * MiB : WS_XB;
constexpr size_t WS_QA = 98 * MiB, WS_KA = 130 * MiB, WS_VA = 162 * MiB;
constexpr size_t WS_CQKV = 194 * MiB;
constexpr size_t WS_QM = 218 * MiB, WS_KM = 266 * MiB;
constexpr size_t WS_VM = 314 * MiB;
constexpr size_t WS_AO = 346 * MiB;
constexpr size_t WS_ACT = 98 * MiB;
constexpr size_t WS_END = (H1B_SEPARATE ? 474 : 410) * MiB;
#endif
static_assert(WS_KR + (size_t)M * 32 * 4 <= WS_XB && (OUT_SCRATCH || WS_ACT + (size_t)M * DFF * 2 <= WS_AO) && WS_WD + (size_t)DM * DFF * 2 <= WS_RX, "d_ws map");

__device__ __forceinline__ void sincos_d(double a, double& s, double& c) {
    const double kd = __builtin_rint(a * 0.63661977236758134308);
    double r = __builtin_fma(-kd, 1.57079632679489655800e+00, a); r = __builtin_fma(-kd, 6.12323399573676603587e-17, r);
    const int k = (int)kd & 3; const double r2 = r * r;
    const double sp = r * (1.0 + r2 * (-1.0 / 6 + r2 * (1.0 / 120 + r2 * (-1.0 / 5040 + r2 * (1.0 / 362880 + r2 * (-1.0 / 39916800 + r2 * (1.0 / 6227020800.0 + r2 * (-1.0 / 1307674368000.0))))))));
    const double cp = 1.0 + r2 * (-0.5 + r2 * (1.0 / 24 + r2 * (-1.0 / 720 + r2 * (1.0 / 40320 + r2 * (-1.0 / 3628800 + r2 * (1.0 / 479001600 + r2 * (-1.0 / 87178291200.0 + r2 * (1.0 / 20922789888000.0))))))));
    s = (k == 0) ? sp : (k == 1) ? cp : (k == 2) ? -sp : -cp;
    c = (k == 0) ? cp : (k == 1) ? -sp : (k == 2) ? -cp : sp;
}
__device__ __forceinline__ void rope_table_entry(int i, float* tab) {
    const int pos = i / 48, f = i % 48, steps = f < 32 ? f : 2 * (f - 32);
    double inv = 1.0; for (int j = 0; j < steps; ++j) inv *= 0.7498942093324558;
    const float ang = (float)pos * (float)inv;
    double s, c; sincos_d((double)ang, s, c);
    if (f < 32) { __hip_atomic_store(tab + pos * 32 + f, (float)c, __ATOMIC_RELAXED, __HIP_MEMORY_SCOPE_AGENT); __hip_atomic_store(tab + 2048 * 32 + pos * 32 + f, (float)s, __ATOMIC_RELAXED, __HIP_MEMORY_SCOPE_AGENT); }
    else { __hip_atomic_store(tab + 2 * 2048 * 32 + pos * 16 + (f - 32), (float)c, __ATOMIC_RELAXED, __HIP_MEMORY_SCOPE_AGENT); __hip_atomic_store(tab + 2 * 2048 * 32 + 2048 * 16 + pos * 16 + (f - 32), (float)s, __ATOMIC_RELAXED, __HIP_MEMORY_SCOPE_AGENT); }
}
__global__ __launch_bounds__(256) void n_tables(float* tab) { const int i = blockIdx.x * 256 + threadIdx.x; if (i < 2048 * 48) rope_table_entry(i, tab); }
namespace nv {
__device__ __forceinline__ float bf2f(bf16_t v) { return __uint_as_float((unsigned)v << 16); }
__device__ __forceinline__ bf16_t f2bf(float f) { unsigned u = __float_as_uint(f); return (bf16_t)((u + 0x7fffu + ((u >> 16) & 1u)) >> 16); }

__global__ __launch_bounds__(256) void n_rowstat(const float* __restrict__ x, float* __restrict__ RX) {
    const int row = blockIdx.x * 4 + (threadIdx.x >> 6), lane = threadIdx.x & 63;
    const float* xr = x + (size_t)row * DM; float s = 0.f;
    for (int i = lane; i < DM; i += 64) { const float v = xr[i]; s += v * v; }
    for (int o = 1; o < 64; o <<= 1) s += __shfl_xor(s, o);
    if (lane == 0) RX[row] = 1.0f / sqrtf(s * (1.0f / DM) + EPS);
}

template <class OP> __global__ __launch_bounds__(256) void ngemm(OP op) {
    __shared__ float As[16][64], Bs[16][64], B2s[OP::DUAL ? 16 : 1][64], T[64][65], T2[OP::DUAL ? 64 : 1][65];
    const int tid = threadIdx.x, ty = tid >> 4, tx = tid & 15, row0 = blockIdx.y * 64, col0 = blockIdx.x * 64;
    float acc[4][4] = {}, acc2[4][4] = {};
    for (int k0 = 0; k0 < OP::K; k0 += 16) {
#pragma unroll
        for (int l = 0; l < 4; ++l) { const int idx = tid + 256 * l;
            { const int m = idx >> 4, k = idx & 15; As[k][m] = op.a(row0 + m, k0 + k); }
            { const int k = idx >> 6, n = idx & 63; const bool in = (col0 + n) < OP::N; Bs[k][n] = in ? op.b(k0 + k, col0 + n) : 0.f; if (OP::DUAL) B2s[k][n] = in ? op.b2(k0 + k, col0 + n) : 0.f; } }
        __syncthreads();
#pragma unroll
        for (int k = 0; k < 16; ++k) { float a[4], b[4], c[4];
#pragma unroll
            for (int i = 0; i < 4; ++i) { a[i] = As[k][ty * 4 + i]; b[i] = Bs[k][tx * 4 + i]; c[i] = OP::DUAL ? B2s[k][tx * 4 + i] : 0.f; }
#pragma unroll
            for (int i = 0; i < 4; ++i)
#pragma unroll
                for (int j = 0; j < 4; ++j) { acc[i][j] = fmaf(a[i], b[j], acc[i][j]); if (OP::DUAL) acc2[i][j] = fmaf(a[i], c[j], acc2[i][j]); } }
        __syncthreads();
    }
#pragma unroll
    for (int i = 0; i < 4; ++i)
#pragma unroll
        for (int j = 0; j < 4; ++j) { T[ty * 4 + i][tx * 4 + j] = acc[i][j]; if (OP::DUAL) T2[ty * 4 + i][tx * 4 + j] = acc2[i][j]; }
    __syncthreads();
    op.epi(T, T2, row0, col0, tid);
}

struct Bufs {
    const float* x; const float* in[16]; float* out;
    float *RX, *CQSS, *CKVSS, *KPESS, *KR, *KMEANP, *H1SS, *COSA, *SINA, *COSB, *SINB;
    bf16_t *QA, *KA, *VA, *CQKV, *QM, *KM, *VM, *AO, *H1B, *ACT;
};
enum { I_X = 0, I_GATT = 1, I_WIN = 2, I_GMQ = 3, I_GMK = 4, I_GQA = 5, I_WQUP = 6, I_GKVA = 7, I_WKVUP = 8, I_GLQ = 9, I_GLK = 10, I_WO = 11, I_GFFN = 12, I_WG = 13, I_WU = 14, I_WD = 15 };

struct OpInProj { static constexpr int K = DM, N = INW; static constexpr bool DUAL = false; Bufs B;
    __device__ float a(int m, int k) const { return B.x[(size_t)m * DM + k] * B.RX[m] * B.in[I_GATT][k]; }
    __device__ float b(int k, int n) const { return B.in[I_WIN][(size_t)k * INW + n]; }
    __device__ float b2(int, int) const { return 0.f; }
    __device__ void epi(float (*T)[65], float (*)[65], int row0, int col0, int tid) const {
        const int r = tid & 63, row = row0 + r, pos = row & (SEQ - 1);
        if (col0 < 1024) {
            const bool isq = col0 < 512; const float* g = B.in[isq ? I_GMQ : I_GMK];
            if (tid < 64) { float ss = 0.f; for (int d = 0; d < 64; ++d) ss += T[r][d] * T[r][d];
                const float rn = 1.0f / sqrtf(ss * (1.0f / 64) + EPS); float o[64];
#pragma unroll
                for (int d = 0; d < 32; ++d) { const float x1 = T[r][d] * rn * g[d], x2 = T[r][d + 32] * rn * g[d + 32], c = B.COSA[pos * 32 + d], s = B.SINA[pos * 32 + d]; o[d] = x1 * c - x2 * s; o[d + 32] = x2 * c + x1 * s; }
#pragma unroll
                for (int d = 0; d < 64; ++d) { T[r][d] = o[d]; if (isq) B.QA[(size_t)row * MW + col0 + d] = f2bf(o[d] * C2A); else B.KA[(size_t)row * MW + (col0 - 512) + d] = f2bf(o[d]); } }
            __syncthreads();
            if (!isq && tid < 64) { float cs = 0.f; for (int rr = 0; rr < 64; ++rr) cs += T[rr][tid];
                B.KMEANP[((size_t)(row0 >> 8) * 4 + ((row0 & 255) >> 6)) * MW + (col0 - 512) + tid] = cs; }
        } else if (col0 < 1536) { if (tid < 64) for (int d = 0; d < 64; ++d) B.VA[(size_t)row * MW + (col0 - 1024) + d] = f2bf(T[r][d]);
        } else if (col0 < 1792) { if (tid < 64) { float ss = 0.f; for (int d = 0; d < 64; ++d) { ss += T[r][d] * T[r][d]; B.CQKV[(size_t)row * 384 + (col0 - 1536) + d] = f2bf(T[r][d]); } B.CQSS[(size_t)row * 4 + ((col0 - 1536) >> 6)] = ss; }
        } else if (col0 < 1920) { if (tid < 64) { float ss = 0.f; for (int d = 0; d < 64; ++d) { ss += T[r][d] * T[r][d]; B.CQKV[(size_t)row * 384 + 256 + (col0 - 1792) + d] = f2bf(T[r][d]); } B.CKVSS[(size_t)row * 2 + ((col0 - 1792) >> 6)] = ss; }
        } else { if (tid < 64) { float ss = 0.f; for (int d = 0; d < 32; ++d) ss += T[r][d] * T[r][d]; B.KPESS[row] = ss; const float* g = B.in[I_GLK] + 64;
                for (int i = 0; i < 16; ++i) { const float x1 = T[r][i] * g[i], x2 = T[r][i + 16] * g[i + 16], c = B.COSB[pos * 16 + i], s = B.SINB[pos * 16 + i];
                    B.KR[(size_t)row * 32 + i] = x1 * c - x2 * s; B.KR[(size_t)row * 32 + i + 16] = x2 * c + x1 * s; } } }
    }
};
struct OpQUp { static constexpr int K = QR, N = 768; static constexpr bool DUAL = false; Bufs B;
    __device__ float a(int m, int k) const { return bf2f(B.CQKV[(size_t)m * 384 + k]) * B.in[I_GQA][k]; }
    __device__ float b(int k, int n) const { return B.in[I_WQUP][(size_t)k * 768 + n]; }
    __device__ float b2(int, int) const { return 0.f; }
    __device__ void epi(float (*T)[65], float (*)[65], int row0, int col0, int tid) const {
        if (tid < 64) { const int r = tid, row = row0 + r; const float* s4 = B.CQSS + (size_t)row * 4; const float rc = 1.0f / sqrtf((s4[0] + s4[1] + s4[2] + s4[3]) * (1.0f / QR) + EPS);
            for (int d = 0; d < 64; ++d) B.QM[(size_t)row * 768 + col0 + d] = f2bf(T[r][d] * rc); }
    }
};
struct OpKvUp { static constexpr int K = KVR, N = 1024; static constexpr bool DUAL = false; Bufs B;
    __device__ float a(int m, int k) const { return bf2f(B.CQKV[(size_t)m * 384 + 256 + k]) * B.in[I_GKVA][k]; }
    __device__ float b(int k, int n) const { return B.in[I_WKVUP][(size_t)k * 1024 + n]; }
    __device__ float b2(int, int) const { return 0.f; }
    __device__ void epi(float (*T)[65], float (*)[65], int row0, int col0, int tid) const {
        if (tid < 64) { const int r = tid, row = row0 + r, head = col0 >> 7; const float* s2 = B.CKVSS + (size_t)row * 2; const float rc = 1.0f / sqrtf((s2[0] + s2[1]) * (1.0f / KVR) + EPS);
            if ((col0 >> 6) & 1) { for (int d = 0; d < 64; ++d) B.VM[(size_t)row * MW + head * 64 + d] = f2bf(T[r][d] * rc); }
            else { float ss = B.KPESS[row]; for (int d = 0; d < 64; ++d) { const float v = T[r][d] * rc; ss += v * v; }
                const float rk = 1.0f / sqrtf(ss * (1.0f / QKD) + EPS); const float* g = B.in[I_GLK];
                for (int d = 0; d < 64; ++d) B.KM[(size_t)row * 768 + head * 96 + d] = f2bf(T[r][d] * rc * rk * g[d]);
                for (int d = 0; d < 32; ++d) B.KM[(size_t)row * 768 + head * 96 + 64 + d] = f2bf(B.KR[(size_t)row * 32 + d] * rk); } }
    }
};
struct OpOProj { static constexpr int K = DM, N = DM; static constexpr bool DUAL = false; Bufs B;
    __device__ float a(int m, int k) const { return bf2f(B.AO[(size_t)m * DM + k]); }
    __device__ float b(int k, int n) const { return B.in[I_WO][(size_t)k * DM + n]; }
    __device__ float b2(int, int) const { return 0.f; }
    __device__ void epi(float (*T)[65], float (*)[65], int row0, int col0, int tid) const {
        if (tid < 64) { const int r = tid, row = row0 + r; float ss = 0.f;
            for (int d = 0; d < 64; ++d) { const float h = B.x[(size_t)row * DM + col0 + d] + T[r][d]; ss += h * h; B.H1B[(size_t)row * DM + col0 + d] = f2bf(h); }
            atomicAdd(B.H1SS + row, ss); }
    }
};
struct OpFfn1 { static constexpr int K = DM, N = DFF; static constexpr bool DUAL = true; Bufs B;
    __device__ float a(int m, int k) const { return bf2f(B.H1B[(size_t)m * DM + k]) * B.in[I_GFFN][k]; }
    __device__ float b(int k, int n) const { return B.in[I_WG][(size_t)k * DFF + n]; }
    __device__ float b2(int k, int n) const { return B.in[I_WU][(size_t)k * DFF + n]; }
    __device__ void epi(float (*T)[65], float (*T2)[65], int row0, int col0, int tid) const {
        if (tid < 64) { const int r = tid, row = row0 + r; const float t = B.H1SS[row];
            const float rh = 1.0f / sqrtf(t * (1.0f / DM) + EPS);
            for (int d = 0; d < 64; ++d) { const float g = T[r][d] * rh, u = T2[r][d] * rh; B.ACT[(size_t)row * DFF + col0 + d] = f2bf(g / (1.0f + __expf(-g)) * u); } }
    }
};
struct OpFfn2 { static constexpr int K = DFF, N = DM; static constexpr bool DUAL = false; Bufs B;
    __device__ float a(int m, int k) const { return bf2f(B.ACT[(size_t)m * DFF + k]); }
    __device__ float b(int k, int n) const { return B.in[I_WD][(size_t)k * DM + n]; }
    __device__ float b2(int, int) const { return 0.f; }
    __device__ void epi(float (*T)[65], float (*)[65], int row0, int col0, int tid) const {
        if (tid < 64) { const int r = tid, row = row0 + r; for (int d = 0; d < 64; ++d) B.out[(size_t)row * DM + col0 + d] = bf2f(B.H1B[(size_t)row * DM + col0 + d]) + T[r][d]; }
    }
};

__global__ __launch_bounds__(256) void n_attn_moba(Bufs B) {
    const int gid = blockIdx.x * 256 + threadIdx.x, q = gid & (SEQ - 1), h = (gid >> 11) & 7, b = gid >> 14, row = b * SEQ + q, n = q >> 8;
    float qv[64];
#pragma unroll
    for (int d = 0; d < 64; ++d) qv[d] = bf2f(B.QA[(size_t)row * MW + h * 64 + d]);
    unsigned sel = (1u << n) - 1u;
    if (n > 3) { float gate[8];
#pragma unroll
        for (int j = 0; j < 8; ++j) { gate[j] = -INFINITY; if (j < n) { float g = 0.f; const float* kp = B.KMEANP + (size_t)(b * 8 + j) * 4 * MW + h * 64;
#pragma unroll
                for (int d = 0; d < 64; ++d) g += qv[d] * ((kp[d] + kp[MW + d]) + (kp[2 * MW + d] + kp[3 * MW + d])); gate[j] = g; } }
        sel = 0u;
#pragma unroll
        for (int j = 0; j < 8; ++j) { int rank = 0;
#pragma unroll
            for (int i = 0; i < 8; ++i) rank += (gate[i] > gate[j] || (gate[i] == gate[j] && i < j)) ? 1 : 0;
            if (j < n && rank < 3) sel |= 1u << j; } }
    float m = -INFINITY, l = 0.f, o[64];
#pragma unroll
    for (int d = 0; d < 64; ++d) o[d] = 0.f;
    for (int j = 0; j <= n; ++j) {
        const bool mine = (j == n) || ((sel >> j) & 1u);
        for (int kk = 0; kk < 256; ++kk) { const int key = j * 256 + kk; if (!mine || key > q) continue;
            const bf16_t* kr = B.KA + (size_t)(b * SEQ + key) * MW + h * 64; float s = 0.f;
#pragma unroll
            for (int d = 0; d < 64; ++d) s += qv[d] * bf2f(kr[d]);
            const float mn = fmaxf(m, s), al = exp2f(m - mn), p = exp2f(s - mn); m = mn; l = l * al + p;
            const bf16_t* vr = B.VA + (size_t)(b * SEQ + key) * MW + h * 64;
#pragma unroll
            for (int d = 0; d < 64; ++d) o[d] = o[d] * al + p * bf2f(vr[d]); } }
    const float il = 1.0f / l;
#pragma unroll
    for (int d = 0; d < 64; ++d) B.AO[(size_t)row * DM + h * 64 + d] = f2bf(o[d] * il);
}
__global__ __launch_bounds__(256) void n_attn_mla(Bufs B) {
    const int gid = blockIdx.x * 256 + threadIdx.x, q = gid & (SEQ - 1), h = (gid >> 11) & 7, b = gid >> 14, row = b * SEQ + q;
    float qv[96]; float ss = 0.f;
#pragma unroll
    for (int d = 0; d < 96; ++d) { qv[d] = bf2f(B.QM[(size_t)row * 768 + h * 96 + d]); ss += qv[d] * qv[d]; }
    const float rq = 1.0f / sqrtf(ss * (1.0f / QKD) + EPS); const float* g = B.in[I_GLQ];
#pragma unroll
    for (int d = 0; d < 96; ++d) qv[d] = qv[d] * rq * g[d];
#pragma unroll
    for (int i = 0; i < 16; ++i) { const float x1 = qv[64 + i], x2 = qv[80 + i], c = B.COSB[q * 16 + i], s = B.SINB[q * 16 + i]; qv[64 + i] = x1 * c - x2 * s; qv[80 + i] = x2 * c + x1 * s; }
#pragma unroll
    for (int d = 0; d < 96; ++d) qv[d] *= C2B;
    float m = -INFINITY, l = 0.f, o[64];
#pragma unroll
    for (int d = 0; d < 64; ++d) o[d] = 0.f;
    const int qmax = q | 63;
    for (int key = 0; key <= qmax; ++key) { if (key > q) continue;
        const bf16_t* kr = B.KM + (size_t)(b * SEQ + key) * 768 + h * 96; float s = 0.f;
#pragma unroll
        for (int d = 0; d < 96; ++d) s += qv[d] * bf2f(kr[d]);
        const float mn = fmaxf(m, s), al = exp2f(m - mn), p = exp2f(s - mn); m = mn; l = l * al + p;
        const bf16_t* vr = B.VM + (size_t)(b * SEQ + key) * MW + h * 64;
#pragma unroll
        for (int d = 0; d < 64; ++d) o[d] = o[d] * al + p * bf2f(vr[d]); }
    const float il = 1.0f / l;
#pragma unroll
    for (int d = 0; d < 64; ++d) B.AO[(size_t)row * DM + 512 + h * 64 + d] = f2bf(o[d] * il);
}
}
#ifndef H1SS_LDS
#define H1SS_LDS 0
#endif
constexpr int EPI_RED_LDS = 131072 + 2048;
#ifndef PROBE_ATOM2
#define PROBE_ATOM2 0
#endif
#ifndef EPI_LOAD_ALL
#define EPI_LOAD_ALL 0
#endif
constexpr size_t WS_GAIN = WS_TAB + 768 * 1024;
struct Ctx { const float* x; float* out; unsigned char* ws;
#define CTX_F(NAME, OFF) __device__ __forceinline__ float* NAME() const { return (float*)(ws + (OFF)); }
#define CTX_H(NAME, OFF) __device__ __forceinline__ bf16_t* NAME() const { return (bf16_t*)(ws + (OFF)); }
    CTX_F(RX, WS_RX) CTX_F(CQSS, WS_CQSS) CTX_F(CKVSS, WS_CKVSS) CTX_F(KPESS, WS_KPESS) CTX_F(KR, WS_KR) CTX_F(KMEANP, WS_KMEANP) CTX_F(H1SS, WS_H1SS) CTX_F(H1SSP, WS_H1SSP)
    CTX_F(COSA, WS_TAB) CTX_F(SINA, WS_TAB + 2048 * 32 * 4) CTX_F(COSB, WS_TAB + 2 * 2048 * 32 * 4) CTX_F(SINB, WS_TAB + 2 * 2048 * 32 * 4 + 2048 * 16 * 4)
    CTX_F(gmq, WS_GAIN) CTX_F(gmk, WS_GAIN + 256) CTX_F(glq, WS_GAIN + 512) CTX_F(glk, WS_GAIN + 896)
#if OUT_SCRATCH
#define CTX_O(NAME, OFF) __device__ __forceinline__ bf16_t* NAME() const { return (bf16_t*)((unsigned char*)out + (OFF)); }
    CTX_O(QA, OS_QA) CTX_O(KA, OS_KA) CTX_O(VA, OS_VA) CTX_O(CQKV, OS_CQKV)
#undef CTX_O
    CTX_H(QM, WS_QM) CTX_H(KM, WS_KM)
#else
    CTX_H(QA, WS_QA) CTX_H(KA, WS_KA) CTX_H(VA, WS_VA) CTX_H(CQKV, WS_CQKV) CTX_H(QM, WS_QM) CTX_H(KM, WS_KM)
#endif
    CTX_H(VM, WS_VM) CTX_H(AO, WS_AO) CTX_H(H1B, WS_H1B) CTX_H(ACT, WS_ACT)
    CTX_H(XB, WS_XB) CTX_H(WIN, WS_WIN) CTX_H(WQUP, WS_WQUP) CTX_H(WKVUP, WS_WKVUP) CTX_H(WO, WS_WO) CTX_H(WGU, WS_WGU) CTX_H(WD, WS_WD)
#undef CTX_F
#undef CTX_H
};
#ifndef WGM_SET
#define WGM_SET 8
#endif
namespace pg8 {
#define PG8_LAS __attribute__((address_space(3)))
typedef short bf16x8 __attribute__((ext_vector_type(8)));
typedef float f32x4 __attribute__((ext_vector_type(4)));
typedef float f32x2 __attribute__((ext_vector_type(2)));
typedef unsigned u32x4 __attribute__((ext_vector_type(4)));
constexpr int BM = 256, BK = 64, HALF = 128, HTB = HALF * BK * 2  , STAGE_BYTES = 8 * HTB, NXCD = 8, WGM = WGM_SET;

__host__ __device__ __forceinline__ int lds_byte(int r, int c) { const int st = (r >> 4) * 2 + (c >> 5), rr = r & 15, cc = c & 31, ob = rr * 64 + cc * 2; return st * 1024 + (ob ^ (((ob >> 9) & 1) << 5)); }
__host__ __device__ __forceinline__ void stage_rc(int b, int& R, int& C) { const int st = b / 1024, sb = b % 1024, swz = sb ^ (((sb >> 9) & 1) << 5); R = (st >> 1) * 16 + swz / 64; C = (st & 1) * 32 + (swz % 64) / 2; }
__host__ __device__ __forceinline__ int perm32(int rho) { const int n = rho >> 4, i = rho & 15; return 8 * (i >> 2) + 4 * n + (i & 3); }

struct Unit { int pm, pn; };
struct Gemm { const bf16_t* A; const bf16_t* Bt; int M, N, K, lda; };

struct StaticOrder {
    int nM, nN, nwg, G, c;
    __host__ __device__ void init(int M_, int N_, int G_, int c_) { nM = M_ / BM; nN = N_ / BM; nwg = nM * nN; G = G_; c = c_; }
    __host__ __device__ bool next(int i, Unit& u) const {
        const long L = (long)i * G + c; if (L >= nwg) return false;
        int wgid = (int)L; { const int q = nwg / NXCD, r = nwg % NXCD, xcd = wgid % NXCD, off = wgid / NXCD; wgid = (xcd < r ? xcd * (q + 1) : r * (q + 1) + (xcd - r) * q) + off; }
        const int nig = WGM * nN, gid = wgid / nig, fm = gid * WGM, gsz = (nM - fm) < WGM ? (nM - fm) : WGM;
        u.pm = fm + ((wgid % nig) % gsz); u.pn = (wgid % nig) / gsz; return true;
    }
    __device__ __forceinline__ void a_ready(const Unit&) const {}
    __device__ __forceinline__ void done(const Unit&) const {}
};

typedef float f32x2_c __attribute__((ext_vector_type(2))); typedef __bf16 bf16x2_c __attribute__((ext_vector_type(2)));
__device__ __forceinline__ unsigned cvt_pk_bf16(float lo, float hi) { f32x2_c v = {lo, hi}; bf16x2_c b = __builtin_convertvector(v, bf16x2_c); return __builtin_bit_cast(unsigned, b); }
__device__ __forceinline__ u32x4 pack8(const f32x4 a, const f32x4 b) { u32x4 w; w.x = cvt_pk_bf16(a[0], a[1]); w.y = cvt_pk_bf16(a[2], a[3]); w.z = cvt_pk_bf16(b[0], b[1]); w.w = cvt_pk_bf16(b[2], b[3]); return w; }
__device__ __forceinline__ float hsum4(const f32x4 a) { return (a[0] + a[1]) + (a[2] + a[3]); }
__device__ __forceinline__ float dot4(const f32x4 a) { return (a[0] * a[0] + a[1] * a[1]) + (a[2] * a[2] + a[3] * a[3]); }
__device__ __forceinline__ float fq_sum(float s) { s += __shfl_xor(s, 16); s += __shfl_xor(s, 32); return s; }
__device__ __forceinline__ float rsq(float v) { return __builtin_amdgcn_rsqf(v); }
#define EPI_FENCE() asm volatile("" ::: "memory")
template <int MODE> __device__ __forceinline__ void st16(void* p, const u32x4 v) {
    if constexpr (MODE == 1) asm volatile("global_store_dwordx4 %0, %1, off sc1\n\ts_nop 1" :: "v"(p), "v"(v) : "memory");
    else if constexpr (MODE == 2) __builtin_nontemporal_store(v, (u32x4*)p);
    else *(u32x4*)p = v; }
#define OPAQUE(x) asm volatile("" : "+v"(x))
#ifndef SMALL_WT
#define SMALL_WT 0
#endif
__device__ __forceinline__ void stf(float* p, float v) { if (SMALL_WT) __hip_atomic_store(p, v, __ATOMIC_RELAXED, __HIP_MEMORY_SCOPE_AGENT); else *p = v; }
__device__ __forceinline__ void stf4(float* p, const f32x4 v) { if (SMALL_WT) asm volatile("global_store_dwordx4 %0, %1, off sc1\n\ts_nop 1" :: "v"(p), "v"(v) : "memory"); else *(f32x4*)p = v; }
#ifndef P1_SMALL_WT
#define P1_SMALL_WT SMALL_WT
#endif
__device__ __forceinline__ void stf1(float* p, float v) { if (P1_SMALL_WT) __hip_atomic_store(p, v, __ATOMIC_RELAXED, __HIP_MEMORY_SCOPE_AGENT); else *p = v; }
__device__ __forceinline__ void stf41(float* p, const f32x4 v) { if (P1_SMALL_WT) asm volatile("global_store_dwordx4 %0, %1, off sc1\n\ts_nop 1" :: "v"(p), "v"(v) : "memory"); else *(f32x4*)p = v; }

__device__ __forceinline__ int lane_now() { int l; asm volatile("v_mbcnt_lo_u32_b32 %0, -1, 0\n\tv_mbcnt_hi_u32_b32 %0, -1, %0" : "=v"(l)); return l; }


#ifndef P1_STORE_MODE
#define P1_STORE_MODE 0
#endif
#ifndef KSUM_EPI
#define KSUM_EPI 0
#endif
struct EpiInProj { static constexpr bool PERM = true, AFTER_DRAIN = false; static constexpr int S_EPI = 0; Ctx B;
    __device__ __forceinline__ void qk(const f32x4 (&acc)[2][2][4][2], const Unit& u, int wr, int wc, int fr, int fq, int rbase, bool isq) const {
        const int head = (u.pn & 1) * 4 + wc; const float* g = isq ? B.gmq() : B.gmk();
        f32x4 g0[2], g1[2], cd[2], sd[2];
#pragma unroll
        for (int n = 0; n < 2; ++n) { g0[n] = *(const f32x4*)(g + fq * 8 + n * 4); g1[n] = *(const f32x4*)(g + 32 + fq * 8 + n * 4);
            cd[n] = *(const f32x4*)(B.COSA() + 16 * 32 + fq * 8 + n * 4); sd[n] = *(const f32x4*)(B.SINA() + 16 * 32 + fq * 8 + n * 4); }
        bf16_t* dst = (isq ? B.QA() : B.KA()) + head * 64 + fq * 8; const float osc = isq ? C2A : 1.0f;
#pragma unroll
        for (int ai = 0; ai < 2; ++ai) { f32x4 c[2], sn[2]; float rx[4]; int rb = rbase + ai * HALF; OPAQUE(rb); const int pos0 = rb & (SEQ - 1);
#if KSUM_EPI
            float ks[16];
#pragma unroll
            for (int j = 0; j < 16; ++j) ks[j] = 0.f;
#endif
#pragma unroll
            for (int m = 0; m < 4; ++m) rx[m] = B.RX()[rb + m * 16];
#pragma unroll
            for (int n = 0; n < 2; ++n) { c[n] = *(const f32x4*)(B.COSA() + pos0 * 32 + fq * 8 + n * 4); sn[n] = *(const f32x4*)(B.SINA() + pos0 * 32 + fq * 8 + n * 4); }
#pragma unroll
            for (int m = 0; m < 4; ++m) { const int row = rb + m * 16; float ss = 0.f;
#pragma unroll
                for (int bj = 0; bj < 2; ++bj)
#pragma unroll
                    for (int n = 0; n < 2; ++n) ss += dot4(acc[ai][bj][m][n]);
                const float rxv = rx[m]; ss = fq_sum(ss) * rxv * rxv; const float rn = rsq(ss * (1.0f / 64) + EPS) * rxv * osc; f32x4 o1[2], o2[2];
#pragma unroll
                for (int n = 0; n < 2; ++n) { const f32x4 x1 = acc[ai][0][m][n] * rn * g0[n], x2 = acc[ai][1][m][n] * rn * g1[n]; o1[n] = x1 * c[n] - x2 * sn[n]; o2[n] = x2 * c[n] + x1 * sn[n];
                    const f32x4 cn = c[n] * cd[n] - sn[n] * sd[n]; sn[n] = sn[n] * cd[n] + c[n] * sd[n]; c[n] = cn; }
                const u32x4 w1 = pack8(o1[0], o1[1]), w2 = pack8(o2[0], o2[1]);
                st16<P1_STORE_MODE>(dst + (size_t)row * MW, w1); st16<P1_STORE_MODE>(dst + (size_t)row * MW + 32, w2);
#if KSUM_EPI
                if (!isq) {
#pragma unroll
                    for (int j = 0; j < 4; ++j) { ks[2 * j] += __uint_as_float(w1[j] << 16); ks[2 * j + 1] += __uint_as_float(w1[j] & 0xffff0000u); ks[8 + 2 * j] += __uint_as_float(w2[j] << 16); ks[9 + 2 * j] += __uint_as_float(w2[j] & 0xffff0000u); } }
#endif
            }
#if KSUM_EPI
            if (!isq) {
#pragma unroll
                for (int j = 0; j < 16; ++j) { float v = ks[j]; v += __shfl_xor(v, 1); v += __shfl_xor(v, 2); v += __shfl_xor(v, 4); v += __shfl_xor(v, 8); ks[j] = v; }
                if (fr == 0) { float* kd = B.KMEANP() + ((size_t)u.pm * 4 + 2 * ai + wr) * MW + head * 64 + fq * 8;
                    stf41(kd, (f32x4){ks[0], ks[1], ks[2], ks[3]}); stf41(kd + 4, (f32x4){ks[4], ks[5], ks[6], ks[7]}); stf41(kd + 32, (f32x4){ks[8], ks[9], ks[10], ks[11]}); stf41(kd + 36, (f32x4){ks[12], ks[13], ks[14], ks[15]}); } }
#endif
        }
    }
    __device__ __forceinline__ void operator()(const f32x4 (&acc)[2][2][4][2], const Unit& u, int wr, int wc, int fr, int fq) const {
        const int pn = u.pn; int rbase = u.pm * BM + wr * 64 + fr; OPAQUE(rbase);
        if (pn < 4) { qk(acc, u, wr, wc, fr, fq, rbase, pn < 2); return; }
        float rx[2][4];
#pragma unroll
        for (int ai = 0; ai < 2; ++ai)
#pragma unroll
            for (int m = 0; m < 4; ++m) rx[ai][m] = B.RX()[rbase + ai * HALF + m * 16];
        if (pn < 6) {
            bf16_t* dst = B.VA() + ((pn - 4) * 4 + wc) * 64 + fq * 8;
#pragma unroll
            for (int ai = 0; ai < 2; ++ai)
#pragma unroll
                for (int m = 0; m < 4; ++m) { const int row = rbase + ai * HALF + m * 16; const float rxv = rx[ai][m];
#pragma unroll
                    for (int bj = 0; bj < 2; ++bj) st16<P1_STORE_MODE>(dst + (size_t)row * MW + bj * 32, pack8(acc[ai][bj][m][0] * rxv, acc[ai][bj][m][1] * rxv)); }
        } else if (pn == 6 || wc < 2) {
            const int cb = (pn == 6 ? 0 : 256) + wc * 64 + fq * 8; float* ssp = pn == 6 ? B.CQSS() + wc : B.CKVSS() + wc; const int sstr = pn == 6 ? 4 : 2;
#pragma unroll
            for (int ai = 0; ai < 2; ++ai)
#pragma unroll
                for (int m = 0; m < 4; ++m) { const int row = rbase + ai * HALF + m * 16; const float rxv = rx[ai][m]; float ss = 0.f;
#pragma unroll
                    for (int bj = 0; bj < 2; ++bj) { const f32x4 a = acc[ai][bj][m][0] * rxv, b = acc[ai][bj][m][1] * rxv; ss += dot4(a) + dot4(b); st16<P1_STORE_MODE>(B.CQKV() + (size_t)row * 384 + cb + bj * 32, pack8(a, b)); }
                    ss = fq_sum(ss); if (fq == 0) stf1(ssp + (size_t)row * sstr, ss); }
        } else if (wc == 2) {
            const float* g = B.glk() + 64 + fq * 8; const f32x4 ga = *(const f32x4*)g, gb = *(const f32x4*)(g + 4); const float sg = fq < 2 ? -1.f : 1.f;
#pragma unroll
            for (int ai = 0; ai < 2; ++ai)
#pragma unroll
                for (int m = 0; m < 4; ++m) { int row = rbase + ai * HALF + m * 16; OPAQUE(row); const int pos = row & (SEQ - 1); const float rxv = rx[ai][m];
                    const f32x4 a = acc[ai][0][m][0] * rxv, b = acc[ai][0][m][1] * rxv; float ss = fq_sum(dot4(a) + dot4(b)); if (fq == 0) stf1(B.KPESS() + row, ss);
                    const f32x4 xa = a * ga, xb = b * gb; f32x4 pa, pb;
#pragma unroll
                    for (int j = 0; j < 4; ++j) { pa[j] = __shfl_xor(xa[j], 32); pb[j] = __shfl_xor(xb[j], 32); }
                    const int ci = pos * 16 + (fq & 1) * 8; const f32x4 ca = *(const f32x4*)(B.COSB() + ci), cb = *(const f32x4*)(B.COSB() + ci + 4), sa = *(const f32x4*)(B.SINB() + ci), sb = *(const f32x4*)(B.SINB() + ci + 4);
                    stf41(B.KR() + (size_t)row * 32 + fq * 8, xa * ca + pa * sa * sg); stf41(B.KR() + (size_t)row * 32 + fq * 8 + 4, xb * cb + pb * sb * sg); }
        }
    }
};
#ifndef P2_STORE_MODE
#define P2_STORE_MODE 0
#endif
struct EpiQUp { static constexpr bool PERM = true, AFTER_DRAIN = false; static constexpr int S_EPI = 8; Ctx B;
    __device__ __forceinline__ void operator()(const f32x4 (&acc)[2][2][4][2], const Unit& u, int wr, int wc, int fr, int fq) const {
        int rbase = u.pm * BM + wr * 64 + fr; OPAQUE(rbase); const int head = 2 * u.pn + (wc >> 1), dbase = (wc & 1) ? 64 : 0; bf16_t* dst = B.QM() + head * 96 + dbase + fq * 8;
#pragma unroll
        for (int ai = 0; ai < 2; ++ai) { int rb = rbase + ai * HALF; OPAQUE(rb); f32x4 s4[4];
#pragma unroll
            for (int m = 0; m < 4; ++m) s4[m] = *(const f32x4*)(B.CQSS() + (size_t)(rb + m * 16) * 4);
#pragma unroll
            for (int m = 0; m < 4; ++m) { const int row = rb + m * 16; const float rc = rsq(hsum4(s4[m]) * (1.0f / QR) + EPS);
                st16<P2_STORE_MODE>(dst + (size_t)row * 768, pack8(acc[ai][0][m][0] * rc, acc[ai][0][m][1] * rc));
                if (!(wc & 1)) st16<P2_STORE_MODE>(dst + (size_t)row * 768 + 32, pack8(acc[ai][1][m][0] * rc, acc[ai][1][m][1] * rc)); } }
    }
};
struct EpiKvUp { static constexpr bool PERM = true, AFTER_DRAIN = false; static constexpr int S_EPI = 16; Ctx B;
    __device__ __forceinline__ void operator()(const f32x4 (&acc)[2][2][4][2], const Unit& u, int wr, int wc, int fr, int fq) const {
        int rbase = u.pm * BM + wr * 64 + fr; OPAQUE(rbase); const int head = 2 * u.pn + (wc >> 1);
        if (wc & 1) { bf16_t* dst = B.VM() + head * 64 + fq * 8; f32x2 s2[2][4];
#pragma unroll
            for (int ai = 0; ai < 2; ++ai)
#pragma unroll
                for (int m = 0; m < 4; ++m) s2[ai][m] = *(const f32x2*)(B.CKVSS() + (size_t)(rbase + ai * HALF + m * 16) * 2);
#pragma unroll
            for (int ai = 0; ai < 2; ++ai)
#pragma unroll
                for (int m = 0; m < 4; ++m) { const int row = rbase + ai * HALF + m * 16; const float rc = rsq((s2[ai][m][0] + s2[ai][m][1]) * (1.0f / KVR) + EPS);
#pragma unroll
                    for (int bj = 0; bj < 2; ++bj) st16<P2_STORE_MODE>(dst + (size_t)row * MW + bj * 32, pack8(acc[ai][bj][m][0] * rc, acc[ai][bj][m][1] * rc)); }
        } else { int fqo = fq; OPAQUE(fqo); const float* g = B.glk() + fqo * 8; f32x4 gg[2][2];
#pragma unroll
            for (int bj = 0; bj < 2; ++bj)
#pragma unroll
                for (int n = 0; n < 2; ++n) gg[bj][n] = *(const f32x4*)(g + bj * 32 + n * 4);
            bf16_t* dst = B.KM() + head * 96 + fq * 8;
#pragma unroll
            for (int ai = 0; ai < 2; ++ai) { int rb = rbase + ai * HALF; OPAQUE(rb); float kp[4]; f32x4 ka[4], kb[4]; f32x2 s2v[4];
#pragma unroll
                for (int m = 0; m < 4; ++m) { const int row = rb + m * 16; kp[m] = B.KPESS()[row]; s2v[m] = *(const f32x2*)(B.CKVSS() + (size_t)row * 2); ka[m] = *(const f32x4*)(B.KR() + (size_t)row * 32 + fq * 8); kb[m] = *(const f32x4*)(B.KR() + (size_t)row * 32 + fq * 8 + 4); }
#pragma unroll
                for (int m = 0; m < 4; ++m) { const int row = rb + m * 16; const float rc = rsq((s2v[m][0] + s2v[m][1]) * (1.0f / KVR) + EPS);
                    f32x4 v[2][2]; float ss = 0.f;
#pragma unroll
                    for (int bj = 0; bj < 2; ++bj)
#pragma unroll
                        for (int n = 0; n < 2; ++n) { v[bj][n] = acc[ai][bj][m][n] * rc; ss += dot4(v[bj][n]); }
                    ss = fq_sum(ss) + kp[m]; const float rk = rsq(ss * (1.0f / QKD) + EPS);
#pragma unroll
                    for (int bj = 0; bj < 2; ++bj) st16<P2_STORE_MODE>(dst + (size_t)row * 768 + bj * 32, pack8(v[bj][0] * rk * gg[bj][0], v[bj][1] * rk * gg[bj][1]));
                    st16<P2_STORE_MODE>(dst + (size_t)row * 768 + 64, pack8(ka[m] * rk, kb[m] * rk)); } }
        }
    }
};
template <int WT = 0> struct EpiOProjT { static constexpr bool PERM = true, AFTER_DRAIN = false; static constexpr int S_EPI = 16; Ctx B;
    __device__ __forceinline__ void operator()(const f32x4 (&acc)[2][2][4][2], const Unit& u, int wr, int wc, int fr, int fq) const {
        const int rbase = u.pm * BM + wr * 64 + fr, col = u.pn * BM + wc * 64 + fq * 8;
#if EPI_LOAD_ALL
        u32x4 xwa[2][4][2];
#pragma unroll
        for (int ai = 0; ai < 2; ++ai) { int rb = rbase + ai * HALF; OPAQUE(rb);
#pragma unroll
            for (int m = 0; m < 4; ++m)
#pragma unroll
                for (int bj = 0; bj < 2; ++bj) xwa[ai][m][bj] = *(const u32x4*)(B.XB() + (size_t)(rb + m * 16) * DM + col + bj * 32); }
#endif
#pragma unroll
        for (int ai = 0; ai < 2; ++ai) { int rb = rbase + ai * HALF; OPAQUE(rb);
#if EPI_LOAD_ALL
            u32x4 (&xw)[4][2] = xwa[ai];
#else
            u32x4 xw[4][2];
#pragma unroll
            for (int m = 0; m < 4; ++m)
#pragma unroll
                for (int bj = 0; bj < 2; ++bj) xw[m][bj] = *(const u32x4*)(B.XB() + (size_t)(rb + m * 16) * DM + col + bj * 32);
#endif
#pragma unroll
            for (int m = 0; m < 4; ++m) { const int row = rb + m * 16; const size_t off = (size_t)row * DM + col; float ss = 0.f;
#pragma unroll
                for (int bj = 0; bj < 2; ++bj) { const u32x4 w = xw[m][bj];
                    const f32x4 x0 = {__uint_as_float(w.x << 16), __uint_as_float(w.x & 0xffff0000u), __uint_as_float(w.y << 16), __uint_as_float(w.y & 0xffff0000u)};
                    const f32x4 x1 = {__uint_as_float(w.z << 16), __uint_as_float(w.z & 0xffff0000u), __uint_as_float(w.w << 16), __uint_as_float(w.w & 0xffff0000u)};
                    const f32x4 a = x0 + acc[ai][bj][m][0], b = x1 + acc[ai][bj][m][1];
                    ss += dot4(a) + dot4(b); st16<WT>(B.H1B() + off + bj * 32, pack8(a, b)); }
                ss = fq_sum(ss);
#if H1SS_LDS
                if (fq == 0) ((PG8_LAS float*)EPI_RED_LDS)[wc * 256 + (row - u.pm * BM)] = ss; } }
        asm volatile("s_waitcnt lgkmcnt(0)" ::: "memory"); __syncthreads();
        if (wr == 0) { const int t = wc * 64 + fq * 16 + fr; PG8_LAS const float* rd = (PG8_LAS const float*)EPI_RED_LDS + t; stf(B.H1SSP() + (size_t)(u.pm * BM + t) * 4 + u.pn, (rd[0] + rd[256]) + (rd[512] + rd[768])); }
#else
                if (fq == 0) { if (PROBE_ATOM2) { atomicAdd(B.H1SS() + row, 0.5f * ss); atomicAdd(B.H1SS() + row, 0.5f * ss); } else atomicAdd(B.H1SS() + row, ss); } } }
#endif
    }
};
#ifndef P4_WT
#define P4_WT 0
#endif
typedef EpiOProjT<P4_WT> EpiOProj;
#ifndef FFN1_FMA
#define FFN1_FMA 0
#endif
template <int WT = 0> struct EpiFfn1T { static constexpr bool PERM = true, AFTER_DRAIN = false; static constexpr int S_EPI = 8; Ctx B;
    __device__ __forceinline__ void operator()(const f32x4 (&acc)[2][2][4][2], const Unit& u, int wr, int wc, int fr, int fq) const {
        const int rbase = u.pm * BM + wr * 64 + fr, col = u.pn * HALF + wc * 32 + fq * 8; float ssv[2][4];
#pragma unroll
        for (int ai = 0; ai < 2; ++ai)
#pragma unroll
#if H1SS_LDS
            for (int m = 0; m < 4; ++m) ssv[ai][m] = hsum4(*(const f32x4*)(B.H1SSP() + (size_t)(rbase + ai * HALF + m * 16) * 4));
#else
            for (int m = 0; m < 4; ++m) ssv[ai][m] = B.H1SS()[rbase + ai * HALF + m * 16];
#endif
#pragma unroll
        for (int ai = 0; ai < 2; ++ai)
#pragma unroll
            for (int m = 0; m < 4; ++m) { int row = rbase + ai * HALF + m * 16; OPAQUE(row);
#if FFN1_FMA
                const float q = ssv[ai][m] * (1.0f / DM) + EPS, nrl = -LOG2E * rsq(q); f32x4 o[2];
#pragma unroll
                for (int n = 0; n < 2; ++n) { const f32x4 ga = acc[ai][0][m][n], gu = ga * acc[ai][1][m][n], x = ga * nrl; f32x4 e, r;
#pragma unroll
                    for (int j = 0; j < 4; ++j) e[j] = __builtin_amdgcn_exp2f(x[j]);
                    const f32x4 d = e * q + q;
#pragma unroll
                    for (int j = 0; j < 4; ++j) r[j] = __builtin_amdgcn_rcpf(d[j]);
                    o[n] = gu * r; }
#else
                const float rh = rsq(ssv[ai][m] * (1.0f / DM) + EPS), nrl = -LOG2E * rh, rh2 = rh * rh; f32x4 o[2];
#pragma unroll
                for (int n = 0; n < 2; ++n) { const f32x4 ga = acc[ai][0][m][n], gu = ga * acc[ai][1][m][n];
#pragma unroll
                    for (int j = 0; j < 4; ++j) o[n][j] = gu[j] * (rh2 * __builtin_amdgcn_rcpf(1.0f + __builtin_amdgcn_exp2f(ga[j] * nrl))); }
#endif
                st16<WT>(B.ACT() + (size_t)row * DFF + col, pack8(o[0], o[1])); }
    }
};
#ifndef ACT_STORE_MODE
#define ACT_STORE_MODE 0
#endif
typedef EpiFfn1T<ACT_STORE_MODE> EpiFfn1;
#ifndef OUT_XPOSE
#define OUT_XPOSE 0
#endif
#ifndef OUT_WT
#define OUT_WT 0
#endif
#ifndef OUT_STORE_NT
#define OUT_STORE_NT 0
#endif
struct EpiFfn2 { static constexpr bool PERM = true, AFTER_DRAIN = false; static constexpr int S_EPI = 32; Ctx B;
    __device__ __forceinline__ void operator()(const f32x4 (&acc)[2][2][4][2], const Unit& u, int wr, int wc, int fr, int fq) const {
        const int rbase = u.pm * BM + wr * 64 + fr, col = u.pn * BM + wc * 64 + fq * 8;
#if EPI_LOAD_ALL
        u32x4 hwa[2][4][2];
#pragma unroll
        for (int ai = 0; ai < 2; ++ai) { int rb = rbase + ai * HALF; OPAQUE(rb);
#pragma unroll
            for (int m = 0; m < 4; ++m)
#pragma unroll
                for (int bj = 0; bj < 2; ++bj) hwa[ai][m][bj] = __builtin_nontemporal_load((const u32x4*)(B.H1B() + (size_t)(rb + m * 16) * DM + col + bj * 32)); }
#endif
#pragma unroll
        for (int ai = 0; ai < 2; ++ai) { int rb = rbase + ai * HALF; OPAQUE(rb);
#if EPI_LOAD_ALL
            u32x4 (&hw)[4][2] = hwa[ai];
#else
            u32x4 hw[4][2];
#pragma unroll
            for (int m = 0; m < 4; ++m)
#pragma unroll
                for (int bj = 0; bj < 2; ++bj) hw[m][bj] = __builtin_nontemporal_load((const u32x4*)(B.H1B() + (size_t)(rb + m * 16) * DM + col + bj * 32));
#endif
#pragma unroll
            for (int m = 0; m < 4; ++m) { const size_t off = (size_t)(rb + m * 16) * DM + col;
#pragma unroll
                for (int bj = 0; bj < 2; ++bj) { const u32x4 w = hw[m][bj];
                    const f32x4 h0 = {__uint_as_float(w.x << 16), __uint_as_float(w.x & 0xffff0000u), __uint_as_float(w.y << 16), __uint_as_float(w.y & 0xffff0000u)};
                    const f32x4 h1 = {__uint_as_float(w.z << 16), __uint_as_float(w.z & 0xffff0000u), __uint_as_float(w.w << 16), __uint_as_float(w.w & 0xffff0000u)};
                    f32x4 o0 = h0 + acc[ai][bj][m][0], o1 = h1 + acc[ai][bj][m][1];
#if OUT_XPOSE
#pragma unroll
                    for (int k = 0; k < 4; ++k) { auto r = __builtin_amdgcn_permlane16_swap(__float_as_uint(o0[k]), __float_as_uint(o1[k]), false, false); auto q = __builtin_amdgcn_permlane32_swap(r[0], r[1], false, false); o0[k] = __uint_as_float(q[0]); o1[k] = __uint_as_float(q[1]); }
                    float* po = B.out + (off - fq * 4) + bj * 32;
#if OUT_WT
                    WT_STORE16_ASM(po, o0); WT_STORE16_ASM(po + 16, o1); } } }
#else
                    __builtin_nontemporal_store(o0, (f32x4*)po); __builtin_nontemporal_store(o1, (f32x4*)(po + 16)); } } }
#endif
#elif OUT_WT
                    WT_STORE16_ASM(B.out + off + bj * 32, o0); WT_STORE16_ASM(B.out + off + bj * 32 + 4, o1); } } }
#elif OUT_STORE_NT
                    __builtin_nontemporal_store(o0, (f32x4*)(B.out + off + bj * 32)); __builtin_nontemporal_store(o1, (f32x4*)(B.out + off + bj * 32 + 4)); } } }
#else
                    *(f32x4*)(B.out + off + bj * 32) = o0; *(f32x4*)(B.out + off + bj * 32 + 4) = o1; } } }
#endif
    }
};

template <class Epi, class Sched, bool ALIGN_EPI>
__device__ __forceinline__ void gemm_phase(PG8_LAS unsigned char* lds, const Gemm g, const Sched& S, const Epi& E) {
    const int tid = threadIdx.x, wid = __builtin_amdgcn_readfirstlane(tid >> 6), lane = tid & 63, wr = wid >> 2, wc = wid & 3, fr = lane & 15, fq = lane >> 4;
    const int K = g.K, nt = K / BK, lda = g.lda;
    unsigned voffA[2], voffB[2];
#pragma unroll
    for (int i = 0; i < 2; ++i) { int R, C; stage_rc(tid * 16 + i * 8192, R, C); const int Rb = Epi::PERM ? ((R & ~31) + perm32(R & 31)) : R;
        voffA[i] = (unsigned)(R * lda + C) * 2u; voffB[i] = (unsigned)(Rb * K + C) * 2u; }
    const size_t kstep = (size_t)(BK * 2);
    const size_t hstepA = (size_t)HALF * lda * 2, hstepB = (size_t)HALF * K * 2;
    const size_t tstepA = 2 * hstepA, tstepB = 2 * hstepB;
    const unsigned ldsw = (unsigned)wid * 1024u;
    const int aoff = lds_byte(wr * 64 + fr, fq * 8), boff = lds_byte(wc * 32 + fr, fq * 8);
#define PG8_SA(b, h) (((b) * 2 + (h)) * HTB)
#define PG8_SB(b, h) ((4 + (b) * 2 + (h)) * HTB)
#define PG8_STAGE(bufoff, gbase, voff) do { _Pragma("unroll") for (int _i = 0; _i < 2; ++_i) \
        __builtin_amdgcn_global_load_lds((const unsigned*)((const char*)(gbase) + (voff)[_i]), (PG8_LAS unsigned*)(lds + (bufoff) + ldsw + _i * 8192), 16, 0, 0); } while (0)
#define PG8_LDA(dst, b, h) do { _Pragma("unroll") for (int m = 0; m < 4; ++m) _Pragma("unroll") for (int k = 0; k < 2; ++k) dst[m][k] = *(const PG8_LAS bf16x8*)(lds + PG8_SA(b, h) + aoff + m * 2048 + k * 1024); } while (0)
#define PG8_LDB(dst, b, h) do { _Pragma("unroll") for (int n = 0; n < 2; ++n) _Pragma("unroll") for (int k = 0; k < 2; ++k) dst[n][k] = *(const PG8_LAS bf16x8*)(lds + PG8_SB(b, h) + boff + n * 2048 + k * 1024); } while (0)
#define PG8_MMA(ai, bj, At, Bt) do { __builtin_amdgcn_s_setprio(1); _Pragma("unroll") for (int m = 0; m < 4; ++m) _Pragma("unroll") for (int n = 0; n < 2; ++n) _Pragma("unroll") for (int k = 0; k < 2; ++k) \
        acc[ai][bj][m][n] = __builtin_amdgcn_mfma_f32_16x16x32_bf16(Bt[n][k], At[m][k], acc[ai][bj][m][n], 0, 0, 0); __builtin_amdgcn_s_setprio(0); } while (0)
#define PG8_WAIT_V(n) asm volatile("s_waitcnt vmcnt(" #n ")" ::: "memory")
#define PG8_WAIT_L(n) asm volatile("s_waitcnt lgkmcnt(" #n ")" ::: "memory")
#define PG8_BAR __builtin_amdgcn_s_barrier()
#define PG8_SCHED __builtin_amdgcn_sched_barrier(0)
    Unit cur, nxt; int ui = 0;
    if (!S.next(0, cur)) return;
    f32x4 acc[2][2][4][2];
#pragma unroll
    for (int a = 0; a < 2; ++a)
#pragma unroll
        for (int b = 0; b < 2; ++b)
#pragma unroll
            for (int m = 0; m < 4; ++m)
#pragma unroll
                for (int n = 0; n < 2; ++n) acc[a][b][m][n] = (f32x4){0.f, 0.f, 0.f, 0.f};
    bf16x8 At[4][2], B0[2][2], B1[2][2];
    const char* cA = (const char*)g.A + (size_t)cur.pm * tstepA; const char* cB = (const char*)g.Bt + (size_t)cur.pn * tstepB;
    S.a_ready(cur);
    PG8_STAGE(PG8_SB(0, 0), cB, voffB); PG8_STAGE(PG8_SB(0, 1), cB + hstepB, voffB); PG8_STAGE(PG8_SA(0, 0), cA, voffA); PG8_STAGE(PG8_SA(0, 1), cA + hstepA, voffA);
    if (wr == 1) PG8_BAR;
    PG8_WAIT_V(2); PG8_BAR;
    PG8_STAGE(PG8_SB(1, 0), cB + kstep, voffB); PG8_STAGE(PG8_SA(1, 0), cA + kstep, voffA); PG8_STAGE(PG8_SB(1, 1), cB + hstepB + kstep, voffB);
    PG8_WAIT_V(6); PG8_BAR;
    for (;;) {
        const bool has_next = S.next(ui + 1, nxt);
        const char* nA = has_next ? (const char*)g.A + (size_t)nxt.pm * tstepA : cA; const char* nB = has_next ? (const char*)g.Bt + (size_t)nxt.pn * tstepB : cB;
#pragma unroll 1
        for (int t = 0; t < nt; t += 2) {
            const bool last = (t == nt - 2);
            const char* a1 = cA + (size_t)(t + 1) * kstep;
            const char* a2 = last ? nA : cA + (size_t)(t + 2) * kstep; const char* b2 = last ? nB : cB + (size_t)(t + 2) * kstep;
            const char* a3 = a2 + kstep; const char* b3 = b2 + kstep;
            if (last && has_next) S.a_ready(nxt);
            PG8_LDB(B0, 0, 0); PG8_LDB(B1, 0, 1); PG8_SCHED; PG8_LDA(At, 0, 0); PG8_STAGE(PG8_SA(1, 1), a1 + hstepA, voffA);
            PG8_WAIT_V(8); PG8_WAIT_L(0); PG8_BAR; PG8_MMA(0, 0, At, B0); PG8_MMA(0, 1, At, B1); PG8_BAR; PG8_SCHED;
            PG8_LDA(At, 0, 1); PG8_STAGE(PG8_SB(0, 0), b2, voffB); PG8_STAGE(PG8_SB(0, 1), b2 + hstepB, voffB); PG8_STAGE(PG8_SA(0, 0), a2, voffA);
            PG8_WAIT_V(8); PG8_WAIT_L(0); PG8_BAR; PG8_MMA(1, 0, At, B0); PG8_MMA(1, 1, At, B1); PG8_BAR; PG8_SCHED;
            PG8_LDB(B0, 1, 0); PG8_LDB(B1, 1, 1); PG8_SCHED; PG8_LDA(At, 1, 0); PG8_STAGE(PG8_SA(0, 1), a2 + hstepA, voffA);
            PG8_WAIT_V(8); PG8_WAIT_L(0); PG8_BAR; PG8_MMA(0, 0, At, B0); PG8_MMA(0, 1, At, B1); PG8_BAR; PG8_SCHED;
            PG8_LDA(At, 1, 1); PG8_STAGE(PG8_SB(1, 0), b3, voffB); PG8_STAGE(PG8_SB(1, 1), b3 + hstepB, voffB); PG8_STAGE(PG8_SA(1, 0), a3, voffA);
            PG8_WAIT_V(8); PG8_WAIT_L(0); PG8_BAR; PG8_MMA(1, 0, At, B0); PG8_MMA(1, 1, At, B1); PG8_BAR; PG8_SCHED;
        }
        if constexpr (ALIGN_EPI) { if (wr == 0) PG8_BAR; }
        { int fr_ = fr, fq_ = fq; OPAQUE(fr_); OPAQUE(fq_); E(acc, cur, wr, wc, fr_, fq_); } S.done(cur);
        if (!has_next) break;
#pragma unroll
        for (int a = 0; a < 2; ++a)
#pragma unroll
            for (int b = 0; b < 2; ++b)
#pragma unroll
                for (int m = 0; m < 4; ++m)
#pragma unroll
                    for (int n = 0; n < 2; ++n) acc[a][b][m][n] = (f32x4){0.f, 0.f, 0.f, 0.f};
        cur = nxt; cA = nA; cB = nB; ++ui;
        if constexpr (ALIGN_EPI) { if (wr == 1) PG8_BAR; }
    }
    PG8_WAIT_V(0);
    if constexpr (!ALIGN_EPI) { if (wr == 0) PG8_BAR; }
    PG8_BAR;
#undef PG8_SA
#undef PG8_SB
#undef PG8_STAGE
#undef PG8_LDA
#undef PG8_LDB
#undef PG8_MMA
#undef PG8_WAIT_V
#undef PG8_WAIT_L
#undef PG8_BAR
#undef PG8_SCHED
}

#ifndef STREAM_ALIGN_EPI
#define STREAM_ALIGN_EPI 1
#endif
struct GDesc { const bf16_t* A; const bf16_t* Bt; int K, lda; };
struct UnitX { int pm, pn, kind; };
#ifndef RELAX_EPI_WAIT
#define RELAX_EPI_WAIT 0
#endif
template <class Prog, int A_AUX = 0>
__device__ __forceinline__ void gemm_stream(PG8_LAS unsigned char* lds, Prog& P, int wave_s) {
    const int wid = wave_s, lane = lane_now(), tid = wid * 64 + lane, wr = wid >> 2, wc = wid & 3, fr = lane & 15, fq = lane >> 4;
    int R_[2], C_[2], Rb_[2];
#pragma unroll
    for (int i = 0; i < 2; ++i) { stage_rc(tid * 16 + i * 8192, R_[i], C_[i]); Rb_[i] = (R_[i] & ~31) + perm32(R_[i] & 31); }
    const size_t kstep = (size_t)(BK * 2);
    const unsigned ldsw = (unsigned)wid * 1024u;
    const int aoff = lds_byte(wr * 64 + fr, fq * 8), boff = lds_byte(wc * 32 + fr, fq * 8);
#define PG8_SA(b, h) (((b) * 2 + (h)) * HTB)
#define PG8_SB(b, h) ((4 + (b) * 2 + (h)) * HTB)
#define PG8_STAGE2(bufoff, gbase, v0, v1) do { \
        __builtin_amdgcn_global_load_lds((const unsigned*)((const char*)(gbase) + (v0)), (PG8_LAS unsigned*)(lds + (bufoff) + ldsw), 16, 0, 0); \
        __builtin_amdgcn_global_load_lds((const unsigned*)((const char*)(gbase) + (v1)), (PG8_LAS unsigned*)(lds + (bufoff) + ldsw + 8192), 16, 0, 0); } while (0)
#define PG8_STAGE2A(bufoff, gbase, v0, v1) do { \
        __builtin_amdgcn_global_load_lds((const unsigned*)((const char*)(gbase) + (v0)), (PG8_LAS unsigned*)(lds + (bufoff) + ldsw), 16, 0, A_AUX); \
        __builtin_amdgcn_global_load_lds((const unsigned*)((const char*)(gbase) + (v1)), (PG8_LAS unsigned*)(lds + (bufoff) + ldsw + 8192), 16, 0, A_AUX); } while (0)
#define PG8_LDA(dst, b, h) do { _Pragma("unroll") for (int m = 0; m < 4; ++m) _Pragma("unroll") for (int k = 0; k < 2; ++k) dst[m][k] = *(const PG8_LAS bf16x8*)(lds + PG8_SA(b, h) + aoff + m * 2048 + k * 1024); } while (0)
#define PG8_LDB(dst, b, h) do { _Pragma("unroll") for (int n = 0; n < 2; ++n) _Pragma("unroll") for (int k = 0; k < 2; ++k) dst[n][k] = *(const PG8_LAS bf16x8*)(lds + PG8_SB(b, h) + boff + n * 2048 + k * 1024); } while (0)
#define PG8_MMA(ai, bj, At, Bt) do { __builtin_amdgcn_s_setprio(1); _Pragma("unroll") for (int m = 0; m < 4; ++m) _Pragma("unroll") for (int n = 0; n < 2; ++n) _Pragma("unroll") for (int k = 0; k < 2; ++k) \
        acc[ai][bj][m][n] = __builtin_amdgcn_mfma_f32_16x16x32_bf16(Bt[n][k], At[m][k], acc[ai][bj][m][n], 0, 0, 0); __builtin_amdgcn_s_setprio(0); } while (0)
#define PG8_WAIT_V(n) asm volatile("s_waitcnt vmcnt(" #n ")" ::: "memory")
#define PG8_WAIT_L(n) asm volatile("s_waitcnt lgkmcnt(" #n ")" ::: "memory")
#define PG8_WAIT_VN(n) asm volatile("s_waitcnt vmcnt(%0)" :: "n"(n) : "memory")
#define PG8_BAR __builtin_amdgcn_s_barrier()
#define PG8_SCHED __builtin_amdgcn_sched_barrier(0)
#define PG8_SETUP(u, pA, pB, vA0, vA1, vB0, vB1, hA, hB, ntv) do { const GDesc d_ = P.desc((u).kind); (ntv) = d_.K / BK; (hA) = (size_t)HALF * d_.lda * 2; (hB) = (size_t)HALF * d_.K * 2; \
        (pA) = (const char*)d_.A + (size_t)(u).pm * 2 * (hA); (pB) = (const char*)d_.Bt + (size_t)(u).pn * 2 * (hB); \
        (vA0) = (unsigned)(R_[0] * d_.lda + C_[0]) * 2u; (vA1) = (unsigned)(R_[1] * d_.lda + C_[1]) * 2u; (vB0) = (unsigned)(Rb_[0] * d_.K + C_[0]) * 2u; (vB1) = (unsigned)(Rb_[1] * d_.K + C_[1]) * 2u; } while (0)
    UnitX cur, nxt; int ui = 0;
    if (!P.next(0, cur)) return;
    const char *cA, *cB, *nA, *nB; unsigned cvA0, cvA1, cvB0, cvB1, nvA0, nvA1, nvB0, nvB1; size_t chA, chB, nhA, nhB; int cnt, nnt;
    PG8_SETUP(cur, cA, cB, cvA0, cvA1, cvB0, cvB1, chA, chB, cnt);
    f32x4 acc[2][2][4][2];
#pragma unroll
    for (int a = 0; a < 2; ++a)
#pragma unroll
        for (int b = 0; b < 2; ++b)
#pragma unroll
            for (int m = 0; m < 4; ++m)
#pragma unroll
                for (int n = 0; n < 2; ++n) acc[a][b][m][n] = (f32x4){0.f, 0.f, 0.f, 0.f};
    bf16x8 At[4][2], B0[2][2], B1[2][2];
    P.a_ready(cur);
    PG8_STAGE2(PG8_SB(0, 0), cB, cvB0, cvB1); PG8_STAGE2(PG8_SB(0, 1), cB + chB, cvB0, cvB1); PG8_STAGE2A(PG8_SA(0, 0), cA, cvA0, cvA1); PG8_STAGE2A(PG8_SA(0, 1), cA + chA, cvA0, cvA1);
    if (wr == 1) PG8_BAR;
    PG8_WAIT_V(2); PG8_BAR;
    PG8_STAGE2(PG8_SB(1, 0), cB + kstep, cvB0, cvB1); PG8_STAGE2A(PG8_SA(1, 0), cA + kstep, cvA0, cvA1); PG8_STAGE2(PG8_SB(1, 1), cB + chB + kstep, cvB0, cvB1);
    PG8_WAIT_V(6); PG8_BAR;
    for (;;) {
        const bool has_next = P.next(ui + 1, nxt);
        if (has_next) { PG8_SETUP(nxt, nA, nB, nvA0, nvA1, nvB0, nvB1, nhA, nhB, nnt); }
        else { nA = cA; nB = cB; nvA0 = cvA0; nvA1 = cvA1; nvB0 = cvB0; nvB1 = cvB1; nhA = chA; nhB = chB; nnt = cnt; }
#pragma unroll 1
        for (int t = 0; t < cnt; t += 2) {
            const bool last = (t == cnt - 2);
            const char* a1 = cA + (size_t)(t + 1) * kstep;
            const char* a2 = last ? nA : cA + (size_t)(t + 2) * kstep; const char* b2 = last ? nB : cB + (size_t)(t + 2) * kstep;
            const char* a3 = a2 + kstep; const char* b3 = b2 + kstep;
            const unsigned xA0 = last ? nvA0 : cvA0, xA1 = last ? nvA1 : cvA1, xB0 = last ? nvB0 : cvB0, xB1 = last ? nvB1 : cvB1; const size_t xhA = last ? nhA : chA, xhB = last ? nhB : chB;
            if (last && has_next) P.a_ready(nxt);
            const bool relax = RELAX_EPI_WAIT && Prog::S_EPI > 0 && t == 0 && ui > 0;
            PG8_LDB(B0, 0, 0); PG8_LDB(B1, 0, 1); PG8_SCHED; PG8_LDA(At, 0, 0); PG8_STAGE2A(PG8_SA(1, 1), a1 + chA, cvA0, cvA1);
            if (relax) PG8_WAIT_VN(8 + Prog::S_EPI); else PG8_WAIT_V(8);
            PG8_WAIT_L(0); PG8_BAR; PG8_MMA(0, 0, At, B0); PG8_MMA(0, 1, At, B1); PG8_BAR; PG8_SCHED;
            PG8_LDA(At, 0, 1); PG8_STAGE2(PG8_SB(0, 0), b2, xB0, xB1); PG8_STAGE2(PG8_SB(0, 1), b2 + xhB, xB0, xB1); PG8_STAGE2A(PG8_SA(0, 0), a2, xA0, xA1);
            if (relax) PG8_WAIT_VN(8 + Prog::S_EPI); else PG8_WAIT_V(8);
            PG8_WAIT_L(0); PG8_BAR; PG8_MMA(1, 0, At, B0); PG8_MMA(1, 1, At, B1); PG8_BAR; PG8_SCHED;
            PG8_LDB(B0, 1, 0); PG8_LDB(B1, 1, 1); PG8_SCHED; PG8_LDA(At, 1, 0); PG8_STAGE2A(PG8_SA(0, 1), a2 + xhA, xA0, xA1);
            PG8_WAIT_V(8); if (t == 0) P.publish();
            PG8_WAIT_L(0); PG8_BAR; PG8_MMA(0, 0, At, B0); PG8_MMA(0, 1, At, B1); PG8_BAR; PG8_SCHED;
            PG8_LDA(At, 1, 1); PG8_STAGE2(PG8_SB(1, 0), b3, xB0, xB1); PG8_STAGE2(PG8_SB(1, 1), b3 + xhB, xB0, xB1); PG8_STAGE2A(PG8_SA(1, 0), a3, xA0, xA1);
            PG8_WAIT_V(8); PG8_WAIT_L(0); PG8_BAR; PG8_MMA(1, 0, At, B0); PG8_MMA(1, 1, At, B1); PG8_BAR; PG8_SCHED;
        }
#if STREAM_ALIGN_EPI
        if (wr == 0) PG8_BAR;
#endif
        { const int l_ = lane_now(); const int fr_ = l_ & 15, fq_ = l_ >> 4; P.epi(acc, cur, wr, wc, fr_, fq_); } P.done(cur);
        if (!has_next) break;
#pragma unroll
        for (int a = 0; a < 2; ++a)
#pragma unroll
            for (int b = 0; b < 2; ++b)
#pragma unroll
                for (int m = 0; m < 4; ++m)
#pragma unroll
                    for (int n = 0; n < 2; ++n) acc[a][b][m][n] = (f32x4){0.f, 0.f, 0.f, 0.f};
        cur = nxt; cA = nA; cB = nB; cvA0 = nvA0; cvA1 = nvA1; cvB0 = nvB0; cvB1 = nvB1; chA = nhA; chB = nhB; cnt = nnt; ++ui;
#if STREAM_ALIGN_EPI
        if (wr == 1) PG8_BAR;
#endif
    }
    PG8_WAIT_V(0); P.publish();
#if !STREAM_ALIGN_EPI
    if (wr == 0) PG8_BAR;
#endif
    PG8_BAR;
#undef PG8_SA
#undef PG8_SB
#undef PG8_STAGE2
#undef PG8_STAGE2A
#undef PG8_LDA
#undef PG8_LDB
#undef PG8_MMA
#undef PG8_WAIT_V
#undef PG8_WAIT_L
#undef PG8_WAIT_VN
#undef PG8_BAR
#undef PG8_SCHED
#undef PG8_SETUP
}
#ifndef QUP_FUSED
#define QUP_FUSED 0
#endif
struct ProgP2 { Ctx B; StaticOrder S; static constexpr int S_EPI = 8;
    __device__ __forceinline__ void init(const Ctx& b, int G, int c) { B = b; S.init(M, 1024, G, c); }
#if QUP_FUSED
    __device__ __forceinline__ bool next(int i, UnitX& u) const { Unit t; if (!S.next(i, t)) return false; u.pm = t.pm; u.pn = t.pn; u.kind = 1; return true; }
#else
    __device__ __forceinline__ bool next(int i, UnitX& u) const { Unit t; const int per = (S.nwg - S.c + S.G - 1) / S.G; const bool q = i < per; if (!S.next(q ? i : i - per, t)) return false; u.pm = t.pm; u.pn = t.pn; u.kind = q ? 0 : 1; return true; }
#endif
    __device__ __forceinline__ GDesc desc(int kind) const { return kind == 0 ? GDesc{B.CQKV(), B.WQUP(), 256, 384} : GDesc{B.CQKV() + 256, B.WKVUP(), 128, 384}; }
    __device__ __forceinline__ void epi(const f32x4 (&acc)[2][2][4][2], const UnitX& u, int wr, int wc, int fr, int fq) const { const Unit t{u.pm, u.pn};
        if (u.kind == 0) EpiQUp{B}(acc, t, wr, wc, fr, fq); else EpiKvUp{B}(acc, t, wr, wc, fr, fq); }
    __device__ __forceinline__ void a_ready(const UnitX&) const {}
    __device__ __forceinline__ void done(const UnitX&) const {}
    __device__ __forceinline__ void publish() const {}
};

template <class Epi, int DUPMODE = 0> struct ProgOne { Ctx B; StaticOrder S; GDesc d; static constexpr int S_EPI = DUPMODE ? 0 : Epi::S_EPI;
    __device__ __forceinline__ void init(const Ctx& b, const GDesc& g, int N, int G, int c) { B = b; d = g; S.init(M, N, G, c); }
    __device__ __forceinline__ bool next(int i, UnitX& u) const { Unit t; if (!S.next(DUPMODE ? (i >> 1) : i, t)) return false; u.pm = t.pm; u.pn = t.pn; u.kind = (DUPMODE == 2 && !(i & 1)) ? 1 : 0; return true; }
    __device__ __forceinline__ GDesc desc(int) const { return d; }
    __device__ __forceinline__ void epi(const f32x4 (&acc)[2][2][4][2], const UnitX& u, int wr, int wc, int fr, int fq) const { if (DUPMODE == 2 && u.kind == 1) return; const Unit t{u.pm, u.pn}; Epi{B}(acc, t, wr, wc, fr, fq); }
    __device__ __forceinline__ void a_ready(const UnitX&) const {}
    __device__ __forceinline__ void done(const UnitX&) const {}
    __device__ __forceinline__ void publish() const {}
};

struct ProgFFN { static constexpr int S_EPI = 0; Ctx B; StaticOrder S4, S5; unsigned* cnt4; unsigned* cnt5; unsigned* tmo; int seg, p6, acq4; unsigned* pend;
    enum { K_P4 = 0, K_P5 = 1, K_P6 = 2 };
    __device__ __forceinline__ void init(const Ctx& b, int G, int c, unsigned* c4, unsigned* c5, unsigned* t) { B = b; S4.init(M, DM, G, c); S5.init(M, 2 * DFF, G, c); cnt4 = c4; cnt5 = c5; tmo = t; seg = 0; p6 = 1 + (c >> 3) % 5; acq4 = -1; pend = nullptr; }
    __device__ __forceinline__ bool next(int i, UnitX& u) const { Unit t; int kind, r;
        if (seg == 0) { if (i > 1) return false; kind = K_P4; r = i; }
        else if (seg == 1) { if (i < 6) { kind = K_P5; r = i; } else if (i < 12) { const int k = i - 6; if (k == p6) { kind = K_P6; r = 0; } else { kind = K_P5; r = 6 + (k < p6 ? k : k - 1); } } else return false; }
        else { if (i > 0) return false; kind = K_P6; r = 1; }
        if (!(kind == K_P5 ? S5.next(r, t) : S4.next(r, t))) return false;
        u.pm = t.pm; u.pn = t.pn; u.kind = kind; return true; }
    __device__ __forceinline__ GDesc desc(int kind) const { return kind == K_P4 ? GDesc{B.AO(), B.WO(), DM, DM} : kind == K_P5 ? GDesc{B.H1B(), B.WGU(), DM, DM} : GDesc{B.ACT(), B.WD(), DFF, DFF}; }
    __device__ __forceinline__ void epi(const f32x4 (&acc)[2][2][4][2], const UnitX& u, int wr, int wc, int fr, int fq) const { const Unit t{u.pm, u.pn};
        if (u.kind == K_P4) EpiOProjT<1>{B}(acc, t, wr, wc, fr, fq); else if (u.kind == K_P5) EpiFfn1T<1>{B}(acc, t, wr, wc, fr, fq); else EpiFfn2{B}(acc, t, wr, wc, fr, fq); }
    __device__ __forceinline__ void a_ready(const UnitX& u) {
        if (u.kind == K_P4 || (u.kind == K_P5 && u.pm == acq4)) return;
        if (threadIdx.x < 64) {
            unsigned* c = u.kind == K_P5 ? cnt4 + 64 * u.pm : cnt5 + 64 * u.pm; const unsigned need = u.kind == K_P5 ? 4u * 8u : 22u * 8u; unsigned sp = 0u;
            while ((unsigned)__builtin_amdgcn_readfirstlane(__hip_atomic_load(c, __ATOMIC_RELAXED, __HIP_MEMORY_SCOPE_AGENT)) < need) { __builtin_amdgcn_s_sleep(2);
                if ((++sp & 255u) == 0u) { if (__builtin_amdgcn_readfirstlane(__hip_atomic_load(tmo, __ATOMIC_RELAXED, __HIP_MEMORY_SCOPE_AGENT)) != 0u) break; if (sp > (1u << 18)) { if (threadIdx.x == 0) atomicAdd(tmo, 1u); break; } } }
            __builtin_amdgcn_fence(__ATOMIC_ACQUIRE, "agent");
            asm volatile("s_waitcnt vmcnt(0)" ::: "memory");
        }
        asm volatile("" ::: "memory"); __builtin_amdgcn_s_barrier(); asm volatile("" ::: "memory");
        if (u.kind == K_P5) acq4 = u.pm;
    }
    __device__ __forceinline__ void done(const UnitX& u) { pend = u.kind == K_P4 ? cnt4 + 64 * u.pm : u.kind == K_P5 ? cnt5 + 64 * u.pm : nullptr; }
    __device__ __forceinline__ void publish() { if (pend) { if ((threadIdx.x & 63) == 0) (void)__hip_atomic_fetch_add(pend, 1u, __ATOMIC_RELAXED, __HIP_MEMORY_SCOPE_AGENT); pend = nullptr; } }
};
}
namespace attm {
using bf16=bf16_t;
using bf16x8=__attribute__((ext_vector_type(8)))short;
using s16x4=__attribute__((ext_vector_type(4)))short;
using f32x16=__attribute__((ext_vector_type(16)))float;
using u32x4=__attribute__((ext_vector_type(4)))unsigned;
using f32x4=__attribute__((ext_vector_type(4)))float;
constexpr int D=64,DM=512,DMO=1024;
constexpr int NW=8,QBLK=32,QB=QBLK*NW,KVBLK=64;
__device__ __forceinline__ int crow(int r,int hi){return (r&3)+8*(r>>2)+4*hi;}
#define SBAR() __builtin_amdgcn_sched_barrier(0)
__device__ __forceinline__ void cmask(f32x16&p0,f32x16&p1,int jb,int qrel,int hi){
  const float NEG=-INFINITY; int kb=64*jb+4*hi;
  #pragma unroll
  for(int r=0;r<16;++r){int kv=kb+(r&3)+8*(r>>2); if(kv>qrel)p0[r]=NEG; if(kv+32>qrel)p1[r]=NEG;}
}

constexpr int NSLOT=3, SLOTB=8192;
constexpr int LDS_K=0, LDS_V=NSLOT*SLOTB, LDS_WS=2*NSLOT*SLOTB, LDS_OST=LDS_WS+NW*64*4, LDS_BYTES=LDS_OST+NW*4096;
constexpr float C2=0.125f*1.4426950408889634f;
__device__ __forceinline__ void glds16(const void*gsrc,unsigned lds_dst){unsigned keep;
  asm volatile("s_mov_b32 %0, m0\n\ts_mov_b32 m0, %2\n\ts_nop 0\n\tglobal_load_lds_dwordx4 %1, off\n\ts_mov_b32 m0, %0":"=&s"(keep):"v"(gsrc),"s"(lds_dst):"memory");}
__device__ __forceinline__ float max3f(float a,float b,float c){float r;asm("v_max3_f32 %0, %1, %2, %3":"=v"(r):"v"(a),"v"(b),"v"(c));return r;}
__device__ __forceinline__ float max2f(float a,float b){float r;asm("v_max_f32_e32 %0, %1, %2":"=v"(r):"v"(a),"v"(b));return r;}
__device__ __forceinline__ float fadd_s(float a,float b){float r;asm("v_add_f32_e32 %0, %1, %2":"=v"(r):"v"(a),"v"(b));return r;}
__device__ __forceinline__ float fsub_s(float a,float b){float r;asm("v_sub_f32_e32 %0, %1, %2":"=v"(r):"v"(a),"v"(b));return r;}
typedef float f32x2_t __attribute__((ext_vector_type(2))); typedef __bf16 bf16x2_t __attribute__((ext_vector_type(2)));
__device__ __forceinline__ unsigned cvtpk_s(float lo,float hi){f32x2_t v={lo,hi};bf16x2_t b=__builtin_convertvector(v,bf16x2_t);return __builtin_bit_cast(unsigned,b);}
__device__ __forceinline__ void glds16s(const void*sbase,unsigned voff,unsigned lds_dst){unsigned keep;
  asm volatile("s_mov_b32 %0, m0\n\ts_mov_b32 m0, %3\n\ts_nop 0\n\tglobal_load_lds_dwordx4 %1, %2\n\ts_mov_b32 m0, %0":"=&s"(keep):"v"(voff),"s"(sbase),"s"(lds_dst):"memory");}
__device__ __forceinline__ const bf16_t* uptr(const bf16_t*p){ const unsigned long long v=(unsigned long long)p; const unsigned lo=__builtin_amdgcn_readfirstlane((unsigned)v),hi=__builtin_amdgcn_readfirstlane((unsigned)(v>>32)); return (const bf16_t*)(((unsigned long long)hi<<32)|lo); }
#define WAIT_BAR(N) asm volatile("s_waitcnt vmcnt(" #N ") lgkmcnt(0)\n\ts_barrier":::"memory")

__device__ __forceinline__ void qkt(f32x16&p0,f32x16&p1,const char*Kslot,const bf16x8*qr,const f32x16&negm,int r32,int hi){
  const char*kb=Kslot+hi*1024+r32*16;
  #pragma unroll
  for(int d0=0;d0<4;++d0){
    const bf16x8 b0=*reinterpret_cast<const bf16x8*>(kb+d0*2048);
    const bf16x8 b1=*reinterpret_cast<const bf16x8*>(kb+d0*2048+512);
    if(d0==0){p0=__builtin_amdgcn_mfma_f32_32x32x16_bf16(b0,qr[0],negm,0,0,0);p1=__builtin_amdgcn_mfma_f32_32x32x16_bf16(b1,qr[0],negm,0,0,0);}
    else{p0=__builtin_amdgcn_mfma_f32_32x32x16_bf16(b0,qr[d0],p0,0,0,0);p1=__builtin_amdgcn_mfma_f32_32x32x16_bf16(b1,qr[d0],p1,0,0,0);}}
}
typedef __attribute__((address_space(3))) const char* lds_cptr;
typedef short v4i16_t __attribute__((ext_vector_type(4)));
__device__ __forceinline__ void kload8(bf16x8*kf,lds_cptr kp){
  kf[0]=*(const __attribute__((address_space(3))) bf16x8*)(kp);      kf[1]=*(const __attribute__((address_space(3))) bf16x8*)(kp+512);
  kf[2]=*(const __attribute__((address_space(3))) bf16x8*)(kp+2048); kf[3]=*(const __attribute__((address_space(3))) bf16x8*)(kp+2560);
  kf[4]=*(const __attribute__((address_space(3))) bf16x8*)(kp+4096); kf[5]=*(const __attribute__((address_space(3))) bf16x8*)(kp+4608);
  kf[6]=*(const __attribute__((address_space(3))) bf16x8*)(kp+6144); kf[7]=*(const __attribute__((address_space(3))) bf16x8*)(kp+6656);
}
__device__ __forceinline__ void kload2(bf16x8*kf,lds_cptr kp,int j){ kf[2*j]=*(const __attribute__((address_space(3))) bf16x8*)(kp+j*2048); kf[2*j+1]=*(const __attribute__((address_space(3))) bf16x8*)(kp+j*2048+512); }
__device__ __forceinline__ s16x4 vtr(lds_cptr p){ return __builtin_bit_cast(s16x4,__builtin_amdgcn_ds_read_tr16_b64_v4i16((__attribute__((address_space(3))) v4i16_t*)p)); }
__device__ __forceinline__ float rowmax(const f32x16&p0,const f32x16&p1){
  float a=max3f(p0[0],p0[1],p1[0]),b=max3f(p0[2],p0[3],p1[1]);a=max3f(a,p1[2],p1[3]);
  #pragma unroll
  for(int r=4;r<16;r+=4){a=max3f(a,p0[r],p0[r+1]);b=max3f(b,p0[r+2],p0[r+3]);a=max3f(a,p1[r],p1[r+1]);b=max3f(b,p1[r+2],p1[r+3]);}
  const float m=max2f(a,b);
  auto rr=__builtin_amdgcn_permlane32_swap(__float_as_uint(m),__float_as_uint(m),false,false);
  return max2f(__uint_as_float(rr[0]),__uint_as_float(rr[1]));
}
__device__ __forceinline__ void pv(f32x16*o,int vb,bf16x8 pa0,bf16x8 pa1,bf16x8 pa2,bf16x8 pa3){
  #pragma unroll
  for(int d0=0;d0<2;++d0){s16x4 lo[4],hi[4];
    #pragma unroll
    for(int ks=0;ks<4;++ks){
      asm volatile("ds_read_b64_tr_b16 %0,%1 offset:%c2":"=&v"(lo[ks]):"v"(vb),"i"(d0*4096+ks*1024):"memory");
      asm volatile("ds_read_b64_tr_b16 %0,%1 offset:%c2":"=&v"(hi[ks]):"v"(vb),"i"(d0*4096+ks*1024+512):"memory");}
    asm volatile("s_waitcnt lgkmcnt(0)":::"memory");SBAR();
    #define PK(k) (bf16x8){lo[k][0],lo[k][1],lo[k][2],lo[k][3],hi[k][0],hi[k][1],hi[k][2],hi[k][3]}
    o[d0]=__builtin_amdgcn_mfma_f32_32x32x16_bf16(pa0,PK(0),o[d0],0,0,0);
    o[d0]=__builtin_amdgcn_mfma_f32_32x32x16_bf16(pa1,PK(1),o[d0],0,0,0);
    o[d0]=__builtin_amdgcn_mfma_f32_32x32x16_bf16(pa2,PK(2),o[d0],0,0,0);
    o[d0]=__builtin_amdgcn_mfma_f32_32x32x16_bf16(pa3,PK(3),o[d0],0,0,0);
    #undef PK
  }
}

#ifndef NEGM_PERIODIC
#define NEGM_PERIODIC 0
#endif
#ifndef NEGM_MFMA
#define NEGM_MFMA 0
#endif
#ifndef CMASK_SKIP
#define CMASK_SKIP 0
#endif
#ifndef ATTN_STORE16
#define ATTN_STORE16(p,v) (*(u32x4*)(p)=(v))
#endif
template<int THRL,bool NOMAX=false> __device__ __forceinline__ void attn_unit(int qb,int b8,int h,const bf16*Q,const bf16*__restrict__ K,const bf16*__restrict__ V,bf16*O,const Ctx&B,char*shm,int wave_s){
  int lane=pg8::lane_now(); const int tid=wave_s*64+lane;
  const int r32=lane&31,hi=lane>>5; const int wid=wave_s;
  const int q0=qb*QB;
  const bf16*Qw=Q+(long)(q0+wid*QBLK)*DM;
  const bf16*Kh=K,*Vh=V;
  const unsigned lds0=(unsigned)(uintptr_t)shm;
  float*wsf=(float*)(shm+LDS_WS)+wid*64;
  const unsigned koff=(unsigned)(lane*DM+wid*8)*2u;
  const unsigned voffv=(unsigned)((16*(wid&3)+(lane>>2))*DM+(wid>>2)*32+(lane&3)*8)*2u;
  const unsigned kdst=lds0+LDS_K+wid*1024, vdst=lds0+LDS_V+wid*1024;
  #define DMA_K(t,slot) glds16s(uptr(Kh+(long)(t)*KVBLK*DM),koff,(unsigned)__builtin_amdgcn_readfirstlane(kdst+(slot)))
  #define DMA_V(t,slot) glds16s(uptr(Vh+(long)(t)*KVBLK*DM),voffv,(unsigned)__builtin_amdgcn_readfirstlane(vdst+(slot)))
  const int vb0=(int)(lds0+LDS_V)+((lane>>4)&1)*32+(lane&3)*8+(4*hi+((lane&15)>>2))*64;
  const char*Kbase=shm+LDS_K; bf16x8 kf[8];
  const lds_cptr shm3=(lds_cptr)shm; const lds_cptr kp0=shm3+LDS_K+hi*1024+r32*16; const lds_cptr vp0=shm3+LDS_V+((lane>>4)&1)*32+(lane&3)*8+(4*hi+((lane&15)>>2))*64;
  const int NT=(q0+QB)/KVBLK;
  DMA_K(0,0);DMA_V(0,0);DMA_K(1,SLOTB);
  bf16x8 qr[4];
  #pragma unroll
  for(int d0=0;d0<4;++d0)qr[d0]=__builtin_nontemporal_load(reinterpret_cast<const bf16x8*>(&Qw[(long)r32*DM+d0*16+hi*8]));
  unsigned sel=0xffu;
  if(qb>3){
    int r32o=r32; asm volatile("":"+v"(r32o));
    f32x16 G=f32x16{};
    #pragma unroll
    for(int d0=0;d0<4;++d0){ float km[8];
      #pragma unroll
      for(int j=0;j<8;++j)km[j]=0.f;
      if(r32o<qb){ const float*kpp=B.KMEANP()+(size_t)(b8+r32o)*4*512+h*64+d0*16+hi*8;
        #pragma unroll
        for(int qq=0;qq<4;++qq){ const f32x4 a=*(const f32x4*)(kpp+qq*512),bb=*(const f32x4*)(kpp+qq*512+4);
          #pragma unroll
          for(int j=0;j<4;++j){km[j]+=a[j];km[4+j]+=bb[j];} } }
      unsigned whi[4],wlo[4];
      #pragma unroll
      for(int w=0;w<4;++w){ whi[w]=cvtpk_s(km[2*w],km[2*w+1]); wlo[w]=cvtpk_s(km[2*w]-__uint_as_float(whi[w]<<16),km[2*w+1]-__uint_as_float(whi[w]&0xffff0000u)); }
      const u32x4 vh={whi[0],whi[1],whi[2],whi[3]},vl={wlo[0],wlo[1],wlo[2],wlo[3]};
      G=__builtin_amdgcn_mfma_f32_32x32x16_bf16(__builtin_bit_cast(bf16x8,vh),qr[d0],G,0,0,0);
      G=__builtin_amdgcn_mfma_f32_32x32x16_bf16(__builtin_bit_cast(bf16x8,vl),qr[d0],G,0,0,0); }
    float gate[8];
    #pragma unroll
    for(int r=0;r<4;++r){ auto rr=__builtin_amdgcn_permlane32_swap(__float_as_uint(G[r]),__float_as_uint(G[r]),false,false); gate[r]=__uint_as_float(rr[0]); gate[4+r]=__uint_as_float(rr[1]); }
    #pragma unroll
    for(int j=0;j<8;++j)if(j>=qb)gate[j]=-INFINITY;
    sel=0u;
    #pragma unroll
    for(int j=0;j<8;++j){ int rank=0;
      #pragma unroll
      for(int i=0;i<8;++i)rank+=(gate[i]>gate[j]||(gate[i]==gate[j]&&i<j))?1:0;
      if(j<qb&&rank<3)sel|=1u<<j; }
  }
  float mhat=0.f,l_reg=0.f;f32x16 o[2];o[0]=f32x16{};o[1]=f32x16{};f32x16 negm;
#if NEGM_MFMA
  #define SETNEGM(tt) do{ const float nm_=((tt)>=NT-4||((sel>>((tt)>>2))&1u))?-mhat:-INFINITY; const float z16_ __attribute__((ext_vector_type(16)))={0.f,0.f,0.f,0.f,0.f,0.f,0.f,0.f,0.f,0.f,0.f,0.f,0.f,0.f,0.f,0.f}; \
      negm=__builtin_amdgcn_mfma_f32_32x32x2f32(hi?0.f:1.f,hi?0.f:nm_,z16_,0,0,0); }while(0)
#else
  #define SETNEGM(tt) do{ const float nm_=((tt)>=NT-4||((sel>>((tt)>>2))&1u))?-mhat:-INFINITY; _Pragma("unroll") for(int r=0;r<16;++r)negm[r]=nm_; asm volatile("":"+v"(negm)); }while(0)
#endif
  const int qrel=wid*QBLK+r32;
  #define CMASK(P0,P1,t) do{int jb_=(t)-(NT-4); if(CMASK_SKIP>1&&jb_>(wid>>1)){ _Pragma("unroll") for(int r_=0;r_<16;++r_){P0[r_]=-INFINITY;P1[r_]=-INFINITY;} } else if(jb_>=(CMASK_SKIP?(wid>>1):0))cmask(P0,P1,jb_,qrel,hi);}while(0)
  bool resc=false;
  #define START(P0,P1) do{ if(NOMAX){ resc=false;   } else { const float rm=rowmax(P0,P1); resc=false; \
    { const float dl=(rm==-INFINITY)?0.f:rm; mhat=fadd_s(mhat,dl); \
      _Pragma("unroll") for(int r=0;r<16;++r){P0[r]=fsub_s(P0[r],dl);P1[r]=fsub_s(P1[r],dl);} \
      SETNEGM(1); } } \
    _Pragma("unroll") for(int r=0;r<16;++r)P0[r]=__builtin_amdgcn_exp2f(P0[r]); }while(0)
  #define RESC() do{ if(resc){ asm volatile("s_waitcnt lgkmcnt(0)":::"memory"); \
      _Pragma("unroll") for(int d_=0;d_<2;++d_) _Pragma("unroll") for(int r=0;r<16;++r)o[d_][r]*=wsf[crow(r,hi)]; } }while(0)
  f32x16 pA0,pA1,pB0,pB1;
  int sl_prev=0,sl_cur=0,sl_next=SLOTB;
  #define ROT() do{sl_prev=sl_cur;sl_cur=sl_next;sl_next=(sl_next==(NSLOT-1)*SLOTB)?0:sl_next+SLOTB;}while(0)
  DMA_K(2,2*SLOTB);
  WAIT_BAR(3);
  SETNEGM(0);
  qkt(pA0,pA1,Kbase,qr,negm,r32,hi);asm volatile("s_nop 15\n\ts_nop 7":"+v"(pA0),"+v"(pA1));CMASK(pA0,pA1,0);
  START(pA0,pA1);
  _Pragma("unroll") for(int r=0;r<16;++r)pA1[r]=__builtin_amdgcn_exp2f(pA1[r]);
  WAIT_BAR(0);
  DMA_K(3,0);DMA_V(1,SLOTB);
  ROT();
  kload8(kf,kp0+sl_cur);
  WAIT_BAR(2);
  s16x4 vlo[8],vhi[8]; u32x4 pw0,pw1,pw2,pw3;
  #define PKW(P,B) cvtpk_s(P[B],P[B+1])
  #define PAF(k) __builtin_bit_cast(bf16x8,pw##k)
  #define VFR(i) (bf16x8){vlo[i][0],vlo[i][1],vlo[i][2],vlo[i][3],vhi[i][0],vhi[i][1],vhi[i][2],vhi[i][3]}
  #define PIN(x) asm volatile("":"+v"(x))
  #define MX3(a,b,c) __builtin_fmaxf(__builtin_fmaxf((a),(b)),(c))
  #define GAPA(MF,A0,A1,A2,A3,W0,W1,PW) do{ MF; sacc+=A0; sacc+=A1; sacc+=A2; sacc+=A3; PIN(sacc); W0; W1; PIN(PW); SBAR(); }while(0)
  #define EX(v) __builtin_amdgcn_exp2f(v)
  #define GAPB(MF,X,B) do{ MF; X[B]=EX(X[B]); X[B+1]=EX(X[B+1]); X[B+2]=EX(X[B+2]); X[B+3]=EX(X[B+3]); PIN(X); SBAR(); }while(0)
  #define VRD(i) do{ vlo[i]=vtr(vp_+(((i)>>2)*4096+((i)&3)*1024)); vhi[i]=vtr(vp_+(((i)>>2)*4096+((i)&3)*1024+512)); }while(0)
  #define KRD(G,j) do{ if(G){ kload2(kf,kp0+sl_next,j); SBAR(); } }while(0)
  #define STEP(C0,C1,P0,P1,t,GK,GV,GL) do{ SBAR(); \
    const lds_cptr vp_=vp0+sl_prev; \
    VRD(0); SBAR(); float sacc=(P0[0]+P0[1]); \
    GAPA(C0=__builtin_amdgcn_mfma_f32_32x32x16_bf16(kf[0],qr[0],negm,0,0,0), P0[2],P0[3],P0[4],P0[5],     pw0[0]=PKW(P0,0), pw0[1]=PKW(P0,2), pw0); \
    VRD(4); SBAR(); GAPA(C1=__builtin_amdgcn_mfma_f32_32x32x16_bf16(kf[1],qr[0],negm,0,0,0), P0[6],P0[7],P0[8],P0[9],     pw0[2]=PKW(P0,4), pw0[3]=PKW(P0,6), pw0); \
    VRD(1); SBAR(); GAPA(C0=__builtin_amdgcn_mfma_f32_32x32x16_bf16(kf[2],qr[1],C0,0,0,0),   P0[10],P0[11],P0[12],P0[13], pw1[0]=PKW(P0,8), pw1[1]=PKW(P0,10), pw1); \
    VRD(5); SBAR(); GAPA(C1=__builtin_amdgcn_mfma_f32_32x32x16_bf16(kf[3],qr[1],C1,0,0,0),   P0[14],P0[15],P1[0],P1[1],   pw1[2]=PKW(P0,12),pw1[3]=PKW(P0,14), pw1); \
    VRD(2); SBAR(); GAPA(C0=__builtin_amdgcn_mfma_f32_32x32x16_bf16(kf[4],qr[2],C0,0,0,0),   P1[2],P1[3],P1[4],P1[5],     pw2[0]=PKW(P1,0), pw2[1]=PKW(P1,2), pw2); \
    VRD(6); SBAR(); GAPA(C1=__builtin_amdgcn_mfma_f32_32x32x16_bf16(kf[5],qr[2],C1,0,0,0),   P1[6],P1[7],P1[8],P1[9],     pw2[2]=PKW(P1,4), pw2[3]=PKW(P1,6), pw2); \
    VRD(3); SBAR(); GAPA(C0=__builtin_amdgcn_mfma_f32_32x32x16_bf16(kf[6],qr[3],C0,0,0,0),   P1[10],P1[11],P1[12],P1[13], pw3[0]=PKW(P1,8), pw3[1]=PKW(P1,10), pw3); \
    VRD(7); SBAR(); GAPA(C1=__builtin_amdgcn_mfma_f32_32x32x16_bf16(kf[7],qr[3],C1,0,0,0),   P1[14],P1[15],0.f,0.f,       pw3[2]=PKW(P1,12),pw3[3]=PKW(P1,14), pw3); \
    l_reg+=sacc; \
    if(GK){DMA_K((t)+3,sl_cur);} if(GV){DMA_V((t)+1,sl_next);} \
    CMASK(C0,C1,t); \
    if(NOMAX){ resc=false; if(NEGM_PERIODIC?((((t)+1)&3)==0):true){ SETNEGM((t)+1); } } else \
    { float a=MX3(C0[0],C0[1],C1[0]),b=MX3(C0[2],C0[3],C1[1]); a=MX3(a,C1[2],C1[3]); \
      _Pragma("unroll") for(int r=4;r<16;r+=4){a=MX3(a,C0[r],C0[r+1]);b=MX3(b,C0[r+2],C0[r+3]);a=MX3(a,C1[r],C1[r+1]);b=MX3(b,C1[r+2],C1[r+3]);} \
      float rm=__builtin_fmaxf(a,b); { auto rr=__builtin_amdgcn_permlane32_swap(__float_as_uint(rm),__float_as_uint(rm),false,false); rm=__builtin_fmaxf(__uint_as_float(rr[0]),__uint_as_float(rr[1])); } \
      resc=false; \
      if(__builtin_expect(__any(rm>(float)THRL),0)){ const float dl=__builtin_fmaxf(rm,0.f); mhat+=dl; \
        _Pragma("unroll") for(int r=0;r<16;++r){C0[r]-=dl;C1[r]-=dl;} \
        const float f=__builtin_amdgcn_exp2f(-dl); l_reg*=f; if(hi==0)wsf[r32]=f; resc=true; } \
      SETNEGM((t)+1); } \
    SBAR(); \
    GAPB(o[0]=__builtin_amdgcn_mfma_f32_32x32x16_bf16(PAF(0),VFR(0),o[0],0,0,0), C0,0); \
    GAPB(o[1]=__builtin_amdgcn_mfma_f32_32x32x16_bf16(PAF(0),VFR(4),o[1],0,0,0), C0,4); \
    KRD(GL,0); GAPB(o[0]=__builtin_amdgcn_mfma_f32_32x32x16_bf16(PAF(1),VFR(1),o[0],0,0,0), C0,8); \
    KRD(GL,1); GAPB(o[1]=__builtin_amdgcn_mfma_f32_32x32x16_bf16(PAF(1),VFR(5),o[1],0,0,0), C0,12); \
    KRD(GL,2); GAPB(o[0]=__builtin_amdgcn_mfma_f32_32x32x16_bf16(PAF(2),VFR(2),o[0],0,0,0), C1,0); \
    KRD(GL,3); GAPB(o[1]=__builtin_amdgcn_mfma_f32_32x32x16_bf16(PAF(2),VFR(6),o[1],0,0,0), C1,4); \
    GAPB(o[0]=__builtin_amdgcn_mfma_f32_32x32x16_bf16(PAF(3),VFR(3),o[0],0,0,0), C1,8); \
    GAPB(o[1]=__builtin_amdgcn_mfma_f32_32x32x16_bf16(PAF(3),VFR(7),o[1],0,0,0), C1,12); \
    }while(0)
  int t=1;
  #undef CMASK
  #define CMASK(P0,P1,t) do{}while(0)
  for(;t+5<NT;t+=2){
    STEP(pB0,pB1,pA0,pA1,t,true,true,true);     WAIT_BAR(2); RESC(); ROT();
    STEP(pA0,pA1,pB0,pB1,t+1,true,true,true);   WAIT_BAR(2); RESC(); ROT();
  }
  #undef CMASK
  #define CMASK(P0,P1,t) do{int jb_=(t)-(NT-4); if(CMASK_SKIP>1&&jb_>(wid>>1)){ _Pragma("unroll") for(int r_=0;r_<16;++r_){P0[r_]=-INFINITY;P1[r_]=-INFINITY;} } else if(jb_>=(CMASK_SKIP?(wid>>1):0))cmask(P0,P1,jb_,qrel,hi);}while(0)
  #define ENDW(tt) do{ if((tt)+3<NT){WAIT_BAR(2);} else if((tt)+2<NT){WAIT_BAR(1);} else {WAIT_BAR(0);} }while(0)
  for(;t+1<NT;t+=2){
    STEP(pB0,pB1,pA0,pA1,t,(t+3<NT),(t+1<NT),(t+1<NT));       ENDW(t);   RESC(); ROT();
    STEP(pA0,pA1,pB0,pB1,t+1,(t+4<NT),(t+2<NT),(t+2<NT));     ENDW(t+1); RESC(); ROT();
  }
  STEP(pB0,pB1,pA0,pA1,NT-1,false,false,false); RESC();
  { float sacc=pB0[0]+pB0[1]; _Pragma("unroll") for(int r=2;r<16;++r)sacc+=pB0[r]; _Pragma("unroll") for(int r=0;r<16;++r)sacc+=pB1[r]; l_reg+=sacc;
    pw0=(u32x4){PKW(pB0,0),PKW(pB0,2),PKW(pB0,4),PKW(pB0,6)};pw1=(u32x4){PKW(pB0,8),PKW(pB0,10),PKW(pB0,12),PKW(pB0,14)};pw2=(u32x4){PKW(pB1,0),PKW(pB1,2),PKW(pB1,4),PKW(pB1,6)};pw3=(u32x4){PKW(pB1,8),PKW(pB1,10),PKW(pB1,12),PKW(pB1,14)};
    SBAR(); pv(o,vb0+sl_cur,PAF(0),PAF(1),PAF(2),PAF(3)); }
  #undef PKW
  #undef PAF
  #undef VFR
  #undef PIN
  #undef MX3
  #undef GAPA
  #undef GAPB
  #undef EX
  #undef VRD
  #undef KRD
  #undef STEP
  #undef ENDW
  {auto rr=__builtin_amdgcn_permlane32_swap(__float_as_uint(l_reg),__float_as_uint(l_reg),false,false);l_reg=__uint_as_float(rr[0])+__uint_as_float(rr[1]);}
  if(hi==0)wsf[32+r32]=l_reg;asm volatile("s_waitcnt lgkmcnt(0)":::"memory");
  float rli[16];
  #pragma unroll
  for(int r=0;r<16;++r)rli[r]=__builtin_amdgcn_rcpf(wsf[32+crow(r,hi)]);
  int lno=lane; asm volatile("":"+v"(lno));
  bf16*Ow=O+(long)(q0+wid*QBLK)*DMO;
  { bf16*stg=(bf16*)(shm+LDS_OST)+wid*2048;
    #pragma unroll
    for(int r=0;r<16;++r){const int orow=crow(r,hi);
      #pragma unroll
      for(int d0=0;d0<2;++d0)stg[orow*64+d0*32+r32]=(bf16)(cvtpk_s(o[d0][r]*rli[r],0.f)&0xffffu);}
    asm volatile("s_waitcnt lgkmcnt(0)":::"memory");
    #pragma unroll
    for(int i=0;i<4;++i){const int row=i*8+(lno>>3),ch=lno&7; const u32x4 v=*(const u32x4*)(stg+row*64+ch*8); ATTN_STORE16(Ow+(long)row*DMO+ch*8,v);} }
  asm volatile("s_waitcnt lgkmcnt(0)\n\ts_barrier":::"memory");
  #undef DMA_K
  #undef DMA_V
  #undef CMASK
  #undef START
  #undef RESC
  #undef ROT
}
constexpr int ATTN_LDS_BYTES=LDS_BYTES;
#undef SBAR
#undef WAIT_BAR
#undef SETNEGM
}
namespace attl {
using bf16=bf16_t;
using bf16x8=__attribute__((ext_vector_type(8)))short;
using s16x4=__attribute__((ext_vector_type(4)))short;
using f32x16=__attribute__((ext_vector_type(16)))float;
using u32x4=__attribute__((ext_vector_type(4)))unsigned;
using f32x4=__attribute__((ext_vector_type(4)))float;
constexpr int DMK=768,DMV=512,DMO=1024;
constexpr int NW=8,QBLK=32,QB=QBLK*NW,KVBLK=64;
__device__ __forceinline__ int crow(int r,int hi){return (r&3)+8*(r>>2)+4*hi;}
#define SBAR() __builtin_amdgcn_sched_barrier(0)
__device__ __forceinline__ void cmask(f32x16&p0,f32x16&p1,int jb,int qrel,int hi){
  const float NEG=-INFINITY; int kb=64*jb+4*hi;
  #pragma unroll
  for(int r=0;r<16;++r){int kv=kb+(r&3)+8*(r>>2); if(kv>qrel)p0[r]=NEG; if(kv+32>qrel)p1[r]=NEG;}
}

constexpr int NSLOT=3, SLOTK=12288, SLOTV=8192;
constexpr int LDS_K=0, LDS_V=NSLOT*SLOTK, LDS_WS=LDS_V+NSLOT*SLOTV, LDS_OST=LDS_WS+NW*64*4, LDS_BYTES=LDS_OST+NW*4096;
constexpr float C2=0.125f*1.4426950408889634f;
__device__ __forceinline__ void glds16(const void*gsrc,unsigned lds_dst){unsigned keep;
  asm volatile("s_mov_b32 %0, m0\n\ts_mov_b32 m0, %2\n\ts_nop 0\n\tglobal_load_lds_dwordx4 %1, off\n\ts_mov_b32 m0, %0":"=&s"(keep):"v"(gsrc),"s"(lds_dst):"memory");}
__device__ __forceinline__ float max3f(float a,float b,float c){float r;asm("v_max3_f32 %0, %1, %2, %3":"=v"(r):"v"(a),"v"(b),"v"(c));return r;}
__device__ __forceinline__ float max2f(float a,float b){float r;asm("v_max_f32_e32 %0, %1, %2":"=v"(r):"v"(a),"v"(b));return r;}
__device__ __forceinline__ float fadd_s(float a,float b){float r;asm("v_add_f32_e32 %0, %1, %2":"=v"(r):"v"(a),"v"(b));return r;}
__device__ __forceinline__ float fsub_s(float a,float b){float r;asm("v_sub_f32_e32 %0, %1, %2":"=v"(r):"v"(a),"v"(b));return r;}
typedef float f32x2_t __attribute__((ext_vector_type(2))); typedef __bf16 bf16x2_t __attribute__((ext_vector_type(2)));
__device__ __forceinline__ unsigned cvtpk_s(float lo,float hi){f32x2_t v={lo,hi};bf16x2_t b=__builtin_convertvector(v,bf16x2_t);return __builtin_bit_cast(unsigned,b);}
__device__ __forceinline__ void glds16s(const void*sbase,unsigned voff,unsigned lds_dst){unsigned keep;
  asm volatile("s_mov_b32 %0, m0\n\ts_mov_b32 m0, %3\n\ts_nop 0\n\tglobal_load_lds_dwordx4 %1, %2\n\ts_mov_b32 m0, %0":"=&s"(keep):"v"(voff),"s"(sbase),"s"(lds_dst):"memory");}
__device__ __forceinline__ const bf16_t* uptr(const bf16_t*p){ const unsigned long long v=(unsigned long long)p; const unsigned lo=__builtin_amdgcn_readfirstlane((unsigned)v),hi=__builtin_amdgcn_readfirstlane((unsigned)(v>>32)); return (const bf16_t*)(((unsigned long long)hi<<32)|lo); }
#define WAIT_BAR(N) asm volatile("s_waitcnt vmcnt(" #N ") lgkmcnt(0)\n\ts_barrier":::"memory")

__device__ __forceinline__ void qkt(f32x16&p0,f32x16&p1,const char*Kslot,const bf16x8*qr,const f32x16&negm,int r32,int hi){
  const char*kb=Kslot+hi*1024+r32*16;
  #pragma unroll
  for(int d0=0;d0<6;++d0){
    const bf16x8 b0=*reinterpret_cast<const bf16x8*>(kb+d0*2048);
    const bf16x8 b1=*reinterpret_cast<const bf16x8*>(kb+d0*2048+512);
    if(d0==0){p0=__builtin_amdgcn_mfma_f32_32x32x16_bf16(b0,qr[0],negm,0,0,0);p1=__builtin_amdgcn_mfma_f32_32x32x16_bf16(b1,qr[0],negm,0,0,0);}
    else{p0=__builtin_amdgcn_mfma_f32_32x32x16_bf16(b0,qr[d0],p0,0,0,0);p1=__builtin_amdgcn_mfma_f32_32x32x16_bf16(b1,qr[d0],p1,0,0,0);}}
}
typedef __attribute__((address_space(3))) const char* lds_cptr;
typedef short v4i16_t __attribute__((ext_vector_type(4)));
__device__ __forceinline__ void kload8(bf16x8*kf,lds_cptr kp){
  kf[0]=*(const __attribute__((address_space(3))) bf16x8*)(kp);      kf[1]=*(const __attribute__((address_space(3))) bf16x8*)(kp+512);
  kf[2]=*(const __attribute__((address_space(3))) bf16x8*)(kp+2048); kf[3]=*(const __attribute__((address_space(3))) bf16x8*)(kp+2560);
  kf[4]=*(const __attribute__((address_space(3))) bf16x8*)(kp+4096); kf[5]=*(const __attribute__((address_space(3))) bf16x8*)(kp+4608);
  kf[6]=*(const __attribute__((address_space(3))) bf16x8*)(kp+6144); kf[7]=*(const __attribute__((address_space(3))) bf16x8*)(kp+6656);
  kf[8]=*(const __attribute__((address_space(3))) bf16x8*)(kp+8192); kf[9]=*(const __attribute__((address_space(3))) bf16x8*)(kp+8704);
  kf[10]=*(const __attribute__((address_space(3))) bf16x8*)(kp+10240); kf[11]=*(const __attribute__((address_space(3))) bf16x8*)(kp+10752);
}
__device__ __forceinline__ void kload2(bf16x8*kf,lds_cptr kp,int j){ kf[2*j]=*(const __attribute__((address_space(3))) bf16x8*)(kp+j*2048); kf[2*j+1]=*(const __attribute__((address_space(3))) bf16x8*)(kp+j*2048+512); }
__device__ __forceinline__ s16x4 vtr(lds_cptr p){ return __builtin_bit_cast(s16x4,__builtin_amdgcn_ds_read_tr16_b64_v4i16((__attribute__((address_space(3))) v4i16_t*)p)); }
__device__ __forceinline__ float rowmax(const f32x16&p0,const f32x16&p1){
  float a=max3f(p0[0],p0[1],p1[0]),b=max3f(p0[2],p0[3],p1[1]);a=max3f(a,p1[2],p1[3]);
  #pragma unroll
  for(int r=4;r<16;r+=4){a=max3f(a,p0[r],p0[r+1]);b=max3f(b,p0[r+2],p0[r+3]);a=max3f(a,p1[r],p1[r+1]);b=max3f(b,p1[r+2],p1[r+3]);}
  const float m=max2f(a,b);
  auto rr=__builtin_amdgcn_permlane32_swap(__float_as_uint(m),__float_as_uint(m),false,false);
  return max2f(__uint_as_float(rr[0]),__uint_as_float(rr[1]));
}
__device__ __forceinline__ void pv(f32x16*o,int vb,bf16x8 pa0,bf16x8 pa1,bf16x8 pa2,bf16x8 pa3){
  #pragma unroll
  for(int d0=0;d0<2;++d0){s16x4 lo[4],hi[4];
    #pragma unroll
    for(int ks=0;ks<4;++ks){
      asm volatile("ds_read_b64_tr_b16 %0,%1 offset:%c2":"=&v"(lo[ks]):"v"(vb),"i"(d0*4096+ks*1024):"memory");
      asm volatile("ds_read_b64_tr_b16 %0,%1 offset:%c2":"=&v"(hi[ks]):"v"(vb),"i"(d0*4096+ks*1024+512):"memory");}
    asm volatile("s_waitcnt lgkmcnt(0)":::"memory");SBAR();
    #define PK(k) (bf16x8){lo[k][0],lo[k][1],lo[k][2],lo[k][3],hi[k][0],hi[k][1],hi[k][2],hi[k][3]}
    o[d0]=__builtin_amdgcn_mfma_f32_32x32x16_bf16(pa0,PK(0),o[d0],0,0,0);
    o[d0]=__builtin_amdgcn_mfma_f32_32x32x16_bf16(pa1,PK(1),o[d0],0,0,0);
    o[d0]=__builtin_amdgcn_mfma_f32_32x32x16_bf16(pa2,PK(2),o[d0],0,0,0);
    o[d0]=__builtin_amdgcn_mfma_f32_32x32x16_bf16(pa3,PK(3),o[d0],0,0,0);
    #undef PK
  }
}

#ifndef QUP_PIPE
#define QUP_PIPE 0
#endif
#ifndef CMASK_SKIP
#define CMASK_SKIP 0
#endif
#ifndef ATTN_STORE16
#define ATTN_STORE16(p,v) (*(u32x4*)(p)=(v))
#endif
template<int THRL,bool NOMAX=false> __device__ __forceinline__ void attn_unit(int qb,const bf16*Q,const bf16*__restrict__ K,const bf16*__restrict__ V,bf16*O,const Ctx&B,char*shm,int wave_s,int h_,size_t rb_){
  int lane=pg8::lane_now(); const int tid=wave_s*64+lane;
  const int r32=lane&31,hi=lane>>5; const int wid=wave_s;
  const int q0=qb*QB;
  const bf16*Qw=Q+(long)(q0+wid*QBLK)*DMK;
  const bf16*Kh=K,*Vh=V;
  const unsigned lds0=(unsigned)(uintptr_t)shm;
  float*wsf=(float*)(shm+LDS_WS)+wid*64;
  const unsigned koff=(unsigned)(lane*DMK+wid*8)*2u, koff2=(unsigned)(lane*DMK+(8+(wid&3))*8)*2u;
  const unsigned voffv=(unsigned)((16*(wid&3)+(lane>>2))*DMV+(wid>>2)*32+(lane&3)*8)*2u;
  const unsigned kdst=lds0+LDS_K+wid*1024, kdst2=lds0+LDS_K+(8+(wid&3))*1024, vdst=lds0+LDS_V+wid*1024;
  #define DMA_K(t,slot) do{ const bf16*kb_=uptr(Kh+(long)(t)*KVBLK*DMK); glds16s(kb_,koff,(unsigned)__builtin_amdgcn_readfirstlane(kdst+(slot)*SLOTK)); glds16s(kb_,koff2,(unsigned)__builtin_amdgcn_readfirstlane(kdst2+(slot)*SLOTK)); }while(0)
  #define DMA_V(t,slot) glds16s(uptr(Vh+(long)(t)*KVBLK*DMV),voffv,(unsigned)__builtin_amdgcn_readfirstlane(vdst+(slot)*SLOTV))
  const char*Kbase=shm+LDS_K; bf16x8 kf[12];
  const lds_cptr shm3=(lds_cptr)shm; const lds_cptr kp0=shm3+LDS_K+hi*1024+r32*16; const lds_cptr vp0=shm3+LDS_V+((lane>>4)&1)*32+(lane&3)*8+(4*hi+((lane&15)>>2))*64;
  const int NT=(q0+QB)/KVBLK;
  DMA_K(0,0);DMA_V(0,0);DMA_K(1,1);
#if QUP_FUSED
  constexpr int LDS_W=LDS_OST;
  { const bf16*whu=uptr(B.WQUP()+(size_t)h_*(96*256));
    #pragma unroll
    for(int j=0;j<6;++j){ const int p=wid*6+j,c=p*64+lane,row=c>>5,kc=(c&31)^(row&31);
      glds16s(whu,(unsigned)((row*256+kc*8)*2),(unsigned)__builtin_amdgcn_readfirstlane((int)(lds0+LDS_W)+p*1024)); } }
  bf16x8 qr[6];
  { const bf16*Cw=Q+(long)(q0+wid*QBLK+r32)*384+hi*8; bf16x8 cf[16];
    #pragma unroll
    for(int ks=0;ks<16;++ks)cf[ks]=*reinterpret_cast<const bf16x8*>(Cw+ks*16);
    const f32x4 s4=*(const f32x4*)(B.CQSS()+(rb_+(size_t)(q0+wid*QBLK+r32))*4);
    asm volatile("s_waitcnt vmcnt(0)\n\ts_barrier":::"memory");
    DMA_K(2,2);
    const int ri=(r32&3)+4*(r32>>3), pi=16*(ri>>3)+8*((r32>>2)&1)+(ri&7);
    const lds_cptr wp=shm3+LDS_W+pi*512;
    f32x16 qa[3]; qa[0]=f32x16{}; qa[1]=f32x16{}; qa[2]=f32x16{};
    asm volatile("":"+v"(qa[0]),"+v"(qa[1]),"+v"(qa[2]));
#if QUP_PIPE
    bf16x8 wq[3][3];
    #define LOADW(S,KS) do{ const int sw_=(((2*(KS)+hi)^pi)&31)*16; _Pragma("unroll") for(int T=0;T<3;++T)wq[S][T]=*(const __attribute__((address_space(3))) bf16x8*)(wp+T*(32*512)+sw_); }while(0)
    LOADW(0,0); LOADW(1,1); SBAR();
    #pragma unroll
    for(int ks=0;ks<16;++ks){ if(ks+2<16){ LOADW((ks+2)%3,ks+2); } SBAR();
      #pragma unroll
      for(int T=0;T<3;++T)qa[T]=__builtin_amdgcn_mfma_f32_32x32x16_bf16(wq[ks%3][T],cf[ks],qa[T],0,0,0);
      SBAR(); }
    #undef LOADW
#else
    #pragma unroll
    for(int ks=0;ks<16;++ks){ const int sw=(((2*ks+hi)^pi)&31)*16;
      #pragma unroll
      for(int T=0;T<3;++T){ const bf16x8 wa=*(const __attribute__((address_space(3))) bf16x8*)(wp+T*(32*512)+sw); qa[T]=__builtin_amdgcn_mfma_f32_32x32x16_bf16(wa,cf[ks],qa[T],0,0,0); } }
#endif
    const float rc=__builtin_amdgcn_rsqf((s4[0]+s4[1]+s4[2]+s4[3])*(1.0f/256)+EPS);
    float qf[6][8]; float ss=0.f;
    #pragma unroll
    for(int d0=0;d0<6;++d0)
      #pragma unroll
      for(int e=0;e<8;++e){ const float v=qa[d0>>1][8*(d0&1)+e]*rc; qf[d0][e]=v; ss+=v*v; }
    { auto rr=__builtin_amdgcn_permlane32_swap(__float_as_uint(ss),__float_as_uint(ss),false,false); ss=__uint_as_float(rr[0])+__uint_as_float(rr[1]); }
    const float rq=(1.0f/sqrtf(ss*(1.0f/96)+EPS))*C2B; const float*g=B.glq()+hi*8;
    #pragma unroll
    for(int d0=0;d0<6;++d0){ const f32x4 ga=*(const f32x4*)(g+d0*16),gb=*(const f32x4*)(g+d0*16+4);
      #pragma unroll
      for(int e=0;e<8;++e)qf[d0][e]*=rq*(e<4?ga[e]:gb[e-4]); }
    { const int pos=q0+wid*QBLK+r32; const f32x4 ca=*(const f32x4*)(B.COSB()+pos*16+hi*8),cb=*(const f32x4*)(B.COSB()+pos*16+hi*8+4),sa=*(const f32x4*)(B.SINB()+pos*16+hi*8),sb=*(const f32x4*)(B.SINB()+pos*16+hi*8+4);
      #pragma unroll
      for(int j=0;j<8;++j){ const float c=j<4?ca[j]:cb[j-4],sn=j<4?sa[j]:sb[j-4],x1=qf[4][j],x2=qf[5][j]; qf[4][j]=x1*c-x2*sn; qf[5][j]=x2*c+x1*sn; } }
    #pragma unroll
    for(int d0=0;d0<6;++d0){ const u32x4 w={cvtpk_s(qf[d0][0],qf[d0][1]),cvtpk_s(qf[d0][2],qf[d0][3]),cvtpk_s(qf[d0][4],qf[d0][5]),cvtpk_s(qf[d0][6],qf[d0][7])}; qr[d0]=__builtin_bit_cast(bf16x8,w); } }
#else
  bf16x8 qr[6];
  { u32x4 raw[6]; float ss=0.f; const bf16*Ql=Qw+(long)r32*DMK+hi*8;
    #pragma unroll
    for(int d0=0;d0<6;++d0){ raw[d0]=__builtin_nontemporal_load(reinterpret_cast<const u32x4*>(Ql+d0*16));
      #pragma unroll
      for(int w=0;w<4;++w){ const float a=__uint_as_float(raw[d0][w]<<16),bb=__uint_as_float(raw[d0][w]&0xffff0000u); ss+=a*a+bb*bb; } }
    { auto rr=__builtin_amdgcn_permlane32_swap(__float_as_uint(ss),__float_as_uint(ss),false,false); ss=__uint_as_float(rr[0])+__uint_as_float(rr[1]); }
    const float rq=(1.0f/sqrtf(ss*(1.0f/96)+EPS))*C2B; const float*g=B.glq()+hi*8;
    float qf[6][8];
    #pragma unroll
    for(int d0=0;d0<6;++d0){ const f32x4 ga=*(const f32x4*)(g+d0*16),gb=*(const f32x4*)(g+d0*16+4);
      #pragma unroll
      for(int w=0;w<4;++w){ qf[d0][2*w]=__uint_as_float(raw[d0][w]<<16)*rq*(w<2?ga[2*w]:gb[2*w-4]); qf[d0][2*w+1]=__uint_as_float(raw[d0][w]&0xffff0000u)*rq*(w<2?ga[2*w+1]:gb[2*w-3]); } }
    { const int pos=q0+wid*QBLK+r32; const f32x4 ca=*(const f32x4*)(B.COSB()+pos*16+hi*8),cb=*(const f32x4*)(B.COSB()+pos*16+hi*8+4),sa=*(const f32x4*)(B.SINB()+pos*16+hi*8),sb=*(const f32x4*)(B.SINB()+pos*16+hi*8+4);
      #pragma unroll
      for(int j=0;j<8;++j){ const float c=j<4?ca[j]:cb[j-4],sn=j<4?sa[j]:sb[j-4],x1=qf[4][j],x2=qf[5][j]; qf[4][j]=x1*c-x2*sn; qf[5][j]=x2*c+x1*sn; } }
    #pragma unroll
    for(int d0=0;d0<6;++d0){ const u32x4 w={cvtpk_s(qf[d0][0],qf[d0][1]),cvtpk_s(qf[d0][2],qf[d0][3]),cvtpk_s(qf[d0][4],qf[d0][5]),cvtpk_s(qf[d0][6],qf[d0][7])}; qr[d0]=__builtin_bit_cast(bf16x8,w); } }
#endif
  float mhat=0.f,l_reg=0.f;f32x16 o[2];o[0]=f32x16{};o[1]=f32x16{};
  int never_=0; asm volatile("":"+s"(never_));
  #define MSUB(tt) (mhat)
  const int qrel=wid*QBLK+r32;
  #define CMASK(P0,P1,t) do{int jb_=(t)-(NT-4); if(CMASK_SKIP>1&&jb_>(wid>>1)){ _Pragma("unroll") for(int r_=0;r_<16;++r_){P0[r_]=-INFINITY;P1[r_]=-INFINITY;} } else if(jb_>=(CMASK_SKIP?(wid>>1):0))cmask(P0,P1,jb_,qrel,hi);}while(0)
  bool resc=false;
  #define START(P0,P1) do{ if(NOMAX){ resc=false; msub0=0.f; _Pragma("unroll") for(int r=0;r<16;++r)P0[r]=__builtin_amdgcn_exp2f(P0[r]); } else { \
    const float rm=fsub_s(rowmax(P0,P1),MSUB(0)); resc=false; \
    { const float dl=(rm==-INFINITY)?0.f:rm; mhat=fadd_s(mhat,dl); } \
    msub0=MSUB(0); \
    _Pragma("unroll") for(int r=0;r<16;++r)P0[r]=__builtin_amdgcn_exp2f(fsub_s(P0[r],msub0)); } }while(0)
  #define RESC() do{ if(resc){ asm volatile("s_waitcnt lgkmcnt(0)":::"memory"); \
      _Pragma("unroll") for(int d_=0;d_<2;++d_) _Pragma("unroll") for(int r=0;r<16;++r)o[d_][r]*=wsf[crow(r,hi)]; } }while(0)
  f32x16 pA0,pA1,pB0,pB1;
  int sl_prev=0,sl_cur=0,sl_next=1;
  #define ROT() do{sl_prev=sl_cur;sl_cur=sl_next;sl_next=(sl_next==NSLOT-1)?0:sl_next+1;}while(0)
#if !QUP_FUSED
  DMA_K(2,2);
#endif
  WAIT_BAR(5);
  const f32x16 zc=f32x16{}; float msub0;
  qkt(pA0,pA1,Kbase,qr,zc,r32,hi);asm volatile("s_nop 15\n\ts_nop 7":"+v"(pA0),"+v"(pA1));CMASK(pA0,pA1,0);
  START(pA0,pA1);
  _Pragma("unroll") for(int r=0;r<16;++r)pA1[r]=NOMAX?__builtin_amdgcn_exp2f(pA1[r]):__builtin_amdgcn_exp2f(fsub_s(pA1[r],msub0));
  WAIT_BAR(0);
  DMA_K(3,0);DMA_V(1,1);
  ROT();
  kload8(kf,kp0+sl_cur*SLOTK);
  WAIT_BAR(3);
  s16x4 vlo[8],vhi[8]; u32x4 pw0,pw1,pw2,pw3;
  #define PKW(P,B) cvtpk_s(P[B],P[B+1])
  #define PAF(k) __builtin_bit_cast(bf16x8,pw##k)
  #define VFR(i) (bf16x8){vlo[i][0],vlo[i][1],vlo[i][2],vlo[i][3],vhi[i][0],vhi[i][1],vhi[i][2],vhi[i][3]}
  #define PIN(x) asm volatile("":"+v"(x))
  #define MX3(a,b,c) __builtin_fmaxf(__builtin_fmaxf((a),(b)),(c))
  #define GAPA(MF,A0,A1,A2,A3,W0,W1,PW) do{ MF; sacc+=A0; sacc+=A1; sacc+=A2; sacc+=A3; PIN(sacc); W0; W1; PIN(PW); SBAR(); }while(0)
  #define EX(v) (NOMAX?__builtin_amdgcn_exp2f(v):__builtin_amdgcn_exp2f((v)-msub))
  #define GAPB(MF,X,B) do{ MF; X[B]=EX(X[B]); X[B+1]=EX(X[B+1]); X[B+2]=EX(X[B+2]); X[B+3]=EX(X[B+3]); PIN(X); SBAR(); }while(0)
  #define VRD(i) do{ vlo[i]=vtr(vp_+(((i)>>2)*4096+((i)&3)*1024)); vhi[i]=vtr(vp_+(((i)>>2)*4096+((i)&3)*1024+512)); }while(0)
  #define KRD(G,j) do{ if(G){ kload2(kf,kp0+sl_next*SLOTK,j); SBAR(); } }while(0)
  #define STEP(C0,C1,P0,P1,t,GK,GV,GL) do{ SBAR(); float msub; \
    const lds_cptr vp_=vp0+sl_prev*SLOTV; \
    C0=__builtin_amdgcn_mfma_f32_32x32x16_bf16(kf[8],qr[4],zc,0,0,0); C1=__builtin_amdgcn_mfma_f32_32x32x16_bf16(kf[9],qr[4],zc,0,0,0); SBAR(); \
    C0=__builtin_amdgcn_mfma_f32_32x32x16_bf16(kf[10],qr[5],C0,0,0,0); C1=__builtin_amdgcn_mfma_f32_32x32x16_bf16(kf[11],qr[5],C1,0,0,0); SBAR(); \
    VRD(0); SBAR(); float sacc=(P0[0]+P0[1]); \
    GAPA(C0=__builtin_amdgcn_mfma_f32_32x32x16_bf16(kf[0],qr[0],C0,0,0,0), P0[2],P0[3],P0[4],P0[5],     pw0[0]=PKW(P0,0), pw0[1]=PKW(P0,2), pw0); \
    VRD(4); SBAR(); GAPA(C1=__builtin_amdgcn_mfma_f32_32x32x16_bf16(kf[1],qr[0],C1,0,0,0), P0[6],P0[7],P0[8],P0[9],     pw0[2]=PKW(P0,4), pw0[3]=PKW(P0,6), pw0); \
    VRD(1); SBAR(); GAPA(C0=__builtin_amdgcn_mfma_f32_32x32x16_bf16(kf[2],qr[1],C0,0,0,0),   P0[10],P0[11],P0[12],P0[13], pw1[0]=PKW(P0,8), pw1[1]=PKW(P0,10), pw1); \
    VRD(5); SBAR(); GAPA(C1=__builtin_amdgcn_mfma_f32_32x32x16_bf16(kf[3],qr[1],C1,0,0,0),   P0[14],P0[15],P1[0],P1[1],   pw1[2]=PKW(P0,12),pw1[3]=PKW(P0,14), pw1); \
    VRD(2); SBAR(); GAPA(C0=__builtin_amdgcn_mfma_f32_32x32x16_bf16(kf[4],qr[2],C0,0,0,0),   P1[2],P1[3],P1[4],P1[5],     pw2[0]=PKW(P1,0), pw2[1]=PKW(P1,2), pw2); \
    VRD(6); SBAR(); GAPA(C1=__builtin_amdgcn_mfma_f32_32x32x16_bf16(kf[5],qr[2],C1,0,0,0),   P1[6],P1[7],P1[8],P1[9],     pw2[2]=PKW(P1,4), pw2[3]=PKW(P1,6), pw2); \
    VRD(3); SBAR(); GAPA(C0=__builtin_amdgcn_mfma_f32_32x32x16_bf16(kf[6],qr[3],C0,0,0,0),   P1[10],P1[11],P1[12],P1[13], pw3[0]=PKW(P1,8), pw3[1]=PKW(P1,10), pw3); \
    VRD(7); SBAR(); GAPA(C1=__builtin_amdgcn_mfma_f32_32x32x16_bf16(kf[7],qr[3],C1,0,0,0),   P1[14],P1[15],0.f,0.f,       pw3[2]=PKW(P1,12),pw3[3]=PKW(P1,14), pw3); \
    l_reg+=sacc; \
    if(GK){DMA_K((t)+3,sl_cur);} if(GV){DMA_V((t)+1,sl_next);} \
    CMASK(C0,C1,t); \
    if(NOMAX){ msub=0.f; resc=false; if(__builtin_expect(never_!=0,0)){ asm volatile("s_nop 0"); } } else \
    { float a=MX3(C0[0],C0[1],C1[0]),b=MX3(C0[2],C0[3],C1[1]); a=MX3(a,C1[2],C1[3]); \
      _Pragma("unroll") for(int r=4;r<16;r+=4){a=MX3(a,C0[r],C0[r+1]);b=MX3(b,C0[r+2],C0[r+3]);a=MX3(a,C1[r],C1[r+1]);b=MX3(b,C1[r+2],C1[r+3]);} \
      float rm=__builtin_fmaxf(a,b); { auto rr=__builtin_amdgcn_permlane32_swap(__float_as_uint(rm),__float_as_uint(rm),false,false); rm=__builtin_fmaxf(__uint_as_float(rr[0]),__uint_as_float(rr[1])); } \
      msub=MSUB(t); rm-=msub; \
      resc=false; \
      if(__builtin_expect(__any(rm>(float)THRL),0)){ const float dl=__builtin_fmaxf(rm,0.f); mhat+=dl; msub+=dl; \
        const float f=__builtin_amdgcn_exp2f(-dl); l_reg*=f; if(hi==0)wsf[r32]=f; resc=true; } } \
    SBAR(); \
    GAPB(o[0]=__builtin_amdgcn_mfma_f32_32x32x16_bf16(PAF(0),VFR(0),o[0],0,0,0), C0,0); \
    KRD(GL,0); GAPB(o[1]=__builtin_amdgcn_mfma_f32_32x32x16_bf16(PAF(0),VFR(4),o[1],0,0,0), C0,4); \
    KRD(GL,1); GAPB(o[0]=__builtin_amdgcn_mfma_f32_32x32x16_bf16(PAF(1),VFR(1),o[0],0,0,0), C0,8); \
    KRD(GL,2); GAPB(o[1]=__builtin_amdgcn_mfma_f32_32x32x16_bf16(PAF(1),VFR(5),o[1],0,0,0), C0,12); \
    KRD(GL,3); GAPB(o[0]=__builtin_amdgcn_mfma_f32_32x32x16_bf16(PAF(2),VFR(2),o[0],0,0,0), C1,0); \
    KRD(GL,4); GAPB(o[1]=__builtin_amdgcn_mfma_f32_32x32x16_bf16(PAF(2),VFR(6),o[1],0,0,0), C1,4); \
    KRD(GL,5); GAPB(o[0]=__builtin_amdgcn_mfma_f32_32x32x16_bf16(PAF(3),VFR(3),o[0],0,0,0), C1,8); \
    GAPB(o[1]=__builtin_amdgcn_mfma_f32_32x32x16_bf16(PAF(3),VFR(7),o[1],0,0,0), C1,12); \
    }while(0)
  int t=1;
  #undef CMASK
  #define CMASK(P0,P1,t) do{}while(0)
  for(;t+5<NT;t+=2){
    STEP(pB0,pB1,pA0,pA1,t,true,true,true);     WAIT_BAR(3); RESC(); ROT();
    STEP(pA0,pA1,pB0,pB1,t+1,true,true,true);   WAIT_BAR(3); RESC(); ROT();
  }
  #undef CMASK
  #define CMASK(P0,P1,t) do{int jb_=(t)-(NT-4); if(CMASK_SKIP>1&&jb_>(wid>>1)){ _Pragma("unroll") for(int r_=0;r_<16;++r_){P0[r_]=-INFINITY;P1[r_]=-INFINITY;} } else if(jb_>=(CMASK_SKIP?(wid>>1):0))cmask(P0,P1,jb_,qrel,hi);}while(0)
  #define ENDW(tt) do{ if((tt)+3<NT){WAIT_BAR(3);} else if((tt)+2<NT){WAIT_BAR(1);} else {WAIT_BAR(0);} }while(0)
  for(;t+1<NT;t+=2){
    STEP(pB0,pB1,pA0,pA1,t,(t+3<NT),(t+1<NT),(t+1<NT));       ENDW(t);   RESC(); ROT();
    STEP(pA0,pA1,pB0,pB1,t+1,(t+4<NT),(t+2<NT),(t+2<NT));     ENDW(t+1); RESC(); ROT();
  }
  STEP(pB0,pB1,pA0,pA1,NT-1,false,false,false); RESC();
  { float sacc=pB0[0]+pB0[1]; _Pragma("unroll") for(int r=2;r<16;++r)sacc+=pB0[r]; _Pragma("unroll") for(int r=0;r<16;++r)sacc+=pB1[r]; l_reg+=sacc;
    pw0=(u32x4){PKW(pB0,0),PKW(pB0,2),PKW(pB0,4),PKW(pB0,6)};pw1=(u32x4){PKW(pB0,8),PKW(pB0,10),PKW(pB0,12),PKW(pB0,14)};pw2=(u32x4){PKW(pB1,0),PKW(pB1,2),PKW(pB1,4),PKW(pB1,6)};pw3=(u32x4){PKW(pB1,8),PKW(pB1,10),PKW(pB1,12),PKW(pB1,14)};
    SBAR(); pv(o,(int)(unsigned)(__UINTPTR_TYPE__)vp0+sl_cur*SLOTV,PAF(0),PAF(1),PAF(2),PAF(3)); }
  #undef PKW
  #undef PAF
  #undef VFR
  #undef PIN
  #undef MX3
  #undef GAPA
  #undef GAPB
  #undef EX
  #undef VRD
  #undef KRD
  #undef STEP
  #undef ENDW
  {auto rr=__builtin_amdgcn_permlane32_swap(__float_as_uint(l_reg),__float_as_uint(l_reg),false,false);l_reg=__uint_as_float(rr[0])+__uint_as_float(rr[1]);}
  if(hi==0)wsf[32+r32]=l_reg;asm volatile("s_waitcnt lgkmcnt(0)":::"memory");
  float rli[16];
  #pragma unroll
  for(int r=0;r<16;++r)rli[r]=__builtin_amdgcn_rcpf(wsf[32+crow(r,hi)]);
  int lno=lane; asm volatile("":"+v"(lno));
  bf16*Ow=O+(long)(q0+wid*QBLK)*DMO;
  { bf16*stg=(bf16*)(shm+LDS_OST)+wid*2048;
    #pragma unroll
    for(int r=0;r<16;++r){const int orow=crow(r,hi);
      #pragma unroll
      for(int d0=0;d0<2;++d0)stg[orow*64+d0*32+r32]=(bf16)(cvtpk_s(o[d0][r]*rli[r],0.f)&0xffffu);}
    asm volatile("s_waitcnt lgkmcnt(0)":::"memory");
    #pragma unroll
    for(int i=0;i<4;++i){const int row=i*8+(lno>>3),ch=lno&7; const u32x4 v=*(const u32x4*)(stg+row*64+ch*8); ATTN_STORE16(Ow+(long)row*DMO+ch*8,v);} }
  asm volatile("s_waitcnt lgkmcnt(0)\n\ts_barrier":::"memory");
  #undef DMA_K
  #undef DMA_V
  #undef CMASK
  #undef START
  #undef RESC
  #undef ROT
}
constexpr int ATTN_LDS_BYTES=QUP_FUSED?(LDS_OST+49152):LDS_BYTES;
#undef SBAR
#undef WAIT_BAR
#undef MSUB
}
constexpr int NWAVES = 8;
constexpr int N_PHASES = 7;
constexpr int CW_TMO = 0, CW_CODE = 1;
constexpr int CW_BAR = 4096;
constexpr int CW_DEP4 = 65536, CW_DEP5 = CW_DEP4 + 128 * 64;
constexpr int CW_GRID0 = 49152;
constexpr int CW_GRP = 32768;
constexpr int RING_OFF = 0, RING_BYTES = 131072;
constexpr int LDSCTL_OFF = RING_BYTES, MISC_OFF = LDSCTL_OFF + 320;
constexpr int LDS_BYTES = 147456;
static_assert(attm::ATTN_LDS_BYTES <= RING_BYTES && attl::ATTN_LDS_BYTES <= RING_BYTES && pg8::STAGE_BYTES <= RING_BYTES, "LDS map");

#define GAS __attribute__((address_space(1)))
#define LAS __attribute__((address_space(3)))
typedef unsigned v4u __attribute__((ext_vector_type(4)));
typedef float f32x4 __attribute__((ext_vector_type(4)));
typedef GAS unsigned gu32;
#define RLX_AGENT __ATOMIC_RELAXED, __HIP_MEMORY_SCOPE_AGENT
#define LDS_WAIT() asm volatile("s_waitcnt lgkmcnt(0)" ::: "memory")
#define VM_WAIT() asm volatile("s_waitcnt vmcnt(0)" ::: "memory")
__device__ __forceinline__ unsigned f2bf(float f) { unsigned u = __builtin_bit_cast(unsigned, f); return (u + 0x7fffu + ((u >> 16) & 1u)) >> 16; }
__device__ __forceinline__ unsigned pk2(float lo, float hi) { return f2bf(lo) | (f2bf(hi) << 16); }

#define XB_TMO      128
#define XB_XCNT(j)  (256  + 64 * (j))
#define XB_XSUB(j)  (1280 + 64 * (j))
#define XB_XGEN(j)  (2304 + 64 * (j))
#define XB_TOP      3328
#define XB_TOPGEN   3392
#define XCD_BAR_WORDS 3456
#define XB_SPIN_CAP (1u << 18)
__device__ __forceinline__ unsigned xb_ld(unsigned* p)              { return __hip_atomic_load(p, __ATOMIC_RELAXED, __HIP_MEMORY_SCOPE_AGENT); }
__device__ __forceinline__ unsigned xb_add(unsigned* p, unsigned v) { return __hip_atomic_fetch_add(p, v, __ATOMIC_RELAXED, __HIP_MEMORY_SCOPE_AGENT); }
__device__ __forceinline__ unsigned xb_xcc_id() { return (unsigned)__builtin_amdgcn_s_getreg((3 << 11) | 20) & 0xFu; }
#define XB_SPIN(cond, bar) do { unsigned _sp = 0; while (cond) { __builtin_amdgcn_s_sleep(1); \
    if ((++_sp & 255u) == 0u) { if (xb_ld(&(bar)[XB_TMO])) break; if (_sp > XB_SPIN_CAP) { atomicAdd(&(bar)[XB_TMO], 1u); break; } } } } while (0)
struct XcdBarrier { unsigned* bar; unsigned x; volatile LAS unsigned* st; };
__device__ __forceinline__ XcdBarrier xcd_barrier_post(unsigned* bar, volatile LAS unsigned* st, bool t0) {
    XcdBarrier b; b.bar = bar; b.x = xb_xcc_id(); b.st = st;
    if (t0) (void)xb_add(&bar[XB_XCNT(b.x)], 1u);
    return b;
}
__device__ __forceinline__ void xcd_barrier_complete(unsigned* bar, unsigned x, unsigned& nloc, unsigned& nx) {
    const unsigned G = gridDim.x * gridDim.y * gridDim.z;
    unsigned sum, cnt, mine, sp = 0u;
    for (;;) {
        sum = 0u; cnt = 0u; mine = 0u;
#pragma unroll
        for (unsigned j = 0; j < 16; ++j) { const unsigned c = xb_ld(&bar[XB_XCNT(j)]); sum += c; cnt += (c > 0u) ? 1u : 0u; mine = (j == x) ? c : mine; }
        if (sum == G) break;
        __builtin_amdgcn_s_sleep(1);
        if ((++sp & 255u) == 0u) { if (xb_ld(&bar[XB_TMO])) break; if (sp > XB_SPIN_CAP) { atomicAdd(&bar[XB_TMO], 1u); break; } }
    }
    nloc = mine > 0u ? mine : 1u; nx = cnt > 0u ? cnt : 1u;
}
__device__ __forceinline__ void xcd_barrier(const XcdBarrier& b, bool t0) {
    asm volatile("s_waitcnt vmcnt(0)" ::: "memory");
    __syncthreads();
    if (t0) {
        unsigned* bar = b.bar;
        __builtin_amdgcn_s_waitcnt(0);
        unsigned nloc = b.st[0], nx = b.st[1];
        if (nloc == 0u) { xcd_barrier_complete(bar, b.x, nloc, nx); b.st[0] = nloc; b.st[1] = nx; }
        const unsigned old = xb_add(&bar[XB_XSUB(b.x)], 1u);
        const unsigned gen = old / nloc;
        if (old + 1u == (gen + 1u) * nloc) {
            __builtin_amdgcn_fence(__ATOMIC_RELEASE, "agent");
            asm volatile("s_waitcnt vmcnt(0)" ::: "memory");
            const unsigned og = xb_add(&bar[XB_TOP], 1u);
            const unsigned tg = og / nx;
            if (og + 1u == (tg + 1u) * nx) xb_add(&bar[XB_TOPGEN], 1u);
            else XB_SPIN(xb_ld(&bar[XB_TOPGEN]) == tg, bar);
            __builtin_amdgcn_fence(__ATOMIC_ACQUIRE, "agent");
            xb_add(&bar[XB_XGEN(b.x)], 1u);
            asm volatile("s_waitcnt vmcnt(0)" ::: "memory");
        } else {
            XB_SPIN(xb_ld(&bar[XB_XGEN(b.x)]) == gen, bar);
            __builtin_amdgcn_fence(__ATOMIC_ACQUIRE, "agent");
            asm volatile("s_waitcnt vmcnt(0)" ::: "memory");
        }
    }
    __syncthreads();
}

#ifndef PROBE_LIGHT_DUP
#define PROBE_LIGHT_DUP 0
#endif
#ifndef ACQ_MIN_SEAM
#define ACQ_MIN_SEAM 1
#endif
#ifndef SEAM0_FLAGS
#define SEAM0_FLAGS 0
#endif
#ifndef WBL2_SEAMS
#define WBL2_SEAMS 0
#endif
#ifndef GRP_NO_WBL2
#define GRP_NO_WBL2 0
#endif
#ifndef GRP_FLAGS
#define GRP_FLAGS 0
#endif
struct GrpBarrier { unsigned* cnt; unsigned size, gen; };
__device__ __forceinline__ void grid_barrier_flags(unsigned* flags, unsigned* tmo, int wave_s, unsigned me, unsigned G) {
    asm volatile("s_waitcnt vmcnt(0)" ::: "memory");
    __syncthreads();
    if (wave_s == 0) { const unsigned l = (unsigned)pg8::lane_now();
        if (l == 0) __hip_atomic_store(flags + me, 1u, __ATOMIC_RELAXED, __HIP_MEMORY_SCOPE_AGENT);
        unsigned sp = 0u;
        for (;;) { unsigned ok = 1u;
#pragma unroll
            for (unsigned j = 0; j < 4; ++j) { const unsigned m = l + 64u * j; const unsigned v = (m < G) ? xb_ld(flags + m) : 1u; ok &= v; }
            if (__all((int)(ok != 0u))) break;
            __builtin_amdgcn_s_sleep(2);
            if ((++sp & 255u) == 0u) { if (xb_ld(tmo)) break; if (sp > XB_SPIN_CAP) { if (l == 0) atomicAdd(tmo, 1u); break; } } }
        asm volatile("s_waitcnt vmcnt(0)" ::: "memory");
    }
    __syncthreads();
}
__device__ __forceinline__ void grp_barrier_flags(GrpBarrier& b, unsigned* tmo, int wave_s, unsigned me, unsigned gen, bool fences = true, bool acq = true, bool wb = false) {
    asm volatile("s_waitcnt vmcnt(0)" ::: "memory");
    __syncthreads();
    if (wave_s == 0) { const unsigned l = (unsigned)pg8::lane_now();
        if (fences && (!GRP_NO_WBL2 || wb)) __builtin_amdgcn_fence(__ATOMIC_RELEASE, "agent");
        asm volatile("s_waitcnt vmcnt(0)" ::: "memory");
        if (l == 0) __hip_atomic_store(b.cnt + me, gen + 1u, __ATOMIC_RELAXED, __HIP_MEMORY_SCOPE_AGENT);
        unsigned sp = 0u;
        for (;;) { const unsigned v = (l < b.size) ? xb_ld(b.cnt + l) : 0xffffffffu;
            if (__all((int)(v >= gen + 1u))) break;
            __builtin_amdgcn_s_sleep(1);
            if ((++sp & 255u) == 0u) { if (xb_ld(tmo)) break; if (sp > XB_SPIN_CAP) { if (l == 0) atomicAdd(tmo, 1u); break; } } }
        if (fences && acq) __builtin_amdgcn_fence(__ATOMIC_ACQUIRE, "agent");
        asm volatile("s_waitcnt vmcnt(0)" ::: "memory");
    }
    __syncthreads();
}
__device__ __forceinline__ void grp_barrier(GrpBarrier& b, unsigned* tmo, bool t0, unsigned gen) {
    asm volatile("s_waitcnt vmcnt(0)" ::: "memory");
    __syncthreads();
    if (t0) {
        __builtin_amdgcn_fence(__ATOMIC_RELEASE, "agent");
        asm volatile("s_waitcnt vmcnt(0)" ::: "memory");
        (void)xb_add(b.cnt, 1u);
        const unsigned target = b.size * (gen + 1u); unsigned sp = 0u;
        while (xb_ld(b.cnt) < target) { __builtin_amdgcn_s_sleep(1); if ((++sp & 255u) == 0u) { if (xb_ld(tmo)) break; if (sp > XB_SPIN_CAP) { atomicAdd(tmo, 1u); break; } } }
        __builtin_amdgcn_fence(__ATOMIC_ACQUIRE, "agent");
        asm volatile("s_waitcnt vmcnt(0)" ::: "memory");
    }
    __syncthreads();
}

#ifndef P0_WT
#define P0_WT 0
#endif
#if P0_WT
#define P0ST(p, v) WT_STORE16_ASM((const void*)(p), v)
#else
#define P0ST(p, v) (*(p) = (v))
#endif
__device__ __forceinline__ void p0_item(const float* W, int ldw, int col0, int ksrc0, const float* gain, bf16_t* WT, int Kdst, int rowdst0, int kdst0, LAS float* scr, int lane) {
    const int c = lane & 7;
    if (W == nullptr) {
#pragma unroll
        for (int j = 0; j < 4; ++j) { const int n = (lane >> 3) + 8 * j; const v4u z4 = {0u, 0u, 0u, 0u}; P0ST((GAS v4u*)(WT + (size_t)(rowdst0 + n) * Kdst + kdst0 + 8 * c), z4); }
        return; }
    const float gvec = gain ? gain[ksrc0 + lane] : 1.0f;
    float wv[32];
#pragma unroll
    for (int i = 0; i < 32; ++i) wv[i] = __builtin_nontemporal_load(W + (size_t)(ksrc0 + 2 * i + (lane >> 5)) * ldw + col0 + (lane & 31));
#pragma unroll
    for (int i = 0; i < 32; ++i) { const int kk = 2 * i + (lane >> 5); scr[kk * 33 + (lane & 31)] = wv[i] * __shfl(gvec, kk); }
    LDS_WAIT(); asm volatile("" ::: "memory");
#pragma unroll
    for (int j = 0; j < 4; ++j) { const int n = (lane >> 3) + 8 * j; const LAS float* s = scr + (8 * c) * 33 + n;
        v4u o; o.x = pg8::cvt_pk_bf16(s[0 * 33], s[1 * 33]); o.y = pg8::cvt_pk_bf16(s[2 * 33], s[3 * 33]); o.z = pg8::cvt_pk_bf16(s[4 * 33], s[5 * 33]); o.w = pg8::cvt_pk_bf16(s[6 * 33], s[7 * 33]);
        P0ST((GAS v4u*)(WT + (size_t)(rowdst0 + n) * Kdst + kdst0 + 8 * c), o); }
    LDS_WAIT(); asm volatile("" ::: "memory");
}
__device__ __forceinline__ float wave_sum(float v) {
#pragma unroll
    for (int o = 1; o < 64; o <<= 1) v += __shfl_xor(v, o);
    return v;
}

struct Args { float* out; unsigned char* ws; int ph_lo, ph_hi, li, pad; const float* in[16]; };
__global__ void __launch_bounds__(NWAVES * 64, 2) fwd_mega(Args args) {
    extern __shared__ __attribute__((aligned(16))) unsigned char lds_raw[];
    LAS unsigned char* lds = (LAS unsigned char*)lds_raw;
    volatile LAS unsigned* MISC = (volatile LAS unsigned*)(lds + MISC_OFF);
    const int wave = __builtin_amdgcn_readfirstlane((int)threadIdx.x >> 6);
#define LANE pg8::lane_now()
#define TID (wave * 64 + pg8::lane_now())
#define T0 (wave == 0 && pg8::lane_now() == 0)
    const int G = gridDim.x, bx = blockIdx.x, vcu = (G % 8 == 0) ? (bx % 8) * (G / 8) + bx / 8 : bx;
    unsigned char* ws = args.ws; Ctx B; B.x = nullptr; B.out = args.out; B.ws = ws;
    const float* const* inp = (const float* const*)((const char*)__builtin_amdgcn_kernarg_segment_ptr() + __builtin_offsetof(Args, in));
    gu32* ctl = (gu32*)(ws + WS_CTL);
    for (int u = TID; u < (LDS_BYTES - LDSCTL_OFF) / 4; u += NWAVES * 64) ((LAS unsigned*)(lds + LDSCTL_OFF))[u] = 0u;
    __syncthreads();
    XcdBarrier bar = xcd_barrier_post((unsigned*)(ctl + CW_BAR) + args.li * XCD_BAR_WORDS, MISC + 8, T0);
#ifndef GROUPED_SEAMS
#define GROUPED_SEAMS 1
#endif
    const bool grouped = GROUPED_SEAMS && (G == 256);
    GrpBarrier gbar; gbar.cnt = (unsigned*)(ctl + CW_GRP) + (args.li * 8 + (bx & 7)) * 64; gbar.size = (unsigned)(G / 8); gbar.gen = 0u;
    const int lo = args.ph_lo, hi = args.ph_hi;
#ifndef PHASE_MASK
#define PHASE_MASK 0x7f
#endif
#define IN(k) (((PHASE_MASK >> (k)) & 1) && lo <= (k) && (k) < hi)
#ifndef REP0
#define REP0 1
#endif
#ifndef REP1
#define REP1 1
#endif
#ifndef REP2
#define REP2 1
#endif
#ifndef REP3
#define REP3 1
#endif
#ifndef REP4
#define REP4 1
#endif
#ifndef REP5
#define REP5 1
#endif
#ifndef DUPU1
#define DUPU1 0
#endif
#ifndef DUPU5
#define DUPU5 0
#endif
#ifndef DUPU6
#define DUPU6 0
#endif
#ifndef REPG
#define REPG 1
#endif
#ifndef REPB
#define REPB 1
#endif
#define SEAM(k) do { if (IN(k) && IN((k) + 1)) { for (int rb_ = 0; rb_ < REPB; ++rb_) { if ((k) == 0 && SEAM0_FLAGS && grouped && rb_ == 0) grid_barrier_flags((unsigned*)(ctl + CW_GRID0) + args.li * 256, (unsigned*)(ctl + CW_BAR) + args.li * XCD_BAR_WORDS + XB_TMO, wave, (unsigned)bx, (unsigned)G); else if ((k) == 0 || !grouped) xcd_barrier(bar, T0); else if (GRP_FLAGS) grp_barrier_flags(gbar, (unsigned*)(ctl + CW_BAR) + args.li * XCD_BAR_WORDS + XB_TMO, wave, (unsigned)(bx >> 3), (unsigned)(((k) - (lo > 1 ? lo : 1)) * REPB + rb_), !(PROBE_LIGHT_DUP && rb_ > 0), (k) >= ACQ_MIN_SEAM, ((WBL2_SEAMS >> (k)) & 1) != 0); else grp_barrier(gbar, (unsigned*)(ctl + CW_BAR) + args.li * XCD_BAR_WORDS + XB_TMO, T0, (unsigned)(((k) - (lo > 1 ? lo : 1)) * REPB + rb_)); } } } while (0)

    if (IN(0)) { B.x = inp[0]; const int lane = LANE, tid = wave * 64 + lane; for (int rep_ = 0; rep_ < REP0; ++rep_) {
        LAS float* scr = (LAS float*)(lds + RING_OFF + wave * 16384);
        const int hw = wave & 3, gw = vcu * 4 + hw, NGW = G * 4;
        constexpr int I_IN = 64 * 16, I_QU = 32 * 4, I_KVU = 32 * 2, I_O = 32 * 16, I_GU = 176 * 16, I_D = 32 * 44, NITEMS = I_IN + I_QU + I_KVU + I_O + I_GU + I_D;
#ifndef REPW
#define REPW 1
#endif
#ifndef REPX
#define REPX 1
#endif
        if (wave >= 4)
        for (int rw_ = 0; rw_ < REPW; ++rw_)
        for (int it = gw; it < NITEMS; it += NGW) {
            int r = it;
            if (r < I_IN) { const int Gp = r >> 4, kb = r & 15, pn = Gp >> 3, bj = (Gp >> 2) & 1, wc = Gp & 3, col0 = pn * 256 + wc * 64 + bj * 32;
                p0_item(col0 < INW ? inp[nv::I_WIN] : nullptr, INW, col0, kb * 64, inp[nv::I_GATT], B.WIN(), DM, Gp * 32, kb * 64, scr, lane); continue; } r -= I_IN;
#if QUP_FUSED
            if (r < I_QU) { if (r < 24 * 4) { const int Gp = r >> 2, kb = r & 3; p0_item(inp[nv::I_WQUP], 768, Gp * 32, kb * 64, inp[nv::I_GQA], B.WQUP(), 256, Gp * 32, kb * 64, scr, lane); } continue; } r -= I_QU;
#else
            if (r < I_QU) { const int Gp = r >> 2, kb = r & 3, pn = Gp >> 3, bj = (Gp >> 2) & 1, wc = Gp & 3, head = 2 * pn + (wc >> 1); const bool z = (wc & 1) && bj; const int col0 = head * 96 + ((wc & 1) ? 64 : bj * 32);
                p0_item(z ? nullptr : inp[nv::I_WQUP], 768, col0, kb * 64, inp[nv::I_GQA], B.WQUP(), 256, Gp * 32, kb * 64, scr, lane); continue; } r -= I_QU;
#endif
            if (r < I_KVU) { const int Gp = r >> 1, kb = r & 1, pn = Gp >> 3, bj = (Gp >> 2) & 1, wc = Gp & 3, col0 = pn * 256 + wc * 64 + bj * 32;
                p0_item(inp[nv::I_WKVUP], 1024, col0, kb * 64, inp[nv::I_GKVA], B.WKVUP(), 128, Gp * 32, kb * 64, scr, lane); continue; } r -= I_KVU;
            if (r < I_O) { const int Gp = r >> 4, kb = r & 15, pn = Gp >> 3, bj = (Gp >> 2) & 1, wc = Gp & 3, col0 = pn * 256 + wc * 64 + bj * 32;
                p0_item(inp[nv::I_WO], DM, col0, kb * 64, nullptr, B.WO(), DM, Gp * 32, kb * 64, scr, lane); continue; } r -= I_O;
            if (r < I_GU) { const int Gp = r >> 4, kb = r & 15, pn = Gp >> 3, bj = (Gp >> 2) & 1, wc = Gp & 3, col0 = pn * 128 + wc * 32;
                p0_item(inp[bj ? nv::I_WU : nv::I_WG], DFF, col0, kb * 64, inp[nv::I_GFFN], B.WGU(), DM, Gp * 32, kb * 64, scr, lane); continue; } r -= I_GU;
            { const int Gp = r / 44, kb = r % 44, pn = Gp >> 3, bj = (Gp >> 2) & 1, wc = Gp & 3, col0 = pn * 256 + wc * 64 + bj * 32;
                p0_item(inp[nv::I_WD], DM, col0, kb * 64, nullptr, B.WD(), DFF, Gp * 32, kb * 64, scr, lane); }
        }
        if (wave < 4)
        for (int rx_ = 0; rx_ < REPX; ++rx_)
        for (int m0 = gw; m0 < M; m0 += 4 * NGW) {
            f32x4 v[4][4]; float ssq[4];
#pragma unroll
            for (int q = 0; q < 4; ++q) { const int m = m0 + q * NGW; if (m < M) { const GAS f32x4* xr = (const GAS f32x4*)(B.x + (size_t)m * DM) + 2 * lane;
#pragma unroll
                for (int j = 0; j < 2; ++j) { v[q][2 * j] = __builtin_nontemporal_load(xr + 128 * j); v[q][2 * j + 1] = __builtin_nontemporal_load(xr + 128 * j + 1); } } }
#pragma unroll
            for (int q = 0; q < 4; ++q) { float sq = 0.f;
#pragma unroll
                for (int j = 0; j < 4; ++j) sq += (v[q][j].x * v[q][j].x + v[q][j].y * v[q][j].y) + (v[q][j].z * v[q][j].z + v[q][j].w * v[q][j].w);
                ssq[q] = wave_sum(sq); }
#pragma unroll
            for (int q = 0; q < 4; ++q) { const int m = m0 + q * NGW; if (m < M) { if (lane == 0) pg8::stf(B.RX() + m, 1.0f / sqrtf(ssq[q] * (1.0f / DM) + EPS));
                GAS v4u* o16 = (GAS v4u*)(B.XB() + (size_t)m * DM) + lane;
#pragma unroll
                for (int j = 0; j < 2; ++j) { const pg8::u32x4 w = pg8::pack8(v[q][2 * j], v[q][2 * j + 1]); const v4u w4 = {w.x, w.y, w.z, w.w}; P0ST(o16 + 64 * j, w4); } } }
        }
        for (int i = vcu * NWAVES * 64 + tid; i < 2048 * 48; i += G * NWAVES * 64) rope_table_entry(i, B.COSA());
        if (bx == 0 && tid < 320) { const int t = tid; pg8::stf(B.gmq() + t, t < 64 ? inp[nv::I_GMQ][t] : t < 128 ? inp[nv::I_GMK][t - 64] : t < 224 ? inp[nv::I_GLQ][t - 128] : inp[nv::I_GLK][t - 224]); } }
        SEAM(0);
    }
    if (IN(1)) { for (int rep_ = 0; rep_ < REP1; ++rep_) {
        pg8::ProgOne<pg8::EpiInProj, DUPU1> P1; P1.init(B, pg8::GDesc{B.XB(), B.WIN(), DM, DM}, 2048, G, bx); pg8::gemm_stream(lds + RING_OFF, P1, wave); }
        SEAM(1);
    }
    if (IN(2)) { for (int rep_ = 0; rep_ < REP2; ++rep_) {
        if (!KSUM_EPI) { const int lane = LANE;
        for (int it = vcu; it < 256; it += G) { const int tile = it >> 1, c0 = (it & 1) * 256 + lane * 4; const bf16_t* kp = B.KA() + ((size_t)tile * 256 + wave * 32) * MW + c0; float a0 = 0.f, a1 = 0.f, a2 = 0.f, a3 = 0.f;
#pragma unroll 8
            for (int r = 0; r < 32; ++r) { const unsigned long long w = *(const GAS unsigned long long*)(kp + (size_t)r * MW); const unsigned lo = (unsigned)w, hi2 = (unsigned)(w >> 32);
                a0 += __uint_as_float(lo << 16); a1 += __uint_as_float(lo & 0xffff0000u); a2 += __uint_as_float(hi2 << 16); a3 += __uint_as_float(hi2 & 0xffff0000u); }
            LAS f32x4* red = (LAS f32x4*)(lds + RING_OFF); red[wave * 64 + lane] = (f32x4){a0, a1, a2, a3};
            LDS_WAIT(); __syncthreads();
            if (wave < 4) { const f32x4 s0 = red[(2 * wave) * 64 + lane], s1 = red[(2 * wave + 1) * 64 + lane]; *(GAS f32x4*)(B.KMEANP() + ((size_t)tile * 4 + wave) * MW + c0) = s0 + s1; }
            __syncthreads(); } }
#if QUP_FUSED
        pg8::ProgOne<pg8::EpiKvUp, 0> P2; P2.init(B, pg8::GDesc{B.CQKV() + 256, B.WKVUP(), 128, 384}, 1024, G, bx); pg8::gemm_stream(lds + RING_OFF, P2, wave); }
#else
        pg8::ProgP2 P2; P2.init(B, G, bx); pg8::gemm_stream(lds + RING_OFF, P2, wave); }
#endif
        SEAM(2);
    }
    if (IN(3)) { for (int rep_ = 0; rep_ < REP3; ++rep_) {
        if (!H1SS_LDS) { const int rpc = (M + G - 1) / G; for (int i = vcu * rpc + TID; i < (vcu + 1) * rpc && i < M; i += NWAVES * 64) pg8::stf(B.H1SS() + i, 0.f); }
#if ATT_PRIO
        if (wave >= 4) __builtin_amdgcn_s_setprio(1);
#endif
#ifndef MLA_NOMAX_ONLY
#define MLA_NOMAX_ONLY 0
#endif
#ifndef MLA_NOMAX
#define MLA_NOMAX 0
#endif
        bool mla_nomax = false;
        if (MLA_NOMAX) { const int lane = LANE; float gq = fabsf(B.glq()[lane]), gk = fabsf(B.glk()[lane]); if (lane < 32) { gq = fmaxf(gq, fabsf(B.glq()[64 + lane])); gk = fmaxf(gk, fabsf(B.glk()[64 + lane])); }
#pragma unroll
            for (int o_ = 1; o_ < 64; o_ <<= 1) { gq = fmaxf(gq, __shfl_xor(gq, o_)); gk = fmaxf(gk, __shfl_xor(gk, o_)); }
            mla_nomax = __builtin_amdgcn_readfirstlane((int)(96.0f * C2B * gq * gk < 48.0f)) != 0; }
#ifndef MOBA_NOMAX
#define MOBA_NOMAX 0
#endif
        bool moba_nomax = false;
        if (MOBA_NOMAX) { const int lane = LANE; float gq = fabsf(B.gmq()[lane]), gk = fabsf(B.gmk()[lane]);
#pragma unroll
            for (int o_ = 1; o_ < 64; o_ <<= 1) { gq = fmaxf(gq, __shfl_xor(gq, o_)); gk = fmaxf(gk, __shfl_xor(gk, o_)); }
            moba_nomax = __builtin_amdgcn_readfirstlane((int)(64.0f * C2A * gq * gk < 48.0f)) != 0; }
        const int nit = (G == 256) ? 4 : (1024 - vcu + G - 1) / G;
        for (int it = 0; it < nit; ++it) { int bh, ty, s;
            if (G == 256) { const int c = vcu >> 2; s = vcu & 3; bh = (2 * (c >> 3) + (it & 1)) * 8 + (c & 7); ty = (it >> 1) ^ (c & 1); }
            const int b = bh >> 3, h = bh & 7; const size_t rb = (size_t)b * SEQ;
#ifndef REPU0
#define REPU0 1
#endif
            for (int e = 0; e < 2; ++e) { const int n = e ? 7 - s : s;
              for (int ru_ = 0; ru_ < ((n == 0) ? REPU0 : 1); ++ru_) {
                if (ty) { if (mla_nomax) attl::attn_unit<8, true>(n, QUP_FUSED ? B.CQKV() + rb * 384 : B.QM() + rb * 768 + h * 96, B.KM() + rb * 768 + h * 96, B.VM() + rb * MW + h * 64, B.AO() + rb * DM + 512 + h * 64, B, (char*)lds_raw + RING_OFF, wave, h, rb);
                          else attl::attn_unit<8, MLA_NOMAX_ONLY ? true : false>(n, QUP_FUSED ? B.CQKV() + rb * 384 : B.QM() + rb * 768 + h * 96, B.KM() + rb * 768 + h * 96, B.VM() + rb * MW + h * 64, B.AO() + rb * DM + 512 + h * 64, B, (char*)lds_raw + RING_OFF, wave, h, rb); }
                else if (moba_nomax) attm::attn_unit<8, true>(n, b * 8, h, B.QA() + rb * MW + h * 64, B.KA() + rb * MW + h * 64, B.VA() + rb * MW + h * 64, B.AO() + rb * DM + h * 64, B, (char*)lds_raw + RING_OFF, wave);
                else attm::attn_unit<8, false>(n, b * 8, h, B.QA() + rb * MW + h * 64, B.KA() + rb * MW + h * 64, B.VA() + rb * MW + h * 64, B.AO() + rb * DM + h * 64, B, (char*)lds_raw + RING_OFF, wave); } } } }
#if ATT_PRIO
        __builtin_amdgcn_s_setprio(0);
#endif
        SEAM(3);
    }
    for (int repg_ = 0; repg_ < REPG; ++repg_) {
    if (repg_ > 0) xcd_barrier(bar, T0);
#ifndef P6_A_AUX
#define P6_A_AUX 0
#endif
#ifndef FFN_STREAM
#define FFN_STREAM 0
#endif
    if (FFN_STREAM && G == 256 && IN(4) && IN(5) && IN(6)) {
        pg8::ProgFFN PF; PF.init(B, G, bx, (unsigned*)(ctl + CW_DEP4), (unsigned*)(ctl + CW_DEP5), (unsigned*)(ctl + CW_BAR) + args.li * XCD_BAR_WORDS + XB_TMO); for (PF.seg = 0; PF.seg < 3; ++PF.seg) pg8::gemm_stream(lds + RING_OFF, PF, wave);
    } else {
#ifndef STAG4
#define STAG4 0
#endif
#ifndef STAG5
#define STAG5 0
#endif
#ifndef STAG6
#define STAG6 0
#endif
#ifndef STAG_NG
#define STAG_NG 4
#endif
#define STAGGER(T) do { if ((T) > 0) { const int j_ = (((bx >> 3) & 7) * STAG_NG) >> 3; if (j_ && T0) { const unsigned long long t0_ = wall_clock64(); while (wall_clock64() - t0_ < (unsigned long long)(j_ * (T))) __builtin_amdgcn_s_sleep(16); } __syncthreads(); } } while (0)
    if (IN(4)) { STAGGER(STAG4); for (int rep_ = 0; rep_ < REP4; ++rep_) {
        pg8::ProgOne<pg8::EpiOProj, 0> P4; P4.init(B, pg8::GDesc{B.AO(), B.WO(), DM, DM}, DM, G, bx); pg8::gemm_stream(lds + RING_OFF, P4, wave); }
        SEAM(4);
    }
    if (IN(5)) { STAGGER(STAG5); for (int rep_ = 0; rep_ < REP5; ++rep_) {
        pg8::ProgOne<pg8::EpiFfn1, DUPU5> P5; P5.init(B, pg8::GDesc{B.H1B(), B.WGU(), DM, DM}, 2 * DFF, G, bx); pg8::gemm_stream(lds + RING_OFF, P5, wave); }
        SEAM(5);
    }
    if (IN(6)) { STAGGER(STAG6);
        pg8::ProgOne<pg8::EpiFfn2, DUPU6> P6; P6.init(B, pg8::GDesc{B.ACT(), B.WD(), DFF, DFF}, DM, G, bx); pg8::gemm_stream<decltype(P6), P6_A_AUX>(lds + RING_OFF, P6, wave);
    }
    }
    }
#undef IN
#undef SEAM
}
#ifndef OPT_MASK
#define OPT_MASK 0x7e
#endif
static nv::Bufs make_bufs(void* const* d_in, void* d_out, void* d_ws) {
    nv::Bufs B{}; unsigned char* ws = (unsigned char*)d_ws;
    B.x = (const float*)d_in[0]; for (int i = 0; i < 16; ++i) B.in[i] = (const float*)d_in[i]; B.out = (float*)d_out;
    B.RX = (float*)(ws + WS_RX); B.CQSS = (float*)(ws + WS_CQSS); B.CKVSS = (float*)(ws + WS_CKVSS); B.KPESS = (float*)(ws + WS_KPESS); B.KR = (float*)(ws + WS_KR);
    B.KMEANP = (float*)(ws + WS_KMEANP); B.H1SS = (float*)(ws + WS_H1SS);
    float* tab = (float*)(ws + WS_TAB); B.COSA = tab; B.SINA = tab + 2048 * 32; B.COSB = tab + 2 * 2048 * 32; B.SINB = tab + 2 * 2048 * 32 + 2048 * 16;
    B.QA = (bf16_t*)(ws + WS_QA); B.KA = (bf16_t*)(ws + WS_KA); B.VA = (bf16_t*)(ws + WS_VA); B.CQKV = (bf16_t*)(ws + WS_CQKV); B.QM = (bf16_t*)(ws + WS_QM); B.KM = (bf16_t*)(ws + WS_KM);
    B.VM = (bf16_t*)(ws + WS_VM); B.AO = (bf16_t*)(ws + WS_AO); B.H1B = (bf16_t*)(ws + WS_H1B); B.ACT = (bf16_t*)(ws + WS_ACT);
    return B;
}
static void naive_stage(int p, const nv::Bufs& B, hipStream_t stream) {
    switch (p) {
    case 1: hipLaunchKernelGGL(nv::ngemm<nv::OpInProj>, dim3(31, M / 64), dim3(256), 0, stream, nv::OpInProj{B}); break;
    case 2: hipLaunchKernelGGL(nv::ngemm<nv::OpQUp>, dim3(12, M / 64), dim3(256), 0, stream, nv::OpQUp{B});
            hipLaunchKernelGGL(nv::ngemm<nv::OpKvUp>, dim3(16, M / 64), dim3(256), 0, stream, nv::OpKvUp{B}); break;
    case 3: hipLaunchKernelGGL(nv::n_attn_moba, dim3(M * NH / 256), dim3(256), 0, stream, B);
            hipLaunchKernelGGL(nv::n_attn_mla, dim3(M * NH / 256), dim3(256), 0, stream, B); break;
    case 4: hipLaunchKernelGGL(nv::ngemm<nv::OpOProj>, dim3(16, M / 64), dim3(256), 0, stream, nv::OpOProj{B}); break;
    case 5: hipLaunchKernelGGL(nv::ngemm<nv::OpFfn1>, dim3(44, M / 64), dim3(256), 0, stream, nv::OpFfn1{B}); break;
    case 6: hipLaunchKernelGGL(nv::ngemm<nv::OpFfn2>, dim3(16, M / 64), dim3(256), 0, stream, nv::OpFfn2{B}); break;
    }
}
extern "C" void kernel_launch(void* const* d_in, const int* in_sizes, int n_in, void* d_out, int out_size, void* d_ws, size_t ws_size, hipStream_t stream) {
    static int grid = 0;
    if (grid == 0) {
        if (n_in != 16 || in_sizes[0] != M * DM || out_size != M * DM || ws_size < WS_END) { fprintf(stderr, "kernel_launch: shape mismatch (n_in %d, in0 %d, out %d, ws %zu; need ws >= %zu)\n", n_in, n_in > 0 ? in_sizes[0] : -1, out_size, ws_size, (size_t)WS_END); grid = -1; return; }
        int dev = 0, cus = 0, per_cu = 0;
        if (hipGetDevice(&dev) != hipSuccess || hipDeviceGetAttribute(&cus, hipDeviceAttributeMultiprocessorCount, dev) != hipSuccess) { fprintf(stderr, "kernel_launch: device query failed\n"); grid = -1; return; }
        if (hipFuncSetAttribute((const void*)fwd_mega, hipFuncAttributeMaxDynamicSharedMemorySize, LDS_BYTES) != hipSuccess) { fprintf(stderr, "kernel_launch: hipFuncSetAttribute(%d B LDS) failed\n", LDS_BYTES); grid = -1; return; }
        if (hipOccupancyMaxActiveBlocksPerMultiprocessor(&per_cu, (const void*)fwd_mega, NWAVES * 64, LDS_BYTES) != hipSuccess || per_cu < 1) { fprintf(stderr, "kernel_launch: occupancy query says %d workgroups per CU; nothing launched\n", per_cu); (void)hipGetLastError(); grid = -1; return; }
        grid = cus;
    }
    if (grid < 0) return;
    if (hipMemsetAsync((char*)d_ws + WS_CTL, 0, CTL_ZERO_BYTES, stream) != hipSuccess) { fprintf(stderr, "kernel_launch: hipMemsetAsync failed\n"); return; }
    nv::Bufs B = make_bufs(d_in, d_out, d_ws);
    constexpr unsigned mask = (unsigned)(OPT_MASK) & 0x7eu; constexpr bool any_opt = mask != 0u, any_naive = mask != 0x7eu;
    if (any_naive) { hipLaunchKernelGGL(n_tables, dim3(384), dim3(256), 0, stream, (float*)((unsigned char*)d_ws + WS_TAB)); hipLaunchKernelGGL(nv::n_rowstat, dim3(M / 4), dim3(256), 0, stream, B.x, B.RX); }
#ifdef PROBE_DUP
    { const int cut[2][2] = {{0, PROBE_DUP + 1}, {PROBE_DUP2, 7}};
      for (int l = 0; l < 2; ++l) { Args a{}; for (int i = 0; i < 16; ++i) a.in[i] = (const float*)d_in[i]; a.out = (float*)d_out; a.ws = (unsigned char*)d_ws; a.ph_lo = cut[l][0]; a.ph_hi = cut[l][1]; a.li = l; a.pad = 0;
        hipLaunchKernelGGL(fwd_mega, dim3(grid), dim3(NWAVES * 64), LDS_BYTES, stream, a); }
      return; }
#endif
    int li = 0, p = any_opt ? 0 : 1;
    while (p <= 6) {
        const bool opt = (p == 0) || ((mask >> p) & 1u);
        if (opt) { int q = p; while (q + 1 <= 6 && ((mask >> (q + 1)) & 1u)) ++q;
            Args a{}; for (int i = 0; i < 16; ++i) a.in[i] = (const float*)d_in[i]; a.out = (float*)d_out; a.ws = (unsigned char*)d_ws; a.ph_lo = p; a.ph_hi = q + 1; a.li = li++; a.pad = 0;
            hipLaunchKernelGGL(fwd_mega, dim3(grid), dim3(NWAVES * 64), LDS_BYTES, stream, a);
            const hipError_t le = hipPeekAtLastError(); if (le != hipSuccess) { fprintf(stderr, "kernel_launch: launch failed: %s\n", hipGetErrorName(le)); return; }
            p = q + 1; }
        else { naive_stage(p, B, stream); ++p; }
    }
}
```

```cpp
#define OPT_MASK 0x7e
#define P1_REPAIR 1
#define KSUM_DPP 1
#define QUP_PIPE 1
#define CQ_FRAG 1
#define QA_FRAG 1
#define KSUM_HALF 1
#define KV_LATE 1
#define ATT_PRIO 1
#define WT_STORE16_ASM(p, v) asm volatile("global_store_dwordx4 %0, %1, off sc1\n\ts_nop 1" :: "v"(p), "v"(v) : "memory")
#define P1_STORE_MODE 1
#define P2_STORE_MODE 1
#define P4_WT 1
#define P0_WT 1
#define KSUM_EPI 1
#define ATTN_STORE16(p, v) WT_STORE16_ASM(p, v)
#define FFN1_FMA 1
#define MLA_NOMAX 1
#define MOBA_NOMAX 1
#define NEGM_PERIODIC 1
#define CMASK_SKIP 1
#define SMALL_WT 1
#define P1_SMALL_WT 0
#define WBL2_SEAMS 0x2
#define GRP_FLAGS 1
#define GRP_NO_WBL2 1
#define H1B_SEPARATE 1
#define QUP_FUSED 1
#ifndef OUT_SCRATCH
#define OUT_SCRATCH 1
#endif
#ifndef ACQ_MIN_SEAM
#define ACQ_MIN_SEAM (OUT_SCRATCH ? 6 : 5)
#endif
#define SEAM0_FLAGS 1
#ifndef ACT_STORE_MODE
#define ACT_STORE_MODE 1
#endif
#ifndef OUT_STORE_NT
#define OUT_STORE_NT 1
#endif
#include <hip/hip_runtime.h>
#include <cstdio>
#include <cstdint>

typedef unsigned short bf16_t;
constexpr int BATCH = 16, SEQ = 2048, DM = 1024, M = BATCH * SEQ;
constexpr int NH = 8, HD = 64, MW = 512;
constexpr int QR = 256, KVR = 128, ROPE = 32, NOPE = 64, QKD = 96;
constexpr int INW = 1952, DFF = 2816;
constexpr float EPS = 1e-6f, LOG2E = 1.4426950408889634f;
constexpr float C2A = 0.125f * LOG2E;
constexpr float C2B = 0.10206207261596577f * LOG2E;

constexpr size_t MiB = 1u << 20;
constexpr size_t WS_CTL = 0, CTL_ZERO_BYTES = 1 * MiB;
constexpr size_t WS_TAB = 1 * MiB;
constexpr size_t WS_WIN = 2 * MiB;
constexpr size_t WS_WQUP = 6 * MiB;
constexpr size_t WS_WKVUP = 6 * MiB + 512 * 1024;
constexpr size_t WS_WO = 7 * MiB;
constexpr size_t WS_WGU = 9 * MiB;
constexpr size_t WS_WD = 20 * MiB;
constexpr size_t WS_RX = 26 * MiB;
constexpr size_t WS_KPESS = WS_RX + 128 * 1024;
constexpr size_t WS_CKVSS = WS_KPESS + 128 * 1024;
constexpr size_t WS_CQSS = WS_CKVSS + 256 * 1024;
constexpr size_t WS_KMEANP = WS_CQSS + 512 * 1024;
constexpr size_t WS_H1SS = WS_CTL + 512 * 1024;
constexpr size_t WS_KR = WS_KMEANP + 1024 * 1024;
constexpr size_t WS_H1SSP = 32 * MiB;
constexpr size_t WS_XB = 34 * MiB;
#ifndef H1B_SEPARATE
#define H1B_SEPARATE 0
#endif
#ifndef OUT_SCRATCH
#define OUT_SCRATCH 0
#endif
#if OUT_SCRATCH
constexpr size_t OS_QA = 0, OS_KA = 32 * MiB, OS_VA = 64 * MiB, OS_CQKV = 96 * MiB;
constexpr size_t WS_QA = 0, WS_KA = 0, WS_VA = 0, WS_CQKV = 0, WS_QM = 0;
constexpr size_t WS_KM = 98 * MiB;
constexpr size_t WS_VM = 146 * MiB;
constexpr size_t WS_AO = 178 * MiB;
constexpr size_t WS_H1B = 242 * MiB;
constexpr size_t WS_ACT = 306 * MiB;
constexpr size_t WS_CQF = 482 * MiB;
constexpr size_t WS_END = 498 * MiB;
static_assert(WS_ACT + (size_t)M * DFF * 2 <= WS_END && OS_CQKV + (size_t)M * 384 * 2 <= (size_t)M * DM * 4, "d_ws / d_out map");
#else
constexpr size_t WS_H1B = H1B_SEPARATE ? 410 * MiB : WS_XB;
constexpr size_t WS_QA = 98 * MiB, WS_KA = 130 * MiB, WS_VA = 162 * MiB;
constexpr size_t WS_CQKV = 194 * MiB;
constexpr size_t WS_QM = 218 * MiB, WS_KM = 266 * MiB;
constexpr size_t WS_VM = 314 * MiB;
constexpr size_t WS_AO = 346 * MiB;
constexpr size_t WS_ACT = 98 * MiB;
constexpr size_t WS_END = (H1B_SEPARATE ? 474 : 410) * MiB;
#endif
static_assert(WS_KR + (size_t)M * 32 * 4 <= WS_XB && (OUT_SCRATCH || WS_ACT + (size_t)M * DFF * 2 <= WS_AO) && WS_WD + (size_t)DM * DFF * 2 <= WS_RX, "d_ws map");

__device__ __forceinline__ void sincos_d(double a, double& s, double& c) {
    const double kd = __builtin_rint(a * 0.63661977236758134308);
    double r = __builtin_fma(-kd, 1.57079632679489655800e+00, a); r = __builtin_fma(-kd, 6.12323399573676603587e-17, r);
    const int k = (int)kd & 3; const double r2 = r * r;
    const double sp = r * (1.0 + r2 * (-1.0 / 6 + r2 * (1.0 / 120 + r2 * (-1.0 / 5040 + r2 * (1.0 / 362880 + r2 * (-1.0 / 39916800 + r2 * (1.0 / 6227020800.0 + r2 * (-1.0 / 1307674368000.0))))))));
    const double cp = 1.0 + r2 * (-0.5 + r2 * (1.0 / 24 + r2 * (-1.0 / 720 + r2 * (1.0 / 40320 + r2 * (-1.0 / 3628800 + r2 * (1.0 / 479001600 + r2 * (-1.0 / 87178291200.0 + r2 * (1.0 / 20922789888000.0))))))));
    s = (k == 0) ? sp : (k == 1) ? cp : (k == 2) ? -sp : -cp;
    c = (k == 0) ? cp : (k == 1) ? -sp : (k == 2) ? -cp : sp;
}
__device__ __forceinline__ void rope_table_entry(int i, float* tab) {
    const int pos = i / 48, f = i % 48, steps = f < 32 ? f : 2 * (f - 32);
    double inv = 1.0; for (int j = 0; j < steps; ++j) inv *= 0.7498942093324558;
    const float ang = (float)pos * (float)inv;
    double s, c; sincos_d((double)ang, s, c);
    if (f < 32) { __hip_atomic_store(tab + pos * 32 + f, (float)c, __ATOMIC_RELAXED, __HIP_MEMORY_SCOPE_AGENT); __hip_atomic_store(tab + 2048 * 32 + pos * 32 + f, (float)s, __ATOMIC_RELAXED, __HIP_MEMORY_SCOPE_AGENT); }
    else { __hip_atomic_store(tab + 2 * 2048 * 32 + pos * 16 + (f - 32), (float)c, __ATOMIC_RELAXED, __HIP_MEMORY_SCOPE_AGENT); __hip_atomic_store(tab + 2 * 2048 * 32 + 2048 * 16 + pos * 16 + (f - 32), (float)s, __ATOMIC_RELAXED, __HIP_MEMORY_SCOPE_AGENT); }
}
__global__ __launch_bounds__(256) void n_tables(float* tab) { const int i = blockIdx.x * 256 + threadIdx.x; if (i < 2048 * 48) rope_table_entry(i, tab); }
namespace nv {
__device__ __forceinline__ float bf2f(bf16_t v) { return __uint_as_float((unsigned)v << 16); }
__device__ __forceinline__ bf16_t f2bf(float f) { unsigned u = __float_as_uint(f); return (bf16_t)((u + 0x7fffu + ((u >> 16) & 1u)) >> 16); }

__global__ __launch_bounds__(256) void n_rowstat(const float* __restrict__ x, float* __restrict__ RX) {
    const int row = blockIdx.x * 4 + (threadIdx.x >> 6), lane = threadIdx.x & 63;
    const float* xr = x + (size_t)row * DM; float s = 0.f;
    for (int i = lane; i < DM; i += 64) { const float v = xr[i]; s += v * v; }
    for (int o = 1; o < 64; o <<= 1) s += __shfl_xor(s, o);
    if (lane == 0) RX[row] = 1.0f / sqrtf(s * (1.0f / DM) + EPS);
}

template <class OP> __global__ __launch_bounds__(256) void ngemm(OP op) {
    __shared__ float As[16][64], Bs[16][64], B2s[OP::DUAL ? 16 : 1][64], T[64][65], T2[OP::DUAL ? 64 : 1][65];
    const int tid = threadIdx.x, ty = tid >> 4, tx = tid & 15, row0 = blockIdx.y * 64, col0 = blockIdx.x * 64;
    float acc[4][4] = {}, acc2[4][4] = {};
    for (int k0 = 0; k0 < OP::K; k0 += 16) {
#pragma unroll
        for (int l = 0; l < 4; ++l) { const int idx = tid + 256 * l;
            { const int m = idx >> 4, k = idx & 15; As[k][m] = op.a(row0 + m, k0 + k); }
            { const int k = idx >> 6, n = idx & 63; const bool in = (col0 + n) < OP::N; Bs[k][n] = in ? op.b(k0 + k, col0 + n) : 0.f; if (OP::DUAL) B2s[k][n] = in ? op.b2(k0 + k, col0 + n) : 0.f; } }
        __syncthreads();
#pragma unroll
        for (int k = 0; k < 16; ++k) { float a[4], b[4], c[4];
#pragma unroll
            for (int i = 0; i < 4; ++i) { a[i] = As[k][ty * 4 + i]; b[i] = Bs[k][tx * 4 + i]; c[i] = OP::DUAL ? B2s[k][tx * 4 + i] : 0.f; }
#pragma unroll
            for (int i = 0; i < 4; ++i)
#pragma unroll
                for (int j = 0; j < 4; ++j) { acc[i][j] = fmaf(a[i], b[j], acc[i][j]); if (OP::DUAL) acc2[i][j] = fmaf(a[i], c[j], acc2[i][j]); } }
        __syncthreads();
    }
#pragma unroll
    for (int i = 0; i < 4; ++i)
#pragma unroll
        for (int j = 0; j < 4; ++j) { T[ty * 4 + i][tx * 4 + j] = acc[i][j]; if (OP::DUAL) T2[ty * 4 + i][tx * 4 + j] = acc2[i][j]; }
    __syncthreads();
    op.epi(T, T2, row0, col0, tid);
}

struct Bufs {
    const float* x; const float* in[16]; float* out;
    float *RX, *CQSS, *CKVSS, *KPESS, *KR, *KMEANP, *H1SS, *COSA, *SINA, *COSB, *SINB;
    bf16_t *QA, *KA, *VA, *CQKV, *QM, *KM, *VM, *AO, *H1B, *ACT;
};
enum { I_X = 0, I_GATT = 1, I_WIN = 2, I_GMQ = 3, I_GMK = 4, I_GQA = 5, I_WQUP = 6, I_GKVA = 7, I_WKVUP = 8, I_GLQ = 9, I_GLK = 10, I_WO = 11, I_GFFN = 12, I_WG = 13, I_WU = 14, I_WD = 15 };

struct OpInProj { static constexpr int K = DM, N = INW; static constexpr bool DUAL = false; Bufs B;
    __device__ float a(int m, int k) const { return B.x[(size_t)m * DM + k] * B.RX[m] * B.in[I_GATT][k]; }
    __device__ float b(int k, int n) const { return B.in[I_WIN][(size_t)k * INW + n]; }
    __device__ float b2(int, int) const { return 0.f; }
    __device__ void epi(float (*T)[65], float (*)[65], int row0, int col0, int tid) const {
        const int r = tid & 63, row = row0 + r, pos = row & (SEQ - 1);
        if (col0 < 1024) {
            const bool isq = col0 < 512; const float* g = B.in[isq ? I_GMQ : I_GMK];
            if (tid < 64) { float ss = 0.f; for (int d = 0; d < 64; ++d) ss += T[r][d] * T[r][d];
                const float rn = 1.0f / sqrtf(ss * (1.0f / 64) + EPS); float o[64];
#pragma unroll
                for (int d = 0; d < 32; ++d) { const float x1 = T[r][d] * rn * g[d], x2 = T[r][d + 32] * rn * g[d + 32], c = B.COSA[pos * 32 + d], s = B.SINA[pos * 32 + d]; o[d] = x1 * c - x2 * s; o[d + 32] = x2 * c + x1 * s; }
#pragma unroll
                for (int d = 0; d < 64; ++d) { T[r][d] = o[d]; if (isq) B.QA[(size_t)row * MW + col0 + d] = f2bf(o[d] * C2A); else B.KA[(size_t)row * MW + (col0 - 512) + d] = f2bf(o[d]); } }
            __syncthreads();
            if (!isq && tid < 64) { float cs = 0.f; for (int rr = 0; rr < 64; ++rr) cs += T[rr][tid];
                B.KMEANP[((size_t)(row0 >> 8) * 4 + ((row0 & 255) >> 6)) * MW + (col0 - 512) + tid] = cs; }
        } else if (col0 < 1536) { if (tid < 64) for (int d = 0; d < 64; ++d) B.VA[(size_t)row * MW + (col0 - 1024) + d] = f2bf(T[r][d]);
        } else if (col0 < 1792) { if (tid < 64) { float ss = 0.f; for (int d = 0; d < 64; ++d) { ss += T[r][d] * T[r][d]; B.CQKV[(size_t)row * 384 + (col0 - 1536) + d] = f2bf(T[r][d]); } B.CQSS[(size_t)row * 4 + ((col0 - 1536) >> 6)] = ss; }
        } else if (col0 < 1920) { if (tid < 64) { float ss = 0.f; for (int d = 0; d < 64; ++d) { ss += T[r][d] * T[r][d]; B.CQKV[(size_t)row * 384 + 256 + (col0 - 1792) + d] = f2bf(T[r][d]); } B.CKVSS[(size_t)row * 2 + ((col0 - 1792) >> 6)] = ss; }
        } else { if (tid < 64) { float ss = 0.f; for (int d = 0; d < 32; ++d) ss += T[r][d] * T[r][d]; B.KPESS[row] = ss; const float* g = B.in[I_GLK] + 64;
                for (int i = 0; i < 16; ++i) { const float x1 = T[r][i] * g[i], x2 = T[r][i + 16] * g[i + 16], c = B.COSB[pos * 16 + i], s = B.SINB[pos * 16 + i];
                    B.KR[(size_t)row * 32 + i] = x1 * c - x2 * s; B.KR[(size_t)row * 32 + i + 16] = x2 * c + x1 * s; } } }
    }
};
struct OpQUp { static constexpr int K = QR, N = 768; static constexpr bool DUAL = false; Bufs B;
    __device__ float a(int m, int k) const { return bf2f(B.CQKV[(size_t)m * 384 + k]) * B.in[I_GQA][k]; }
    __device__ float b(int k, int n) const { return B.in[I_WQUP][(size_t)k * 768 + n]; }
    __device__ float b2(int, int) const { return 0.f; }
    __device__ void epi(float (*T)[65], float (*)[65], int row0, int col0, int tid) const {
        if (tid < 64) { const int r = tid, row = row0 + r; const float* s4 = B.CQSS + (size_t)row * 4; const float rc = 1.0f / sqrtf((s4[0] + s4[1] + s4[2] + s4[3]) * (1.0f / QR) + EPS);
            for (int d = 0; d < 64; ++d) B.QM[(size_t)row * 768 + col0 + d] = f2bf(T[r][d] * rc); }
    }
};
struct OpKvUp { static constexpr int K = KVR, N = 1024; static constexpr bool DUAL = false; Bufs B;
    __device__ float a(int m, int k) const { return bf2f(B.CQKV[(size_t)m * 384 + 256 + k]) * B.in[I_GKVA][k]; }
    __device__ float b(int k, int n) const { return B.in[I_WKVUP][(size_t)k * 1024 + n]; }
    __device__ float b2(int, int) const { return 0.f; }
    __device__ void epi(float (*T)[65], float (*)[65], int row0, int col0, int tid) const {
        if (tid < 64) { const int r = tid, row = row0 + r, head = col0 >> 7; const float* s2 = B.CKVSS + (size_t)row * 2; const float rc = 1.0f / sqrtf((s2[0] + s2[1]) * (1.0f / KVR) + EPS);
            if ((col0 >> 6) & 1) { for (int d = 0; d < 64; ++d) B.VM[(size_t)row * MW + head * 64 + d] = f2bf(T[r][d] * rc); }
            else { float ss = B.KPESS[row]; for (int d = 0; d < 64; ++d) { const float v = T[r][d] * rc; ss += v * v; }
                const float rk = 1.0f / sqrtf(ss * (1.0f / QKD) + EPS); const float* g = B.in[I_GLK];
                for (int d = 0; d < 64; ++d) B.KM[(size_t)row * 768 + head * 96 + d] = f2bf(T[r][d] * rc * rk * g[d]);
                for (int d = 0; d < 32; ++d) B.KM[(size_t)row * 768 + head * 96 + 64 + d] = f2bf(B.KR[(size_t)row * 32 + d] * rk); } }
    }
};
struct OpOProj { static constexpr int K = DM, N = DM; static constexpr bool DUAL = false; Bufs B;
    __device__ float a(int m, int k) const { return bf2f(B.AO[(size_t)m * DM + k]); }
    __device__ float b(int k, int n) const { return B.in[I_WO][(size_t)k * DM + n]; }
    __device__ float b2(int, int) const { return 0.f; }
    __device__ void epi(float (*T)[65], float (*)[65], int row0, int col0, int tid) const {
        if (tid < 64) { const int r = tid, row = row0 + r; float ss = 0.f;
            for (int d = 0; d < 64; ++d) { const float h = B.x[(size_t)row * DM + col0 + d] + T[r][d]; ss += h * h; B.H1B[(size_t)row * DM + col0 + d] = f2bf(h); }
            atomicAdd(B.H1SS + row, ss); }
    }
};
struct OpFfn1 { static constexpr int K = DM, N = DFF; static constexpr bool DUAL = true; Bufs B;
    __device__ float a(int m, int k) const { return bf2f(B.H1B[(size_t)m * DM + k]) * B.in[I_GFFN][k]; }
    __device__ float b(int k, int n) const { return B.in[I_WG][(size_t)k * DFF + n]; }
    __device__ float b2(int k, int n) const { return B.in[I_WU][(size_t)k * DFF + n]; }
    __device__ void epi(float (*T)[65], float (*T2)[65], int row0, int col0, int tid) const {
        if (tid < 64) { const int r = tid, row = row0 + r; const float t = B.H1SS[row];
            const float rh = 1.0f / sqrtf(t * (1.0f / DM) + EPS);
            for (int d = 0; d < 64; ++d) { const float g = T[r][d] * rh, u = T2[r][d] * rh; B.ACT[(size_t)row * DFF + col0 + d] = f2bf(g / (1.0f + __expf(-g)) * u); } }
    }
};
struct OpFfn2 { static constexpr int K = DFF, N = DM; static constexpr bool DUAL = false; Bufs B;
    __device__ float a(int m, int k) const { return bf2f(B.ACT[(size_t)m * DFF + k]); }
    __device__ float b(int k, int n) const { return B.in[I_WD][(size_t)k * DM + n]; }
    __device__ float b2(int, int) const { return 0.f; }
    __device__ void epi(float (*T)[65], float (*)[65], int row0, int col0, int tid) const {
        if (tid < 64) { const int r = tid, row = row0 + r; for (int d = 0; d < 64; ++d) B.out[(size_t)row * DM + col0 + d] = bf2f(B.H1B[(size_t)row * DM + col0 + d]) + T[r][d]; }
    }
};

__global__ __launch_bounds__(256) void n_attn_moba(Bufs B) {
    const int gid = blockIdx.x * 256 + threadIdx.x, q = gid & (SEQ - 1), h = (gid >> 11) & 7, b = gid >> 14, row = b * SEQ + q, n = q >> 8;
    float qv[64];
#pragma unroll
    for (int d = 0; d < 64; ++d) qv[d] = bf2f(B.QA[(size_t)row * MW + h * 64 + d]);
    unsigned sel = (1u << n) - 1u;
    if (n > 3) { float gate[8];
#pragma unroll
        for (int j = 0; j < 8; ++j) { gate[j] = -INFINITY; if (j < n) { float g = 0.f; const float* kp = B.KMEANP + (size_t)(b * 8 + j) * 4 * MW + h * 64;
#pragma unroll
                for (int d = 0; d < 64; ++d) g += qv[d] * ((kp[d] + kp[MW + d]) + (kp[2 * MW + d] + kp[3 * MW + d])); gate[j] = g; } }
        sel = 0u;
#pragma unroll
        for (int j = 0; j < 8; ++j) { int rank = 0;
#pragma unroll
            for (int i = 0; i < 8; ++i) rank += (gate[i] > gate[j] || (gate[i] == gate[j] && i < j)) ? 1 : 0;
            if (j < n && rank < 3) sel |= 1u << j; } }
    float m = -INFINITY, l = 0.f, o[64];
#pragma unroll
    for (int d = 0; d < 64; ++d) o[d] = 0.f;
    for (int j = 0; j <= n; ++j) {
        const bool mine = (j == n) || ((sel >> j) & 1u);
        for (int kk = 0; kk < 256; ++kk) { const int key = j * 256 + kk; if (!mine || key > q) continue;
            const bf16_t* kr = B.KA + (size_t)(b * SEQ + key) * MW + h * 64; float s = 0.f;
#pragma unroll
            for (int d = 0; d < 64; ++d) s += qv[d] * bf2f(kr[d]);
            const float mn = fmaxf(m, s), al = exp2f(m - mn), p = exp2f(s - mn); m = mn; l = l * al + p;
            const bf16_t* vr = B.VA + (size_t)(b * SEQ + key) * MW + h * 64;
#pragma unroll
            for (int d = 0; d < 64; ++d) o[d] = o[d] * al + p * bf2f(vr[d]); } }
    const float il = 1.0f / l;
#pragma unroll
    for (int d = 0; d < 64; ++d) B.AO[(size_t)row * DM + h * 64 + d] = f2bf(o[d] * il);
}
__global__ __launch_bounds__(256) void n_attn_mla(Bufs B) {
    const int gid = blockIdx.x * 256 + threadIdx.x, q = gid & (SEQ - 1), h = (gid >> 11) & 7, b = gid >> 14, row = b * SEQ + q;
    float qv[96]; float ss = 0.f;
#pragma unroll
    for (int d = 0; d < 96; ++d) { qv[d] = bf2f(B.QM[(size_t)row * 768 + h * 96 + d]); ss += qv[d] * qv[d]; }
    const float rq = 1.0f / sqrtf(ss * (1.0f / QKD) + EPS); const float* g = B.in[I_GLQ];
#pragma unroll
    for (int d = 0; d < 96; ++d) qv[d] = qv[d] * rq * g[d];
#pragma unroll
    for (int i = 0; i < 16; ++i) { const float x1 = qv[64 + i], x2 = qv[80 + i], c = B.COSB[q * 16 + i], s = B.SINB[q * 16 + i]; qv[64 + i] = x1 * c - x2 * s; qv[80 + i] = x2 * c + x1 * s; }
#pragma unroll
    for (int d = 0; d < 96; ++d) qv[d] *= C2B;
    float m = -INFINITY, l = 0.f, o[64];
#pragma unroll
    for (int d = 0; d < 64; ++d) o[d] = 0.f;
    const int qmax = q | 63;
    for (int key = 0; key <= qmax; ++key) { if (key > q) continue;
        const bf16_t* kr = B.KM + (size_t)(b * SEQ + key) * 768 + h * 96; float s = 0.f;
#pragma unroll
        for (int d = 0; d < 96; ++d) s += qv[d] * bf2f(kr[d]);
        const float mn = fmaxf(m, s), al = exp2f(m - mn), p = exp2f(s - mn); m = mn; l = l * al + p;
        const bf16_t* vr = B.VM + (size_t)(b * SEQ + key) * MW + h * 64;
#pragma unroll
        for (int d = 0; d < 64; ++d) o[d] = o[d] * al + p * bf2f(vr[d]); }
    const float il = 1.0f / l;
#pragma unroll
    for (int d = 0; d < 64; ++d) B.AO[(size_t)row * DM + 512 + h * 64 + d] = f2bf(o[d] * il);
}
}
#ifndef H1SS_LDS
#define H1SS_LDS 0
#endif
constexpr int EPI_RED_LDS = 131072 + 2048;
#ifndef PROBE_ATOM2
#define PROBE_ATOM2 0
#endif
#ifndef EPI_LOAD_ALL
#define EPI_LOAD_ALL 0
#endif
constexpr size_t WS_GAIN = WS_TAB + 768 * 1024;
struct Ctx { const float* x; float* out; unsigned char* ws;
#define CTX_F(NAME, OFF) __device__ __forceinline__ float* NAME() const { return (float*)(ws + (OFF)); }
#define CTX_H(NAME, OFF) __device__ __forceinline__ bf16_t* NAME() const { return (bf16_t*)(ws + (OFF)); }
    CTX_F(RX, WS_RX) CTX_F(CQSS, WS_CQSS) CTX_F(CKVSS, WS_CKVSS) CTX_F(KPESS, WS_KPESS) CTX_F(KR, WS_KR) CTX_F(KMEANP, WS_KMEANP) CTX_F(H1SS, WS_H1SS) CTX_F(H1SSP, WS_H1SSP)
    CTX_F(COSA, WS_TAB) CTX_F(SINA, WS_TAB + 2048 * 32 * 4) CTX_F(COSB, WS_TAB + 2 * 2048 * 32 * 4) CTX_F(SINB, WS_TAB + 2 * 2048 * 32 * 4 + 2048 * 16 * 4)
    CTX_F(gmq, WS_GAIN) CTX_F(gmk, WS_GAIN + 256) CTX_F(glq, WS_GAIN + 512) CTX_F(glk, WS_GAIN + 896)
#if OUT_SCRATCH
#define CTX_O(NAME, OFF) __device__ __forceinline__ bf16_t* NAME() const { return (bf16_t*)((unsigned char*)out + (OFF)); }
    CTX_O(QA, OS_QA) CTX_O(KA, OS_KA) CTX_O(VA, OS_VA) CTX_O(CQKV, OS_CQKV)
#undef CTX_O
    CTX_H(QM, WS_QM) CTX_H(KM, WS_KM)
#else
    CTX_H(QA, WS_QA) CTX_H(KA, WS_KA) CTX_H(VA, WS_VA) CTX_H(CQKV, WS_CQKV) CTX_H(QM, WS_QM) CTX_H(KM, WS_KM)
#endif
    CTX_H(VM, WS_VM) CTX_H(AO, WS_AO) CTX_H(H1B, WS_H1B) CTX_H(ACT, WS_ACT)
    CTX_H(CQF, WS_CQF) CTX_H(XB, WS_XB) CTX_H(WIN, WS_WIN) CTX_H(WQUP, WS_WQUP) CTX_H(WKVUP, WS_WKVUP) CTX_H(WO, WS_WO) CTX_H(WGU, WS_WGU) CTX_H(WD, WS_WD)
#undef CTX_F
#undef CTX_H
};
#ifndef WGM_SET
#define WGM_SET 8
#endif
namespace pg8 {
#define PG8_LAS __attribute__((address_space(3)))
typedef short bf16x8 __attribute__((ext_vector_type(8)));
typedef float f32x4 __attribute__((ext_vector_type(4)));
typedef float f32x2 __attribute__((ext_vector_type(2)));
typedef unsigned u32x4 __attribute__((ext_vector_type(4)));
constexpr int BM = 256, BK = 64, HALF = 128, HTB = HALF * BK * 2  , STAGE_BYTES = 8 * HTB, NXCD = 8, WGM = WGM_SET;

__host__ __device__ __forceinline__ int lds_byte(int r, int c) { const int st = (r >> 4) * 2 + (c >> 5), rr = r & 15, cc = c & 31, ob = rr * 64 + cc * 2; return st * 1024 + (ob ^ (((ob >> 9) & 1) << 5)); }
__host__ __device__ __forceinline__ void stage_rc(int b, int& R, int& C) { const int st = b / 1024, sb = b % 1024, swz = sb ^ (((sb >> 9) & 1) << 5); R = (st >> 1) * 16 + swz / 64; C = (st & 1) * 32 + (swz % 64) / 2; }
__host__ __device__ __forceinline__ int perm32(int rho) { const int n = rho >> 4, i = rho & 15; return 8 * (i >> 2) + 4 * n + (i & 3); }

struct Unit { int pm, pn; };
struct Gemm { const bf16_t* A; const bf16_t* Bt; int M, N, K, lda; };

struct StaticOrder {
    int nM, nN, nwg, G, c;
    __host__ __device__ void init(int M_, int N_, int G_, int c_) { nM = M_ / BM; nN = N_ / BM; nwg = nM * nN; G = G_; c = c_; }
    __host__ __device__ bool next(int i, Unit& u) const {
        const long L = (long)i * G + c; if (L >= nwg) return false;
        int wgid = (int)L; { const int q = nwg / NXCD, r = nwg % NXCD, xcd = wgid % NXCD, off = wgid / NXCD; wgid = (xcd < r ? xcd * (q + 1) : r * (q + 1) + (xcd - r) * q) + off; }
        const int nig = WGM * nN, gid = wgid / nig, fm = gid * WGM, gsz = (nM - fm) < WGM ? (nM - fm) : WGM;
        u.pm = fm + ((wgid % nig) % gsz); u.pn = (wgid % nig) / gsz; return true;
    }
    __device__ __forceinline__ void a_ready(const Unit&) const {}
    __device__ __forceinline__ void done(const Unit&) const {}
};

typedef float f32x2_c __attribute__((ext_vector_type(2))); typedef __bf16 bf16x2_c __attribute__((ext_vector_type(2)));
__device__ __forceinline__ unsigned cvt_pk_bf16(float lo, float hi) { f32x2_c v = {lo, hi}; bf16x2_c b = __builtin_convertvector(v, bf16x2_c); return __builtin_bit_cast(unsigned, b); }
__device__ __forceinline__ u32x4 pack8(const f32x4 a, const f32x4 b) { u32x4 w; w.x = cvt_pk_bf16(a[0], a[1]); w.y = cvt_pk_bf16(a[2], a[3]); w.z = cvt_pk_bf16(b[0], b[1]); w.w = cvt_pk_bf16(b[2], b[3]); return w; }
__device__ __forceinline__ float hsum4(const f32x4 a) { return (a[0] + a[1]) + (a[2] + a[3]); }
__device__ __forceinline__ float dot4(const f32x4 a) { return (a[0] * a[0] + a[1] * a[1]) + (a[2] * a[2] + a[3] * a[3]); }
__device__ __forceinline__ float fq_sum(float s) { s += __shfl_xor(s, 16); s += __shfl_xor(s, 32); return s; }
__device__ __forceinline__ float rsq(float v) { return __builtin_amdgcn_rsqf(v); }
#define EPI_FENCE() asm volatile("" ::: "memory")
template <int MODE> __device__ __forceinline__ void st16(void* p, const u32x4 v) {
    if constexpr (MODE == 1) asm volatile("global_store_dwordx4 %0, %1, off sc1\n\ts_nop 1" :: "v"(p), "v"(v) : "memory");
    else if constexpr (MODE == 2) __builtin_nontemporal_store(v, (u32x4*)p);
    else *(u32x4*)p = v; }
#define OPAQUE(x) asm volatile("" : "+v"(x))
#ifndef SMALL_WT
#define SMALL_WT 0
#endif
__device__ __forceinline__ void stf(float* p, float v) { if (SMALL_WT) __hip_atomic_store(p, v, __ATOMIC_RELAXED, __HIP_MEMORY_SCOPE_AGENT); else *p = v; }
__device__ __forceinline__ void stf4(float* p, const f32x4 v) { if (SMALL_WT) asm volatile("global_store_dwordx4 %0, %1, off sc1\n\ts_nop 1" :: "v"(p), "v"(v) : "memory"); else *(f32x4*)p = v; }
#ifndef P1_SMALL_WT
#define P1_SMALL_WT SMALL_WT
#endif
__device__ __forceinline__ void stf1(float* p, float v) { if (P1_SMALL_WT) __hip_atomic_store(p, v, __ATOMIC_RELAXED, __HIP_MEMORY_SCOPE_AGENT); else *p = v; }
__device__ __forceinline__ void stf41(float* p, const f32x4 v) { if (P1_SMALL_WT) asm volatile("global_store_dwordx4 %0, %1, off sc1\n\ts_nop 1" :: "v"(p), "v"(v) : "memory"); else *(f32x4*)p = v; }

__device__ __forceinline__ int lane_now() { int l; asm volatile("v_mbcnt_lo_u32_b32 %0, -1, 0\n\tv_mbcnt_hi_u32_b32 %0, -1, %0" : "=v"(l)); return l; }


#ifndef P1_STORE_MODE
#define P1_STORE_MODE 0
#endif
#ifndef KSUM_DPP
#define KSUM_DPP 0
#endif
template <int CTRL> __device__ __forceinline__ float dpp_add(float v) { return v + __int_as_float(__builtin_amdgcn_update_dpp(0, __float_as_int(v), CTRL, 0xf, 0xf, false)); }
__device__ __forceinline__ float row16_sum(float v) { v = dpp_add<0x128>(v); v = dpp_add<0x124>(v); v = dpp_add<0x122>(v); v = dpp_add<0x121>(v); return v; }
__device__ __forceinline__ float shfl16_sum(float v) { v += __shfl_xor(v, 1); v += __shfl_xor(v, 2); v += __shfl_xor(v, 4); v += __shfl_xor(v, 8); return v; }
#ifndef KSUM_HALF
#define KSUM_HALF 0
#endif
#ifndef QA_FRAG
#define QA_FRAG 0
#endif
#ifndef CQ_FRAG
#define CQ_FRAG 0
#endif
#ifndef KSUM_EPI
#define KSUM_EPI 0
#endif
struct EpiInProj { static constexpr bool PERM = true, AFTER_DRAIN = false; static constexpr int S_EPI = 0; Ctx B;
    __device__ __forceinline__ void qk(const f32x4 (&acc)[2][2][4][2], const Unit& u, int wr, int wc, int fr, int fq, int rbase, bool isq) const {
        const int head = (u.pn & 1) * 4 + wc; const float* g = isq ? B.gmq() : B.gmk();
        f32x4 g0[2], g1[2], cd[2], sd[2];
#pragma unroll
        for (int n = 0; n < 2; ++n) { g0[n] = *(const f32x4*)(g + fq * 8 + n * 4); g1[n] = *(const f32x4*)(g + 32 + fq * 8 + n * 4);
            cd[n] = *(const f32x4*)(B.COSA() + 16 * 32 + fq * 8 + n * 4); sd[n] = *(const f32x4*)(B.SINA() + 16 * 32 + fq * 8 + n * 4); }
        bf16_t* dst = (isq ? B.QA() : B.KA()) + head * 64 + fq * 8; const float osc = isq ? C2A : 1.0f;
#if KSUM_EPI && KSUM_HALF
        float ks[16];
#pragma unroll
        for (int j = 0; j < 16; ++j) ks[j] = 0.f;
#endif
#pragma unroll
        for (int ai = 0; ai < 2; ++ai) { f32x4 c[2], sn[2]; float rx[4]; int rb = rbase + ai * HALF; OPAQUE(rb); const int pos0 = rb & (SEQ - 1);
#if KSUM_EPI && !KSUM_HALF
            float ks[16];
#pragma unroll
            for (int j = 0; j < 16; ++j) ks[j] = 0.f;
#endif
#pragma unroll
            for (int m = 0; m < 4; ++m) rx[m] = B.RX()[rb + m * 16];
#pragma unroll
            for (int n = 0; n < 2; ++n) { c[n] = *(const f32x4*)(B.COSA() + pos0 * 32 + fq * 8 + n * 4); sn[n] = *(const f32x4*)(B.SINA() + pos0 * 32 + fq * 8 + n * 4); }
#pragma unroll
            for (int m = 0; m < 4; ++m) { const int row = rb + m * 16; float ss = 0.f;
#pragma unroll
                for (int bj = 0; bj < 2; ++bj)
#pragma unroll
                    for (int n = 0; n < 2; ++n) ss += dot4(acc[ai][bj][m][n]);
                const float rxv = rx[m]; ss = fq_sum(ss) * rxv * rxv; const float rn = rsq(ss * (1.0f / 64) + EPS) * rxv * osc; f32x4 o1[2], o2[2];
#pragma unroll
                for (int n = 0; n < 2; ++n) { const f32x4 x1 = acc[ai][0][m][n] * rn * g0[n], x2 = acc[ai][1][m][n] * rn * g1[n]; o1[n] = x1 * c[n] - x2 * sn[n]; o2[n] = x2 * c[n] + x1 * sn[n];
                    const f32x4 cn = c[n] * cd[n] - sn[n] * sd[n]; sn[n] = sn[n] * cd[n] + c[n] * sd[n]; c[n] = cn; }
                const u32x4 w1 = pack8(o1[0], o1[1]), w2 = pack8(o2[0], o2[1]);
                if (QA_FRAG && isq) {
                    bf16_t* qf_ = B.QA() + ((size_t)head * M + (size_t)(row & ~31)) * 64 + (size_t)(row & 31) * 8;
                    st16<P1_STORE_MODE>(qf_ + (((fq >> 1) * 2 + (fq & 1)) * 32) * 8, w1); st16<P1_STORE_MODE>(qf_ + (((2 + (fq >> 1)) * 2 + (fq & 1)) * 32) * 8, w2); }
                else { st16<P1_STORE_MODE>(dst + (size_t)row * MW, w1); st16<P1_STORE_MODE>(dst + (size_t)row * MW + 32, w2); }
#if KSUM_EPI
                if (!isq) {
#pragma unroll
                    for (int j = 0; j < 4; ++j) { ks[2 * j] += __uint_as_float(w1[j] << 16); ks[2 * j + 1] += __uint_as_float(w1[j] & 0xffff0000u); ks[8 + 2 * j] += __uint_as_float(w2[j] << 16); ks[9 + 2 * j] += __uint_as_float(w2[j] & 0xffff0000u); } }
#endif
            }
#if KSUM_EPI
            if (!isq && (!KSUM_HALF || ai == 1)) {
#pragma unroll
                for (int j = 0; j < 16; ++j) ks[j] = KSUM_DPP ? row16_sum(ks[j]) : shfl16_sum(ks[j]);
                if (fr == 0) { float* kd = B.KMEANP() + ((size_t)u.pm * 4 + (KSUM_HALF ? wr : 2 * ai + wr)) * MW + head * 64 + fq * 8;
                    stf41(kd, (f32x4){ks[0], ks[1], ks[2], ks[3]}); stf41(kd + 4, (f32x4){ks[4], ks[5], ks[6], ks[7]}); stf41(kd + 32, (f32x4){ks[8], ks[9], ks[10], ks[11]}); stf41(kd + 36, (f32x4){ks[12], ks[13], ks[14], ks[15]}); } }
#endif
        }
    }
    __device__ __forceinline__ void operator()(const f32x4 (&acc)[2][2][4][2], const Unit& u, int wr, int wc, int fr, int fq) const {
        const int pn = u.pn; int rbase = u.pm * BM + wr * 64 + fr; OPAQUE(rbase);
        if (pn < 4) { qk(acc, u, wr, wc, fr, fq, rbase, pn < 2); return; }
        float rx[2][4];
#pragma unroll
        for (int ai = 0; ai < 2; ++ai)
#pragma unroll
            for (int m = 0; m < 4; ++m) rx[ai][m] = B.RX()[rbase + ai * HALF + m * 16];
        if (pn < 6) {
            bf16_t* dst = B.VA() + ((pn - 4) * 4 + wc) * 64 + fq * 8;
#pragma unroll
            for (int ai = 0; ai < 2; ++ai)
#pragma unroll
                for (int m = 0; m < 4; ++m) { const int row = rbase + ai * HALF + m * 16; const float rxv = rx[ai][m];
#pragma unroll
                    for (int bj = 0; bj < 2; ++bj) st16<P1_STORE_MODE>(dst + (size_t)row * MW + bj * 32, pack8(acc[ai][bj][m][0] * rxv, acc[ai][bj][m][1] * rxv)); }
        } else if (pn == 6 || wc < 2) {
            const int cb = (pn == 6 ? 0 : 256) + wc * 64 + fq * 8; float* ssp = pn == 6 ? B.CQSS() + wc : B.CKVSS() + wc; const int sstr = pn == 6 ? 4 : 2;
#pragma unroll
            for (int ai = 0; ai < 2; ++ai)
#pragma unroll
                for (int m = 0; m < 4; ++m) { const int row = rbase + ai * HALF + m * 16; const float rxv = rx[ai][m]; float ss = 0.f;
#pragma unroll
                    for (int bj = 0; bj < 2; ++bj) { const f32x4 a = acc[ai][bj][m][0] * rxv, b = acc[ai][bj][m][1] * rxv; ss += dot4(a) + dot4(b); if (CQ_FRAG && pn == 6) { const int c_ = 8 * wc + 4 * bj + fq;
                        st16<P1_STORE_MODE>(B.CQF() + ((((size_t)(row >> 5) * 16 + (c_ >> 1)) * 2 + (c_ & 1)) * 32 + (row & 31)) * 8, pack8(a, b)); }
                    else st16<P1_STORE_MODE>(B.CQKV() + (size_t)row * 384 + cb + bj * 32, pack8(a, b)); }
                    ss = fq_sum(ss); if (fq == 0) stf1(ssp + (size_t)row * sstr, ss); }
        } else if (wc == 2) {
            const float* g = B.glk() + 64 + fq * 8; const f32x4 ga = *(const f32x4*)g, gb = *(const f32x4*)(g + 4); const float sg = fq < 2 ? -1.f : 1.f;
#pragma unroll
            for (int ai = 0; ai < 2; ++ai)
#pragma unroll
                for (int m = 0; m < 4; ++m) { int row = rbase + ai * HALF + m * 16; OPAQUE(row); const int pos = row & (SEQ - 1); const float rxv = rx[ai][m];
                    const f32x4 a = acc[ai][0][m][0] * rxv, b = acc[ai][0][m][1] * rxv; float ss = fq_sum(dot4(a) + dot4(b)); if (fq == 0) stf1(B.KPESS() + row, ss);
                    const f32x4 xa = a * ga, xb = b * gb; f32x4 pa, pb;
#pragma unroll
                    for (int j = 0; j < 4; ++j) { pa[j] = __shfl_xor(xa[j], 32); pb[j] = __shfl_xor(xb[j], 32); }
                    const int ci = pos * 16 + (fq & 1) * 8; const f32x4 ca = *(const f32x4*)(B.COSB() + ci), cb = *(const f32x4*)(B.COSB() + ci + 4), sa = *(const f32x4*)(B.SINB() + ci), sb = *(const f32x4*)(B.SINB() + ci + 4);
                    stf41(B.KR() + (size_t)row * 32 + fq * 8, xa * ca + pa * sa * sg); stf41(B.KR() + (size_t)row * 32 + fq * 8 + 4, xb * cb + pb * sb * sg); }
        }
    }
};
#ifndef P2_STORE_MODE
#define P2_STORE_MODE 0
#endif
struct EpiQUp { static constexpr bool PERM = true, AFTER_DRAIN = false; static constexpr int S_EPI = 8; Ctx B;
    __device__ __forceinline__ void operator()(const f32x4 (&acc)[2][2][4][2], const Unit& u, int wr, int wc, int fr, int fq) const {
        int rbase = u.pm * BM + wr * 64 + fr; OPAQUE(rbase); const int head = 2 * u.pn + (wc >> 1), dbase = (wc & 1) ? 64 : 0; bf16_t* dst = B.QM() + head * 96 + dbase + fq * 8;
#pragma unroll
        for (int ai = 0; ai < 2; ++ai) { int rb = rbase + ai * HALF; OPAQUE(rb); f32x4 s4[4];
#pragma unroll
            for (int m = 0; m < 4; ++m) s4[m] = *(const f32x4*)(B.CQSS() + (size_t)(rb + m * 16) * 4);
#pragma unroll
            for (int m = 0; m < 4; ++m) { const int row = rb + m * 16; const float rc = rsq(hsum4(s4[m]) * (1.0f / QR) + EPS);
                st16<P2_STORE_MODE>(dst + (size_t)row * 768, pack8(acc[ai][0][m][0] * rc, acc[ai][0][m][1] * rc));
                if (!(wc & 1)) st16<P2_STORE_MODE>(dst + (size_t)row * 768 + 32, pack8(acc[ai][1][m][0] * rc, acc[ai][1][m][1] * rc)); } }
    }
};
struct EpiKvUp { static constexpr bool PERM = true, AFTER_DRAIN = false; static constexpr int S_EPI = 16; Ctx B;
    __device__ __forceinline__ void operator()(const f32x4 (&acc)[2][2][4][2], const Unit& u, int wr, int wc, int fr, int fq) const {
        int rbase = u.pm * BM + wr * 64 + fr; OPAQUE(rbase); const int head = 2 * u.pn + (wc >> 1);
        if (wc & 1) { bf16_t* dst = B.VM() + head * 64 + fq * 8; f32x2 s2[2][4];
#pragma unroll
            for (int ai = 0; ai < 2; ++ai)
#pragma unroll
                for (int m = 0; m < 4; ++m) s2[ai][m] = *(const f32x2*)(B.CKVSS() + (size_t)(rbase + ai * HALF + m * 16) * 2);
#pragma unroll
            for (int ai = 0; ai < 2; ++ai)
#pragma unroll
                for (int m = 0; m < 4; ++m) { const int row = rbase + ai * HALF + m * 16; const float rc = rsq((s2[ai][m][0] + s2[ai][m][1]) * (1.0f / KVR) + EPS);
#pragma unroll
                    for (int bj = 0; bj < 2; ++bj) st16<P2_STORE_MODE>(dst + (size_t)row * MW + bj * 32, pack8(acc[ai][bj][m][0] * rc, acc[ai][bj][m][1] * rc)); }
        } else { int fqo = fq; OPAQUE(fqo); const float* g = B.glk() + fqo * 8; f32x4 gg[2][2];
#pragma unroll
            for (int bj = 0; bj < 2; ++bj)
#pragma unroll
                for (int n = 0; n < 2; ++n) gg[bj][n] = *(const f32x4*)(g + bj * 32 + n * 4);
            bf16_t* dst = B.KM() + head * 96 + fq * 8;
#pragma unroll
            for (int ai = 0; ai < 2; ++ai) { int rb = rbase + ai * HALF; OPAQUE(rb); float kp[4]; f32x4 ka[4], kb[4]; f32x2 s2v[4];
#pragma unroll
                for (int m = 0; m < 4; ++m) { const int row = rb + m * 16; kp[m] = B.KPESS()[row]; s2v[m] = *(const f32x2*)(B.CKVSS() + (size_t)row * 2); ka[m] = *(const f32x4*)(B.KR() + (size_t)row * 32 + fq * 8); kb[m] = *(const f32x4*)(B.KR() + (size_t)row * 32 + fq * 8 + 4); }
#pragma unroll
                for (int m = 0; m < 4; ++m) { const int row = rb + m * 16; const float rc = rsq((s2v[m][0] + s2v[m][1]) * (1.0f / KVR) + EPS);
                    f32x4 v[2][2]; float ss = 0.f;
#pragma unroll
                    for (int bj = 0; bj < 2; ++bj)
#pragma unroll
                        for (int n = 0; n < 2; ++n) { v[bj][n] = acc[ai][bj][m][n] * rc; ss += dot4(v[bj][n]); }
                    ss = fq_sum(ss) + kp[m]; const float rk = rsq(ss * (1.0f / QKD) + EPS);
#pragma unroll
                    for (int bj = 0; bj < 2; ++bj) st16<P2_STORE_MODE>(dst + (size_t)row * 768 + bj * 32, pack8(v[bj][0] * rk * gg[bj][0], v[bj][1] * rk * gg[bj][1]));
                    st16<P2_STORE_MODE>(dst + (size_t)row * 768 + 64, pack8(ka[m] * rk, kb[m] * rk)); } }
        }
    }
};
template <int WT = 0> struct EpiOProjT { static constexpr bool PERM = true, AFTER_DRAIN = false; static constexpr int S_EPI = 16; Ctx B;
    __device__ __forceinline__ void operator()(const f32x4 (&acc)[2][2][4][2], const Unit& u, int wr, int wc, int fr, int fq) const {
        const int rbase = u.pm * BM + wr * 64 + fr, col = u.pn * BM + wc * 64 + fq * 8;
#if EPI_LOAD_ALL
        u32x4 xwa[2][4][2];
#pragma unroll
        for (int ai = 0; ai < 2; ++ai) { int rb = rbase + ai * HALF; OPAQUE(rb);
#pragma unroll
            for (int m = 0; m < 4; ++m)
#pragma unroll
                for (int bj = 0; bj < 2; ++bj) xwa[ai][m][bj] = *(const u32x4*)(B.XB() + (size_t)(rb + m * 16) * DM + col + bj * 32); }
#endif
#pragma unroll
        for (int ai = 0; ai < 2; ++ai) { int rb = rbase + ai * HALF; OPAQUE(rb);
#if EPI_LOAD_ALL
            u32x4 (&xw)[4][2] = xwa[ai];
#else
            u32x4 xw[4][2];
#pragma unroll
            for (int m = 0; m < 4; ++m)
#pragma unroll
                for (int bj = 0; bj < 2; ++bj) xw[m][bj] = *(const u32x4*)(B.XB() + (size_t)(rb + m * 16) * DM + col + bj * 32);
#endif
#pragma unroll
            for (int m = 0; m < 4; ++m) { const int row = rb + m * 16; const size_t off = (size_t)row * DM + col; float ss = 0.f;
#pragma unroll
                for (int bj = 0; bj < 2; ++bj) { const u32x4 w = xw[m][bj];
                    const f32x4 x0 = {__uint_as_float(w.x << 16), __uint_as_float(w.x & 0xffff0000u), __uint_as_float(w.y << 16), __uint_as_float(w.y & 0xffff0000u)};
                    const f32x4 x1 = {__uint_as_float(w.z << 16), __uint_as_float(w.z & 0xffff0000u), __uint_as_float(w.w << 16), __uint_as_float(w.w & 0xffff0000u)};
                    const f32x4 a = x0 + acc[ai][bj][m][0], b = x1 + acc[ai][bj][m][1];
                    ss += dot4(a) + dot4(b); st16<WT>(B.H1B() + off + bj * 32, pack8(a, b)); }
                ss = fq_sum(ss);
#if H1SS_LDS
                if (fq == 0) ((PG8_LAS float*)EPI_RED_LDS)[wc * 256 + (row - u.pm * BM)] = ss; } }
        asm volatile("s_waitcnt lgkmcnt(0)" ::: "memory"); __syncthreads();
        if (wr == 0) { const int t = wc * 64 + fq * 16 + fr; PG8_LAS const float* rd = (PG8_LAS const float*)EPI_RED_LDS + t; stf(B.H1SSP() + (size_t)(u.pm * BM + t) * 4 + u.pn, (rd[0] + rd[256]) + (rd[512] + rd[768])); }
#else
                if (fq == 0) { if (PROBE_ATOM2) { atomicAdd(B.H1SS() + row, 0.5f * ss); atomicAdd(B.H1SS() + row, 0.5f * ss); } else atomicAdd(B.H1SS() + row, ss); } } }
#endif
    }
};
#ifndef P4_WT
#define P4_WT 0
#endif
typedef EpiOProjT<P4_WT> EpiOProj;
#ifndef FFN1_FMA
#define FFN1_FMA 0
#endif
template <int WT = 0> struct EpiFfn1T { static constexpr bool PERM = true, AFTER_DRAIN = false; static constexpr int S_EPI = 8; Ctx B;
    __device__ __forceinline__ void operator()(const f32x4 (&acc)[2][2][4][2], const Unit& u, int wr, int wc, int fr, int fq) const {
        const int rbase = u.pm * BM + wr * 64 + fr, col = u.pn * HALF + wc * 32 + fq * 8; float ssv[2][4];
#pragma unroll
        for (int ai = 0; ai < 2; ++ai)
#pragma unroll
#if H1SS_LDS
            for (int m = 0; m < 4; ++m) ssv[ai][m] = hsum4(*(const f32x4*)(B.H1SSP() + (size_t)(rbase + ai * HALF + m * 16) * 4));
#else
            for (int m = 0; m < 4; ++m) ssv[ai][m] = B.H1SS()[rbase + ai * HALF + m * 16];
#endif
#pragma unroll
        for (int ai = 0; ai < 2; ++ai)
#pragma unroll
            for (int m = 0; m < 4; ++m) { int row = rbase + ai * HALF + m * 16; OPAQUE(row);
#if FFN1_FMA
                const float q = ssv[ai][m] * (1.0f / DM) + EPS, nrl = -LOG2E * rsq(q); f32x4 o[2];
#pragma unroll
                for (int n = 0; n < 2; ++n) { const f32x4 ga = acc[ai][0][m][n], gu = ga * acc[ai][1][m][n], x = ga * nrl; f32x4 e, r;
#pragma unroll
                    for (int j = 0; j < 4; ++j) e[j] = __builtin_amdgcn_exp2f(x[j]);
                    const f32x4 d = e * q + q;
#pragma unroll
                    for (int j = 0; j < 4; ++j) r[j] = __builtin_amdgcn_rcpf(d[j]);
                    o[n] = gu * r; }
#else
                const float rh = rsq(ssv[ai][m] * (1.0f / DM) + EPS), nrl = -LOG2E * rh, rh2 = rh * rh; f32x4 o[2];
#pragma unroll
                for (int n = 0; n < 2; ++n) { const f32x4 ga = acc[ai][0][m][n], gu = ga * acc[ai][1][m][n];
#pragma unroll
                    for (int j = 0; j < 4; ++j) o[n][j] = gu[j] * (rh2 * __builtin_amdgcn_rcpf(1.0f + __builtin_amdgcn_exp2f(ga[j] * nrl))); }
#endif
                st16<WT>(B.ACT() + (size_t)row * DFF + col, pack8(o[0], o[1])); }
    }
};
#ifndef ACT_STORE_MODE
#define ACT_STORE_MODE 0
#endif
typedef EpiFfn1T<ACT_STORE_MODE> EpiFfn1;
#ifndef OUT_XPOSE
#define OUT_XPOSE 0
#endif
#ifndef OUT_WT
#define OUT_WT 0
#endif
#ifndef OUT_STORE_NT
#define OUT_STORE_NT 0
#endif
struct EpiFfn2 { static constexpr bool PERM = true, AFTER_DRAIN = false; static constexpr int S_EPI = 32; Ctx B;
    __device__ __forceinline__ void operator()(const f32x4 (&acc)[2][2][4][2], const Unit& u, int wr, int wc, int fr, int fq) const {
        const int rbase = u.pm * BM + wr * 64 + fr, col = u.pn * BM + wc * 64 + fq * 8;
#if EPI_LOAD_ALL
        u32x4 hwa[2][4][2];
#pragma unroll
        for (int ai = 0; ai < 2; ++ai) { int rb = rbase + ai * HALF; OPAQUE(rb);
#pragma unroll
            for (int m = 0; m < 4; ++m)
#pragma unroll
                for (int bj = 0; bj < 2; ++bj) hwa[ai][m][bj] = __builtin_nontemporal_load((const u32x4*)(B.H1B() + (size_t)(rb + m * 16) * DM + col + bj * 32)); }
#endif
#pragma unroll
        for (int ai = 0; ai < 2; ++ai) { int rb = rbase + ai * HALF; OPAQUE(rb);
#if EPI_LOAD_ALL
            u32x4 (&hw)[4][2] = hwa[ai];
#else
            u32x4 hw[4][2];
#pragma unroll
            for (int m = 0; m < 4; ++m)
#pragma unroll
                for (int bj = 0; bj < 2; ++bj) hw[m][bj] = __builtin_nontemporal_load((const u32x4*)(B.H1B() + (size_t)(rb + m * 16) * DM + col + bj * 32));
#endif
#pragma unroll
            for (int m = 0; m < 4; ++m) { const size_t off = (size_t)(rb + m * 16) * DM + col;
#pragma unroll
                for (int bj = 0; bj < 2; ++bj) { const u32x4 w = hw[m][bj];
                    const f32x4 h0 = {__uint_as_float(w.x << 16), __uint_as_float(w.x & 0xffff0000u), __uint_as_float(w.y << 16), __uint_as_float(w.y & 0xffff0000u)};
                    const f32x4 h1 = {__uint_as_float(w.z << 16), __uint_as_float(w.z & 0xffff0000u), __uint_as_float(w.w << 16), __uint_as_float(w.w & 0xffff0000u)};
                    f32x4 o0 = h0 + acc[ai][bj][m][0], o1 = h1 + acc[ai][bj][m][1];
#if OUT_XPOSE
#pragma unroll
                    for (int k = 0; k < 4; ++k) { auto r = __builtin_amdgcn_permlane16_swap(__float_as_uint(o0[k]), __float_as_uint(o1[k]), false, false); auto q = __builtin_amdgcn_permlane32_swap(r[0], r[1], false, false); o0[k] = __uint_as_float(q[0]); o1[k] = __uint_as_float(q[1]); }
                    float* po = B.out + (off - fq * 4) + bj * 32;
#if OUT_WT
                    WT_STORE16_ASM(po, o0); WT_STORE16_ASM(po + 16, o1); } } }
#else
                    __builtin_nontemporal_store(o0, (f32x4*)po); __builtin_nontemporal_store(o1, (f32x4*)(po + 16)); } } }
#endif
#elif OUT_WT
                    WT_STORE16_ASM(B.out + off + bj * 32, o0); WT_STORE16_ASM(B.out + off + bj * 32 + 4, o1); } } }
#elif OUT_STORE_NT
                    __builtin_nontemporal_store(o0, (f32x4*)(B.out + off + bj * 32)); __builtin_nontemporal_store(o1, (f32x4*)(B.out + off + bj * 32 + 4)); } } }
#else
                    *(f32x4*)(B.out + off + bj * 32) = o0; *(f32x4*)(B.out + off + bj * 32 + 4) = o1; } } }
#endif
    }
};

template <class Epi, class Sched, bool ALIGN_EPI>
__device__ __forceinline__ void gemm_phase(PG8_LAS unsigned char* lds, const Gemm g, const Sched& S, const Epi& E) {
    const int tid = threadIdx.x, wid = __builtin_amdgcn_readfirstlane(tid >> 6), lane = tid & 63, wr = wid >> 2, wc = wid & 3, fr = lane & 15, fq = lane >> 4;
    const int K = g.K, nt = K / BK, lda = g.lda;
    unsigned voffA[2], voffB[2];
#pragma unroll
    for (int i = 0; i < 2; ++i) { int R, C; stage_rc(tid * 16 + i * 8192, R, C); const int Rb = Epi::PERM ? ((R & ~31) + perm32(R & 31)) : R;
        voffA[i] = (unsigned)(R * lda + C) * 2u; voffB[i] = (unsigned)(Rb * K + C) * 2u; }
    const size_t kstep = (size_t)(BK * 2);
    const size_t hstepA = (size_t)HALF * lda * 2, hstepB = (size_t)HALF * K * 2;
    const size_t tstepA = 2 * hstepA, tstepB = 2 * hstepB;
    const unsigned ldsw = (unsigned)wid * 1024u;
    const int aoff = lds_byte(wr * 64 + fr, fq * 8), boff = lds_byte(wc * 32 + fr, fq * 8);
#define PG8_SA(b, h) (((b) * 2 + (h)) * HTB)
#define PG8_SB(b, h) ((4 + (b) * 2 + (h)) * HTB)
#define PG8_STAGE(bufoff, gbase, voff) do { _Pragma("unroll") for (int _i = 0; _i < 2; ++_i) \
        __builtin_amdgcn_global_load_lds((const unsigned*)((const char*)(gbase) + (voff)[_i]), (PG8_LAS unsigned*)(lds + (bufoff) + ldsw + _i * 8192), 16, 0, 0); } while (0)
#define PG8_LDA(dst, b, h) do { _Pragma("unroll") for (int m = 0; m < 4; ++m) _Pragma("unroll") for (int k = 0; k < 2; ++k) dst[m][k] = *(const PG8_LAS bf16x8*)(lds + PG8_SA(b, h) + aoff + m * 2048 + k * 1024); } while (0)
#define PG8_LDB(dst, b, h) do { _Pragma("unroll") for (int n = 0; n < 2; ++n) _Pragma("unroll") for (int k = 0; k < 2; ++k) dst[n][k] = *(const PG8_LAS bf16x8*)(lds + PG8_SB(b, h) + boff + n * 2048 + k * 1024); } while (0)
#define PG8_MMA(ai, bj, At, Bt) do { __builtin_amdgcn_s_setprio(1); _Pragma("unroll") for (int m = 0; m < 4; ++m) _Pragma("unroll") for (int n = 0; n < 2; ++n) _Pragma("unroll") for (int k = 0; k < 2; ++k) \
        acc[ai][bj][m][n] = __builtin_amdgcn_mfma_f32_16x16x32_bf16(Bt[n][k], At[m][k], acc[ai][bj][m][n], 0, 0, 0); __builtin_amdgcn_s_setprio(0); } while (0)
#define PG8_WAIT_V(n) asm volatile("s_waitcnt vmcnt(" #n ")" ::: "memory")
#define PG8_WAIT_L(n) asm volatile("s_waitcnt lgkmcnt(" #n ")" ::: "memory")
#define PG8_BAR __builtin_amdgcn_s_barrier()
#define PG8_SCHED __builtin_amdgcn_sched_barrier(0)
    Unit cur, nxt; int ui = 0;
    if (!S.next(0, cur)) return;
    f32x4 acc[2][2][4][2];
#pragma unroll
    for (int a = 0; a < 2; ++a)
#pragma unroll
        for (int b = 0; b < 2; ++b)
#pragma unroll
            for (int m = 0; m < 4; ++m)
#pragma unroll
                for (int n = 0; n < 2; ++n) acc[a][b][m][n] = (f32x4){0.f, 0.f, 0.f, 0.f};
    bf16x8 At[4][2], B0[2][2], B1[2][2];
    const char* cA = (const char*)g.A + (size_t)cur.pm * tstepA; const char* cB = (const char*)g.Bt + (size_t)cur.pn * tstepB;
    S.a_ready(cur);
    PG8_STAGE(PG8_SB(0, 0), cB, voffB); PG8_STAGE(PG8_SB(0, 1), cB + hstepB, voffB); PG8_STAGE(PG8_SA(0, 0), cA, voffA); PG8_STAGE(PG8_SA(0, 1), cA + hstepA, voffA);
    if (wr == 1) PG8_BAR;
    PG8_WAIT_V(2); PG8_BAR;
    PG8_STAGE(PG8_SB(1, 0), cB + kstep, voffB); PG8_STAGE(PG8_SA(1, 0), cA + kstep, voffA); PG8_STAGE(PG8_SB(1, 1), cB + hstepB + kstep, voffB);
    PG8_WAIT_V(6); PG8_BAR;
    for (;;) {
        const bool has_next = S.next(ui + 1, nxt);
        const char* nA = has_next ? (const char*)g.A + (size_t)nxt.pm * tstepA : cA; const char* nB = has_next ? (const char*)g.Bt + (size_t)nxt.pn * tstepB : cB;
#pragma unroll 1
        for (int t = 0; t < nt; t += 2) {
            const bool last = (t == nt - 2);
            const char* a1 = cA + (size_t)(t + 1) * kstep;
            const char* a2 = last ? nA : cA + (size_t)(t + 2) * kstep; const char* b2 = last ? nB : cB + (size_t)(t + 2) * kstep;
            const char* a3 = a2 + kstep; const char* b3 = b2 + kstep;
            if (last && has_next) S.a_ready(nxt);
            PG8_LDB(B0, 0, 0); PG8_LDB(B1, 0, 1); PG8_SCHED; PG8_LDA(At, 0, 0); PG8_STAGE(PG8_SA(1, 1), a1 + hstepA, voffA);
            PG8_WAIT_V(8); PG8_WAIT_L(0); PG8_BAR; PG8_MMA(0, 0, At, B0); PG8_MMA(0, 1, At, B1); PG8_BAR; PG8_SCHED;
            PG8_LDA(At, 0, 1); PG8_STAGE(PG8_SB(0, 0), b2, voffB); PG8_STAGE(PG8_SB(0, 1), b2 + hstepB, voffB); PG8_STAGE(PG8_SA(0, 0), a2, voffA);
            PG8_WAIT_V(8); PG8_WAIT_L(0); PG8_BAR; PG8_MMA(1, 0, At, B0); PG8_MMA(1, 1, At, B1); PG8_BAR; PG8_SCHED;
            PG8_LDB(B0, 1, 0); PG8_LDB(B1, 1, 1); PG8_SCHED; PG8_LDA(At, 1, 0); PG8_STAGE(PG8_SA(0, 1), a2 + hstepA, voffA);
            PG8_WAIT_V(8); PG8_WAIT_L(0); PG8_BAR; PG8_MMA(0, 0, At, B0); PG8_MMA(0, 1, At, B1); PG8_BAR; PG8_SCHED;
            PG8_LDA(At, 1, 1); PG8_STAGE(PG8_SB(1, 0), b3, voffB); PG8_STAGE(PG8_SB(1, 1), b3 + hstepB, voffB); PG8_STAGE(PG8_SA(1, 0), a3, voffA);
            PG8_WAIT_V(8); PG8_WAIT_L(0); PG8_BAR; PG8_MMA(1, 0, At, B0); PG8_MMA(1, 1, At, B1); PG8_BAR; PG8_SCHED;
        }
        if constexpr (ALIGN_EPI) { if (wr == 0) PG8_BAR; }
        { int fr_ = fr, fq_ = fq; OPAQUE(fr_); OPAQUE(fq_); E(acc, cur, wr, wc, fr_, fq_); } S.done(cur);
        if (!has_next) break;
#pragma unroll
        for (int a = 0; a < 2; ++a)
#pragma unroll
            for (int b = 0; b < 2; ++b)
#pragma unroll
                for (int m = 0; m < 4; ++m)
#pragma unroll
                    for (int n = 0; n < 2; ++n) acc[a][b][m][n] = (f32x4){0.f, 0.f, 0.f, 0.f};
        cur = nxt; cA = nA; cB = nB; ++ui;
        if constexpr (ALIGN_EPI) { if (wr == 1) PG8_BAR; }
    }
    PG8_WAIT_V(0);
    if constexpr (!ALIGN_EPI) { if (wr == 0) PG8_BAR; }
    PG8_BAR;
#undef PG8_SA
#undef PG8_SB
#undef PG8_STAGE
#undef PG8_LDA
#undef PG8_LDB
#undef PG8_MMA
#undef PG8_WAIT_V
#undef PG8_WAIT_L
#undef PG8_BAR
#undef PG8_SCHED
}

#ifndef STREAM_ALIGN_EPI
#define STREAM_ALIGN_EPI 1
#endif
struct GDesc { const bf16_t* A; const bf16_t* Bt; int K, lda; };
struct UnitX { int pm, pn, kind; };
#ifndef RELAX_EPI_WAIT
#define RELAX_EPI_WAIT 0
#endif
template <class Prog, int A_AUX = 0>
__device__ __forceinline__ void gemm_stream(PG8_LAS unsigned char* lds, Prog& P, int wave_s) {
    const int wid = wave_s, lane = lane_now(), tid = wid * 64 + lane, wr = wid >> 2, wc = wid & 3, fr = lane & 15, fq = lane >> 4;
    int R_[2], C_[2], Rb_[2];
#pragma unroll
    for (int i = 0; i < 2; ++i) { stage_rc(tid * 16 + i * 8192, R_[i], C_[i]); Rb_[i] = (R_[i] & ~31) + perm32(R_[i] & 31); }
    const size_t kstep = (size_t)(BK * 2);
    const unsigned ldsw = (unsigned)wid * 1024u;
    const int aoff = lds_byte(wr * 64 + fr, fq * 8), boff = lds_byte(wc * 32 + fr, fq * 8);
#define PG8_SA(b, h) (((b) * 2 + (h)) * HTB)
#define PG8_SB(b, h) ((4 + (b) * 2 + (h)) * HTB)
#define PG8_STAGE2(bufoff, gbase, v0, v1) do { \
        __builtin_amdgcn_global_load_lds((const unsigned*)((const char*)(gbase) + (v0)), (PG8_LAS unsigned*)(lds + (bufoff) + ldsw), 16, 0, 0); \
        __builtin_amdgcn_global_load_lds((const unsigned*)((const char*)(gbase) + (v1)), (PG8_LAS unsigned*)(lds + (bufoff) + ldsw + 8192), 16, 0, 0); } while (0)
#define PG8_STAGE2A(bufoff, gbase, v0, v1) do { \
        __builtin_amdgcn_global_load_lds((const unsigned*)((const char*)(gbase) + (v0)), (PG8_LAS unsigned*)(lds + (bufoff) + ldsw), 16, 0, A_AUX); \
        __builtin_amdgcn_global_load_lds((const unsigned*)((const char*)(gbase) + (v1)), (PG8_LAS unsigned*)(lds + (bufoff) + ldsw + 8192), 16, 0, A_AUX); } while (0)
#define PG8_LDA(dst, b, h) do { _Pragma("unroll") for (int m = 0; m < 4; ++m) _Pragma("unroll") for (int k = 0; k < 2; ++k) dst[m][k] = *(const PG8_LAS bf16x8*)(lds + PG8_SA(b, h) + aoff + m * 2048 + k * 1024); } while (0)
#define PG8_LDB(dst, b, h) do { _Pragma("unroll") for (int n = 0; n < 2; ++n) _Pragma("unroll") for (int k = 0; k < 2; ++k) dst[n][k] = *(const PG8_LAS bf16x8*)(lds + PG8_SB(b, h) + boff + n * 2048 + k * 1024); } while (0)
#define PG8_MMA(ai, bj, At, Bt) do { __builtin_amdgcn_s_setprio(1); _Pragma("unroll") for (int m = 0; m < 4; ++m) _Pragma("unroll") for (int n = 0; n < 2; ++n) _Pragma("unroll") for (int k = 0; k < 2; ++k) \
        acc[ai][bj][m][n] = __builtin_amdgcn_mfma_f32_16x16x32_bf16(Bt[n][k], At[m][k], acc[ai][bj][m][n], 0, 0, 0); __builtin_amdgcn_s_setprio(0); } while (0)
#define PG8_WAIT_V(n) asm volatile("s_waitcnt vmcnt(" #n ")" ::: "memory")
#define PG8_WAIT_L(n) asm volatile("s_waitcnt lgkmcnt(" #n ")" ::: "memory")
#define PG8_WAIT_VN(n) asm volatile("s_waitcnt vmcnt(%0)" :: "n"(n) : "memory")
#define PG8_BAR __builtin_amdgcn_s_barrier()
#define PG8_SCHED __builtin_amdgcn_sched_barrier(0)
#define PG8_SETUP(u, pA, pB, vA0, vA1, vB0, vB1, hA, hB, ntv) do { const GDesc d_ = P.desc((u).kind); (ntv) = d_.K / BK; (hA) = (size_t)HALF * d_.lda * 2; (hB) = (size_t)HALF * d_.K * 2; \
        (pA) = (const char*)d_.A + (size_t)(u).pm * 2 * (hA); (pB) = (const char*)d_.Bt + (size_t)(u).pn * 2 * (hB); \
        (vA0) = (unsigned)(R_[0] * d_.lda + C_[0]) * 2u; (vA1) = (unsigned)(R_[1] * d_.lda + C_[1]) * 2u; (vB0) = (unsigned)(Rb_[0] * d_.K + C_[0]) * 2u; (vB1) = (unsigned)(Rb_[1] * d_.K + C_[1]) * 2u; } while (0)
    UnitX cur, nxt; int ui = 0;
    if (!P.next(0, cur)) return;
    const char *cA, *cB, *nA, *nB; unsigned cvA0, cvA1, cvB0, cvB1, nvA0, nvA1, nvB0, nvB1; size_t chA, chB, nhA, nhB; int cnt, nnt;
    PG8_SETUP(cur, cA, cB, cvA0, cvA1, cvB0, cvB1, chA, chB, cnt);
    f32x4 acc[2][2][4][2];
#pragma unroll
    for (int a = 0; a < 2; ++a)
#pragma unroll
        for (int b = 0; b < 2; ++b)
#pragma unroll
            for (int m = 0; m < 4; ++m)
#pragma unroll
                for (int n = 0; n < 2; ++n) acc[a][b][m][n] = (f32x4){0.f, 0.f, 0.f, 0.f};
    bf16x8 At[4][2], B0[2][2], B1[2][2];
    P.a_ready(cur);
    PG8_STAGE2(PG8_SB(0, 0), cB, cvB0, cvB1); PG8_STAGE2(PG8_SB(0, 1), cB + chB, cvB0, cvB1); PG8_STAGE2A(PG8_SA(0, 0), cA, cvA0, cvA1); PG8_STAGE2A(PG8_SA(0, 1), cA + chA, cvA0, cvA1);
    if (wr == 1) PG8_BAR;
    PG8_WAIT_V(2); PG8_BAR;
    PG8_STAGE2(PG8_SB(1, 0), cB + kstep, cvB0, cvB1); PG8_STAGE2A(PG8_SA(1, 0), cA + kstep, cvA0, cvA1); PG8_STAGE2(PG8_SB(1, 1), cB + chB + kstep, cvB0, cvB1);
    PG8_WAIT_V(6); PG8_BAR;
    for (;;) {
        const bool has_next = P.next(ui + 1, nxt);
        if (has_next) { PG8_SETUP(nxt, nA, nB, nvA0, nvA1, nvB0, nvB1, nhA, nhB, nnt); }
        else { nA = cA; nB = cB; nvA0 = cvA0; nvA1 = cvA1; nvB0 = cvB0; nvB1 = cvB1; nhA = chA; nhB = chB; nnt = cnt; }
#pragma unroll 1
        for (int t = 0; t < cnt; t += 2) {
            const bool last = (t == cnt - 2);
            const char* a1 = cA + (size_t)(t + 1) * kstep;
            const char* a2 = last ? nA : cA + (size_t)(t + 2) * kstep; const char* b2 = last ? nB : cB + (size_t)(t + 2) * kstep;
            const char* a3 = a2 + kstep; const char* b3 = b2 + kstep;
            const unsigned xA0 = last ? nvA0 : cvA0, xA1 = last ? nvA1 : cvA1, xB0 = last ? nvB0 : cvB0, xB1 = last ? nvB1 : cvB1; const size_t xhA = last ? nhA : chA, xhB = last ? nhB : chB;
            if (last && has_next) P.a_ready(nxt);
            const bool relax = RELAX_EPI_WAIT && Prog::S_EPI > 0 && t == 0 && ui > 0;
            PG8_LDB(B0, 0, 0); PG8_LDB(B1, 0, 1); PG8_SCHED; PG8_LDA(At, 0, 0); PG8_STAGE2A(PG8_SA(1, 1), a1 + chA, cvA0, cvA1);
            if (relax) PG8_WAIT_VN(8 + Prog::S_EPI); else PG8_WAIT_V(8);
            PG8_WAIT_L(0); PG8_BAR; PG8_MMA(0, 0, At, B0); PG8_MMA(0, 1, At, B1); PG8_BAR; PG8_SCHED;
            PG8_LDA(At, 0, 1); PG8_STAGE2(PG8_SB(0, 0), b2, xB0, xB1); PG8_STAGE2(PG8_SB(0, 1), b2 + xhB, xB0, xB1); PG8_STAGE2A(PG8_SA(0, 0), a2, xA0, xA1);
            if (relax) PG8_WAIT_VN(8 + Prog::S_EPI); else PG8_WAIT_V(8);
            PG8_WAIT_L(0); PG8_BAR; PG8_MMA(1, 0, At, B0); PG8_MMA(1, 1, At, B1); PG8_BAR; PG8_SCHED;
            PG8_LDB(B0, 1, 0); PG8_LDB(B1, 1, 1); PG8_SCHED; PG8_LDA(At, 1, 0); PG8_STAGE2A(PG8_SA(0, 1), a2 + xhA, xA0, xA1);
            PG8_WAIT_V(8); if (t == 0) P.publish();
            PG8_WAIT_L(0); PG8_BAR; PG8_MMA(0, 0, At, B0); PG8_MMA(0, 1, At, B1); PG8_BAR; PG8_SCHED;
            PG8_LDA(At, 1, 1); PG8_STAGE2(PG8_SB(1, 0), b3, xB0, xB1); PG8_STAGE2(PG8_SB(1, 1), b3 + xhB, xB0, xB1); PG8_STAGE2A(PG8_SA(1, 0), a3, xA0, xA1);
            PG8_WAIT_V(8); PG8_WAIT_L(0); PG8_BAR; PG8_MMA(1, 0, At, B0); PG8_MMA(1, 1, At, B1); PG8_BAR; PG8_SCHED;
        }
#if STREAM_ALIGN_EPI
        if (wr == 0) PG8_BAR;
#endif
        { const int l_ = lane_now(); const int fr_ = l_ & 15, fq_ = l_ >> 4; P.epi(acc, cur, wr, wc, fr_, fq_); } P.done(cur);
        if (!has_next) break;
#pragma unroll
        for (int a = 0; a < 2; ++a)
#pragma unroll
            for (int b = 0; b < 2; ++b)
#pragma unroll
                for (int m = 0; m < 4; ++m)
#pragma unroll
                    for (int n = 0; n < 2; ++n) acc[a][b][m][n] = (f32x4){0.f, 0.f, 0.f, 0.f};
        cur = nxt; cA = nA; cB = nB; cvA0 = nvA0; cvA1 = nvA1; cvB0 = nvB0; cvB1 = nvB1; chA = nhA; chB = nhB; cnt = nnt; ++ui;
#if STREAM_ALIGN_EPI
        if (wr == 1) PG8_BAR;
#endif
    }
    PG8_WAIT_V(0); P.publish();
#if !STREAM_ALIGN_EPI
    if (wr == 0) PG8_BAR;
#endif
    PG8_BAR;
#undef PG8_SA
#undef PG8_SB
#undef PG8_STAGE2
#undef PG8_STAGE2A
#undef PG8_LDA
#undef PG8_LDB
#undef PG8_MMA
#undef PG8_WAIT_V
#undef PG8_WAIT_L
#undef PG8_WAIT_VN
#undef PG8_BAR
#undef PG8_SCHED
#undef PG8_SETUP
}
#ifndef QUP_FUSED
#define QUP_FUSED 0
#endif
struct ProgP2 { Ctx B; StaticOrder S; static constexpr int S_EPI = 8;
    __device__ __forceinline__ void init(const Ctx& b, int G, int c) { B = b; S.init(M, 1024, G, c); }
#if QUP_FUSED
    __device__ __forceinline__ bool next(int i, UnitX& u) const { Unit t; if (!S.next(i, t)) return false; u.pm = t.pm; u.pn = t.pn; u.kind = 1; return true; }
#else
    __device__ __forceinline__ bool next(int i, UnitX& u) const { Unit t; const int per = (S.nwg - S.c + S.G - 1) / S.G; const bool q = i < per; if (!S.next(q ? i : i - per, t)) return false; u.pm = t.pm; u.pn = t.pn; u.kind = q ? 0 : 1; return true; }
#endif
    __device__ __forceinline__ GDesc desc(int kind) const { return kind == 0 ? GDesc{B.CQKV(), B.WQUP(), 256, 384} : GDesc{B.CQKV() + 256, B.WKVUP(), 128, 384}; }
    __device__ __forceinline__ void epi(const f32x4 (&acc)[2][2][4][2], const UnitX& u, int wr, int wc, int fr, int fq) const { const Unit t{u.pm, u.pn};
        if (u.kind == 0) EpiQUp{B}(acc, t, wr, wc, fr, fq); else EpiKvUp{B}(acc, t, wr, wc, fr, fq); }
    __device__ __forceinline__ void a_ready(const UnitX&) const {}
    __device__ __forceinline__ void done(const UnitX&) const {}
    __device__ __forceinline__ void publish() const {}
};

template <class Epi, int DUPMODE = 0> struct ProgOne { Ctx B; StaticOrder S; GDesc d; static constexpr int S_EPI = DUPMODE ? 0 : Epi::S_EPI;
    __device__ __forceinline__ void init(const Ctx& b, const GDesc& g, int N, int G, int c) { B = b; d = g; S.init(M, N, G, c); }
    __device__ __forceinline__ bool next(int i, UnitX& u) const { Unit t; if (!S.next(DUPMODE ? (i >> 1) : i, t)) return false; u.pm = t.pm; u.pn = t.pn; u.kind = (DUPMODE == 2 && !(i & 1)) ? 1 : 0; return true; }
    __device__ __forceinline__ GDesc desc(int) const { return d; }
    __device__ __forceinline__ void epi(const f32x4 (&acc)[2][2][4][2], const UnitX& u, int wr, int wc, int fr, int fq) const { if (DUPMODE == 2 && u.kind == 1) return; const Unit t{u.pm, u.pn}; Epi{B}(acc, t, wr, wc, fr, fq); }
    __device__ __forceinline__ void a_ready(const UnitX&) const {}
    __device__ __forceinline__ void done(const UnitX&) const {}
    __device__ __forceinline__ void publish() const {}
};

struct ProgP1 { Ctx B; StaticOrder S; GDesc d; static constexpr int S_EPI = 0;
    __device__ __forceinline__ void init(const Ctx& b, const GDesc& g, int N, int G, int c) { B = b; d = g; S.init(M, N, G, c); }
    __device__ __forceinline__ bool next(int i, UnitX& u) const { Unit t; if (!S.next(i, t)) return false; u.pm = t.pm; u.pn = t.pn < 4 ? t.pn : (t.pn < 6 ? t.pn + 2 : t.pn - 2); u.kind = 0; return true; }
    __device__ __forceinline__ GDesc desc(int) const { return d; }
    __device__ __forceinline__ void epi(const f32x4 (&acc)[2][2][4][2], const UnitX& u, int wr, int wc, int fr, int fq) const { const Unit t{u.pm, u.pn}; EpiInProj{B}(acc, t, wr, wc, fr, fq); }
    __device__ __forceinline__ void a_ready(const UnitX&) const {}
    __device__ __forceinline__ void done(const UnitX&) const {}
    __device__ __forceinline__ void publish() const {}
};
struct ProgFFN { static constexpr int S_EPI = 0; Ctx B; StaticOrder S4, S5; unsigned* cnt4; unsigned* cnt5; unsigned* tmo; int seg, p6, acq4; unsigned* pend;
    enum { K_P4 = 0, K_P5 = 1, K_P6 = 2 };
    __device__ __forceinline__ void init(const Ctx& b, int G, int c, unsigned* c4, unsigned* c5, unsigned* t) { B = b; S4.init(M, DM, G, c); S5.init(M, 2 * DFF, G, c); cnt4 = c4; cnt5 = c5; tmo = t; seg = 0; p6 = 1 + (c >> 3) % 5; acq4 = -1; pend = nullptr; }
    __device__ __forceinline__ bool next(int i, UnitX& u) const { Unit t; int kind, r;
        if (seg == 0) { if (i > 1) return false; kind = K_P4; r = i; }
        else if (seg == 1) { if (i < 6) { kind = K_P5; r = i; } else if (i < 12) { const int k = i - 6; if (k == p6) { kind = K_P6; r = 0; } else { kind = K_P5; r = 6 + (k < p6 ? k : k - 1); } } else return false; }
        else { if (i > 0) return false; kind = K_P6; r = 1; }
        if (!(kind == K_P5 ? S5.next(r, t) : S4.next(r, t))) return false;
        u.pm = t.pm; u.pn = t.pn; u.kind = kind; return true; }
    __device__ __forceinline__ GDesc desc(int kind) const { return kind == K_P4 ? GDesc{B.AO(), B.WO(), DM, DM} : kind == K_P5 ? GDesc{B.H1B(), B.WGU(), DM, DM} : GDesc{B.ACT(), B.WD(), DFF, DFF}; }
    __device__ __forceinline__ void epi(const f32x4 (&acc)[2][2][4][2], const UnitX& u, int wr, int wc, int fr, int fq) const { const Unit t{u.pm, u.pn};
        if (u.kind == K_P4) EpiOProjT<1>{B}(acc, t, wr, wc, fr, fq); else if (u.kind == K_P5) EpiFfn1T<1>{B}(acc, t, wr, wc, fr, fq); else EpiFfn2{B}(acc, t, wr, wc, fr, fq); }
    __device__ __forceinline__ void a_ready(const UnitX& u) {
        if (u.kind == K_P4 || (u.kind == K_P5 && u.pm == acq4)) return;
        if (threadIdx.x < 64) {
            unsigned* c = u.kind == K_P5 ? cnt4 + 64 * u.pm : cnt5 + 64 * u.pm; const unsigned need = u.kind == K_P5 ? 4u * 8u : 22u * 8u; unsigned sp = 0u;
            while ((unsigned)__builtin_amdgcn_readfirstlane(__hip_atomic_load(c, __ATOMIC_RELAXED, __HIP_MEMORY_SCOPE_AGENT)) < need) { __builtin_amdgcn_s_sleep(2);
                if ((++sp & 255u) == 0u) { if (__builtin_amdgcn_readfirstlane(__hip_atomic_load(tmo, __ATOMIC_RELAXED, __HIP_MEMORY_SCOPE_AGENT)) != 0u) break; if (sp > (1u << 18)) { if (threadIdx.x == 0) atomicAdd(tmo, 1u); break; } } }
            __builtin_amdgcn_fence(__ATOMIC_ACQUIRE, "agent");
            asm volatile("s_waitcnt vmcnt(0)" ::: "memory");
        }
        asm volatile("" ::: "memory"); __builtin_amdgcn_s_barrier(); asm volatile("" ::: "memory");
        if (u.kind == K_P5) acq4 = u.pm;
    }
    __device__ __forceinline__ void done(const UnitX& u) { pend = u.kind == K_P4 ? cnt4 + 64 * u.pm : u.kind == K_P5 ? cnt5 + 64 * u.pm : nullptr; }
    __device__ __forceinline__ void publish() { if (pend) { if ((threadIdx.x & 63) == 0) (void)__hip_atomic_fetch_add(pend, 1u, __ATOMIC_RELAXED, __HIP_MEMORY_SCOPE_AGENT); pend = nullptr; } }
};
}
namespace attm {
using bf16=bf16_t;
using bf16x8=__attribute__((ext_vector_type(8)))short;
using s16x4=__attribute__((ext_vector_type(4)))short;
using f32x16=__attribute__((ext_vector_type(16)))float;
using u32x4=__attribute__((ext_vector_type(4)))unsigned;
using f32x4=__attribute__((ext_vector_type(4)))float;
constexpr int D=64,DM=512,DMO=1024;
constexpr int NW=8,QBLK=32,QB=QBLK*NW,KVBLK=64;
__device__ __forceinline__ int crow(int r,int hi){return (r&3)+8*(r>>2)+4*hi;}
#define SBAR() __builtin_amdgcn_sched_barrier(0)
__device__ __forceinline__ void cmask(f32x16&p0,f32x16&p1,int jb,int qrel,int hi){
  const float NEG=-INFINITY; int kb=64*jb+4*hi;
  #pragma unroll
  for(int r=0;r<16;++r){int kv=kb+(r&3)+8*(r>>2); if(kv>qrel)p0[r]=NEG; if(kv+32>qrel)p1[r]=NEG;}
}

constexpr int NSLOT=3, SLOTB=8192;
constexpr int LDS_K=0, LDS_V=NSLOT*SLOTB, LDS_WS=2*NSLOT*SLOTB, LDS_OST=LDS_WS+NW*64*4, LDS_BYTES=LDS_OST+NW*4096;
constexpr float C2=0.125f*1.4426950408889634f;
__device__ __forceinline__ void glds16(const void*gsrc,unsigned lds_dst){unsigned keep;
  asm volatile("s_mov_b32 %0, m0\n\ts_mov_b32 m0, %2\n\ts_nop 0\n\tglobal_load_lds_dwordx4 %1, off\n\ts_mov_b32 m0, %0":"=&s"(keep):"v"(gsrc),"s"(lds_dst):"memory");}
__device__ __forceinline__ float max3f(float a,float b,float c){float r;asm("v_max3_f32 %0, %1, %2, %3":"=v"(r):"v"(a),"v"(b),"v"(c));return r;}
__device__ __forceinline__ float max2f(float a,float b){float r;asm("v_max_f32_e32 %0, %1, %2":"=v"(r):"v"(a),"v"(b));return r;}
__device__ __forceinline__ float fadd_s(float a,float b){float r;asm("v_add_f32_e32 %0, %1, %2":"=v"(r):"v"(a),"v"(b));return r;}
__device__ __forceinline__ float fsub_s(float a,float b){float r;asm("v_sub_f32_e32 %0, %1, %2":"=v"(r):"v"(a),"v"(b));return r;}
typedef float f32x2_t __attribute__((ext_vector_type(2))); typedef __bf16 bf16x2_t __attribute__((ext_vector_type(2)));
__device__ __forceinline__ unsigned cvtpk_s(float lo,float hi){f32x2_t v={lo,hi};bf16x2_t b=__builtin_convertvector(v,bf16x2_t);return __builtin_bit_cast(unsigned,b);}
__device__ __forceinline__ void glds16s(const void*sbase,unsigned voff,unsigned lds_dst){unsigned keep;
  asm volatile("s_mov_b32 %0, m0\n\ts_mov_b32 m0, %3\n\ts_nop 0\n\tglobal_load_lds_dwordx4 %1, %2\n\ts_mov_b32 m0, %0":"=&s"(keep):"v"(voff),"s"(sbase),"s"(lds_dst):"memory");}
__device__ __forceinline__ const bf16_t* uptr(const bf16_t*p){ const unsigned long long v=(unsigned long long)p; const unsigned lo=__builtin_amdgcn_readfirstlane((unsigned)v),hi=__builtin_amdgcn_readfirstlane((unsigned)(v>>32)); return (const bf16_t*)(((unsigned long long)hi<<32)|lo); }
#define WAIT_BAR(N) asm volatile("s_waitcnt vmcnt(" #N ") lgkmcnt(0)\n\ts_barrier":::"memory")

__device__ __forceinline__ void qkt(f32x16&p0,f32x16&p1,const char*Kslot,const bf16x8*qr,const f32x16&negm,int r32,int hi){
  const char*kb=Kslot+hi*1024+r32*16;
  #pragma unroll
  for(int d0=0;d0<4;++d0){
    const bf16x8 b0=*reinterpret_cast<const bf16x8*>(kb+d0*2048);
    const bf16x8 b1=*reinterpret_cast<const bf16x8*>(kb+d0*2048+512);
    if(d0==0){p0=__builtin_amdgcn_mfma_f32_32x32x16_bf16(b0,qr[0],negm,0,0,0);p1=__builtin_amdgcn_mfma_f32_32x32x16_bf16(b1,qr[0],negm,0,0,0);}
    else{p0=__builtin_amdgcn_mfma_f32_32x32x16_bf16(b0,qr[d0],p0,0,0,0);p1=__builtin_amdgcn_mfma_f32_32x32x16_bf16(b1,qr[d0],p1,0,0,0);}}
}
typedef __attribute__((address_space(3))) const char* lds_cptr;
typedef short v4i16_t __attribute__((ext_vector_type(4)));
__device__ __forceinline__ void kload8(bf16x8*kf,lds_cptr kp){
  kf[0]=*(const __attribute__((address_space(3))) bf16x8*)(kp);      kf[1]=*(const __attribute__((address_space(3))) bf16x8*)(kp+512);
  kf[2]=*(const __attribute__((address_space(3))) bf16x8*)(kp+2048); kf[3]=*(const __attribute__((address_space(3))) bf16x8*)(kp+2560);
  kf[4]=*(const __attribute__((address_space(3))) bf16x8*)(kp+4096); kf[5]=*(const __attribute__((address_space(3))) bf16x8*)(kp+4608);
  kf[6]=*(const __attribute__((address_space(3))) bf16x8*)(kp+6144); kf[7]=*(const __attribute__((address_space(3))) bf16x8*)(kp+6656);
}
__device__ __forceinline__ void kload2(bf16x8*kf,lds_cptr kp,int j){ kf[2*j]=*(const __attribute__((address_space(3))) bf16x8*)(kp+j*2048); kf[2*j+1]=*(const __attribute__((address_space(3))) bf16x8*)(kp+j*2048+512); }
__device__ __forceinline__ s16x4 vtr(lds_cptr p){ return __builtin_bit_cast(s16x4,__builtin_amdgcn_ds_read_tr16_b64_v4i16((__attribute__((address_space(3))) v4i16_t*)p)); }
__device__ __forceinline__ float rowmax(const f32x16&p0,const f32x16&p1){
  float a=max3f(p0[0],p0[1],p1[0]),b=max3f(p0[2],p0[3],p1[1]);a=max3f(a,p1[2],p1[3]);
  #pragma unroll
  for(int r=4;r<16;r+=4){a=max3f(a,p0[r],p0[r+1]);b=max3f(b,p0[r+2],p0[r+3]);a=max3f(a,p1[r],p1[r+1]);b=max3f(b,p1[r+2],p1[r+3]);}
  const float m=max2f(a,b);
  auto rr=__builtin_amdgcn_permlane32_swap(__float_as_uint(m),__float_as_uint(m),false,false);
  return max2f(__uint_as_float(rr[0]),__uint_as_float(rr[1]));
}
__device__ __forceinline__ void pv(f32x16*o,int vb,bf16x8 pa0,bf16x8 pa1,bf16x8 pa2,bf16x8 pa3){
  #pragma unroll
  for(int d0=0;d0<2;++d0){s16x4 lo[4],hi[4];
    #pragma unroll
    for(int ks=0;ks<4;++ks){
      asm volatile("ds_read_b64_tr_b16 %0,%1 offset:%c2":"=&v"(lo[ks]):"v"(vb),"i"(d0*4096+ks*1024):"memory");
      asm volatile("ds_read_b64_tr_b16 %0,%1 offset:%c2":"=&v"(hi[ks]):"v"(vb),"i"(d0*4096+ks*1024+512):"memory");}
    asm volatile("s_waitcnt lgkmcnt(0)":::"memory");SBAR();
    #define PK(k) (bf16x8){lo[k][0],lo[k][1],lo[k][2],lo[k][3],hi[k][0],hi[k][1],hi[k][2],hi[k][3]}
    o[d0]=__builtin_amdgcn_mfma_f32_32x32x16_bf16(pa0,PK(0),o[d0],0,0,0);
    o[d0]=__builtin_amdgcn_mfma_f32_32x32x16_bf16(pa1,PK(1),o[d0],0,0,0);
    o[d0]=__builtin_amdgcn_mfma_f32_32x32x16_bf16(pa2,PK(2),o[d0],0,0,0);
    o[d0]=__builtin_amdgcn_mfma_f32_32x32x16_bf16(pa3,PK(3),o[d0],0,0,0);
    #undef PK
  }
}

#ifndef NEGM_PERIODIC
#define NEGM_PERIODIC 0
#endif
#ifndef NEGM_MFMA
#define NEGM_MFMA 0
#endif
#ifndef CMASK_SKIP
#define CMASK_SKIP 0
#endif
#ifndef ATTN_STORE16
#define ATTN_STORE16(p,v) (*(u32x4*)(p)=(v))
#endif
template<int THRL,bool NOMAX=false> __device__ __forceinline__ void attn_unit(int qb,int b8,int h,const bf16*Q,const bf16*__restrict__ K,const bf16*__restrict__ V,bf16*O,const Ctx&B,char*shm,int wave_s){
  int lane=pg8::lane_now(); const int tid=wave_s*64+lane;
  const int r32=lane&31,hi=lane>>5; const int wid=wave_s;
  const int q0=qb*QB;
  const bf16*Qw=Q+(long)(q0+wid*QBLK)*DM;
  const bf16*Kh=K,*Vh=V;
  const unsigned lds0=(unsigned)(uintptr_t)shm;
  float*wsf=(float*)(shm+LDS_WS)+wid*64;
  const unsigned koff=(unsigned)(lane*DM+wid*8)*2u;
  const unsigned voffv=(unsigned)((16*(wid&3)+(lane>>2))*DM+(wid>>2)*32+(lane&3)*8)*2u;
  const unsigned kdst=lds0+LDS_K+wid*1024, vdst=lds0+LDS_V+wid*1024;
  #define DMA_K(t,slot) glds16s(uptr(Kh+(long)(t)*KVBLK*DM),koff,(unsigned)__builtin_amdgcn_readfirstlane(kdst+(slot)))
  #define DMA_V(t,slot) glds16s(uptr(Vh+(long)(t)*KVBLK*DM),voffv,(unsigned)__builtin_amdgcn_readfirstlane(vdst+(slot)))
  const int vb0=(int)(lds0+LDS_V)+((lane>>4)&1)*32+(lane&3)*8+(4*hi+((lane&15)>>2))*64;
  const char*Kbase=shm+LDS_K; bf16x8 kf[8];
  const lds_cptr shm3=(lds_cptr)shm; const lds_cptr kp0=shm3+LDS_K+hi*1024+r32*16; const lds_cptr vp0=shm3+LDS_V+((lane>>4)&1)*32+(lane&3)*8+(4*hi+((lane&15)>>2))*64;
  const int NT=(q0+QB)/KVBLK;
  DMA_K(0,0);DMA_V(0,0);DMA_K(1,SLOTB);
  bf16x8 qr[4];
  #pragma unroll
#if QA_FRAG
  for(int d0=0;d0<4;++d0)qr[d0]=__builtin_nontemporal_load(reinterpret_cast<const bf16x8*>(Q+((long)(q0+wid*QBLK)*64)+((d0*2+hi)*32+r32)*8));
#else
  for(int d0=0;d0<4;++d0)qr[d0]=__builtin_nontemporal_load(reinterpret_cast<const bf16x8*>(&Qw[(long)r32*DM+d0*16+hi*8]));
#endif
  unsigned sel=0xffu;
  if(qb>3){
    int r32o=r32; asm volatile("":"+v"(r32o));
    f32x16 G=f32x16{};
    #pragma unroll
    for(int d0=0;d0<4;++d0){ float km[8];
      #pragma unroll
      for(int j=0;j<8;++j)km[j]=0.f;
      if(r32o<qb){ const float*kpp=B.KMEANP()+(size_t)(b8+r32o)*4*512+h*64+d0*16+hi*8;
        #pragma unroll
        for(int qq=0;qq<(KSUM_HALF?2:4);++qq){ const f32x4 a=*(const f32x4*)(kpp+qq*512),bb=*(const f32x4*)(kpp+qq*512+4);
          #pragma unroll
          for(int j=0;j<4;++j){km[j]+=a[j];km[4+j]+=bb[j];} } }
      unsigned whi[4],wlo[4];
      #pragma unroll
      for(int w=0;w<4;++w){ whi[w]=cvtpk_s(km[2*w],km[2*w+1]); wlo[w]=cvtpk_s(km[2*w]-__uint_as_float(whi[w]<<16),km[2*w+1]-__uint_as_float(whi[w]&0xffff0000u)); }
      const u32x4 vh={whi[0],whi[1],whi[2],whi[3]},vl={wlo[0],wlo[1],wlo[2],wlo[3]};
      G=__builtin_amdgcn_mfma_f32_32x32x16_bf16(__builtin_bit_cast(bf16x8,vh),qr[d0],G,0,0,0);
      G=__builtin_amdgcn_mfma_f32_32x32x16_bf16(__builtin_bit_cast(bf16x8,vl),qr[d0],G,0,0,0); }
    float gate[8];
    #pragma unroll
    for(int r=0;r<4;++r){ auto rr=__builtin_amdgcn_permlane32_swap(__float_as_uint(G[r]),__float_as_uint(G[r]),false,false); gate[r]=__uint_as_float(rr[0]); gate[4+r]=__uint_as_float(rr[1]); }
    #pragma unroll
    for(int j=0;j<8;++j)if(j>=qb)gate[j]=-INFINITY;
    sel=0u;
    #pragma unroll
    for(int j=0;j<8;++j){ int rank=0;
      #pragma unroll
      for(int i=0;i<8;++i)rank+=(gate[i]>gate[j]||(gate[i]==gate[j]&&i<j))?1:0;
      if(j<qb&&rank<3)sel|=1u<<j; }
  }
  float mhat=0.f,l_reg=0.f;f32x16 o[2];o[0]=f32x16{};o[1]=f32x16{};f32x16 negm;
#if NEGM_MFMA
  #define SETNEGM(tt) do{ const float nm_=((tt)>=NT-4||((sel>>((tt)>>2))&1u))?-mhat:-INFINITY; const float z16_ __attribute__((ext_vector_type(16)))={0.f,0.f,0.f,0.f,0.f,0.f,0.f,0.f,0.f,0.f,0.f,0.f,0.f,0.f,0.f,0.f}; \
      negm=__builtin_amdgcn_mfma_f32_32x32x2f32(hi?0.f:1.f,hi?0.f:nm_,z16_,0,0,0); }while(0)
#else
  #define SETNEGM(tt) do{ const float nm_=((tt)>=NT-4||((sel>>((tt)>>2))&1u))?-mhat:-INFINITY; _Pragma("unroll") for(int r=0;r<16;++r)negm[r]=nm_; asm volatile("":"+v"(negm)); }while(0)
#endif
  const int qrel=wid*QBLK+r32;
  #define CMASK(P0,P1,t) do{int jb_=(t)-(NT-4); if(CMASK_SKIP>1&&jb_>(wid>>1)){ _Pragma("unroll") for(int r_=0;r_<16;++r_){P0[r_]=-INFINITY;P1[r_]=-INFINITY;} } else if(jb_>=(CMASK_SKIP?(wid>>1):0))cmask(P0,P1,jb_,qrel,hi);}while(0)
  bool resc=false;
  #define START(P0,P1) do{ if(NOMAX){ resc=false;   } else { const float rm=rowmax(P0,P1); resc=false; \
    { const float dl=(rm==-INFINITY)?0.f:rm; mhat=fadd_s(mhat,dl); \
      _Pragma("unroll") for(int r=0;r<16;++r){P0[r]=fsub_s(P0[r],dl);P1[r]=fsub_s(P1[r],dl);} \
      SETNEGM(1); } } \
    _Pragma("unroll") for(int r=0;r<16;++r)P0[r]=__builtin_amdgcn_exp2f(P0[r]); }while(0)
  #define RESC() do{ if(resc){ asm volatile("s_waitcnt lgkmcnt(0)":::"memory"); \
      _Pragma("unroll") for(int d_=0;d_<2;++d_) _Pragma("unroll") for(int r=0;r<16;++r)o[d_][r]*=wsf[crow(r,hi)]; } }while(0)
  f32x16 pA0,pA1,pB0,pB1;
  int sl_prev=0,sl_cur=0,sl_next=SLOTB;
  #define ROT() do{sl_prev=sl_cur;sl_cur=sl_next;sl_next=(sl_next==(NSLOT-1)*SLOTB)?0:sl_next+SLOTB;}while(0)
  DMA_K(2,2*SLOTB);
  WAIT_BAR(3);
  SETNEGM(0);
  qkt(pA0,pA1,Kbase,qr,negm,r32,hi);asm volatile("s_nop 15\n\ts_nop 7":"+v"(pA0),"+v"(pA1));CMASK(pA0,pA1,0);
  START(pA0,pA1);
  _Pragma("unroll") for(int r=0;r<16;++r)pA1[r]=__builtin_amdgcn_exp2f(pA1[r]);
  WAIT_BAR(0);
  DMA_K(3,0);DMA_V(1,SLOTB);
  ROT();
  kload8(kf,kp0+sl_cur);
  WAIT_BAR(2);
  s16x4 vlo[8],vhi[8]; u32x4 pw0,pw1,pw2,pw3;
  #define PKW(P,B) cvtpk_s(P[B],P[B+1])
  #define PAF(k) __builtin_bit_cast(bf16x8,pw##k)
  #define VFR(i) (bf16x8){vlo[i][0],vlo[i][1],vlo[i][2],vlo[i][3],vhi[i][0],vhi[i][1],vhi[i][2],vhi[i][3]}
  #define PIN(x) asm volatile("":"+v"(x))
  #define MX3(a,b,c) __builtin_fmaxf(__builtin_fmaxf((a),(b)),(c))
  #define GAPA(MF,A0,A1,A2,A3,W0,W1,PW) do{ MF; sacc+=A0; sacc+=A1; sacc+=A2; sacc+=A3; PIN(sacc); W0; W1; PIN(PW); SBAR(); }while(0)
  #define EX(v) __builtin_amdgcn_exp2f(v)
  #define GAPB(MF,X,B) do{ MF; X[B]=EX(X[B]); X[B+1]=EX(X[B+1]); X[B+2]=EX(X[B+2]); X[B+3]=EX(X[B+3]); PIN(X); SBAR(); }while(0)
  #define VRD(i) do{ vlo[i]=vtr(vp_+(((i)>>2)*4096+((i)&3)*1024)); vhi[i]=vtr(vp_+(((i)>>2)*4096+((i)&3)*1024+512)); }while(0)
  #define KRD(G,j) do{ if(G){ kload2(kf,kp0+sl_next,j); SBAR(); } }while(0)
  #define STEP(C0,C1,P0,P1,t,GK,GV,GL) do{ SBAR(); \
    const lds_cptr vp_=vp0+sl_prev; \
    VRD(0); SBAR(); float sacc=(P0[0]+P0[1]); \
    GAPA(C0=__builtin_amdgcn_mfma_f32_32x32x16_bf16(kf[0],qr[0],negm,0,0,0), P0[2],P0[3],P0[4],P0[5],     pw0[0]=PKW(P0,0), pw0[1]=PKW(P0,2), pw0); \
    VRD(4); SBAR(); GAPA(C1=__builtin_amdgcn_mfma_f32_32x32x16_bf16(kf[1],qr[0],negm,0,0,0), P0[6],P0[7],P0[8],P0[9],     pw0[2]=PKW(P0,4), pw0[3]=PKW(P0,6), pw0); \
    VRD(1); SBAR(); GAPA(C0=__builtin_amdgcn_mfma_f32_32x32x16_bf16(kf[2],qr[1],C0,0,0,0),   P0[10],P0[11],P0[12],P0[13], pw1[0]=PKW(P0,8), pw1[1]=PKW(P0,10), pw1); \
    VRD(5); SBAR(); GAPA(C1=__builtin_amdgcn_mfma_f32_32x32x16_bf16(kf[3],qr[1],C1,0,0,0),   P0[14],P0[15],P1[0],P1[1],   pw1[2]=PKW(P0,12),pw1[3]=PKW(P0,14), pw1); \
    VRD(2); SBAR(); GAPA(C0=__builtin_amdgcn_mfma_f32_32x32x16_bf16(kf[4],qr[2],C0,0,0,0),   P1[2],P1[3],P1[4],P1[5],     pw2[0]=PKW(P1,0), pw2[1]=PKW(P1,2), pw2); \
    VRD(6); SBAR(); GAPA(C1=__builtin_amdgcn_mfma_f32_32x32x16_bf16(kf[5],qr[2],C1,0,0,0),   P1[6],P1[7],P1[8],P1[9],     pw2[2]=PKW(P1,4), pw2[3]=PKW(P1,6), pw2); \
    VRD(3); SBAR(); GAPA(C0=__builtin_amdgcn_mfma_f32_32x32x16_bf16(kf[6],qr[3],C0,0,0,0),   P1[10],P1[11],P1[12],P1[13], pw3[0]=PKW(P1,8), pw3[1]=PKW(P1,10), pw3); \
    VRD(7); SBAR(); GAPA(C1=__builtin_amdgcn_mfma_f32_32x32x16_bf16(kf[7],qr[3],C1,0,0,0),   P1[14],P1[15],0.f,0.f,       pw3[2]=PKW(P1,12),pw3[3]=PKW(P1,14), pw3); \
    l_reg+=sacc; \
    if(GK){DMA_K((t)+3,sl_cur);} if(GV){DMA_V((t)+1,sl_next);} \
    CMASK(C0,C1,t); \
    if(NOMAX){ resc=false; if(NEGM_PERIODIC?((((t)+1)&3)==0):true){ SETNEGM((t)+1); } } else \
    { float a=MX3(C0[0],C0[1],C1[0]),b=MX3(C0[2],C0[3],C1[1]); a=MX3(a,C1[2],C1[3]); \
      _Pragma("unroll") for(int r=4;r<16;r+=4){a=MX3(a,C0[r],C0[r+1]);b=MX3(b,C0[r+2],C0[r+3]);a=MX3(a,C1[r],C1[r+1]);b=MX3(b,C1[r+2],C1[r+3]);} \
      float rm=__builtin_fmaxf(a,b); { auto rr=__builtin_amdgcn_permlane32_swap(__float_as_uint(rm),__float_as_uint(rm),false,false); rm=__builtin_fmaxf(__uint_as_float(rr[0]),__uint_as_float(rr[1])); } \
      resc=false; \
      if(__builtin_expect(__any(rm>(float)THRL),0)){ const float dl=__builtin_fmaxf(rm,0.f); mhat+=dl; \
        _Pragma("unroll") for(int r=0;r<16;++r){C0[r]-=dl;C1[r]-=dl;} \
        const float f=__builtin_amdgcn_exp2f(-dl); l_reg*=f; if(hi==0)wsf[r32]=f; resc=true; } \
      SETNEGM((t)+1); } \
    SBAR(); \
    GAPB(o[0]=__builtin_amdgcn_mfma_f32_32x32x16_bf16(PAF(0),VFR(0),o[0],0,0,0), C0,0); \
    GAPB(o[1]=__builtin_amdgcn_mfma_f32_32x32x16_bf16(PAF(0),VFR(4),o[1],0,0,0), C0,4); \
    KRD(GL,0); GAPB(o[0]=__builtin_amdgcn_mfma_f32_32x32x16_bf16(PAF(1),VFR(1),o[0],0,0,0), C0,8); \
    KRD(GL,1); GAPB(o[1]=__builtin_amdgcn_mfma_f32_32x32x16_bf16(PAF(1),VFR(5),o[1],0,0,0), C0,12); \
    KRD(GL,2); GAPB(o[0]=__builtin_amdgcn_mfma_f32_32x32x16_bf16(PAF(2),VFR(2),o[0],0,0,0), C1,0); \
    KRD(GL,3); GAPB(o[1]=__builtin_amdgcn_mfma_f32_32x32x16_bf16(PAF(2),VFR(6),o[1],0,0,0), C1,4); \
    GAPB(o[0]=__builtin_amdgcn_mfma_f32_32x32x16_bf16(PAF(3),VFR(3),o[0],0,0,0), C1,8); \
    GAPB(o[1]=__builtin_amdgcn_mfma_f32_32x32x16_bf16(PAF(3),VFR(7),o[1],0,0,0), C1,12); \
    }while(0)
  int t=1;
  #undef CMASK
  #define CMASK(P0,P1,t) do{}while(0)
  for(;t+5<NT;t+=2){
    STEP(pB0,pB1,pA0,pA1,t,true,true,true);     WAIT_BAR(2); RESC(); ROT();
    STEP(pA0,pA1,pB0,pB1,t+1,true,true,true);   WAIT_BAR(2); RESC(); ROT();
  }
  #undef CMASK
  #define CMASK(P0,P1,t) do{int jb_=(t)-(NT-4); if(CMASK_SKIP>1&&jb_>(wid>>1)){ _Pragma("unroll") for(int r_=0;r_<16;++r_){P0[r_]=-INFINITY;P1[r_]=-INFINITY;} } else if(jb_>=(CMASK_SKIP?(wid>>1):0))cmask(P0,P1,jb_,qrel,hi);}while(0)
  #define ENDW(tt) do{ if((tt)+3<NT){WAIT_BAR(2);} else if((tt)+2<NT){WAIT_BAR(1);} else {WAIT_BAR(0);} }while(0)
  for(;t+1<NT;t+=2){
    STEP(pB0,pB1,pA0,pA1,t,(t+3<NT),(t+1<NT),(t+1<NT));       ENDW(t);   RESC(); ROT();
    STEP(pA0,pA1,pB0,pB1,t+1,(t+4<NT),(t+2<NT),(t+2<NT));     ENDW(t+1); RESC(); ROT();
  }
  STEP(pB0,pB1,pA0,pA1,NT-1,false,false,false); RESC();
  { float sacc=pB0[0]+pB0[1]; _Pragma("unroll") for(int r=2;r<16;++r)sacc+=pB0[r]; _Pragma("unroll") for(int r=0;r<16;++r)sacc+=pB1[r]; l_reg+=sacc;
    pw0=(u32x4){PKW(pB0,0),PKW(pB0,2),PKW(pB0,4),PKW(pB0,6)};pw1=(u32x4){PKW(pB0,8),PKW(pB0,10),PKW(pB0,12),PKW(pB0,14)};pw2=(u32x4){PKW(pB1,0),PKW(pB1,2),PKW(pB1,4),PKW(pB1,6)};pw3=(u32x4){PKW(pB1,8),PKW(pB1,10),PKW(pB1,12),PKW(pB1,14)};
    SBAR(); pv(o,vb0+sl_cur,PAF(0),PAF(1),PAF(2),PAF(3)); }
  #undef PKW
  #undef PAF
  #undef VFR
  #undef PIN
  #undef MX3
  #undef GAPA
  #undef GAPB
  #undef EX
  #undef VRD
  #undef KRD
  #undef STEP
  #undef ENDW
  {auto rr=__builtin_amdgcn_permlane32_swap(__float_as_uint(l_reg),__float_as_uint(l_reg),false,false);l_reg=__uint_as_float(rr[0])+__uint_as_float(rr[1]);}
  if(hi==0)wsf[32+r32]=l_reg;asm volatile("s_waitcnt lgkmcnt(0)":::"memory");
  float rli[16];
  #pragma unroll
  for(int r=0;r<16;++r)rli[r]=__builtin_amdgcn_rcpf(wsf[32+crow(r,hi)]);
  int lno=lane; asm volatile("":"+v"(lno));
  bf16*Ow=O+(long)(q0+wid*QBLK)*DMO;
  { bf16*stg=(bf16*)(shm+LDS_OST)+wid*2048;
    #pragma unroll
    for(int r=0;r<16;++r){const int orow=crow(r,hi);
      #pragma unroll
      for(int d0=0;d0<2;++d0)stg[orow*64+d0*32+r32]=(bf16)(cvtpk_s(o[d0][r]*rli[r],0.f)&0xffffu);}
    asm volatile("s_waitcnt lgkmcnt(0)":::"memory");
    #pragma unroll
    for(int i=0;i<4;++i){const int row=i*8+(lno>>3),ch=lno&7; const u32x4 v=*(const u32x4*)(stg+row*64+ch*8); ATTN_STORE16(Ow+(long)row*DMO+ch*8,v);} }
  asm volatile("s_waitcnt lgkmcnt(0)\n\ts_barrier":::"memory");
  #undef DMA_K
  #undef DMA_V
  #undef CMASK
  #undef START
  #undef RESC
  #undef ROT
}
constexpr int ATTN_LDS_BYTES=LDS_BYTES;
#undef SBAR
#undef WAIT_BAR
#undef SETNEGM
}
namespace attl {
using bf16=bf16_t;
using bf16x8=__attribute__((ext_vector_type(8)))short;
using s16x4=__attribute__((ext_vector_type(4)))short;
using f32x16=__attribute__((ext_vector_type(16)))float;
using u32x4=__attribute__((ext_vector_type(4)))unsigned;
using f32x4=__attribute__((ext_vector_type(4)))float;
constexpr int DMK=768,DMV=512,DMO=1024;
constexpr int NW=8,QBLK=32,QB=QBLK*NW,KVBLK=64;
__device__ __forceinline__ int crow(int r,int hi){return (r&3)+8*(r>>2)+4*hi;}
#define SBAR() __builtin_amdgcn_sched_barrier(0)
__device__ __forceinline__ void cmask(f32x16&p0,f32x16&p1,int jb,int qrel,int hi){
  const float NEG=-INFINITY; int kb=64*jb+4*hi;
  #pragma unroll
  for(int r=0;r<16;++r){int kv=kb+(r&3)+8*(r>>2); if(kv>qrel)p0[r]=NEG; if(kv+32>qrel)p1[r]=NEG;}
}

constexpr int NSLOT=3, SLOTK=12288, SLOTV=8192;
constexpr int LDS_K=0, LDS_V=NSLOT*SLOTK, LDS_WS=LDS_V+NSLOT*SLOTV, LDS_OST=LDS_WS+NW*64*4, LDS_BYTES=LDS_OST+NW*4096;
constexpr float C2=0.125f*1.4426950408889634f;
__device__ __forceinline__ void glds16(const void*gsrc,unsigned lds_dst){unsigned keep;
  asm volatile("s_mov_b32 %0, m0\n\ts_mov_b32 m0, %2\n\ts_nop 0\n\tglobal_load_lds_dwordx4 %1, off\n\ts_mov_b32 m0, %0":"=&s"(keep):"v"(gsrc),"s"(lds_dst):"memory");}
__device__ __forceinline__ float max3f(float a,float b,float c){float r;asm("v_max3_f32 %0, %1, %2, %3":"=v"(r):"v"(a),"v"(b),"v"(c));return r;}
__device__ __forceinline__ float max2f(float a,float b){float r;asm("v_max_f32_e32 %0, %1, %2":"=v"(r):"v"(a),"v"(b));return r;}
__device__ __forceinline__ float fadd_s(float a,float b){float r;asm("v_add_f32_e32 %0, %1, %2":"=v"(r):"v"(a),"v"(b));return r;}
__device__ __forceinline__ float fsub_s(float a,float b){float r;asm("v_sub_f32_e32 %0, %1, %2":"=v"(r):"v"(a),"v"(b));return r;}
typedef float f32x2_t __attribute__((ext_vector_type(2))); typedef __bf16 bf16x2_t __attribute__((ext_vector_type(2)));
__device__ __forceinline__ unsigned cvtpk_s(float lo,float hi){f32x2_t v={lo,hi};bf16x2_t b=__builtin_convertvector(v,bf16x2_t);return __builtin_bit_cast(unsigned,b);}
__device__ __forceinline__ void glds16s(const void*sbase,unsigned voff,unsigned lds_dst){unsigned keep;
  asm volatile("s_mov_b32 %0, m0\n\ts_mov_b32 m0, %3\n\ts_nop 0\n\tglobal_load_lds_dwordx4 %1, %2\n\ts_mov_b32 m0, %0":"=&s"(keep):"v"(voff),"s"(sbase),"s"(lds_dst):"memory");}
__device__ __forceinline__ const bf16_t* uptr(const bf16_t*p){ const unsigned long long v=(unsigned long long)p; const unsigned lo=__builtin_amdgcn_readfirstlane((unsigned)v),hi=__builtin_amdgcn_readfirstlane((unsigned)(v>>32)); return (const bf16_t*)(((unsigned long long)hi<<32)|lo); }
#define WAIT_BAR(N) asm volatile("s_waitcnt vmcnt(" #N ") lgkmcnt(0)\n\ts_barrier":::"memory")

__device__ __forceinline__ void qkt(f32x16&p0,f32x16&p1,const char*Kslot,const bf16x8*qr,const f32x16&negm,int r32,int hi){
  const char*kb=Kslot+hi*1024+r32*16;
  #pragma unroll
  for(int d0=0;d0<6;++d0){
    const bf16x8 b0=*reinterpret_cast<const bf16x8*>(kb+d0*2048);
    const bf16x8 b1=*reinterpret_cast<const bf16x8*>(kb+d0*2048+512);
    if(d0==0){p0=__builtin_amdgcn_mfma_f32_32x32x16_bf16(b0,qr[0],negm,0,0,0);p1=__builtin_amdgcn_mfma_f32_32x32x16_bf16(b1,qr[0],negm,0,0,0);}
    else{p0=__builtin_amdgcn_mfma_f32_32x32x16_bf16(b0,qr[d0],p0,0,0,0);p1=__builtin_amdgcn_mfma_f32_32x32x16_bf16(b1,qr[d0],p1,0,0,0);}}
}
typedef __attribute__((address_space(3))) const char* lds_cptr;
typedef short v4i16_t __attribute__((ext_vector_type(4)));
__device__ __forceinline__ void kload8(bf16x8*kf,lds_cptr kp){
  kf[0]=*(const __attribute__((address_space(3))) bf16x8*)(kp);      kf[1]=*(const __attribute__((address_space(3))) bf16x8*)(kp+512);
  kf[2]=*(const __attribute__((address_space(3))) bf16x8*)(kp+2048); kf[3]=*(const __attribute__((address_space(3))) bf16x8*)(kp+2560);
  kf[4]=*(const __attribute__((address_space(3))) bf16x8*)(kp+4096); kf[5]=*(const __attribute__((address_space(3))) bf16x8*)(kp+4608);
  kf[6]=*(const __attribute__((address_space(3))) bf16x8*)(kp+6144); kf[7]=*(const __attribute__((address_space(3))) bf16x8*)(kp+6656);
  kf[8]=*(const __attribute__((address_space(3))) bf16x8*)(kp+8192); kf[9]=*(const __attribute__((address_space(3))) bf16x8*)(kp+8704);
  kf[10]=*(const __attribute__((address_space(3))) bf16x8*)(kp+10240); kf[11]=*(const __attribute__((address_space(3))) bf16x8*)(kp+10752);
}
__device__ __forceinline__ void kload2(bf16x8*kf,lds_cptr kp,int j){ kf[2*j]=*(const __attribute__((address_space(3))) bf16x8*)(kp+j*2048); kf[2*j+1]=*(const __attribute__((address_space(3))) bf16x8*)(kp+j*2048+512); }
__device__ __forceinline__ s16x4 vtr(lds_cptr p){ return __builtin_bit_cast(s16x4,__builtin_amdgcn_ds_read_tr16_b64_v4i16((__attribute__((address_space(3))) v4i16_t*)p)); }
__device__ __forceinline__ float rowmax(const f32x16&p0,const f32x16&p1){
  float a=max3f(p0[0],p0[1],p1[0]),b=max3f(p0[2],p0[3],p1[1]);a=max3f(a,p1[2],p1[3]);
  #pragma unroll
  for(int r=4;r<16;r+=4){a=max3f(a,p0[r],p0[r+1]);b=max3f(b,p0[r+2],p0[r+3]);a=max3f(a,p1[r],p1[r+1]);b=max3f(b,p1[r+2],p1[r+3]);}
  const float m=max2f(a,b);
  auto rr=__builtin_amdgcn_permlane32_swap(__float_as_uint(m),__float_as_uint(m),false,false);
  return max2f(__uint_as_float(rr[0]),__uint_as_float(rr[1]));
}
__device__ __forceinline__ void pv(f32x16*o,int vb,bf16x8 pa0,bf16x8 pa1,bf16x8 pa2,bf16x8 pa3){
  #pragma unroll
  for(int d0=0;d0<2;++d0){s16x4 lo[4],hi[4];
    #pragma unroll
    for(int ks=0;ks<4;++ks){
      asm volatile("ds_read_b64_tr_b16 %0,%1 offset:%c2":"=&v"(lo[ks]):"v"(vb),"i"(d0*4096+ks*1024):"memory");
      asm volatile("ds_read_b64_tr_b16 %0,%1 offset:%c2":"=&v"(hi[ks]):"v"(vb),"i"(d0*4096+ks*1024+512):"memory");}
    asm volatile("s_waitcnt lgkmcnt(0)":::"memory");SBAR();
    #define PK(k) (bf16x8){lo[k][0],lo[k][1],lo[k][2],lo[k][3],hi[k][0],hi[k][1],hi[k][2],hi[k][3]}
    o[d0]=__builtin_amdgcn_mfma_f32_32x32x16_bf16(pa0,PK(0),o[d0],0,0,0);
    o[d0]=__builtin_amdgcn_mfma_f32_32x32x16_bf16(pa1,PK(1),o[d0],0,0,0);
    o[d0]=__builtin_amdgcn_mfma_f32_32x32x16_bf16(pa2,PK(2),o[d0],0,0,0);
    o[d0]=__builtin_amdgcn_mfma_f32_32x32x16_bf16(pa3,PK(3),o[d0],0,0,0);
    #undef PK
  }
}

#ifndef QUP_PIPE
#define QUP_PIPE 0
#endif
#ifndef KV_LATE
#define KV_LATE 0
#endif
#ifndef CMASK_SKIP
#define CMASK_SKIP 0
#endif
#ifndef ATTN_STORE16
#define ATTN_STORE16(p,v) (*(u32x4*)(p)=(v))
#endif
template<int THRL,bool NOMAX=false> __device__ __forceinline__ void attn_unit(int qb,const bf16*Q,const bf16*__restrict__ K,const bf16*__restrict__ V,bf16*O,const Ctx&B,char*shm,int wave_s,int h_,size_t rb_){
  int lane=pg8::lane_now(); const int tid=wave_s*64+lane;
  const int r32=lane&31,hi=lane>>5; const int wid=wave_s;
  const int q0=qb*QB;
  const bf16*Qw=Q+(long)(q0+wid*QBLK)*DMK;
  const bf16*Kh=K,*Vh=V;
  const unsigned lds0=(unsigned)(uintptr_t)shm;
  float*wsf=(float*)(shm+LDS_WS)+wid*64;
  const unsigned koff=(unsigned)(lane*DMK+wid*8)*2u, koff2=(unsigned)(lane*DMK+(8+(wid&3))*8)*2u;
  const unsigned voffv=(unsigned)((16*(wid&3)+(lane>>2))*DMV+(wid>>2)*32+(lane&3)*8)*2u;
  const unsigned kdst=lds0+LDS_K+wid*1024, kdst2=lds0+LDS_K+(8+(wid&3))*1024, vdst=lds0+LDS_V+wid*1024;
  #define DMA_K(t,slot) do{ const bf16*kb_=uptr(Kh+(long)(t)*KVBLK*DMK); glds16s(kb_,koff,(unsigned)__builtin_amdgcn_readfirstlane(kdst+(slot)*SLOTK)); glds16s(kb_,koff2,(unsigned)__builtin_amdgcn_readfirstlane(kdst2+(slot)*SLOTK)); }while(0)
  #define DMA_V(t,slot) glds16s(uptr(Vh+(long)(t)*KVBLK*DMV),voffv,(unsigned)__builtin_amdgcn_readfirstlane(vdst+(slot)*SLOTV))
  const char*Kbase=shm+LDS_K; bf16x8 kf[12];
  const lds_cptr shm3=(lds_cptr)shm; const lds_cptr kp0=shm3+LDS_K+hi*1024+r32*16; const lds_cptr vp0=shm3+LDS_V+((lane>>4)&1)*32+(lane&3)*8+(4*hi+((lane&15)>>2))*64;
  const int NT=(q0+QB)/KVBLK;
#if !(QUP_FUSED && KV_LATE)
  DMA_K(0,0);DMA_V(0,0);DMA_K(1,1);
#endif
#if QUP_FUSED
  constexpr int LDS_W=LDS_OST;
  { const bf16*whu=uptr(B.WQUP()+(size_t)h_*(96*256));
    #pragma unroll
    for(int j=0;j<6;++j){ const int p=wid*6+j,c=p*64+lane,row=c>>5,kc=(c&31)^(row&31);
      glds16s(whu,(unsigned)((row*256+kc*8)*2),(unsigned)__builtin_amdgcn_readfirstlane((int)(lds0+LDS_W)+p*1024)); } }
  bf16x8 qr[6];
  { bf16x8 cf[16];
#if CQ_FRAG
    const bf16*Cw=Q+((long)(qb*8+wid)*16*2+hi)*(32*8)+r32*8;
    #pragma unroll
    for(int ks=0;ks<16;++ks)cf[ks]=*reinterpret_cast<const bf16x8*>(Cw+(long)ks*(2*32*8));
#else
    const bf16*Cw=Q+(long)(q0+wid*QBLK+r32)*384+hi*8;
    #pragma unroll
    for(int ks=0;ks<16;++ks)cf[ks]=*reinterpret_cast<const bf16x8*>(Cw+ks*16);
#endif
    const f32x4 s4=*(const f32x4*)(B.CQSS()+(rb_+(size_t)(q0+wid*QBLK+r32))*4);
    asm volatile("s_waitcnt vmcnt(0)\n\ts_barrier":::"memory");
#if KV_LATE
    DMA_K(0,0);DMA_V(0,0);DMA_K(1,1);
#endif
    DMA_K(2,2);
    const int ri=(r32&3)+4*(r32>>3), pi=16*(ri>>3)+8*((r32>>2)&1)+(ri&7);
    const lds_cptr wp=shm3+LDS_W+pi*512;
    f32x16 qa[3]; qa[0]=f32x16{}; qa[1]=f32x16{}; qa[2]=f32x16{};
    asm volatile("":"+v"(qa[0]),"+v"(qa[1]),"+v"(qa[2]));
#if QUP_PIPE
    bf16x8 wq[3][3];
    #define LOADW(S,KS) do{ const int sw_=(((2*(KS)+hi)^pi)&31)*16; _Pragma("unroll") for(int T=0;T<3;++T)wq[S][T]=*(const __attribute__((address_space(3))) bf16x8*)(wp+T*(32*512)+sw_); }while(0)
    LOADW(0,0); LOADW(1,1); SBAR();
    #pragma unroll
    for(int ks=0;ks<16;++ks){ if(ks+2<16){ LOADW((ks+2)%3,ks+2); } SBAR();
      #pragma unroll
      for(int T=0;T<3;++T)qa[T]=__builtin_amdgcn_mfma_f32_32x32x16_bf16(wq[ks%3][T],cf[ks],qa[T],0,0,0);
      SBAR(); }
    #undef LOADW
#else
    #pragma unroll
    for(int ks=0;ks<16;++ks){ const int sw=(((2*ks+hi)^pi)&31)*16;
      #pragma unroll
      for(int T=0;T<3;++T){ const bf16x8 wa=*(const __attribute__((address_space(3))) bf16x8*)(wp+T*(32*512)+sw); qa[T]=__builtin_amdgcn_mfma_f32_32x32x16_bf16(wa,cf[ks],qa[T],0,0,0); } }
#endif
    const float rc=__builtin_amdgcn_rsqf((s4[0]+s4[1]+s4[2]+s4[3])*(1.0f/256)+EPS);
    float qf[6][8]; float ss=0.f;
    #pragma unroll
    for(int d0=0;d0<6;++d0)
      #pragma unroll
      for(int e=0;e<8;++e){ const float v=qa[d0>>1][8*(d0&1)+e]*rc; qf[d0][e]=v; ss+=v*v; }
    { auto rr=__builtin_amdgcn_permlane32_swap(__float_as_uint(ss),__float_as_uint(ss),false,false); ss=__uint_as_float(rr[0])+__uint_as_float(rr[1]); }
    const float rq=(1.0f/sqrtf(ss*(1.0f/96)+EPS))*C2B; const float*g=B.glq()+hi*8;
    #pragma unroll
    for(int d0=0;d0<6;++d0){ const f32x4 ga=*(const f32x4*)(g+d0*16),gb=*(const f32x4*)(g+d0*16+4);
      #pragma unroll
      for(int e=0;e<8;++e)qf[d0][e]*=rq*(e<4?ga[e]:gb[e-4]); }
    { const int pos=q0+wid*QBLK+r32; const f32x4 ca=*(const f32x4*)(B.COSB()+pos*16+hi*8),cb=*(const f32x4*)(B.COSB()+pos*16+hi*8+4),sa=*(const f32x4*)(B.SINB()+pos*16+hi*8),sb=*(const f32x4*)(B.SINB()+pos*16+hi*8+4);
      #pragma unroll
      for(int j=0;j<8;++j){ const float c=j<4?ca[j]:cb[j-4],sn=j<4?sa[j]:sb[j-4],x1=qf[4][j],x2=qf[5][j]; qf[4][j]=x1*c-x2*sn; qf[5][j]=x2*c+x1*sn; } }
    #pragma unroll
    for(int d0=0;d0<6;++d0){ const u32x4 w={cvtpk_s(qf[d0][0],qf[d0][1]),cvtpk_s(qf[d0][2],qf[d0][3]),cvtpk_s(qf[d0][4],qf[d0][5]),cvtpk_s(qf[d0][6],qf[d0][7])}; qr[d0]=__builtin_bit_cast(bf16x8,w); } }
#else
  bf16x8 qr[6];
  { u32x4 raw[6]; float ss=0.f; const bf16*Ql=Qw+(long)r32*DMK+hi*8;
    #pragma unroll
    for(int d0=0;d0<6;++d0){ raw[d0]=__builtin_nontemporal_load(reinterpret_cast<const u32x4*>(Ql+d0*16));
      #pragma unroll
      for(int w=0;w<4;++w){ const float a=__uint_as_float(raw[d0][w]<<16),bb=__uint_as_float(raw[d0][w]&0xffff0000u); ss+=a*a+bb*bb; } }
    { auto rr=__builtin_amdgcn_permlane32_swap(__float_as_uint(ss),__float_as_uint(ss),false,false); ss=__uint_as_float(rr[0])+__uint_as_float(rr[1]); }
    const float rq=(1.0f/sqrtf(ss*(1.0f/96)+EPS))*C2B; const float*g=B.glq()+hi*8;
    float qf[6][8];
    #pragma unroll
    for(int d0=0;d0<6;++d0){ const f32x4 ga=*(const f32x4*)(g+d0*16),gb=*(const f32x4*)(g+d0*16+4);
      #pragma unroll
      for(int w=0;w<4;++w){ qf[d0][2*w]=__uint_as_float(raw[d0][w]<<16)*rq*(w<2?ga[2*w]:gb[2*w-4]); qf[d0][2*w+1]=__uint_as_float(raw[d0][w]&0xffff0000u)*rq*(w<2?ga[2*w+1]:gb[2*w-3]); } }
    { const int pos=q0+wid*QBLK+r32; const f32x4 ca=*(const f32x4*)(B.COSB()+pos*16+hi*8),cb=*(const f32x4*)(B.COSB()+pos*16+hi*8+4),sa=*(const f32x4*)(B.SINB()+pos*16+hi*8),sb=*(const f32x4*)(B.SINB()+pos*16+hi*8+4);
      #pragma unroll
      for(int j=0;j<8;++j){ const float c=j<4?ca[j]:cb[j-4],sn=j<4?sa[j]:sb[j-4],x1=qf[4][j],x2=qf[5][j]; qf[4][j]=x1*c-x2*sn; qf[5][j]=x2*c+x1*sn; } }
    #pragma unroll
    for(int d0=0;d0<6;++d0){ const u32x4 w={cvtpk_s(qf[d0][0],qf[d0][1]),cvtpk_s(qf[d0][2],qf[d0][3]),cvtpk_s(qf[d0][4],qf[d0][5]),cvtpk_s(qf[d0][6],qf[d0][7])}; qr[d0]=__builtin_bit_cast(bf16x8,w); } }
#endif
  float mhat=0.f,l_reg=0.f;f32x16 o[2];o[0]=f32x16{};o[1]=f32x16{};
  int never_=0; asm volatile("":"+s"(never_));
  #define MSUB(tt) (mhat)
  const int qrel=wid*QBLK+r32;
  #define CMASK(P0,P1,t) do{int jb_=(t)-(NT-4); if(CMASK_SKIP>1&&jb_>(wid>>1)){ _Pragma("unroll") for(int r_=0;r_<16;++r_){P0[r_]=-INFINITY;P1[r_]=-INFINITY;} } else if(jb_>=(CMASK_SKIP?(wid>>1):0))cmask(P0,P1,jb_,qrel,hi);}while(0)
  bool resc=false;
  #define START(P0,P1) do{ if(NOMAX){ resc=false; msub0=0.f; _Pragma("unroll") for(int r=0;r<16;++r)P0[r]=__builtin_amdgcn_exp2f(P0[r]); } else { \
    const float rm=fsub_s(rowmax(P0,P1),MSUB(0)); resc=false; \
    { const float dl=(rm==-INFINITY)?0.f:rm; mhat=fadd_s(mhat,dl); } \
    msub0=MSUB(0); \
    _Pragma("unroll") for(int r=0;r<16;++r)P0[r]=__builtin_amdgcn_exp2f(fsub_s(P0[r],msub0)); } }while(0)
  #define RESC() do{ if(resc){ asm volatile("s_waitcnt lgkmcnt(0)":::"memory"); \
      _Pragma("unroll") for(int d_=0;d_<2;++d_) _Pragma("unroll") for(int r=0;r<16;++r)o[d_][r]*=wsf[crow(r,hi)]; } }while(0)
  f32x16 pA0,pA1,pB0,pB1;
  int sl_prev=0,sl_cur=0,sl_next=1;
  #define ROT() do{sl_prev=sl_cur;sl_cur=sl_next;sl_next=(sl_next==NSLOT-1)?0:sl_next+1;}while(0)
#if !QUP_FUSED
  DMA_K(2,2);
#endif
  WAIT_BAR(5);
  const f32x16 zc=f32x16{}; float msub0;
  qkt(pA0,pA1,Kbase,qr,zc,r32,hi);asm volatile("s_nop 15\n\ts_nop 7":"+v"(pA0),"+v"(pA1));CMASK(pA0,pA1,0);
  START(pA0,pA1);
  _Pragma("unroll") for(int r=0;r<16;++r)pA1[r]=NOMAX?__builtin_amdgcn_exp2f(pA1[r]):__builtin_amdgcn_exp2f(fsub_s(pA1[r],msub0));
  WAIT_BAR(0);
  DMA_K(3,0);DMA_V(1,1);
  ROT();
  kload8(kf,kp0+sl_cur*SLOTK);
  WAIT_BAR(3);
  s16x4 vlo[8],vhi[8]; u32x4 pw0,pw1,pw2,pw3;
  #define PKW(P,B) cvtpk_s(P[B],P[B+1])
  #define PAF(k) __builtin_bit_cast(bf16x8,pw##k)
  #define VFR(i) (bf16x8){vlo[i][0],vlo[i][1],vlo[i][2],vlo[i][3],vhi[i][0],vhi[i][1],vhi[i][2],vhi[i][3]}
  #define PIN(x) asm volatile("":"+v"(x))
  #define MX3(a,b,c) __builtin_fmaxf(__builtin_fmaxf((a),(b)),(c))
  #define GAPA(MF,A0,A1,A2,A3,W0,W1,PW) do{ MF; sacc+=A0; sacc+=A1; sacc+=A2; sacc+=A3; PIN(sacc); W0; W1; PIN(PW); SBAR(); }while(0)
  #define EX(v) (NOMAX?__builtin_amdgcn_exp2f(v):__builtin_amdgcn_exp2f((v)-msub))
  #define GAPB(MF,X,B) do{ MF; X[B]=EX(X[B]); X[B+1]=EX(X[B+1]); X[B+2]=EX(X[B+2]); X[B+3]=EX(X[B+3]); PIN(X); SBAR(); }while(0)
  #define VRD(i) do{ vlo[i]=vtr(vp_+(((i)>>2)*4096+((i)&3)*1024)); vhi[i]=vtr(vp_+(((i)>>2)*4096+((i)&3)*1024+512)); }while(0)
  #define KRD(G,j) do{ if(G){ kload2(kf,kp0+sl_next*SLOTK,j); SBAR(); } }while(0)
  #define STEP(C0,C1,P0,P1,t,GK,GV,GL) do{ SBAR(); float msub; \
    const lds_cptr vp_=vp0+sl_prev*SLOTV; \
    C0=__builtin_amdgcn_mfma_f32_32x32x16_bf16(kf[8],qr[4],zc,0,0,0); C1=__builtin_amdgcn_mfma_f32_32x32x16_bf16(kf[9],qr[4],zc,0,0,0); SBAR(); \
    C0=__builtin_amdgcn_mfma_f32_32x32x16_bf16(kf[10],qr[5],C0,0,0,0); C1=__builtin_amdgcn_mfma_f32_32x32x16_bf16(kf[11],qr[5],C1,0,0,0); SBAR(); \
    VRD(0); SBAR(); float sacc=(P0[0]+P0[1]); \
    GAPA(C0=__builtin_amdgcn_mfma_f32_32x32x16_bf16(kf[0],qr[0],C0,0,0,0), P0[2],P0[3],P0[4],P0[5],     pw0[0]=PKW(P0,0), pw0[1]=PKW(P0,2), pw0); \
    VRD(4); SBAR(); GAPA(C1=__builtin_amdgcn_mfma_f32_32x32x16_bf16(kf[1],qr[0],C1,0,0,0), P0[6],P0[7],P0[8],P0[9],     pw0[2]=PKW(P0,4), pw0[3]=PKW(P0,6), pw0); \
    VRD(1); SBAR(); GAPA(C0=__builtin_amdgcn_mfma_f32_32x32x16_bf16(kf[2],qr[1],C0,0,0,0),   P0[10],P0[11],P0[12],P0[13], pw1[0]=PKW(P0,8), pw1[1]=PKW(P0,10), pw1); \
    VRD(5); SBAR(); GAPA(C1=__builtin_amdgcn_mfma_f32_32x32x16_bf16(kf[3],qr[1],C1,0,0,0),   P0[14],P0[15],P1[0],P1[1],   pw1[2]=PKW(P0,12),pw1[3]=PKW(P0,14), pw1); \
    VRD(2); SBAR(); GAPA(C0=__builtin_amdgcn_mfma_f32_32x32x16_bf16(kf[4],qr[2],C0,0,0,0),   P1[2],P1[3],P1[4],P1[5],     pw2[0]=PKW(P1,0), pw2[1]=PKW(P1,2), pw2); \
    VRD(6); SBAR(); GAPA(C1=__builtin_amdgcn_mfma_f32_32x32x16_bf16(kf[5],qr[2],C1,0,0,0),   P1[6],P1[7],P1[8],P1[9],     pw2[2]=PKW(P1,4), pw2[3]=PKW(P1,6), pw2); \
    VRD(3); SBAR(); GAPA(C0=__builtin_amdgcn_mfma_f32_32x32x16_bf16(kf[6],qr[3],C0,0,0,0),   P1[10],P1[11],P1[12],P1[13], pw3[0]=PKW(P1,8), pw3[1]=PKW(P1,10), pw3); \
    VRD(7); SBAR(); GAPA(C1=__builtin_amdgcn_mfma_f32_32x32x16_bf16(kf[7],qr[3],C1,0,0,0),   P1[14],P1[15],0.f,0.f,       pw3[2]=PKW(P1,12),pw3[3]=PKW(P1,14), pw3); \
    l_reg+=sacc; \
    if(GK){DMA_K((t)+3,sl_cur);} if(GV){DMA_V((t)+1,sl_next);} \
    CMASK(C0,C1,t); \
    if(NOMAX){ msub=0.f; resc=false; if(__builtin_expect(never_!=0,0)){ asm volatile("s_nop 0"); } } else \
    { float a=MX3(C0[0],C0[1],C1[0]),b=MX3(C0[2],C0[3],C1[1]); a=MX3(a,C1[2],C1[3]); \
      _Pragma("unroll") for(int r=4;r<16;r+=4){a=MX3(a,C0[r],C0[r+1]);b=MX3(b,C0[r+2],C0[r+3]);a=MX3(a,C1[r],C1[r+1]);b=MX3(b,C1[r+2],C1[r+3]);} \
      float rm=__builtin_fmaxf(a,b); { auto rr=__builtin_amdgcn_permlane32_swap(__float_as_uint(rm),__float_as_uint(rm),false,false); rm=__builtin_fmaxf(__uint_as_float(rr[0]),__uint_as_float(rr[1])); } \
      msub=MSUB(t); rm-=msub; \
      resc=false; \
      if(__builtin_expect(__any(rm>(float)THRL),0)){ const float dl=__builtin_fmaxf(rm,0.f); mhat+=dl; msub+=dl; \
        const float f=__builtin_amdgcn_exp2f(-dl); l_reg*=f; if(hi==0)wsf[r32]=f; resc=true; } } \
    SBAR(); \
    GAPB(o[0]=__builtin_amdgcn_mfma_f32_32x32x16_bf16(PAF(0),VFR(0),o[0],0,0,0), C0,0); \
    KRD(GL,0); GAPB(o[1]=__builtin_amdgcn_mfma_f32_32x32x16_bf16(PAF(0),VFR(4),o[1],0,0,0), C0,4); \
    KRD(GL,1); GAPB(o[0]=__builtin_amdgcn_mfma_f32_32x32x16_bf16(PAF(1),VFR(1),o[0],0,0,0), C0,8); \
    KRD(GL,2); GAPB(o[1]=__builtin_amdgcn_mfma_f32_32x32x16_bf16(PAF(1),VFR(5),o[1],0,0,0), C0,12); \
    KRD(GL,3); GAPB(o[0]=__builtin_amdgcn_mfma_f32_32x32x16_bf16(PAF(2),VFR(2),o[0],0,0,0), C1,0); \
    KRD(GL,4); GAPB(o[1]=__builtin_amdgcn_mfma_f32_32x32x16_bf16(PAF(2),VFR(6),o[1],0,0,0), C1,4); \
    KRD(GL,5); GAPB(o[0]=__builtin_amdgcn_mfma_f32_32x32x16_bf16(PAF(3),VFR(3),o[0],0,0,0), C1,8); \
    GAPB(o[1]=__builtin_amdgcn_mfma_f32_32x32x16_bf16(PAF(3),VFR(7),o[1],0,0,0), C1,12); \
    }while(0)
  int t=1;
  #undef CMASK
  #define CMASK(P0,P1,t) do{}while(0)
  for(;t+5<NT;t+=2){
    STEP(pB0,pB1,pA0,pA1,t,true,true,true);     WAIT_BAR(3); RESC(); ROT();
    STEP(pA0,pA1,pB0,pB1,t+1,true,true,true);   WAIT_BAR(3); RESC(); ROT();
  }
  #undef CMASK
  #define CMASK(P0,P1,t) do{int jb_=(t)-(NT-4); if(CMASK_SKIP>1&&jb_>(wid>>1)){ _Pragma("unroll") for(int r_=0;r_<16;++r_){P0[r_]=-INFINITY;P1[r_]=-INFINITY;} } else if(jb_>=(CMASK_SKIP?(wid>>1):0))cmask(P0,P1,jb_,qrel,hi);}while(0)
  #define ENDW(tt) do{ if((tt)+3<NT){WAIT_BAR(3);} else if((tt)+2<NT){WAIT_BAR(1);} else {WAIT_BAR(0);} }while(0)
  for(;t+1<NT;t+=2){
    STEP(pB0,pB1,pA0,pA1,t,(t+3<NT),(t+1<NT),(t+1<NT));       ENDW(t);   RESC(); ROT();
    STEP(pA0,pA1,pB0,pB1,t+1,(t+4<NT),(t+2<NT),(t+2<NT));     ENDW(t+1); RESC(); ROT();
  }
  STEP(pB0,pB1,pA0,pA1,NT-1,false,false,false); RESC();
  { float sacc=pB0[0]+pB0[1]; _Pragma("unroll") for(int r=2;r<16;++r)sacc+=pB0[r]; _Pragma("unroll") for(int r=0;r<16;++r)sacc+=pB1[r]; l_reg+=sacc;
    pw0=(u32x4){PKW(pB0,0),PKW(pB0,2),PKW(pB0,4),PKW(pB0,6)};pw1=(u32x4){PKW(pB0,8),PKW(pB0,10),PKW(pB0,12),PKW(pB0,14)};pw2=(u32x4){PKW(pB1,0),PKW(pB1,2),PKW(pB1,4),PKW(pB1,6)};pw3=(u32x4){PKW(pB1,8),PKW(pB1,10),PKW(pB1,12),PKW(pB1,14)};
    SBAR(); pv(o,(int)(unsigned)(__UINTPTR_TYPE__)vp0+sl_cur*SLOTV,PAF(0),PAF(1),PAF(2),PAF(3)); }
  #undef PKW
  #undef PAF
  #undef VFR
  #undef PIN
  #undef MX3
  #undef GAPA
  #undef GAPB
  #undef EX
  #undef VRD
  #undef KRD
  #undef STEP
  #undef ENDW
  {auto rr=__builtin_amdgcn_permlane32_swap(__float_as_uint(l_reg),__float_as_uint(l_reg),false,false);l_reg=__uint_as_float(rr[0])+__uint_as_float(rr[1]);}
  if(hi==0)wsf[32+r32]=l_reg;asm volatile("s_waitcnt lgkmcnt(0)":::"memory");
  float rli[16];
  #pragma unroll
  for(int r=0;r<16;++r)rli[r]=__builtin_amdgcn_rcpf(wsf[32+crow(r,hi)]);
  int lno=lane; asm volatile("":"+v"(lno));
  bf16*Ow=O+(long)(q0+wid*QBLK)*DMO;
  { bf16*stg=(bf16*)(shm+LDS_OST)+wid*2048;
    #pragma unroll
    for(int r=0;r<16;++r){const int orow=crow(r,hi);
      #pragma unroll
      for(int d0=0;d0<2;++d0)stg[orow*64+d0*32+r32]=(bf16)(cvtpk_s(o[d0][r]*rli[r],0.f)&0xffffu);}
    asm volatile("s_waitcnt lgkmcnt(0)":::"memory");
    #pragma unroll
    for(int i=0;i<4;++i){const int row=i*8+(lno>>3),ch=lno&7; const u32x4 v=*(const u32x4*)(stg+row*64+ch*8); ATTN_STORE16(Ow+(long)row*DMO+ch*8,v);} }
  asm volatile("s_waitcnt lgkmcnt(0)\n\ts_barrier":::"memory");
  #undef DMA_K
  #undef DMA_V
  #undef CMASK
  #undef START
  #undef RESC
  #undef ROT
}
constexpr int ATTN_LDS_BYTES=QUP_FUSED?(LDS_OST+49152):LDS_BYTES;
#undef SBAR
#undef WAIT_BAR
#undef MSUB
}
constexpr int NWAVES = 8;
constexpr int N_PHASES = 7;
constexpr int CW_TMO = 0, CW_CODE = 1;
constexpr int CW_BAR = 4096;
constexpr int CW_DEP4 = 65536, CW_DEP5 = CW_DEP4 + 128 * 64;
constexpr int CW_GRID0 = 49152;
constexpr int CW_GRP = 32768;
constexpr int RING_OFF = 0, RING_BYTES = 131072;
constexpr int LDSCTL_OFF = RING_BYTES, MISC_OFF = LDSCTL_OFF + 320;
constexpr int LDS_BYTES = 147456;
static_assert(attm::ATTN_LDS_BYTES <= RING_BYTES && attl::ATTN_LDS_BYTES <= RING_BYTES && pg8::STAGE_BYTES <= RING_BYTES, "LDS map");

#define GAS __attribute__((address_space(1)))
#define LAS __attribute__((address_space(3)))
typedef unsigned v4u __attribute__((ext_vector_type(4)));
typedef float f32x4 __attribute__((ext_vector_type(4)));
typedef GAS unsigned gu32;
#define RLX_AGENT __ATOMIC_RELAXED, __HIP_MEMORY_SCOPE_AGENT
#define LDS_WAIT() asm volatile("s_waitcnt lgkmcnt(0)" ::: "memory")
#define VM_WAIT() asm volatile("s_waitcnt vmcnt(0)" ::: "memory")
__device__ __forceinline__ unsigned f2bf(float f) { unsigned u = __builtin_bit_cast(unsigned, f); return (u + 0x7fffu + ((u >> 16) & 1u)) >> 16; }
__device__ __forceinline__ unsigned pk2(float lo, float hi) { return f2bf(lo) | (f2bf(hi) << 16); }

#define XB_TMO      128
#define XB_XCNT(j)  (256  + 64 * (j))
#define XB_XSUB(j)  (1280 + 64 * (j))
#define XB_XGEN(j)  (2304 + 64 * (j))
#define XB_TOP      3328
#define XB_TOPGEN   3392
#define XCD_BAR_WORDS 3456
#define XB_SPIN_CAP (1u << 18)
__device__ __forceinline__ unsigned xb_ld(unsigned* p)              { return __hip_atomic_load(p, __ATOMIC_RELAXED, __HIP_MEMORY_SCOPE_AGENT); }
__device__ __forceinline__ unsigned xb_add(unsigned* p, unsigned v) { return __hip_atomic_fetch_add(p, v, __ATOMIC_RELAXED, __HIP_MEMORY_SCOPE_AGENT); }
__device__ __forceinline__ unsigned xb_xcc_id() { return (unsigned)__builtin_amdgcn_s_getreg((3 << 11) | 20) & 0xFu; }
#define XB_SPIN(cond, bar) do { unsigned _sp = 0; while (cond) { __builtin_amdgcn_s_sleep(1); \
    if ((++_sp & 255u) == 0u) { if (xb_ld(&(bar)[XB_TMO])) break; if (_sp > XB_SPIN_CAP) { atomicAdd(&(bar)[XB_TMO], 1u); break; } } } } while (0)
struct XcdBarrier { unsigned* bar; unsigned x; volatile LAS unsigned* st; };
__device__ __forceinline__ XcdBarrier xcd_barrier_post(unsigned* bar, volatile LAS unsigned* st, bool t0) {
    XcdBarrier b; b.bar = bar; b.x = xb_xcc_id(); b.st = st;
    if (t0) (void)xb_add(&bar[XB_XCNT(b.x)], 1u);
    return b;
}
__device__ __forceinline__ void xcd_barrier_complete(unsigned* bar, unsigned x, unsigned& nloc, unsigned& nx) {
    const unsigned G = gridDim.x * gridDim.y * gridDim.z;
    unsigned sum, cnt, mine, sp = 0u;
    for (;;) {
        sum = 0u; cnt = 0u; mine = 0u;
#pragma unroll
        for (unsigned j = 0; j < 16; ++j) { const unsigned c = xb_ld(&bar[XB_XCNT(j)]); sum += c; cnt += (c > 0u) ? 1u : 0u; mine = (j == x) ? c : mine; }
        if (sum == G) break;
        __builtin_amdgcn_s_sleep(1);
        if ((++sp & 255u) == 0u) { if (xb_ld(&bar[XB_TMO])) break; if (sp > XB_SPIN_CAP) { atomicAdd(&bar[XB_TMO], 1u); break; } }
    }
    nloc = mine > 0u ? mine : 1u; nx = cnt > 0u ? cnt : 1u;
}
__device__ __forceinline__ void xcd_barrier(const XcdBarrier& b, bool t0) {
    asm volatile("s_waitcnt vmcnt(0)" ::: "memory");
    __syncthreads();
    if (t0) {
        unsigned* bar = b.bar;
        __builtin_amdgcn_s_waitcnt(0);
        unsigned nloc = b.st[0], nx = b.st[1];
        if (nloc == 0u) { xcd_barrier_complete(bar, b.x, nloc, nx); b.st[0] = nloc; b.st[1] = nx; }
        const unsigned old = xb_add(&bar[XB_XSUB(b.x)], 1u);
        const unsigned gen = old / nloc;
        if (old + 1u == (gen + 1u) * nloc) {
            __builtin_amdgcn_fence(__ATOMIC_RELEASE, "agent");
            asm volatile("s_waitcnt vmcnt(0)" ::: "memory");
            const unsigned og = xb_add(&bar[XB_TOP], 1u);
            const unsigned tg = og / nx;
            if (og + 1u == (tg + 1u) * nx) xb_add(&bar[XB_TOPGEN], 1u);
            else XB_SPIN(xb_ld(&bar[XB_TOPGEN]) == tg, bar);
            __builtin_amdgcn_fence(__ATOMIC_ACQUIRE, "agent");
            xb_add(&bar[XB_XGEN(b.x)], 1u);
            asm volatile("s_waitcnt vmcnt(0)" ::: "memory");
        } else {
            XB_SPIN(xb_ld(&bar[XB_XGEN(b.x)]) == gen, bar);
            __builtin_amdgcn_fence(__ATOMIC_ACQUIRE, "agent");
            asm volatile("s_waitcnt vmcnt(0)" ::: "memory");
        }
    }
    __syncthreads();
}

#ifndef PROBE_LIGHT_DUP
#define PROBE_LIGHT_DUP 0
#endif
#ifndef ACQ_MIN_SEAM
#define ACQ_MIN_SEAM 1
#endif
#ifndef P1_REPAIR
#define P1_REPAIR 0
#endif
#ifndef SEAM0_FLAGS
#define SEAM0_FLAGS 0
#endif
#ifndef WBL2_SEAMS
#define WBL2_SEAMS 0
#endif
#ifndef GRP_NO_WBL2
#define GRP_NO_WBL2 0
#endif
#ifndef GRP_FLAGS
#define GRP_FLAGS 0
#endif
struct GrpBarrier { unsigned* cnt; unsigned size, gen; };
__device__ __forceinline__ void grid_barrier_flags(unsigned* flags, unsigned* tmo, int wave_s, unsigned me, unsigned G) {
    asm volatile("s_waitcnt vmcnt(0)" ::: "memory");
    __syncthreads();
    if (wave_s == 0) { const unsigned l = (unsigned)pg8::lane_now();
        if (l == 0) __hip_atomic_store(flags + me, 1u, __ATOMIC_RELAXED, __HIP_MEMORY_SCOPE_AGENT);
        unsigned sp = 0u;
        for (;;) { unsigned ok = 1u;
#pragma unroll
            for (unsigned j = 0; j < 4; ++j) { const unsigned m = l + 64u * j; const unsigned v = (m < G) ? xb_ld(flags + m) : 1u; ok &= v; }
            if (__all((int)(ok != 0u))) break;
            __builtin_amdgcn_s_sleep(2);
            if ((++sp & 255u) == 0u) { if (xb_ld(tmo)) break; if (sp > XB_SPIN_CAP) { if (l == 0) atomicAdd(tmo, 1u); break; } } }
        asm volatile("s_waitcnt vmcnt(0)" ::: "memory");
    }
    __syncthreads();
}
__device__ __forceinline__ void grp_barrier_flags(GrpBarrier& b, unsigned* tmo, int wave_s, unsigned me, unsigned gen, bool fences = true, bool acq = true, bool wb = false) {
    asm volatile("s_waitcnt vmcnt(0)" ::: "memory");
    __syncthreads();
    if (wave_s == 0) { const unsigned l = (unsigned)pg8::lane_now();
        if (fences && (!GRP_NO_WBL2 || wb)) __builtin_amdgcn_fence(__ATOMIC_RELEASE, "agent");
        asm volatile("s_waitcnt vmcnt(0)" ::: "memory");
        if (l == 0) __hip_atomic_store(b.cnt + me, gen + 1u, __ATOMIC_RELAXED, __HIP_MEMORY_SCOPE_AGENT);
        unsigned sp = 0u;
        for (;;) { const unsigned v = (l < b.size) ? xb_ld(b.cnt + l) : 0xffffffffu;
            if (__all((int)(v >= gen + 1u))) break;
            __builtin_amdgcn_s_sleep(1);
            if ((++sp & 255u) == 0u) { if (xb_ld(tmo)) break; if (sp > XB_SPIN_CAP) { if (l == 0) atomicAdd(tmo, 1u); break; } } }
        if (fences && acq) __builtin_amdgcn_fence(__ATOMIC_ACQUIRE, "agent");
        asm volatile("s_waitcnt vmcnt(0)" ::: "memory");
    }
    __syncthreads();
}
__device__ __forceinline__ void grp_barrier(GrpBarrier& b, unsigned* tmo, bool t0, unsigned gen) {
    asm volatile("s_waitcnt vmcnt(0)" ::: "memory");
    __syncthreads();
    if (t0) {
        __builtin_amdgcn_fence(__ATOMIC_RELEASE, "agent");
        asm volatile("s_waitcnt vmcnt(0)" ::: "memory");
        (void)xb_add(b.cnt, 1u);
        const unsigned target = b.size * (gen + 1u); unsigned sp = 0u;
        while (xb_ld(b.cnt) < target) { __builtin_amdgcn_s_sleep(1); if ((++sp & 255u) == 0u) { if (xb_ld(tmo)) break; if (sp > XB_SPIN_CAP) { atomicAdd(tmo, 1u); break; } } }
        __builtin_amdgcn_fence(__ATOMIC_ACQUIRE, "agent");
        asm volatile("s_waitcnt vmcnt(0)" ::: "memory");
    }
    __syncthreads();
}

#ifndef P0_WT
#define P0_WT 0
#endif
#if P0_WT
#define P0ST(p, v) WT_STORE16_ASM((const void*)(p), v)
#else
#define P0ST(p, v) (*(p) = (v))
#endif
__device__ __forceinline__ void p0_item(const float* W, int ldw, int col0, int ksrc0, const float* gain, bf16_t* WT, int Kdst, int rowdst0, int kdst0, LAS float* scr, int lane) {
    const int c = lane & 7;
    if (W == nullptr) {
#pragma unroll
        for (int j = 0; j < 4; ++j) { const int n = (lane >> 3) + 8 * j; const v4u z4 = {0u, 0u, 0u, 0u}; P0ST((GAS v4u*)(WT + (size_t)(rowdst0 + n) * Kdst + kdst0 + 8 * c), z4); }
        return; }
    const float gvec = gain ? gain[ksrc0 + lane] : 1.0f;
    float wv[32];
#pragma unroll
    for (int i = 0; i < 32; ++i) wv[i] = __builtin_nontemporal_load(W + (size_t)(ksrc0 + 2 * i + (lane >> 5)) * ldw + col0 + (lane & 31));
#pragma unroll
    for (int i = 0; i < 32; ++i) { const int kk = 2 * i + (lane >> 5); scr[kk * 33 + (lane & 31)] = wv[i] * __shfl(gvec, kk); }
    LDS_WAIT(); asm volatile("" ::: "memory");
#pragma unroll
    for (int j = 0; j < 4; ++j) { const int n = (lane >> 3) + 8 * j; const LAS float* s = scr + (8 * c) * 33 + n;
        v4u o; o.x = pg8::cvt_pk_bf16(s[0 * 33], s[1 * 33]); o.y = pg8::cvt_pk_bf16(s[2 * 33], s[3 * 33]); o.z = pg8::cvt_pk_bf16(s[4 * 33], s[5 * 33]); o.w = pg8::cvt_pk_bf16(s[6 * 33], s[7 * 33]);
        P0ST((GAS v4u*)(WT + (size_t)(rowdst0 + n) * Kdst + kdst0 + 8 * c), o); }
    LDS_WAIT(); asm volatile("" ::: "memory");
}
__device__ __forceinline__ float wave_sum(float v) {
#pragma unroll
    for (int o = 1; o < 64; o <<= 1) v += __shfl_xor(v, o);
    return v;
}

struct Args { float* out; unsigned char* ws; int ph_lo, ph_hi, li, pad; const float* in[16]; };
__global__ void __launch_bounds__(NWAVES * 64, 2) fwd_mega(Args args) {
    extern __shared__ __attribute__((aligned(16))) unsigned char lds_raw[];
    LAS unsigned char* lds = (LAS unsigned char*)lds_raw;
    volatile LAS unsigned* MISC = (volatile LAS unsigned*)(lds + MISC_OFF);
    const int wave = __builtin_amdgcn_readfirstlane((int)threadIdx.x >> 6);
#define LANE pg8::lane_now()
#define TID (wave * 64 + pg8::lane_now())
#define T0 (wave == 0 && pg8::lane_now() == 0)
    const int G = gridDim.x, bx = blockIdx.x, vcu = (G % 8 == 0) ? (bx % 8) * (G / 8) + bx / 8 : bx;
    unsigned char* ws = args.ws; Ctx B; B.x = nullptr; B.out = args.out; B.ws = ws;
    const float* const* inp = (const float* const*)((const char*)__builtin_amdgcn_kernarg_segment_ptr() + __builtin_offsetof(Args, in));
    gu32* ctl = (gu32*)(ws + WS_CTL);
    for (int u = TID; u < (LDS_BYTES - LDSCTL_OFF) / 4; u += NWAVES * 64) ((LAS unsigned*)(lds + LDSCTL_OFF))[u] = 0u;
    __syncthreads();
    XcdBarrier bar = xcd_barrier_post((unsigned*)(ctl + CW_BAR) + args.li * XCD_BAR_WORDS, MISC + 8, T0);
#ifndef GROUPED_SEAMS
#define GROUPED_SEAMS 1
#endif
    const bool grouped = GROUPED_SEAMS && (G == 256);
    GrpBarrier gbar; gbar.cnt = (unsigned*)(ctl + CW_GRP) + (args.li * 8 + (bx & 7)) * 64; gbar.size = (unsigned)(G / 8); gbar.gen = 0u;
    const int lo = args.ph_lo, hi = args.ph_hi;
#ifndef PHASE_MASK
#define PHASE_MASK 0x7f
#endif
#define IN(k) (((PHASE_MASK >> (k)) & 1) && lo <= (k) && (k) < hi)
#ifndef REP0
#define REP0 1
#endif
#ifndef REP1
#define REP1 1
#endif
#ifndef REP2
#define REP2 1
#endif
#ifndef REP3
#define REP3 1
#endif
#ifndef REP4
#define REP4 1
#endif
#ifndef REP5
#define REP5 1
#endif
#ifndef DUPU1
#define DUPU1 0
#endif
#ifndef DUPU5
#define DUPU5 0
#endif
#ifndef DUPU6
#define DUPU6 0
#endif
#ifndef REPG
#define REPG 1
#endif
#ifndef REPB
#define REPB 1
#endif
#define SEAM(k) do { if (IN(k) && IN((k) + 1)) { for (int rb_ = 0; rb_ < REPB; ++rb_) { if ((k) == 0 && SEAM0_FLAGS && grouped && rb_ == 0) grid_barrier_flags((unsigned*)(ctl + CW_GRID0) + args.li * 256, (unsigned*)(ctl + CW_BAR) + args.li * XCD_BAR_WORDS + XB_TMO, wave, (unsigned)bx, (unsigned)G); else if ((k) == 0 || !grouped) xcd_barrier(bar, T0); else if (GRP_FLAGS) grp_barrier_flags(gbar, (unsigned*)(ctl + CW_BAR) + args.li * XCD_BAR_WORDS + XB_TMO, wave, (unsigned)(bx >> 3), (unsigned)(((k) - (lo > 1 ? lo : 1)) * REPB + rb_), !(PROBE_LIGHT_DUP && rb_ > 0), (k) >= ACQ_MIN_SEAM, ((WBL2_SEAMS >> (k)) & 1) != 0); else grp_barrier(gbar, (unsigned*)(ctl + CW_BAR) + args.li * XCD_BAR_WORDS + XB_TMO, T0, (unsigned)(((k) - (lo > 1 ? lo : 1)) * REPB + rb_)); } } } while (0)

    if (IN(0)) { B.x = inp[0]; const int lane = LANE, tid = wave * 64 + lane; for (int rep_ = 0; rep_ < REP0; ++rep_) {
        LAS float* scr = (LAS float*)(lds + RING_OFF + wave * 16384);
        const int hw = wave & 3, gw = vcu * 4 + hw, NGW = G * 4;
        constexpr int I_IN = 64 * 16, I_QU = 32 * 4, I_KVU = 32 * 2, I_O = 32 * 16, I_GU = 176 * 16, I_D = 32 * 44, NITEMS = I_IN + I_QU + I_KVU + I_O + I_GU + I_D;
#ifndef REPW
#define REPW 1
#endif
#ifndef REPX
#define REPX 1
#endif
        if (wave >= 4)
        for (int rw_ = 0; rw_ < REPW; ++rw_)
        for (int it = gw; it < NITEMS; it += NGW) {
            int r = it;
            if (r < I_IN) { const int Gp = r >> 4, kb = r & 15, pn = Gp >> 3, bj = (Gp >> 2) & 1, wc = Gp & 3, col0 = pn * 256 + wc * 64 + bj * 32;
                p0_item(col0 < INW ? inp[nv::I_WIN] : nullptr, INW, col0, kb * 64, inp[nv::I_GATT], B.WIN(), DM, Gp * 32, kb * 64, scr, lane); continue; } r -= I_IN;
#if QUP_FUSED
            if (r < I_QU) { if (r < 24 * 4) { const int Gp = r >> 2, kb = r & 3; p0_item(inp[nv::I_WQUP], 768, Gp * 32, kb * 64, inp[nv::I_GQA], B.WQUP(), 256, Gp * 32, kb * 64, scr, lane); } continue; } r -= I_QU;
#else
            if (r < I_QU) { const int Gp = r >> 2, kb = r & 3, pn = Gp >> 3, bj = (Gp >> 2) & 1, wc = Gp & 3, head = 2 * pn + (wc >> 1); const bool z = (wc & 1) && bj; const int col0 = head * 96 + ((wc & 1) ? 64 : bj * 32);
                p0_item(z ? nullptr : inp[nv::I_WQUP], 768, col0, kb * 64, inp[nv::I_GQA], B.WQUP(), 256, Gp * 32, kb * 64, scr, lane); continue; } r -= I_QU;
#endif
            if (r < I_KVU) { const int Gp = r >> 1, kb = r & 1, pn = Gp >> 3, bj = (Gp >> 2) & 1, wc = Gp & 3, col0 = pn * 256 + wc * 64 + bj * 32;
                p0_item(inp[nv::I_WKVUP], 1024, col0, kb * 64, inp[nv::I_GKVA], B.WKVUP(), 128, Gp * 32, kb * 64, scr, lane); continue; } r -= I_KVU;
            if (r < I_O) { const int Gp = r >> 4, kb = r & 15, pn = Gp >> 3, bj = (Gp >> 2) & 1, wc = Gp & 3, col0 = pn * 256 + wc * 64 + bj * 32;
                p0_item(inp[nv::I_WO], DM, col0, kb * 64, nullptr, B.WO(), DM, Gp * 32, kb * 64, scr, lane); continue; } r -= I_O;
            if (r < I_GU) { const int Gp = r >> 4, kb = r & 15, pn = Gp >> 3, bj = (Gp >> 2) & 1, wc = Gp & 3, col0 = pn * 128 + wc * 32;
                p0_item(inp[bj ? nv::I_WU : nv::I_WG], DFF, col0, kb * 64, inp[nv::I_GFFN], B.WGU(), DM, Gp * 32, kb * 64, scr, lane); continue; } r -= I_GU;
            { const int Gp = r / 44, kb = r % 44, pn = Gp >> 3, bj = (Gp >> 2) & 1, wc = Gp & 3, col0 = pn * 256 + wc * 64 + bj * 32;
                p0_item(inp[nv::I_WD], DM, col0, kb * 64, nullptr, B.WD(), DFF, Gp * 32, kb * 64, scr, lane); }
        }
        if (wave < 4)
        for (int rx_ = 0; rx_ < REPX; ++rx_)
        for (int m0 = gw; m0 < M; m0 += 4 * NGW) {
            f32x4 v[4][4]; float ssq[4];
#pragma unroll
            for (int q = 0; q < 4; ++q) { const int m = m0 + q * NGW; if (m < M) { const GAS f32x4* xr = (const GAS f32x4*)(B.x + (size_t)m * DM) + 2 * lane;
#pragma unroll
                for (int j = 0; j < 2; ++j) { v[q][2 * j] = __builtin_nontemporal_load(xr + 128 * j); v[q][2 * j + 1] = __builtin_nontemporal_load(xr + 128 * j + 1); } } }
#pragma unroll
            for (int q = 0; q < 4; ++q) { float sq = 0.f;
#pragma unroll
                for (int j = 0; j < 4; ++j) sq += (v[q][j].x * v[q][j].x + v[q][j].y * v[q][j].y) + (v[q][j].z * v[q][j].z + v[q][j].w * v[q][j].w);
                ssq[q] = wave_sum(sq); }
#pragma unroll
            for (int q = 0; q < 4; ++q) { const int m = m0 + q * NGW; if (m < M) { if (lane == 0) pg8::stf(B.RX() + m, 1.0f / sqrtf(ssq[q] * (1.0f / DM) + EPS));
                GAS v4u* o16 = (GAS v4u*)(B.XB() + (size_t)m * DM) + lane;
#pragma unroll
                for (int j = 0; j < 2; ++j) { const pg8::u32x4 w = pg8::pack8(v[q][2 * j], v[q][2 * j + 1]); const v4u w4 = {w.x, w.y, w.z, w.w}; P0ST(o16 + 64 * j, w4); } } }
        }
        for (int i = vcu * NWAVES * 64 + tid; i < 2048 * 48; i += G * NWAVES * 64) rope_table_entry(i, B.COSA());
        if (bx == 0 && tid < 320) { const int t = tid; pg8::stf(B.gmq() + t, t < 64 ? inp[nv::I_GMQ][t] : t < 128 ? inp[nv::I_GMK][t - 64] : t < 224 ? inp[nv::I_GLQ][t - 128] : inp[nv::I_GLK][t - 224]); } }
        SEAM(0);
    }
    if (IN(1)) { for (int rep_ = 0; rep_ < REP1; ++rep_) {
#if P1_REPAIR
        pg8::ProgP1 P1; P1.init(B, pg8::GDesc{B.XB(), B.WIN(), DM, DM}, 2048, G, bx); pg8::gemm_stream(lds + RING_OFF, P1, wave); }
#else
        pg8::ProgOne<pg8::EpiInProj, DUPU1> P1; P1.init(B, pg8::GDesc{B.XB(), B.WIN(), DM, DM}, 2048, G, bx); pg8::gemm_stream(lds + RING_OFF, P1, wave); }
#endif
        SEAM(1);
    }
    if (IN(2)) { for (int rep_ = 0; rep_ < REP2; ++rep_) {
        if (!KSUM_EPI) { const int lane = LANE;
        for (int it = vcu; it < 256; it += G) { const int tile = it >> 1, c0 = (it & 1) * 256 + lane * 4; const bf16_t* kp = B.KA() + ((size_t)tile * 256 + wave * 32) * MW + c0; float a0 = 0.f, a1 = 0.f, a2 = 0.f, a3 = 0.f;
#pragma unroll 8
            for (int r = 0; r < 32; ++r) { const unsigned long long w = *(const GAS unsigned long long*)(kp + (size_t)r * MW); const unsigned lo = (unsigned)w, hi2 = (unsigned)(w >> 32);
                a0 += __uint_as_float(lo << 16); a1 += __uint_as_float(lo & 0xffff0000u); a2 += __uint_as_float(hi2 << 16); a3 += __uint_as_float(hi2 & 0xffff0000u); }
            LAS f32x4* red = (LAS f32x4*)(lds + RING_OFF); red[wave * 64 + lane] = (f32x4){a0, a1, a2, a3};
            LDS_WAIT(); __syncthreads();
            if (wave < 4) { const f32x4 s0 = red[(2 * wave) * 64 + lane], s1 = red[(2 * wave + 1) * 64 + lane]; *(GAS f32x4*)(B.KMEANP() + ((size_t)tile * 4 + wave) * MW + c0) = s0 + s1; }
            __syncthreads(); } }
#if QUP_FUSED
        pg8::ProgOne<pg8::EpiKvUp, 0> P2; P2.init(B, pg8::GDesc{B.CQKV() + 256, B.WKVUP(), 128, 384}, 1024, G, bx); pg8::gemm_stream(lds + RING_OFF, P2, wave); }
#else
        pg8::ProgP2 P2; P2.init(B, G, bx); pg8::gemm_stream(lds + RING_OFF, P2, wave); }
#endif
        SEAM(2);
    }
    if (IN(3)) { for (int rep_ = 0; rep_ < REP3; ++rep_) {
        if (!H1SS_LDS) { const int rpc = (M + G - 1) / G; for (int i = vcu * rpc + TID; i < (vcu + 1) * rpc && i < M; i += NWAVES * 64) pg8::stf(B.H1SS() + i, 0.f); }
#if ATT_PRIO
        if (wave >= 4) __builtin_amdgcn_s_setprio(1);
#endif
#ifndef MLA_NOMAX_ONLY
#define MLA_NOMAX_ONLY 0
#endif
#ifndef MLA_NOMAX
#define MLA_NOMAX 0
#endif
        bool mla_nomax = false;
        if (MLA_NOMAX) { const int lane = LANE; float gq = fabsf(B.glq()[lane]), gk = fabsf(B.glk()[lane]); if (lane < 32) { gq = fmaxf(gq, fabsf(B.glq()[64 + lane])); gk = fmaxf(gk, fabsf(B.glk()[64 + lane])); }
#pragma unroll
            for (int o_ = 1; o_ < 64; o_ <<= 1) { gq = fmaxf(gq, __shfl_xor(gq, o_)); gk = fmaxf(gk, __shfl_xor(gk, o_)); }
            mla_nomax = __builtin_amdgcn_readfirstlane((int)(96.0f * C2B * gq * gk < 48.0f)) != 0; }
#ifndef MOBA_NOMAX
#define MOBA_NOMAX 0
#endif
        bool moba_nomax = false;
        if (MOBA_NOMAX) { const int lane = LANE; float gq = fabsf(B.gmq()[lane]), gk = fabsf(B.gmk()[lane]);
#pragma unroll
            for (int o_ = 1; o_ < 64; o_ <<= 1) { gq = fmaxf(gq, __shfl_xor(gq, o_)); gk = fmaxf(gk, __shfl_xor(gk, o_)); }
            moba_nomax = __builtin_amdgcn_readfirstlane((int)(64.0f * C2A * gq * gk < 48.0f)) != 0; }
        const int nit = (G == 256) ? 4 : (1024 - vcu + G - 1) / G;
        for (int it = 0; it < nit; ++it) { int bh, ty, s;
            if (G == 256) { const int c = vcu >> 2; s = vcu & 3; bh = (2 * (c >> 3) + (it & 1)) * 8 + (c & 7); ty = (it >> 1) ^ (c & 1); }
            const int b = bh >> 3, h = bh & 7; const size_t rb = (size_t)b * SEQ;
#ifndef REPU0
#define REPU0 1
#endif
            for (int e = 0; e < 2; ++e) { const int n = e ? 7 - s : s;
              for (int ru_ = 0; ru_ < ((n == 0) ? REPU0 : 1); ++ru_) {
                if (ty) { if (mla_nomax) attl::attn_unit<8, true>(n, QUP_FUSED ? (CQ_FRAG ? B.CQF() + rb * 256 : B.CQKV() + rb * 384) : B.QM() + rb * 768 + h * 96, B.KM() + rb * 768 + h * 96, B.VM() + rb * MW + h * 64, B.AO() + rb * DM + 512 + h * 64, B, (char*)lds_raw + RING_OFF, wave, h, rb);
                          else attl::attn_unit<8, MLA_NOMAX_ONLY ? true : false>(n, QUP_FUSED ? (CQ_FRAG ? B.CQF() + rb * 256 : B.CQKV() + rb * 384) : B.QM() + rb * 768 + h * 96, B.KM() + rb * 768 + h * 96, B.VM() + rb * MW + h * 64, B.AO() + rb * DM + 512 + h * 64, B, (char*)lds_raw + RING_OFF, wave, h, rb); }
                else if (moba_nomax) attm::attn_unit<8, true>(n, b * 8, h, QA_FRAG ? B.QA() + ((size_t)h * M + rb) * 64 : B.QA() + rb * MW + h * 64, B.KA() + rb * MW + h * 64, B.VA() + rb * MW + h * 64, B.AO() + rb * DM + h * 64, B, (char*)lds_raw + RING_OFF, wave);
                else attm::attn_unit<8, false>(n, b * 8, h, QA_FRAG ? B.QA() + ((size_t)h * M + rb) * 64 : B.QA() + rb * MW + h * 64, B.KA() + rb * MW + h * 64, B.VA() + rb * MW + h * 64, B.AO() + rb * DM + h * 64, B, (char*)lds_raw + RING_OFF, wave); } } } }
#if ATT_PRIO
        __builtin_amdgcn_s_setprio(0);
#endif
        SEAM(3);
    }
    for (int repg_ = 0; repg_ < REPG; ++repg_) {
    if (repg_ > 0) xcd_barrier(bar, T0);
#ifndef P6_A_AUX
#define P6_A_AUX 0
#endif
#ifndef FFN_STREAM
#define FFN_STREAM 0
#endif
    if (FFN_STREAM && G == 256 && IN(4) && IN(5) && IN(6)) {
        pg8::ProgFFN PF; PF.init(B, G, bx, (unsigned*)(ctl + CW_DEP4), (unsigned*)(ctl + CW_DEP5), (unsigned*)(ctl + CW_BAR) + args.li * XCD_BAR_WORDS + XB_TMO); for (PF.seg = 0; PF.seg < 3; ++PF.seg) pg8::gemm_stream(lds + RING_OFF, PF, wave);
    } else {
#ifndef STAG4
#define STAG4 0
#endif
#ifndef STAG5
#define STAG5 0
#endif
#ifndef STAG6
#define STAG6 0
#endif
#ifndef STAG_NG
#define STAG_NG 4
#endif
#define STAGGER(T) do { if ((T) > 0) { const int j_ = (((bx >> 3) & 7) * STAG_NG) >> 3; if (j_ && T0) { const unsigned long long t0_ = wall_clock64(); while (wall_clock64() - t0_ < (unsigned long long)(j_ * (T))) __builtin_amdgcn_s_sleep(16); } __syncthreads(); } } while (0)
    if (IN(4)) { STAGGER(STAG4); for (int rep_ = 0; rep_ < REP4; ++rep_) {
        pg8::ProgOne<pg8::EpiOProj, 0> P4; P4.init(B, pg8::GDesc{B.AO(), B.WO(), DM, DM}, DM, G, bx); pg8::gemm_stream(lds + RING_OFF, P4, wave); }
        SEAM(4);
    }
    if (IN(5)) { STAGGER(STAG5); for (int rep_ = 0; rep_ < REP5; ++rep_) {
        pg8::ProgOne<pg8::EpiFfn1, DUPU5> P5; P5.init(B, pg8::GDesc{B.H1B(), B.WGU(), DM, DM}, 2 * DFF, G, bx); pg8::gemm_stream(lds + RING_OFF, P5, wave); }
        SEAM(5);
    }
    if (IN(6)) { STAGGER(STAG6);
        pg8::ProgOne<pg8::EpiFfn2, DUPU6> P6; P6.init(B, pg8::GDesc{B.ACT(), B.WD(), DFF, DFF}, DM, G, bx); pg8::gemm_stream<decltype(P6), P6_A_AUX>(lds + RING_OFF, P6, wave);
    }
    }
    }
#undef IN
#undef SEAM
}
#ifndef OPT_MASK
#define OPT_MASK 0x7e
#endif
static nv::Bufs make_bufs(void* const* d_in, void* d_out, void* d_ws) {
    nv::Bufs B{}; unsigned char* ws = (unsigned char*)d_ws;
    B.x = (const float*)d_in[0]; for (int i = 0; i < 16; ++i) B.in[i] = (const float*)d_in[i]; B.out = (float*)d_out;
    B.RX = (float*)(ws + WS_RX); B.CQSS = (float*)(ws + WS_CQSS); B.CKVSS = (float*)(ws + WS_CKVSS); B.KPESS = (float*)(ws + WS_KPESS); B.KR = (float*)(ws + WS_KR);
    B.KMEANP = (float*)(ws + WS_KMEANP); B.H1SS = (float*)(ws + WS_H1SS);
    float* tab = (float*)(ws + WS_TAB); B.COSA = tab; B.SINA = tab + 2048 * 32; B.COSB = tab + 2 * 2048 * 32; B.SINB = tab + 2 * 2048 * 32 + 2048 * 16;
    B.QA = (bf16_t*)(ws + WS_QA); B.KA = (bf16_t*)(ws + WS_KA); B.VA = (bf16_t*)(ws + WS_VA); B.CQKV = (bf16_t*)(ws + WS_CQKV); B.QM = (bf16_t*)(ws + WS_QM); B.KM = (bf16_t*)(ws + WS_KM);
    B.VM = (bf16_t*)(ws + WS_VM); B.AO = (bf16_t*)(ws + WS_AO); B.H1B = (bf16_t*)(ws + WS_H1B); B.ACT = (bf16_t*)(ws + WS_ACT);
    return B;
}
static void naive_stage(int p, const nv::Bufs& B, hipStream_t stream) {
    switch (p) {
    case 1: hipLaunchKernelGGL(nv::ngemm<nv::OpInProj>, dim3(31, M / 64), dim3(256), 0, stream, nv::OpInProj{B}); break;
    case 2: hipLaunchKernelGGL(nv::ngemm<nv::OpQUp>, dim3(12, M / 64), dim3(256), 0, stream, nv::OpQUp{B});
            hipLaunchKernelGGL(nv::ngemm<nv::OpKvUp>, dim3(16, M / 64), dim3(256), 0, stream, nv::OpKvUp{B}); break;
    case 3: hipLaunchKernelGGL(nv::n_attn_moba, dim3(M * NH / 256), dim3(256), 0, stream, B);
            hipLaunchKernelGGL(nv::n_attn_mla, dim3(M * NH / 256), dim3(256), 0, stream, B); break;
    case 4: hipLaunchKernelGGL(nv::ngemm<nv::OpOProj>, dim3(16, M / 64), dim3(256), 0, stream, nv::OpOProj{B}); break;
    case 5: hipLaunchKernelGGL(nv::ngemm<nv::OpFfn1>, dim3(44, M / 64), dim3(256), 0, stream, nv::OpFfn1{B}); break;
    case 6: hipLaunchKernelGGL(nv::ngemm<nv::OpFfn2>, dim3(16, M / 64), dim3(256), 0, stream, nv::OpFfn2{B}); break;
    }
}
extern "C" void kernel_launch(void* const* d_in, const int* in_sizes, int n_in, void* d_out, int out_size, void* d_ws, size_t ws_size, hipStream_t stream) {
    static int grid = 0;
    if (grid == 0) {
        if (n_in != 16 || in_sizes[0] != M * DM || out_size != M * DM || ws_size < WS_END) { fprintf(stderr, "kernel_launch: shape mismatch (n_in %d, in0 %d, out %d, ws %zu; need ws >= %zu)\n", n_in, n_in > 0 ? in_sizes[0] : -1, out_size, ws_size, (size_t)WS_END); grid = -1; return; }
        int dev = 0, cus = 0, per_cu = 0;
        if (hipGetDevice(&dev) != hipSuccess || hipDeviceGetAttribute(&cus, hipDeviceAttributeMultiprocessorCount, dev) != hipSuccess) { fprintf(stderr, "kernel_launch: device query failed\n"); grid = -1; return; }
        if (hipFuncSetAttribute((const void*)fwd_mega, hipFuncAttributeMaxDynamicSharedMemorySize, LDS_BYTES) != hipSuccess) { fprintf(stderr, "kernel_launch: hipFuncSetAttribute(%d B LDS) failed\n", LDS_BYTES); grid = -1; return; }
        if (hipOccupancyMaxActiveBlocksPerMultiprocessor(&per_cu, (const void*)fwd_mega, NWAVES * 64, LDS_BYTES) != hipSuccess || per_cu < 1) { fprintf(stderr, "kernel_launch: occupancy query says %d workgroups per CU; nothing launched\n", per_cu); (void)hipGetLastError(); grid = -1; return; }
        grid = cus;
    }
    if (grid < 0) return;
    if (hipMemsetAsync((char*)d_ws + WS_CTL, 0, CTL_ZERO_BYTES, stream) != hipSuccess) { fprintf(stderr, "kernel_launch: hipMemsetAsync failed\n"); return; }
    nv::Bufs B = make_bufs(d_in, d_out, d_ws);
    constexpr unsigned mask = (unsigned)(OPT_MASK) & 0x7eu; constexpr bool any_opt = mask != 0u, any_naive = mask != 0x7eu;
    if (any_naive) { hipLaunchKernelGGL(n_tables, dim3(384), dim3(256), 0, stream, (float*)((unsigned char*)d_ws + WS_TAB)); hipLaunchKernelGGL(nv::n_rowstat, dim3(M / 4), dim3(256), 0, stream, B.x, B.RX); }
#ifdef PROBE_DUP
    { const int cut[2][2] = {{0, PROBE_DUP + 1}, {PROBE_DUP2, 7}};
      for (int l = 0; l < 2; ++l) { Args a{}; for (int i = 0; i < 16; ++i) a.in[i] = (const float*)d_in[i]; a.out = (float*)d_out; a.ws = (unsigned char*)d_ws; a.ph_lo = cut[l][0]; a.ph_hi = cut[l][1]; a.li = l; a.pad = 0;
        hipLaunchKernelGGL(fwd_mega, dim3(grid), dim3(NWAVES * 64), LDS_BYTES, stream, a); }
      return; }
#endif
    int li = 0, p = any_opt ? 0 : 1;
    while (p <= 6) {
        const bool opt = (p == 0) || ((mask >> p) & 1u);
        if (opt) { int q = p; while (q + 1 <= 6 && ((mask >> (q + 1)) & 1u)) ++q;
            Args a{}; for (int i = 0; i < 16; ++i) a.in[i] = (const float*)d_in[i]; a.out = (float*)d_out; a.ws = (unsigned char*)d_ws; a.ph_lo = p; a.ph_hi = q + 1; a.li = li++; a.pad = 0;
            hipLaunchKernelGGL(fwd_mega, dim3(grid), dim3(NWAVES * 64), LDS_BYTES, stream, a);
            const hipError_t le = hipPeekAtLastError(); if (le != hipSuccess) { fprintf(stderr, "kernel_launch: launch failed: %s\n", hipGetErrorName(le)); return; }
            p = q + 1; }
        else { naive_stage(p, B, stream); ++p; }
    }
}
```
